# Optimizing an MI355X kernel written in HIP

```python
import math
import jax
import jax.numpy as jnp
from jax import lax
import numpy as np


D_MODEL = 1024
BATCH = 16
SEQ = 4096
DEPTH = 1

GRID_W = 64
CTX_LEN = 256
ATT_HEADS = D_MODEL // 256
ATT_QK_DIM = 64
ATT_V_DIM = 2 * ATT_QK_DIM
ATT_WIDTH = ATT_HEADS * ATT_V_DIM
ATT_QK_WIDTH = ATT_HEADS * 2 * ATT_QK_DIM
LRU_WIDTH = D_MODEL - ATT_WIDTH
LRU_BLOCKS = 8
LRU_BLOCK_DIM = LRU_WIDTH // LRU_BLOCKS
LRU_C = 8.0
CONV_W = 4
CONV_LEFT = CONV_W // 2
IN_WIDTH = 2 * ATT_QK_WIDTH + ATT_WIDTH + 2 * LRU_WIDTH
FFN_HIDDEN = int(math.ceil(8 * D_MODEL / 3 / 256)) * 256
N_MOD = 6
Q_BLOCK = 128
ROPE_BASE = 10000.0
ROPE_FREQS = ATT_QK_DIM // 4
ATT_SCALE = ATT_QK_DIM ** -0.5
DEEPNORM_ALPHA = (2 * DEPTH) ** 0.25
DEEPNORM_BETA = (8 * DEPTH) ** -0.25
LN_EPS = 1e-6
RMS_EPS = 1e-5

kernel_name = 'hybrid_diffattn_rglru_block'


def layer_norm(x, g=None, b=None):
    xf = x.astype(jnp.float32)
    mu = jnp.mean(xf, axis=-1, keepdims=True)
    var = jnp.mean(jnp.square(xf - mu), axis=-1, keepdims=True)
    y = (xf - mu) * lax.rsqrt(var + LN_EPS)
    if g is not None:
        y = y * g + b
    return y.astype(x.dtype)


def modulate(h, shift, scale):
    return h * (1 + scale) + shift


def axial_rope_tables(n_tokens):
    rows = n_tokens // GRID_W
    row = jnp.repeat(jnp.arange(rows, dtype=jnp.float32), GRID_W)
    col = jnp.tile(jnp.arange(GRID_W, dtype=jnp.float32), rows)
    inv_freq = ROPE_BASE ** (-jnp.arange(ROPE_FREQS, dtype=jnp.float32) / ROPE_FREQS)
    ang = jnp.stack([row[:, None] * inv_freq, col[:, None] * inv_freq], axis=1)
    return jnp.cos(ang), jnp.sin(ang)


def apply_rope(t, cos, sin):
    tr = t.astype(jnp.float32).reshape(t.shape[:-1] + (2, 2, ROPE_FREQS))
    t1, t2 = tr[..., 0, :], tr[..., 1, :]
    cs, sn = cos[:, None, None], sin[:, None, None]
    out = jnp.stack([t1 * cs - t2 * sn, t2 * cs + t1 * sn], axis=-2)
    return out.reshape(t.shape).astype(t.dtype)


def split_proj(p):
    B, S, _ = p.shape
    q, k, v, u, g = jnp.split(p, [ATT_QK_WIDTH, 2 * ATT_QK_WIDTH, 2 * ATT_QK_WIDTH + ATT_WIDTH,
                                  2 * ATT_QK_WIDTH + ATT_WIDTH + LRU_WIDTH], axis=-1)
    q = q.reshape(B, S, ATT_HEADS, 2, ATT_QK_DIM)
    k = k.reshape(B, S, ATT_HEADS, 2, ATT_QK_DIM)
    v = v.reshape(B, S, ATT_HEADS, ATT_V_DIM)
    return q, k, v, u, g


def diff_attention(q, k_all, v_all, lam):
    B, S, H = q.shape[:3]
    nb = S // Q_BLOCK
    qb = jnp.moveaxis(q.reshape(B, nb, Q_BLOCK, H, 2, ATT_QK_DIM), 1, 0)

    def one_block(q_blk):
        s = jnp.einsum('bqhmd,bkhmd->bmhqk', q_blk, k_all).astype(jnp.float32) * ATT_SCALE
        p = jax.nn.softmax(s, axis=-1)
        a = p[:, 0] - lam * p[:, 1]
        return jnp.einsum('bhqk,bkhd->bqhd', a.astype(v_all.dtype), v_all)

    o = lax.map(one_block, qb)
    return jnp.moveaxis(o, 0, 1).reshape(B, S, H, ATT_V_DIM)


def diff_head_norm(o, g, lam_init):
    B, S = o.shape[:2]
    of = o.astype(jnp.float32)
    y = of * lax.rsqrt(jnp.mean(jnp.square(of), axis=-1, keepdims=True) + RMS_EPS) * g * (1.0 - lam_init)
    return y.astype(o.dtype).reshape(B, S, ATT_WIDTH)


def centred_conv(u, w, b):
    S = u.shape[1]
    up = jnp.pad(u, ((0, 0), (CONV_LEFT, CONV_W - 1 - CONV_LEFT), (0, 0)))
    out = up[:, 0:S] * w[0]
    for j in range(1, CONV_W):
        out = out + up[:, j:j + S] * w[j]
    return out + b


def rglru_coeffs(u, w_gates, b_gates, lam):
    B, S, _ = u.shape
    ub = u.reshape(B, S, LRU_BLOCKS, LRU_BLOCK_DIM)
    z = jnp.einsum('bshi,ghij->gbshj', ub, w_gates) + b_gates[:, None, None]
    gates = jax.nn.sigmoid(z.astype(jnp.float32)).reshape(2, B, S, LRU_WIDTH)
    r, i = gates[0], gates[1]
    log_a = -LRU_C * r * jax.nn.softplus(-lam.astype(jnp.float32))
    a = jnp.exp(log_a)
    mult = jnp.sqrt(-jnp.expm1(2.0 * log_a))
    return a, mult * i * u.astype(jnp.float32)


def linear_scan(a, b, h0, reverse):
    def combine(e1, e2):
        a1, b1 = e1
        a2, b2 = e2
        return a1 * a2, a2 * b1 + b2
    a_cum, h = lax.associative_scan(combine, (a, b), axis=1, reverse=reverse)
    return h + a_cum * h0[:, None]


def mixing_sublayer(h, hc, cos, sin, w_in, lam_q, lam_k, lam_init, subln_g, conv_w, conv_b,
                    w_gates, b_gates, lru_lambda, w_out, ctx_out):
    q, k, v, u, g = split_proj(h @ w_in)
    qc, kc, vc, uc, gc = split_proj(hc @ w_in)
    q = apply_rope(q, cos, sin)
    k = apply_rope(k, cos, sin)
    k_all = jnp.concatenate([k, kc], axis=1)
    v_all = jnp.concatenate([v, vc], axis=1)
    lq = jnp.sum(lam_q.astype(jnp.float32) * lam_k.astype(jnp.float32), axis=-1)
    lam = jnp.exp(lq[0]) - jnp.exp(lq[1]) + lam_init
    o = diff_head_norm(diff_attention(q, k_all, v_all, lam), subln_g, lam_init)
    u_conv = centred_conv(u, conv_w, conv_b)
    uc_conv = centred_conv(uc, conv_w, conv_b)
    zero_state = jnp.zeros((uc.shape[0], LRU_WIDTH), jnp.float32)
    lat_dirs, ctx_dirs = [], []
    for d in range(2):
        rev = d == 1
        a_c, b_c = rglru_coeffs(uc_conv, w_gates[d], b_gates[d], lru_lambda[d])
        hs_c = linear_scan(a_c, b_c, zero_state, rev)
        state = hs_c[:, 0] if rev else hs_c[:, -1]
        a_l, b_l = rglru_coeffs(u_conv, w_gates[d], b_gates[d], lru_lambda[d])
        lat_dirs.append(linear_scan(a_l, b_l, state, rev))
        ctx_dirs.append(hs_c)
    y_lru = (lat_dirs[0] + lat_dirs[1]).astype(u.dtype) * jax.nn.gelu(g)
    y = jnp.concatenate([o, y_lru], axis=-1) @ w_out
    if not ctx_out:
        return y, None
    oc = diff_head_norm(diff_attention(qc, kc, vc, lam), subln_g, lam_init)
    yc_lru = (ctx_dirs[0] + ctx_dirs[1]).astype(uc.dtype) * jax.nn.gelu(gc)
    yc = jnp.concatenate([oc, yc_lru], axis=-1) @ w_out
    return y, yc


def swiglu(h, w1, w2):
    a, b = jnp.split(h @ w1, 2, axis=-1)
    return (jax.nn.silu(a) * b) @ w2


def setup_inputs(seed: int = 0) -> dict:
    key = jax.random.key(seed)
    ks = jax.random.split(key, 22)

    def nrm(k, shape, s):
        return jax.random.normal(k, shape, jnp.float32) * s

    u = jax.random.uniform(ks[14], (DEPTH, 2, LRU_WIDTH), jnp.float32, minval=0.9, maxval=0.999)
    a0 = u ** (1.0 / LRU_C)
    lru_lambda = jnp.log(a0) - jnp.log1p(-a0)
    return {
        'x': nrm(ks[0], (BATCH, SEQ, D_MODEL), 1.0),
        'c': nrm(ks[1], (BATCH, D_MODEL), 1.0),
        'ctx': nrm(ks[2], (BATCH, CTX_LEN, D_MODEL), 1.0),
        'c_ctx': nrm(ks[3], (D_MODEL,), 1.0),
        'w_ada': nrm(ks[4], (DEPTH, D_MODEL, N_MOD * D_MODEL), 0.5 * D_MODEL ** -0.5),
        'b_ada': nrm(ks[5], (DEPTH, N_MOD * D_MODEL), 0.02),
        'w_in': nrm(ks[6], (DEPTH, D_MODEL, IN_WIDTH), D_MODEL ** -0.5),
        'lam_q': nrm(ks[7], (DEPTH, 2, ATT_QK_DIM), 0.1),
        'lam_k': nrm(ks[8], (DEPTH, 2, ATT_QK_DIM), 0.1),
        'subln_g': 1.0 + nrm(ks[9], (DEPTH, ATT_V_DIM), 0.02),
        'conv_w': nrm(ks[10], (DEPTH, CONV_W, LRU_WIDTH), CONV_W ** -0.5),
        'conv_b': nrm(ks[11], (DEPTH, LRU_WIDTH), 0.02),
        'lru_w_gates': nrm(ks[12], (DEPTH, 2, 2, LRU_BLOCKS, LRU_BLOCK_DIM, LRU_BLOCK_DIM), LRU_BLOCK_DIM ** -0.5),
        'lru_b_gates': nrm(ks[13], (DEPTH, 2, 2, LRU_BLOCKS, LRU_BLOCK_DIM), 0.02),
        'lru_lambda': lru_lambda,
        'w_out': nrm(ks[15], (DEPTH, D_MODEL, D_MODEL), DEEPNORM_BETA * D_MODEL ** -0.5),
        'ln1_g': 1.0 + nrm(ks[16], (DEPTH, D_MODEL), 0.02),
        'ln1_b': nrm(ks[17], (DEPTH, D_MODEL), 0.02),
        'w_ffn_in': nrm(ks[18], (DEPTH, D_MODEL, 2 * FFN_HIDDEN), D_MODEL ** -0.5),
        'w_ffn_out': nrm(ks[19], (DEPTH, FFN_HIDDEN, D_MODEL), DEEPNORM_BETA * FFN_HIDDEN ** -0.5),
        'ln2_g': 1.0 + nrm(ks[20], (DEPTH, D_MODEL), 0.02),
        'ln2_b': nrm(ks[21], (DEPTH, D_MODEL), 0.02),
    }


def reference(x, c, ctx, c_ctx, w_ada, b_ada, w_in, lam_q, lam_k, subln_g, conv_w, conv_b,
              lru_w_gates, lru_b_gates, lru_lambda, w_out, ln1_g, ln1_b, w_ffn_in, w_ffn_out,
              ln2_g, ln2_b):
    S = x.shape[1]
    cos, sin = axial_rope_tables(S)
    xc = ctx
    for l in range(DEPTH):
        last = l == DEPTH - 1
        lam_init = 0.8 - 0.6 * math.exp(-0.3 * l)
        mod = jax.nn.silu(c) @ w_ada[l] + b_ada[l]
        mod_c = jax.nn.silu(c_ctx) @ w_ada[l] + b_ada[l]
        sh1, sc1, g1, sh2, sc2, g2 = jnp.split(mod[:, None, :], N_MOD, axis=-1)
        csh1, csc1, cg1, csh2, csc2, cg2 = jnp.split(mod_c, N_MOD, axis=-1)
        y, yc = mixing_sublayer(modulate(layer_norm(x), sh1, sc1), modulate(layer_norm(xc), csh1, csc1),
                                cos, sin, w_in[l], lam_q[l], lam_k[l], lam_init, subln_g[l],
                                conv_w[l], conv_b[l], lru_w_gates[l], lru_b_gates[l], lru_lambda[l],
                                w_out[l], not last)
        x = layer_norm(DEEPNORM_ALPHA * x + g1 * y, ln1_g[l], ln1_b[l])
        f = swiglu(modulate(layer_norm(x), sh2, sc2), w_ffn_in[l], w_ffn_out[l])
        x = layer_norm(DEEPNORM_ALPHA * x + g2 * f, ln2_g[l], ln2_b[l])
        if not last:
            xc = layer_norm(DEEPNORM_ALPHA * xc + cg1 * yc, ln1_g[l], ln1_b[l])
            fc = swiglu(modulate(layer_norm(xc), csh2, csc2), w_ffn_in[l], w_ffn_out[l])
            xc = layer_norm(DEEPNORM_ALPHA * xc + cg2 * fc, ln2_g[l], ln2_b[l])
    return x
```

```cpp
#include <hip/hip_runtime.h>
#include <hip/hip_bf16.h>
#include <cstdio>
#include <cstdint>
#include <cmath>
#define DBG 0
#define MK_N_LAUNCHES 10

namespace pg8 {
#define PG8_LAS __attribute__((address_space(3)))
typedef unsigned short bf16_t;
typedef short bf16x8 __attribute__((ext_vector_type(8)));
typedef float f32x4 __attribute__((ext_vector_type(4)));
typedef unsigned u32x4 __attribute__((ext_vector_type(4)));
constexpr int BM = 256, BK = 64, HALF = 128, HTB = HALF * BK * 2  , STAGE_BYTES = 8 * HTB, NXCD = 8, WGM = 8;

__host__ __device__ __forceinline__ int lds_byte(int r, int c) { const int st = (r >> 4) * 2 + (c >> 5), rr = r & 15, cc = c & 31, ob = rr * 64 + cc * 2; return st * 1024 + (ob ^ (((ob >> 9) & 1) << 5)); }
__host__ __device__ __forceinline__ void stage_rc(int b, int& R, int& C) { const int st = b / 1024, sb = b % 1024, swz = sb ^ (((sb >> 9) & 1) << 5); R = (st >> 1) * 16 + swz / 64; C = (st & 1) * 32 + (swz % 64) / 2; }
__host__ __device__ __forceinline__ int perm32(int rho) { const int n = rho >> 4, i = rho & 15; return 8 * (i >> 2) + 4 * n + (i & 3); }

struct Unit { int pm, pn; };
struct Gemm { const bf16_t* A; const bf16_t* Bt; int M, N, K; };

struct StaticOrder {
    int nM, nN, nwg, G, c;
    __host__ __device__ void init(int M, int N, int G_, int c_) { nM = M / BM; nN = N / BM; nwg = nM * nN; G = G_; c = c_; }
    __host__ __device__ bool next(int i, Unit& u) const {
        const long L = (long)i * G + c; if (L >= nwg) return false;
        int wgid = (int)L; { const int q = nwg / NXCD, r = nwg % NXCD, xcd = wgid % NXCD, off = wgid / NXCD; wgid = (xcd < r ? xcd * (q + 1) : r * (q + 1) + (xcd - r) * q) + off; }
        const int nig = WGM * nN, gid = wgid / nig, fm = gid * WGM, gsz = (nM - fm) < WGM ? (nM - fm) : WGM;
        u.pm = fm + ((wgid % nig) % gsz); u.pn = (wgid % nig) / gsz; return true;
    }
    __device__ __forceinline__ void a_ready(const Unit&) const {}
    __device__ __forceinline__ void done(const Unit&) const {}
};

__device__ __forceinline__ unsigned cvt_pk_bf16(float lo, float hi) { unsigned r; asm volatile("v_cvt_pk_bf16_f32 %0, %1, %2" : "=v"(r) : "v"(lo), "v"(hi)); return r; }
typedef float f32x2 __attribute__((ext_vector_type(2)));
__device__ __forceinline__ f32x2 gelu_pk(f32x2 v) {
    const f32x2 av = __builtin_elementwise_abs(v), d = av * 0.2316418882f + 1.0f;
    f32x2 t; t.x = __builtin_amdgcn_rcpf(d.x); t.y = __builtin_amdgcn_rcpf(d.y);
    f32x2 q = t * 0.5307027145f + (-0.7265760135f); q = q * t + 0.7107068705f; q = q * t + (-0.142248368f); q = q * t + 0.127414796f; q = q * t;
    const f32x2 s = (v * v) * (-0.72134752044f);
    f32x2 e; e.x = __builtin_amdgcn_exp2f(s.x); e.y = __builtin_amdgcn_exp2f(s.y);
    const f32x2 m = v * (q * e), r = v - m;
    f32x2 o; o.x = v.x < 0.f ? m.x : r.x; o.y = v.y < 0.f ? m.y : r.y; return o;
}

template <int ACT  > struct EpiBf16 {
    static constexpr bool PERM = true, AFTER_DRAIN = false; static_assert(ACT == 0 || ACT == 1, "EpiBf16: ACT is 0 (none) or 1 (gelu_pk)");
    bf16_t* O; int ldc; const float* bias; int split_cols; size_t split_stride; float scale0;
    __device__ __forceinline__ void operator()(const f32x4 (&acc)[2][2][4][2], const Unit& u, int wr, int wc, int fr, int fq) const {
        const int row0 = u.pm * BM + wr * 64 + fr; int colt = u.pn * BM; bf16_t* base = O;
        float sc = 1.f; if (split_cols) { const int t = colt / split_cols; base += (size_t)t * split_stride; colt -= t * split_cols; if (t == 0) sc = scale0; }
        const int col0 = colt + wc * 32 + 8 * fq, bcol0 = u.pn * BM + wc * 32 + 8 * fq;
        f32x4 bv[2][2];
#pragma unroll
        for (int bj = 0; bj < 2; ++bj)
#pragma unroll
            for (int n = 0; n < 2; ++n) bv[bj][n] = bias ? *(const f32x4*)(bias + bcol0 + bj * HALF + 4 * n) : (f32x4){0.f, 0.f, 0.f, 0.f};
#pragma unroll
        for (int ai = 0; ai < 2; ++ai)
#pragma unroll
            for (int m = 0; m < 4; ++m) { bf16_t* rowp = base + (size_t)(row0 + ai * HALF + m * 16) * ldc + col0;
#pragma unroll
                for (int bj = 0; bj < 2; ++bj) { f32x4 v0 = acc[ai][bj][m][0] + bv[bj][0], v1 = acc[ai][bj][m][1] + bv[bj][1];
                    if (ACT == 1) { f32x2 a = gelu_pk((f32x2){v0[0], v0[1]}), b = gelu_pk((f32x2){v0[2], v0[3]}), c = gelu_pk((f32x2){v1[0], v1[1]}), d = gelu_pk((f32x2){v1[2], v1[3]});
                        v0 = (f32x4){a.x, a.y, b.x, b.y}; v1 = (f32x4){c.x, c.y, d.x, d.y}; }
                    v0 = v0 * sc; v1 = v1 * sc; u32x4 w; w.x = cvt_pk_bf16(v0[0], v0[1]); w.y = cvt_pk_bf16(v0[2], v0[3]); w.z = cvt_pk_bf16(v1[0], v1[1]); w.w = cvt_pk_bf16(v1[2], v1[3]);
                    *(u32x4*)(rowp + bj * HALF) = w; } }
    }
};

struct PanelStats {
    unsigned* xbuf;
    unsigned* cnt;
    unsigned* tmo;
    int ntn; float eps;
    unsigned code;
    __device__ __forceinline__ bool run(const f32x4 (&v)[2][2][4][2], const Unit& u, int wr, int wc, int fr, int fq, PG8_LAS unsigned char* lds, int wid, int lane) const {
        typedef float f32x2v __attribute__((ext_vector_type(2)));
        PG8_LAS f32x2v* P = (PG8_LAS f32x2v*)lds;
        PG8_LAS f32x2v* S = (PG8_LAS f32x2v*)(lds + 8192);
        PG8_LAS unsigned* flag = (PG8_LAS unsigned*)(lds + 8192 + 2048);
#pragma unroll
        for (int ai = 0; ai < 2; ++ai)
#pragma unroll
            for (int m = 0; m < 4; ++m) {
                float s = 0.f;
#pragma unroll
                for (int bj = 0; bj < 2; ++bj)
#pragma unroll
                    for (int n = 0; n < 2; ++n) { const f32x4 x = v[ai][bj][m][n]; s += (x[0] + x[1]) + (x[2] + x[3]); }
                s += __shfl_xor(s, 16); s += __shfl_xor(s, 32);
                const float mw = s * (1.0f / 64.0f); float q = 0.f;
#pragma unroll
                for (int bj = 0; bj < 2; ++bj)
#pragma unroll
                    for (int n = 0; n < 2; ++n) { const f32x4 d = v[ai][bj][m][n] - mw; q += (d[0] * d[0] + d[1] * d[1]) + (d[2] * d[2] + d[3] * d[3]); }
                q += __shfl_xor(q, 16); q += __shfl_xor(q, 32);
                if (fq == 0) P[(ai * HALF + wr * 64 + m * 16 + fr) * 4 + wc] = (f32x2v){mw, q};
            }
        asm volatile("s_waitcnt lgkmcnt(0)" ::: "memory"); __builtin_amdgcn_s_barrier(); asm volatile("" ::: "memory");
#if defined(BROKEN_EXCHANGE_NO_WAIT)
#warning BROKEN CONTROL BUILD: the row-statistics exchange does not wait; results are wrong by design
        if (blockIdx.x >= 64) { const long long t0_ = clock64(); while (clock64() - t0_ < 60000) __builtin_amdgcn_s_sleep(8); }
#endif
        const int row = wid * 32 + (lane & 31);
        if (lane < 32) {
            const f32x2v a = P[row * 4 + 0], b = P[row * 4 + 1], c = P[row * 4 + 2], d = P[row * 4 + 3];
            const float mt = (a.x + b.x + c.x + d.x) * 0.25f;
            const float da = a.x - mt, db = b.x - mt, dc = c.x - mt, dd = d.x - mt;
            const float m2 = (a.y + b.y) + (c.y + d.y) + 64.0f * ((da * da + db * db) + (dc * dc + dd * dd));
            unsigned long long* slot = (unsigned long long*)xbuf + ((size_t)(u.pm * BM + row) * 4 + u.pn);
            __hip_atomic_store(slot, ((unsigned long long)__float_as_uint(m2) << 32) | __float_as_uint(mt), __ATOMIC_RELAXED, __HIP_MEMORY_SCOPE_AGENT);
        }
        asm volatile("s_waitcnt vmcnt(0)" ::: "memory");
        if (lane == 0) __hip_atomic_fetch_add(cnt + 64 * u.pm, 1u, __ATOMIC_RELAXED, __HIP_MEMORY_SCOPE_AGENT);
        if (wid == 0) {
            bool dead = false; const unsigned long long t0 = __builtin_amdgcn_s_memrealtime(); const unsigned want = 8u * (unsigned)ntn;
            for (;;) {
#if defined(BROKEN_EXCHANGE_NO_WAIT)
                break;
#endif
                if ((unsigned)__builtin_amdgcn_readfirstlane(__hip_atomic_load(cnt + 64 * u.pm, __ATOMIC_RELAXED, __HIP_MEMORY_SCOPE_AGENT)) >= want) break;
                if (__builtin_amdgcn_s_memrealtime() - t0 > 2000000ull) {
                    if (lane == 0) { unsigned expect = 0u; __hip_atomic_compare_exchange_strong(tmo + 1, &expect, code | (unsigned)(u.pm & 0xff), __ATOMIC_RELAXED, __ATOMIC_RELAXED, __HIP_MEMORY_SCOPE_AGENT);
                                     __hip_atomic_store(tmo, 1u, __ATOMIC_RELAXED, __HIP_MEMORY_SCOPE_AGENT); }
                    dead = true; break; }
                __builtin_amdgcn_s_sleep(2);
            }
            __builtin_amdgcn_fence(__ATOMIC_ACQUIRE, "agent");
            if (lane == 0) flag[0] = dead ? 1u : 0u;
        }
        asm volatile("s_waitcnt vmcnt(0) lgkmcnt(0)" ::: "memory"); __builtin_amdgcn_s_barrier(); asm volatile("" ::: "memory");
        const bool bad = flag[0] != 0u;
        if (lane < 32) {
            const unsigned long long* slot = (const unsigned long long*)xbuf + (size_t)(u.pm * BM + row) * 4; float mt[4], m2[4]; float ms = 0.f;
#pragma unroll
            for (int t = 0; t < 4; ++t) { if (t < ntn) { const unsigned long long w = __hip_atomic_load(slot + t, __ATOMIC_RELAXED, __HIP_MEMORY_SCOPE_AGENT); mt[t] = __uint_as_float((unsigned)w); m2[t] = __uint_as_float((unsigned)(w >> 32)); } else { mt[t] = 0.f; m2[t] = 0.f; } ms += mt[t]; }
            const float mean = ms / (float)ntn; float q = 0.f;
#pragma unroll
            for (int t = 0; t < 4; ++t) if (t < ntn) { const float dm = mt[t] - mean; q += m2[t] + 256.0f * dm * dm; }
            S[row] = (f32x2v){mean, 1.0f / sqrtf(q / (256.0f * (float)ntn) + eps)};
        }
        asm volatile("s_waitcnt lgkmcnt(0)" ::: "memory"); __builtin_amdgcn_s_barrier(); asm volatile("" ::: "memory");
        return bad;
    }
};
struct EpiLnRes {
    static constexpr bool PERM = false, AFTER_DRAIN = true;
    const float* base; float* out; int ldc; const float* bias; PanelStats st; unsigned poison;
    __device__ __forceinline__ void fused(f32x4 (&acc)[2][2][4][2], const Unit& u, int wr, int wc, int fr, int fq, PG8_LAS unsigned char* lds, int wid, int lane) const {
        typedef float f32x2v __attribute__((ext_vector_type(2)));
        const PG8_LAS f32x2v* S = (const PG8_LAS f32x2v*)(lds + 8192);
        const int col0 = u.pn * BM + wc * 32 + 4 * fq;
#pragma unroll
        for (int bj = 0; bj < 2; ++bj)
#pragma unroll
            for (int n = 0; n < 2; ++n) { const f32x4 bv = bias ? *(const f32x4*)(bias + col0 + bj * HALF + n * 16) : (f32x4){0.f, 0.f, 0.f, 0.f};
#pragma unroll
                for (int ai = 0; ai < 2; ++ai)
#pragma unroll
                    for (int m = 0; m < 4; ++m) acc[ai][bj][m][n] += bv; }
        f32x4 pre[4][2][2];
#pragma unroll
        for (int m = 0; m < 4; ++m) { const size_t off = (size_t)(u.pm * BM + wr * 64 + m * 16 + fr) * ldc + col0;
#pragma unroll
            for (int bj = 0; bj < 2; ++bj)
#pragma unroll
                for (int n = 0; n < 2; ++n) pre[m][bj][n] = *(const f32x4*)(base + off + bj * HALF + n * 16); }
        const bool bad = st.run(acc, u, wr, wc, fr, fq, lds, wid, lane) || poison != 0u;
        const float qnan = __builtin_nanf("");
#pragma unroll
        for (int ai = 0; ai < 2; ++ai)
#pragma unroll
            for (int m = 0; m < 4; ++m) { const int r = ai * HALF + wr * 64 + m * 16 + fr; const f32x2v sr = S[r]; const size_t off = (size_t)(u.pm * BM + r) * ldc + col0;
#pragma unroll
                for (int bj = 0; bj < 2; ++bj)
#pragma unroll
                    for (int n = 0; n < 2; ++n) { const f32x4 bs = ai == 0 ? pre[m][bj][n] : *(const f32x4*)(base + off + bj * HALF + n * 16); f32x4 o = bs + (acc[ai][bj][m][n] - sr.x) * sr.y;
                        if (bad) o = (f32x4){qnan, qnan, qnan, qnan}; *(f32x4*)(out + off + bj * HALF + n * 16) = o; }
                if (m & 1) asm volatile("" ::: "memory"); }
    }
};
struct EpiLnResLn {
    static constexpr bool PERM = false, AFTER_DRAIN = true;
    const float* base; float* out; bf16_t* xn; int ldc; const float* bias; PanelStats st1, st2; unsigned poison;
    __device__ __forceinline__ void fused(f32x4 (&acc)[2][2][4][2], const Unit& u, int wr, int wc, int fr, int fq, PG8_LAS unsigned char* lds, int wid, int lane) const {
        typedef float f32x2v __attribute__((ext_vector_type(2))); typedef unsigned u32x2v __attribute__((ext_vector_type(2)));
        const PG8_LAS f32x2v* S = (const PG8_LAS f32x2v*)(lds + 8192);
        const int col0 = u.pn * BM + wc * 32 + 4 * fq;
#pragma unroll
        for (int bj = 0; bj < 2; ++bj)
#pragma unroll
            for (int n = 0; n < 2; ++n) { const f32x4 bv = bias ? *(const f32x4*)(bias + col0 + bj * HALF + n * 16) : (f32x4){0.f, 0.f, 0.f, 0.f};
#pragma unroll
                for (int ai = 0; ai < 2; ++ai)
#pragma unroll
                    for (int m = 0; m < 4; ++m) acc[ai][bj][m][n] += bv; }
        bool bad = st1.run(acc, u, wr, wc, fr, fq, lds, wid, lane) || poison != 0u;
        const float qnan = __builtin_nanf("");
#pragma unroll
        for (int ai = 0; ai < 2; ++ai)
#pragma unroll
            for (int m = 0; m < 4; ++m) { const int r = ai * HALF + wr * 64 + m * 16 + fr; const f32x2v sr = S[r]; const size_t off = (size_t)(u.pm * BM + r) * ldc + col0;
#pragma unroll
                for (int bj = 0; bj < 2; ++bj)
#pragma unroll
                    for (int n = 0; n < 2; ++n) { const f32x4 bs = *(const f32x4*)(base + off + bj * HALF + n * 16); acc[ai][bj][m][n] = bs + (acc[ai][bj][m][n] - sr.x) * sr.y; }
                asm volatile("" : "+v"(acc[ai][0][m][0]), "+v"(acc[ai][0][m][1]), "+v"(acc[ai][1][m][0]), "+v"(acc[ai][1][m][1]));
                if (m & 1) asm volatile("" ::: "memory"); }
        const bool bad1 = bad;
        bad = st2.run(acc, u, wr, wc, fr, fq, lds, wid, lane) || bad;
#pragma unroll
        for (int ai = 0; ai < 2; ++ai)
#pragma unroll
            for (int m = 0; m < 4; ++m) { const int r = ai * HALF + wr * 64 + m * 16 + fr; const f32x2v sr = S[r]; const size_t off = (size_t)(u.pm * BM + r) * ldc + col0;
#pragma unroll
                for (int bj = 0; bj < 2; ++bj)
#pragma unroll
                    for (int n = 0; n < 2; ++n) { const f32x4 x1 = acc[ai][bj][m][n]; *(f32x4*)(out + off + bj * HALF + n * 16) = bad1 ? (f32x4){qnan, qnan, qnan, qnan} : x1;
                        const f32x4 o = (x1 - sr.x) * sr.y; u32x2v w; w.x = cvt_pk_bf16(o[0], o[1]); w.y = cvt_pk_bf16(o[2], o[3]);
                        if (bad) { w.x = 0x7fc07fc0u; w.y = 0x7fc07fc0u; } *(u32x2v*)(xn + off + bj * HALF + n * 16) = w; }
                asm volatile("" ::: "memory"); }
    }
};

template <class Epi, class Sched, bool ALIGN_EPI = false, bool SP2 = false>
__device__ __forceinline__ void gemm_phase(PG8_LAS unsigned char* lds, const Gemm g, const Sched& S, const Epi& E) {
    const int tid = threadIdx.x, wid = __builtin_amdgcn_readfirstlane(tid >> 6), lane = tid & 63, wr = wid >> 2, wc = wid & 3, fr = lane & 15, fq = lane >> 4;
    const int K = g.K, nt = K / BK;
    unsigned voffA[2], voffB[2];
#pragma unroll
    for (int i = 0; i < 2; ++i) { int R, C; stage_rc(tid * 16 + i * 8192, R, C); const int Rb = Epi::PERM ? ((R & ~31) + perm32(R & 31)) : R;
        voffA[i] = (unsigned)(R * K + C) * 2u; voffB[i] = (unsigned)(Rb * K + C) * 2u; }
    const size_t kstep = (size_t)(BK * 2);
    const size_t hstep = (size_t)HALF * K * 2;
    const size_t tstep = 2 * hstep;
    const unsigned ldsw = (unsigned)wid * 1024u;
    const int aoff = lds_byte(wr * 64 + fr, fq * 8), boff = lds_byte(wc * 32 + fr, fq * 8);
#define PG8_SA(b, h) (((b) * 2 + (h)) * HTB)
#define PG8_SB(b, h) ((4 + (b) * 2 + (h)) * HTB)
#define PG8_STAGE(bufoff, gbase, voff) do { _Pragma("unroll") for (int _i = 0; _i < 2; ++_i) \
        __builtin_amdgcn_global_load_lds((const unsigned*)((const char*)(gbase) + (voff)[_i]), (PG8_LAS unsigned*)(lds + (bufoff) + ldsw + _i * 8192), 16, 0, 0); } while (0)
#define PG8_LDA(dst, b, h) do { _Pragma("unroll") for (int m = 0; m < 4; ++m) _Pragma("unroll") for (int k = 0; k < 2; ++k) dst[m][k] = *(const PG8_LAS bf16x8*)(lds + PG8_SA(b, h) + aoff + m * 2048 + k * 1024); } while (0)
#define PG8_LDB(dst, b, h) do { _Pragma("unroll") for (int n = 0; n < 2; ++n) _Pragma("unroll") for (int k = 0; k < 2; ++k) dst[n][k] = *(const PG8_LAS bf16x8*)(lds + PG8_SB(b, h) + boff + n * 2048 + k * 1024); } while (0)
#define PG8_MMA(ai, bj, At, Bt) do { __builtin_amdgcn_s_setprio(1); _Pragma("unroll") for (int m = 0; m < 4; ++m) _Pragma("unroll") for (int n = 0; n < 2; ++n) _Pragma("unroll") for (int k = 0; k < 2; ++k) \
        acc[ai][bj][m][n] = __builtin_amdgcn_mfma_f32_16x16x32_bf16(Bt[n][k], At[m][k], acc[ai][bj][m][n], 0, 0, 0); __builtin_amdgcn_s_setprio(0); } while (0)
#define PG8_WAIT_V(n) asm volatile("s_waitcnt vmcnt(" #n ")" ::: "memory")
#define PG8_WAIT_L(n) asm volatile("s_waitcnt lgkmcnt(" #n ")" ::: "memory")
#define PG8_BAR __builtin_amdgcn_s_barrier()
#define PG8_SCHED __builtin_amdgcn_sched_barrier(0)
    Unit cur, nxt; int ui = 0;
    if (!S.next(0, cur)) return;
    f32x4 acc[2][2][4][2];
#pragma unroll
    for (int a = 0; a < 2; ++a)
#pragma unroll
        for (int b = 0; b < 2; ++b)
#pragma unroll
            for (int m = 0; m < 4; ++m)
#pragma unroll
                for (int n = 0; n < 2; ++n) acc[a][b][m][n] = (f32x4){0.f, 0.f, 0.f, 0.f};
    bf16x8 At[4][2], B0[2][2], B1[2][2];
    const char* cA = (const char*)g.A + (size_t)cur.pm * tstep; const char* cB = (const char*)g.Bt + (size_t)cur.pn * tstep;
    S.a_ready(cur);
    if constexpr (SP2) {
        PG8_STAGE(PG8_SB(0, 0), cB, voffB); PG8_STAGE(PG8_SB(0, 1), cB + hstep, voffB); PG8_STAGE(PG8_SA(0, 0), cA, voffA); PG8_STAGE(PG8_SA(0, 1), cA + hstep, voffA);
        if (wr == 1) PG8_BAR;
        PG8_WAIT_V(2); PG8_BAR;
        PG8_STAGE(PG8_SB(1, 0), cB + kstep, voffB); PG8_STAGE(PG8_SA(1, 0), cA + kstep, voffA); PG8_STAGE(PG8_SB(1, 1), cB + hstep + kstep, voffB);
        PG8_WAIT_V(6); PG8_BAR;
    } else {
        PG8_STAGE(PG8_SB(0, 0), cB, voffB); PG8_STAGE(PG8_SA(0, 0), cA, voffA); PG8_STAGE(PG8_SB(0, 1), cB + hstep, voffB); PG8_STAGE(PG8_SA(0, 1), cA + hstep, voffA);
        if (wr == 1) PG8_BAR;
        PG8_WAIT_V(4); PG8_BAR;
        PG8_STAGE(PG8_SB(1, 0), cB + kstep, voffB); PG8_STAGE(PG8_SA(1, 0), cA + kstep, voffA); PG8_STAGE(PG8_SB(1, 1), cB + hstep + kstep, voffB);
        PG8_WAIT_V(6); PG8_BAR;
    }
    for (;;) {
        const bool has_next = S.next(ui + 1, nxt);
        const char* nA = has_next ? (const char*)g.A + (size_t)nxt.pm * tstep : cA; const char* nB = has_next ? (const char*)g.Bt + (size_t)nxt.pn * tstep : cB;
        for (int t = 0; t < nt; t += 2) {
            const bool last = (t == nt - 2);
            const char* a1 = cA + (size_t)(t + 1) * kstep;
            const char* a2 = last ? nA : cA + (size_t)(t + 2) * kstep; const char* b2 = last ? nB : cB + (size_t)(t + 2) * kstep;
            const char* a3 = a2 + kstep; const char* b3 = b2 + kstep;
            if (last && has_next) S.a_ready(nxt);
            if constexpr (SP2) {
            PG8_LDB(B0, 0, 0); PG8_LDB(B1, 0, 1); PG8_SCHED; PG8_LDA(At, 0, 0); PG8_STAGE(PG8_SA(1, 1), a1 + hstep, voffA);
            PG8_WAIT_V(8); PG8_WAIT_L(0); PG8_BAR; PG8_MMA(0, 0, At, B0); PG8_MMA(0, 1, At, B1); PG8_BAR; PG8_SCHED;
            PG8_LDA(At, 0, 1); PG8_STAGE(PG8_SB(0, 0), b2, voffB); PG8_STAGE(PG8_SB(0, 1), b2 + hstep, voffB); PG8_STAGE(PG8_SA(0, 0), a2, voffA);
            PG8_WAIT_V(8); PG8_WAIT_L(0); PG8_BAR; PG8_MMA(1, 0, At, B0); PG8_MMA(1, 1, At, B1); PG8_BAR; PG8_SCHED;
            PG8_LDB(B0, 1, 0); PG8_LDB(B1, 1, 1); PG8_SCHED; PG8_LDA(At, 1, 0); PG8_STAGE(PG8_SA(0, 1), a2 + hstep, voffA);
            PG8_WAIT_V(8); PG8_WAIT_L(0); PG8_BAR; PG8_MMA(0, 0, At, B0); PG8_MMA(0, 1, At, B1); PG8_BAR; PG8_SCHED;
            PG8_LDA(At, 1, 1); PG8_STAGE(PG8_SB(1, 0), b3, voffB); PG8_STAGE(PG8_SB(1, 1), b3 + hstep, voffB); PG8_STAGE(PG8_SA(1, 0), a3, voffA);
            PG8_WAIT_V(8); PG8_WAIT_L(0); PG8_BAR; PG8_MMA(1, 0, At, B0); PG8_MMA(1, 1, At, B1); PG8_BAR; PG8_SCHED;
            } else {
            PG8_LDB(B0, 0, 0); PG8_SCHED; PG8_LDA(At, 0, 0); PG8_STAGE(PG8_SA(1, 1), a1 + hstep, voffA);
            PG8_WAIT_L(8); PG8_BAR; PG8_WAIT_L(0); PG8_MMA(0, 0, At, B0); PG8_BAR; PG8_SCHED;
            PG8_LDB(B1, 0, 1); PG8_STAGE(PG8_SB(0, 0), b2, voffB);
            PG8_BAR; PG8_WAIT_L(0); PG8_MMA(0, 1, At, B1); PG8_BAR;
            PG8_LDA(At, 0, 1); PG8_STAGE(PG8_SA(0, 0), a2, voffA);
            PG8_BAR; PG8_WAIT_L(0); PG8_MMA(1, 0, At, B0); PG8_BAR; PG8_SCHED;
            PG8_STAGE(PG8_SB(0, 1), b2 + hstep, voffB);
            PG8_WAIT_V(6); PG8_BAR; PG8_MMA(1, 1, At, B1); PG8_BAR;
            PG8_LDB(B0, 1, 0); PG8_SCHED; PG8_LDA(At, 1, 0); PG8_STAGE(PG8_SA(0, 1), a2 + hstep, voffA);
            PG8_WAIT_L(8); PG8_BAR; PG8_WAIT_L(0); PG8_MMA(0, 0, At, B0); PG8_BAR; PG8_SCHED;
            PG8_LDB(B1, 1, 1); PG8_STAGE(PG8_SB(1, 0), b3, voffB);
            PG8_BAR; PG8_WAIT_L(0); PG8_MMA(0, 1, At, B1); PG8_BAR;
            PG8_LDA(At, 1, 1); PG8_STAGE(PG8_SA(1, 0), a3, voffA);
            PG8_BAR; PG8_WAIT_L(0); PG8_MMA(1, 0, At, B0); PG8_BAR; PG8_SCHED;
            PG8_STAGE(PG8_SB(1, 1), b3 + hstep, voffB);
            PG8_WAIT_V(6); PG8_BAR; PG8_MMA(1, 1, At, B1); PG8_BAR;
            }
        }
        if constexpr (ALIGN_EPI) { if (wr == 0) PG8_BAR; }
        if constexpr (!Epi::AFTER_DRAIN) { E(acc, cur, wr, wc, fr, fq); S.done(cur); }
        if (!has_next) break;
#pragma unroll
        for (int a = 0; a < 2; ++a)
#pragma unroll
            for (int b = 0; b < 2; ++b)
#pragma unroll
                for (int m = 0; m < 4; ++m)
#pragma unroll
                    for (int n = 0; n < 2; ++n) acc[a][b][m][n] = (f32x4){0.f, 0.f, 0.f, 0.f};
        cur = nxt; cA = nA; cB = nB; ++ui;
        if constexpr (ALIGN_EPI) { if (wr == 1) PG8_BAR; }
    }
    PG8_WAIT_V(0);
    if constexpr (!ALIGN_EPI) { if (wr == 0) PG8_BAR; }
    PG8_BAR;
    if constexpr (Epi::AFTER_DRAIN) { E.fused(acc, cur, wr, wc, fr, fq, lds, wid, lane); S.done(cur); }
#undef PG8_SA
#undef PG8_SB
#undef PG8_STAGE
#undef PG8_LDA
#undef PG8_LDB
#undef PG8_MMA
#undef PG8_WAIT_V
#undef PG8_WAIT_L
#undef PG8_BAR
#undef PG8_SCHED
}
}

namespace pg8 {
constexpr float QK_C2 = 0.125f * 1.4426950408889634f;
struct EpiInProj {
    static constexpr bool PERM = true, AFTER_DRAIN = false;
    bf16_t *Q, *Kb, *Vb, *Ub, *Gb; const float* ropec; const float* ropes; int ctx;
    __device__ __forceinline__ void operator()(const f32x4 (&acc)[2][2][4][2], const Unit& u, int wr, int wc, int fr, int fq) const {
        const int colt = u.pn * BM + (ctx ? 512 : 0), seg = colt >> 9;
        const int cs0 = (colt & 511) + wc * 32 + 8 * fq;
        const bool rope = (seg < 2) && !ctx; const int a = wc & 1;
#pragma unroll
        for (int ai = 0; ai < 2; ++ai)
#pragma unroll
            for (int m = 0; m < 4; ++m) {
                const int r = u.pm * BM + ai * HALF + wr * 64 + m * 16 + fr;
                int bidx, s; size_t rowkv, rowu;
                if (ctx) { bidx = r >> 8; s = r & 255; rowkv = (size_t)bidx * 4352 + 4096 + s; rowu = (size_t)65536 + r; }
                else { bidx = r >> 12; s = r & 4095; rowkv = (size_t)bidx * 4352 + s; rowu = (size_t)r; }
                f32x4 cs = (f32x4){1.f, 1.f, 1.f, 1.f}, sn = (f32x4){0.f, 0.f, 0.f, 0.f};
                if (rope) { const int pos = a ? (s & 63) : (s >> 6); cs = *(const f32x4*)(ropec + pos * 16 + 4 * fq); sn = *(const f32x4*)(ropes + pos * 16 + 4 * fq); }
                bf16_t* dst;
                if (seg == 0) dst = Q + rowu * 512; else if (seg == 1) dst = Kb + rowkv * 512; else if (seg == 2) dst = Vb + rowkv * 512; else if (seg == 3) dst = Ub + rowu * 512; else dst = Gb + rowu * 512;
#pragma unroll
                for (int bj = 0; bj < 2; ++bj) {
                    f32x4 v0 = acc[ai][bj][m][0], v1 = acc[ai][bj][m][1];
                    if (rope) { const f32x4 o1 = v0 * cs - v1 * sn, o2 = v1 * cs + v0 * sn; v0 = o1; v1 = o2; }
                    if (seg == 0) { v0 = v0 * QK_C2; v1 = v1 * QK_C2; }
                    u32x4 w; w.x = cvt_pk_bf16(v0[0], v0[1]); w.y = cvt_pk_bf16(v0[2], v0[3]); w.z = cvt_pk_bf16(v1[0], v1[1]); w.w = cvt_pk_bf16(v1[2], v1[3]);
                    *(u32x4*)(dst + cs0 + bj * HALF) = w;
                }
            }
    }
};
struct EpiSwiglu {
    static constexpr bool PERM = true, AFTER_DRAIN = false;
    bf16_t* H; int ldh;
    __device__ __forceinline__ void operator()(const f32x4 (&acc)[2][2][4][2], const Unit& u, int wr, int wc, int fr, int fq) const {
        const int col0 = u.pn * HALF + wc * 32 + 8 * fq;
#pragma unroll
        for (int ai = 0; ai < 2; ++ai)
#pragma unroll
            for (int m = 0; m < 4; ++m) {
                const size_t r = (size_t)u.pm * BM + ai * HALF + wr * 64 + m * 16 + fr;
                float o[8];
#pragma unroll
                for (int n = 0; n < 2; ++n)
#pragma unroll
                    for (int j = 0; j < 4; ++j) { const float av = acc[ai][0][m][n][j], bv = acc[ai][1][m][n][j];
                        const float sg = __builtin_amdgcn_rcpf(1.f + __builtin_amdgcn_exp2f(-av * 1.4426950408889634f)); o[4 * n + j] = av * sg * bv; }
                u32x4 w; w.x = cvt_pk_bf16(o[0], o[1]); w.y = cvt_pk_bf16(o[2], o[3]); w.z = cvt_pk_bf16(o[4], o[5]); w.w = cvt_pk_bf16(o[6], o[7]);
                *(u32x4*)(H + r * ldh + col0) = w;
            }
    }
};
struct EpiPlain {
    static constexpr bool PERM = true, AFTER_DRAIN = false;
    bf16_t* O; int ldc;
    __device__ __forceinline__ void operator()(const f32x4 (&acc)[2][2][4][2], const Unit& u, int wr, int wc, int fr, int fq) const {
        const int col0 = u.pn * BM + wc * 32 + 8 * fq;
#pragma unroll
        for (int ai = 0; ai < 2; ++ai)
#pragma unroll
            for (int m = 0; m < 4; ++m) {
                bf16_t* rowp = O + ((size_t)u.pm * BM + ai * HALF + wr * 64 + m * 16 + fr) * ldc + col0;
#pragma unroll
                for (int bj = 0; bj < 2; ++bj) { const f32x4 v0 = acc[ai][bj][m][0], v1 = acc[ai][bj][m][1];
                    u32x4 w; w.x = cvt_pk_bf16(v0[0], v0[1]); w.y = cvt_pk_bf16(v0[2], v0[3]); w.z = cvt_pk_bf16(v1[0], v1[1]); w.w = cvt_pk_bf16(v1[2], v1[3]);
                    *(u32x4*)(rowp + bj * HALF) = w; }
            }
    }
};
}

namespace att {
typedef short bf16x8 __attribute__((ext_vector_type(8)));
typedef short s16x4 __attribute__((ext_vector_type(4)));
typedef short v4i16_t __attribute__((ext_vector_type(4)));
typedef float f32x16 __attribute__((ext_vector_type(16)));
typedef float f32x4 __attribute__((ext_vector_type(4)));
typedef unsigned u32x4 __attribute__((ext_vector_type(4)));
#define ATT_LAS __attribute__((address_space(3)))
typedef ATT_LAS const char* lds_cptr;
constexpr int TKV = 4352, NT = TKV / 64, NS = 3, KSLOT = 8192, VSLOT = 16384;
constexpr int LDS_K = 0, LDS_V = NS * KSLOT, LDS_SCR = LDS_V + NS * VSLOT, LDS_FLG = LDS_SCR + 8 * 256, LDS_END = LDS_FLG + 64;
constexpr size_t PARK_FLOATS = 64 * 512;
__device__ __forceinline__ int crow(int r, int hi) { return (r & 3) + 8 * (r >> 2) + 4 * hi; }
__device__ __forceinline__ void glds16(const void* gsrc, unsigned lds_dst) { unsigned keep;
    asm volatile("s_mov_b32 %0, m0\n\ts_mov_b32 m0, %2\n\ts_nop 0\n\tglobal_load_lds_dwordx4 %1, off\n\ts_mov_b32 m0, %0" : "=&s"(keep) : "v"(gsrc), "s"(lds_dst) : "memory"); }
typedef float f32x2_t __attribute__((ext_vector_type(2))); typedef __bf16 bf16x2_t __attribute__((ext_vector_type(2)));
__device__ __forceinline__ unsigned cvtpk(float lo, float hi) { f32x2_t v = {lo, hi}; bf16x2_t b = __builtin_convertvector(v, bf16x2_t); return __builtin_bit_cast(unsigned, b); }
__device__ __forceinline__ s16x4 vtr(lds_cptr p) { return __builtin_bit_cast(s16x4, __builtin_amdgcn_ds_read_tr16_b64_v4i16((ATT_LAS v4i16_t*)p)); }
__device__ __forceinline__ bf16x8 ldsb128(lds_cptr p) { return *(const ATT_LAS bf16x8*)p; }
#define ATT_SB() __builtin_amdgcn_sched_barrier(0)
#define ATT_WAITBAR(N) asm volatile("s_waitcnt vmcnt(" #N ") lgkmcnt(0)\n\ts_barrier" ::: "memory")

template <int MODE>
__device__ __forceinline__ void attn_pass(int m, const short* Qw, const short* Kh, const short* Vh, char* shm, f32x16 (&o)[4], float& l, float& mx) {
    const int tid = threadIdx.x, lane = tid & 63, r32 = lane & 31, hi = lane >> 5; const int wid = __builtin_amdgcn_readfirstlane(tid >> 6);
    const unsigned lds0 = (unsigned)(uintptr_t)shm;
    const short* ksrc = Kh + (size_t)lane * 512 + m * 64 + wid * 8;
    const short* vsrc = Vh + (size_t)(16 * (wid & 3) + (lane >> 2)) * 512 + (wid >> 2) * 32 + (lane & 3) * 8;
    const unsigned kdst = lds0 + LDS_K + wid * 1024, vdst = lds0 + LDS_V + wid * 1024;
#define ATT_DMAK(t, slot) glds16(ksrc + (size_t)(t) * 64 * 512, (unsigned)__builtin_amdgcn_readfirstlane(kdst + (slot)))
#define ATT_DMAV(t, slot) do { const short* vs_ = vsrc + (size_t)(t) * 64 * 512; glds16(vs_, (unsigned)__builtin_amdgcn_readfirstlane(vdst + (slot))); glds16(vs_ + 64, (unsigned)__builtin_amdgcn_readfirstlane(vdst + (slot) + 8192)); } while (0)
    const lds_cptr shm3 = (lds_cptr)shm;
    const lds_cptr kp0 = shm3 + LDS_K + hi * 1024 + r32 * 16;
    const lds_cptr vp0 = shm3 + LDS_V + ((lane >> 4) & 1) * 32 + (lane & 3) * 8 + (4 * hi + ((lane & 15) >> 2)) * 64;
    bf16x8 qr[4];
#pragma unroll
    for (int d0 = 0; d0 < 4; ++d0) qr[d0] = *(const bf16x8*)(Qw + (size_t)r32 * 512 + m * 64 + d0 * 16 + hi * 8);
    asm volatile("" ::: "memory");
    ATT_DMAK(0, 0); ATT_DMAV(0, 0); ATT_DMAK(1, KSLOT); ATT_DMAK(2, 2 * KSLOT); ATT_DMAV(1, VSLOT);
#pragma unroll
    for (int i = 0; i < 4; ++i) o[i] = f32x16{};
    l = 0.f; float nmx = -INFINITY;
    ATT_WAITBAR(3);
    bf16x8 ka0, ka1, ka2, ka3, kb0, kb1, kb2, kb3;
#define ATT_LOADK(slot) do { const lds_cptr kp_ = kp0 + (slot); ka0 = ldsb128(kp_); kb0 = ldsb128(kp_ + 512); ka1 = ldsb128(kp_ + 2048); kb1 = ldsb128(kp_ + 2048 + 512); \
        ka2 = ldsb128(kp_ + 4096); kb2 = ldsb128(kp_ + 4096 + 512); ka3 = ldsb128(kp_ + 6144); kb3 = ldsb128(kp_ + 6144 + 512); } while (0)
    ATT_LOADK(0);
    ATT_WAITBAR(3);
    int ksl = 0, vsl = 0;
#define ATT_VLD(dst, db, ks) do { const s16x4 lo_ = vtr(vp + ((db) * 4 + (ks)) * 1024), hi_ = vtr(vp + ((db) * 4 + (ks)) * 1024 + 512); \
        dst = (bf16x8){lo_[0], lo_[1], lo_[2], lo_[3], hi_[0], hi_[1], hi_[2], hi_[3]}; } while (0)
#define ATT_MF(acc, a, b) acc = __builtin_amdgcn_mfma_f32_32x32x16_bf16(a, b, acc, 0, 0, 0)
#pragma unroll 1
    for (int t = 0; t < NT; ++t) {
        const int ksn = (ksl == 2 * KSLOT) ? 0 : ksl + KSLOT;
        if (t + 3 < NT) ATT_DMAK(t + 3, ksl);
        if (MODE != 1) { if (t + 2 < NT) { const int v2 = (vsl == 0) ? 2 * VSLOT : vsl - VSLOT; ATT_DMAV(t + 2, v2); } }
        const lds_cptr vp = vp0 + vsl;
        f32x16 sa = f32x16{}, sb = f32x16{};
        ATT_MF(sa, ka0, qr[0]); ATT_MF(sb, kb0, qr[0]); ATT_MF(sa, ka1, qr[1]); ATT_MF(sb, kb1, qr[1]);
        ATT_MF(sa, ka2, qr[2]); ATT_MF(sb, kb2, qr[2]); ATT_MF(sa, ka3, qr[3]); ATT_MF(sb, kb3, qr[3]);
        ATT_SB();
        if (t + 1 < NT) ATT_LOADK(ksn);
        if (MODE == 1) {
#pragma unroll
            for (int r = 0; r < 16; ++r) nmx = fmaxf(nmx, fmaxf(sa[r], sb[r]));
            ATT_SB();
        } else {
            bf16x8 va, vb, vc, vd;
            ATT_VLD(va, 0, 0); ATT_VLD(vb, 0, 1);
            ATT_SB();
            float sum = 0.f;
#pragma unroll
            for (int r = 0; r < 16; ++r) { sa[r] = __builtin_amdgcn_exp2f(MODE == 2 ? sa[r] - mx : sa[r]); sb[r] = __builtin_amdgcn_exp2f(MODE == 2 ? sb[r] - mx : sb[r]); sum += sa[r] + sb[r]; }
            l += sum;
            u32x4 w0, w1, w2, w3;
            w0.x = cvtpk(sa[0], sa[1]); w0.y = cvtpk(sa[2], sa[3]); w0.z = cvtpk(sa[4], sa[5]); w0.w = cvtpk(sa[6], sa[7]);
            w1.x = cvtpk(sa[8], sa[9]); w1.y = cvtpk(sa[10], sa[11]); w1.z = cvtpk(sa[12], sa[13]); w1.w = cvtpk(sa[14], sa[15]);
            w2.x = cvtpk(sb[0], sb[1]); w2.y = cvtpk(sb[2], sb[3]); w2.z = cvtpk(sb[4], sb[5]); w2.w = cvtpk(sb[6], sb[7]);
            w3.x = cvtpk(sb[8], sb[9]); w3.y = cvtpk(sb[10], sb[11]); w3.z = cvtpk(sb[12], sb[13]); w3.w = cvtpk(sb[14], sb[15]);
            const bf16x8 p0 = __builtin_bit_cast(bf16x8, w0), p1 = __builtin_bit_cast(bf16x8, w1), p2 = __builtin_bit_cast(bf16x8, w2), p3 = __builtin_bit_cast(bf16x8, w3);
            ATT_SB();
            ATT_VLD(vc, 0, 2); ATT_VLD(vd, 0, 3); ATT_MF(o[0], p0, va); ATT_MF(o[0], p1, vb); ATT_SB();
            ATT_VLD(va, 1, 0); ATT_VLD(vb, 1, 1); ATT_MF(o[0], p2, vc); ATT_MF(o[0], p3, vd); ATT_SB();
            ATT_VLD(vc, 1, 2); ATT_VLD(vd, 1, 3); ATT_MF(o[1], p0, va); ATT_MF(o[1], p1, vb); ATT_SB();
            ATT_VLD(va, 2, 0); ATT_VLD(vb, 2, 1); ATT_MF(o[1], p2, vc); ATT_MF(o[1], p3, vd); ATT_SB();
            ATT_VLD(vc, 2, 2); ATT_VLD(vd, 2, 3); ATT_MF(o[2], p0, va); ATT_MF(o[2], p1, vb); ATT_SB();
            ATT_VLD(va, 3, 0); ATT_VLD(vb, 3, 1); ATT_MF(o[2], p2, vc); ATT_MF(o[2], p3, vd); ATT_SB();
            ATT_VLD(vc, 3, 2); ATT_VLD(vd, 3, 3); ATT_MF(o[3], p0, va); ATT_MF(o[3], p1, vb); ATT_SB();
            ATT_MF(o[3], p2, vc); ATT_MF(o[3], p3, vd); ATT_SB();
        }
        if (MODE != 1) { if (t + 3 < NT) ATT_WAITBAR(3); else if (t + 2 < NT) ATT_WAITBAR(2); else ATT_WAITBAR(0); }
        else { if (t + 3 < NT) ATT_WAITBAR(1); else ATT_WAITBAR(0); }
        ksl = ksn; vsl = (vsl == 2 * VSLOT) ? 0 : vsl + VSLOT;
    }
    if (MODE == 1) mx = fmaxf(nmx, __shfl_xor(nmx, 32));
#undef ATT_MF
#undef ATT_VLD
#undef ATT_LOADK
#undef ATT_DMAK
#undef ATT_DMAV
}

template <int MODE>
__device__ __forceinline__ bool attn_unit(int b, int h, int qb, const short* Q, const short* K, const short* V, short* AO, const float* subg, float lam, float* park, char* shm) {
    const int tid = threadIdx.x, lane = tid & 63, r32 = lane & 31, hi = lane >> 5; const int wid = __builtin_amdgcn_readfirstlane(tid >> 6);
    ATT_LAS float* scr = (ATT_LAS float*)((ATT_LAS char*)shm + LDS_SCR) + wid * 64;
    volatile ATT_LAS unsigned* flgp = (volatile ATT_LAS unsigned*)((ATT_LAS char*)shm + LDS_FLG);
    const size_t qrow = (size_t)b * 4096 + qb * 256 + wid * 32;
    const short* Qw = Q + qrow * 512 + h * 128; const short* Kh = K + (size_t)b * TKV * 512 + h * 128; const short* Vh = V + (size_t)b * TKV * 512 + h * 128;
    if (tid == 0) *flgp = 0u;
    f32x16 o[4]; float l, mx = 0.f; bool bad = false;
    if (MODE == 2) { float dummy; attn_pass<1>(0, Qw, Kh, Vh, shm, o, dummy, mx); }
    attn_pass<(MODE == 2 ? 2 : 0)>(0, Qw, Kh, Vh, shm, o, l, mx);
    l += __shfl_xor(l, 32); bad = bad || !(l > 0.f && l < 3.0e38f);
    if (hi == 0) scr[r32] = l;
    asm volatile("s_waitcnt lgkmcnt(0)" ::: "memory");
    {   float* pk = park + (size_t)tid * 64;
#pragma unroll
        for (int g = 0; g < 4; ++g) { float il[4];
#pragma unroll
            for (int e = 0; e < 4; ++e) il[e] = __builtin_amdgcn_rcpf(scr[crow(4 * g + e, hi)]);
#pragma unroll
            for (int db = 0; db < 4; ++db) *(f32x4*)(pk + db * 16 + 4 * g) = (f32x4){o[db][4 * g] * il[0], o[db][4 * g + 1] * il[1], o[db][4 * g + 2] * il[2], o[db][4 * g + 3] * il[3]}; } }
    if (MODE == 2) { float dummy; attn_pass<1>(1, Qw, Kh, Vh, shm, o, dummy, mx); }
    attn_pass<(MODE == 2 ? 2 : 0)>(1, Qw, Kh, Vh, shm, o, l, mx);
    l += __shfl_xor(l, 32); bad = bad || !(l > 0.f && l < 3.0e38f);
    if (hi == 0) scr[32 + r32] = l;
    asm volatile("s_waitcnt lgkmcnt(0)" ::: "memory");
    float ss[16];
    {   const float* pk = park + (size_t)tid * 64;
#pragma unroll
        for (int r = 0; r < 16; ++r) ss[r] = 0.f;
#pragma unroll
        for (int g = 0; g < 4; ++g) { float il[4];
#pragma unroll
            for (int e = 0; e < 4; ++e) il[e] = lam * __builtin_amdgcn_rcpf(scr[32 + crow(4 * g + e, hi)]);
#pragma unroll
            for (int db = 0; db < 4; ++db) { const f32x4 pv = *(const f32x4*)(pk + db * 16 + 4 * g);
#pragma unroll
                for (int e = 0; e < 4; ++e) { const float v = pv[e] - o[db][4 * g + e] * il[e]; o[db][4 * g + e] = v; ss[4 * g + e] += v * v; } } } }
#pragma unroll
    for (int off = 1; off < 32; off <<= 1)
#pragma unroll
        for (int r = 0; r < 16; ++r) ss[r] += __shfl_xor(ss[r], off);
    float gv[4];
#pragma unroll
    for (int db = 0; db < 4; ++db) gv[db] = subg[32 * db + r32] * 0.8f;
    short* aow = AO + qrow * 1024 + h * 128 + r32;
#pragma unroll
    for (int r = 0; r < 16; ++r) { const float rs = __builtin_amdgcn_rsqf(ss[r] * (1.f / 128.f) + 1e-5f);
#pragma unroll
        for (int db = 0; db < 4; ++db) { const unsigned w = cvtpk(o[db][r] * rs * gv[db], 0.f); aow[(size_t)crow(r, hi) * 1024 + 32 * db] = (short)(w & 0xffffu); } }
    if (MODE == 0) { if (__any(bad)) { if (lane == 0) *flgp = 1u; } }
    asm volatile("s_waitcnt vmcnt(0) lgkmcnt(0)\n\ts_barrier" ::: "memory");
    const unsigned flg = *flgp;
    asm volatile("s_waitcnt lgkmcnt(0)\n\ts_barrier" ::: "memory");
    return __builtin_amdgcn_readfirstlane(flg) != 0u;
}
__device__ __forceinline__ void attn_unit_safe(int b, int h, int qb, const short* Q, const short* K, const short* V, short* AO, const float* subg, float lam, float* park, char* shm, bool force_fallback) {
    const bool redo = attn_unit<0>(b, h, qb, Q, K, V, AO, subg, lam, park, shm);
    if (redo || force_fallback) (void)attn_unit<2>(b, h, qb, Q, K, V, AO, subg, lam, park, shm);
}
}

namespace lru {
typedef short bf16x8 __attribute__((ext_vector_type(8)));
typedef float f32x16 __attribute__((ext_vector_type(16)));
typedef float f32x4 __attribute__((ext_vector_type(4)));
typedef float f32x2 __attribute__((ext_vector_type(2)));
#define LRU_LAS __attribute__((address_space(3)))
constexpr int UCS = 1040, LDS_UC = 0, LDS_CAR = 64 * UCS, LDS_END = LDS_CAR + 4096, NCH = 68;
__device__ __forceinline__ int crow(int r, int hi) { return (r & 3) + 8 * (r >> 2) + 4 * hi; }
__device__ __forceinline__ float bf2f(unsigned short v) { return __uint_as_float((unsigned)v << 16); }
__device__ __forceinline__ unsigned short f2bf(float f) { unsigned u = __float_as_uint(f); return (unsigned short)((u + 0x7fffu + ((u >> 16) & 1u)) >> 16); }
constexpr float L2E = 1.4426950408889634f;

template <bool APPLY>
__device__ __forceinline__ void lru_unit(int b, int j, const unsigned short* U, const unsigned short* G, const float* convw, const float* convb, const unsigned short* WgT, const float* bg,
                                         const float* sp8, f32x2* SUM, unsigned short* AO, LRU_LAS unsigned char* lds) {
    const int tid = threadIdx.x, lane = tid & 63, r32 = lane & 31, hi = lane >> 5; const int w = __builtin_amdgcn_readfirstlane(tid >> 6);
    LRU_LAS float* car = (LRU_LAS float*)(lds + LDS_CAR);
    const bool isctx = j < 4; const int L = isctx ? 256 : 4096, s0 = isctx ? 64 * j : 64 * (j - 4); const size_t rowbase = isctx ? (size_t)65536 + (size_t)b * 256 : (size_t)b * 4096;
    if (APPLY) {
        const int ch = tid; float cf = 0.f, cr = 0.f;
        for (int jj = 0; jj < j; ++jj) { const f32x2 s = SUM[((size_t)(b * NCH + jj) * 2 + 0) * 512 + ch]; cf = s.x * cf + s.y; }
        for (int jj = 3; jj >= 0; --jj) { const f32x2 s = SUM[((size_t)(b * NCH + jj) * 2 + 1) * 512 + ch]; cr = s.x * cr + s.y; }
        for (int jj = NCH - 1; jj > j; --jj) { const f32x2 s = SUM[((size_t)(b * NCH + jj) * 2 + 1) * 512 + ch]; cr = s.x * cr + s.y; }
        car[ch] = cf; car[512 + ch] = cr;
    }
    {
        const int cg = tid & 63, tg = tid >> 6;
        float wv[4][8], bv[8];
#pragma unroll
        for (int jj = 0; jj < 4; ++jj) { const f32x4 a = *(const f32x4*)(convw + jj * 512 + 8 * cg), c = *(const f32x4*)(convw + jj * 512 + 8 * cg + 4);
            wv[jj][0] = a.x; wv[jj][1] = a.y; wv[jj][2] = a.z; wv[jj][3] = a.w; wv[jj][4] = c.x; wv[jj][5] = c.y; wv[jj][6] = c.z; wv[jj][7] = c.w; }
        { const f32x4 a = *(const f32x4*)(convb + 8 * cg), c = *(const f32x4*)(convb + 8 * cg + 4); bv[0] = a.x; bv[1] = a.y; bv[2] = a.z; bv[3] = a.w; bv[4] = c.x; bv[5] = c.y; bv[6] = c.z; bv[7] = c.w; }
        bf16x8 uu[11];
#pragma unroll
        for (int i = 0; i < 11; ++i) { const int s = s0 + 8 * tg - 2 + i; uu[i] = (bf16x8){0, 0, 0, 0, 0, 0, 0, 0};
            if (s >= 0 && s < L) uu[i] = *(const bf16x8*)(U + (rowbase + s) * 512 + 8 * cg); }
#pragma unroll
        for (int tt = 0; tt < 8; ++tt) { bf16x8 o;
#pragma unroll
            for (int e = 0; e < 8; ++e) { float acc = bv[e];
#pragma unroll
                for (int jj = 0; jj < 4; ++jj) acc += wv[jj][e] * bf2f((unsigned short)uu[tt + jj][e]);
                o[e] = (short)f2bf(acc); }
            *(LRU_LAS bf16x8*)(lds + LDS_UC + (8 * tg + tt) * UCS + cg * 16) = o; }
    }
    __syncthreads();
    const size_t row0 = rowbase + s0;
#pragma unroll 1
    for (int nb = 0; nb < 2; ++nb) {
        const int chn = 64 * w + 32 * nb + r32;
        float hs[2][16];
#pragma unroll
        for (int tb = 0; tb < 2; ++tb)
#pragma unroll
            for (int r = 0; r < 16; ++r) hs[tb][r] = 0.f;
#pragma unroll
        for (int dir = 0; dir < 2; ++dir) {
            f32x16 z[2][2];
#pragma unroll
            for (int gate = 0; gate < 2; ++gate) {
                bf16x8 bfr[4];
#pragma unroll
                for (int ks = 0; ks < 4; ++ks) bfr[ks] = *(const bf16x8*)(WgT + ((size_t)(((dir * 2 + gate) * 8 + w) * 64 + 32 * nb + r32)) * 64 + 16 * ks + 8 * hi);
#pragma unroll
                for (int tb = 0; tb < 2; ++tb) { z[gate][tb] = f32x16{};
#pragma unroll
                    for (int ks = 0; ks < 4; ++ks) z[gate][tb] = __builtin_amdgcn_mfma_f32_32x32x16_bf16(*(const LRU_LAS bf16x8*)(lds + LDS_UC + (32 * tb + r32) * UCS + (64 * w + 16 * ks + 8 * hi) * 2), bfr[ks], z[gate][tb], 0, 0, 0); }
            }
            const float br = bg[((dir * 2 + 0) * 8 + w) * 64 + 32 * nb + r32], bi = bg[((dir * 2 + 1) * 8 + w) * 64 + 32 * nb + r32], sp = sp8[dir * 512 + chn];
#pragma unroll
            for (int tb = 0; tb < 2; ++tb)
#pragma unroll
                for (int r = 0; r < 16; ++r) {
                    const float rg = __builtin_amdgcn_rcpf(1.f + __builtin_amdgcn_exp2f(-(z[0][tb][r] + br) * L2E));
                    const float ig = __builtin_amdgcn_rcpf(1.f + __builtin_amdgcn_exp2f(-(z[1][tb][r] + bi) * L2E));
                    const float a = __builtin_amdgcn_exp2f(-rg * sp);
                    const float mult = __builtin_amdgcn_sqrtf(fmaxf(1.f - a * a, 0.f));
                    z[0][tb][r] = a; z[1][tb][r] = mult * ig * bf2f(*(const LRU_LAS unsigned short*)(lds + LDS_UC + (32 * tb + crow(r, hi)) * UCS + chn * 2));
                }
            __builtin_amdgcn_sched_barrier(0);
            float Ao[8], Bo[8], Ax[8], Bx[8];
#pragma unroll
            for (int q = 0; q < 8; ++q) { const int tb = q >> 2, rb = 4 * (q & 3);
                const float a0 = z[0][tb][rb], a1 = z[0][tb][rb + 1], a2 = z[0][tb][rb + 2], a3 = z[0][tb][rb + 3];
                const float b0 = z[1][tb][rb], b1 = z[1][tb][rb + 1], b2 = z[1][tb][rb + 2], b3 = z[1][tb][rb + 3];
                Ao[q] = (a0 * a1) * (a2 * a3);
                Bo[q] = dir == 0 ? ((b0 * a1 + b1) * a2 + b2) * a3 + b3 : ((b3 * a2 + b2) * a1 + b1) * a0 + b0;
                Ax[q] = __shfl_xor(Ao[q], 32); Bx[q] = __shfl_xor(Bo[q], 32); }
            float c = APPLY ? car[dir * 512 + chn] : 0.f, cst[8], atot = 1.f;
            if (dir == 0) {
#pragma unroll
                for (int q = 0; q < 8; ++q) { const float Ae = hi ? Ax[q] : Ao[q], Be = hi ? Bx[q] : Bo[q], Aod = hi ? Ao[q] : Ax[q], Bod = hi ? Bo[q] : Bx[q];
                    const float c1 = Ae * c + Be; cst[q] = hi ? c1 : c; c = Aod * c1 + Bod; atot *= Ao[q] * Ax[q]; }
            } else {
#pragma unroll
                for (int q = 7; q >= 0; --q) { const float Ae = hi ? Ax[q] : Ao[q], Be = hi ? Bx[q] : Bo[q], Aod = hi ? Ao[q] : Ax[q], Bod = hi ? Bo[q] : Bx[q];
                    const float c1 = Aod * c + Bod; cst[q] = hi ? c : c1; c = Ae * c1 + Be; atot *= Ao[q] * Ax[q]; }
            }
            if (APPLY) {
#pragma unroll
                for (int q = 0; q < 8; ++q) { const int tb = q >> 2, rb = 4 * (q & 3); float hcur = cst[q];
                    if (dir == 0) {
#pragma unroll
                        for (int e = 0; e < 4; ++e) { hcur = z[0][tb][rb + e] * hcur + z[1][tb][rb + e]; hs[tb][rb + e] += hcur; }
                    } else {
#pragma unroll
                        for (int e = 3; e >= 0; --e) { hcur = z[0][tb][rb + e] * hcur + z[1][tb][rb + e]; hs[tb][rb + e] += hcur; }
                    } }
            } else {
                if (hi == 0) SUM[((size_t)(b * NCH + j) * 2 + dir) * 512 + chn] = (f32x2){atot, c};
            }
        }
        if (APPLY) {
            const int goff = hi * 4 * 512 + chn, aoff = hi * 4 * 1024 + 512 + chn;
#pragma unroll
            for (int tb = 0; tb < 2; ++tb)
#pragma unroll
                for (int r = 0; r < 16; ++r) { const size_t rowu = row0 + 32 * tb + 8 * (r >> 2) + (r & 3);
                    const unsigned short* gu = G + rowu * 512; unsigned short* au = AO + rowu * 1024;
                    const float g = bf2f(gu[goff]); const float t = 1.5957691216057308f * (g + 0.044715f * g * g * g);
                    const float y = hs[tb][r] * g * __builtin_amdgcn_rcpf(1.f + __builtin_amdgcn_exp2f(-t * L2E));
                    au[aoff] = f2bf(y); }
        }
    }
    __syncthreads();
}
}

#define GAS __attribute__((address_space(1)))
#define LAS __attribute__((address_space(3)))
typedef unsigned short bf16;
typedef unsigned v4u __attribute__((ext_vector_type(4)));
typedef float f32x4 __attribute__((ext_vector_type(4)));
typedef short bf16x8 __attribute__((ext_vector_type(8)));
typedef GAS unsigned gu32;
typedef GAS unsigned long long gu64;
#define RLX_AGENT __ATOMIC_RELAXED, __HIP_MEMORY_SCOPE_AGENT
#define LDS_WAIT() asm volatile("s_waitcnt lgkmcnt(0)" ::: "memory")
#define VM_WAIT() asm volatile("s_waitcnt vmcnt(0)" ::: "memory")
__device__ __forceinline__ unsigned long long rt() { return __builtin_amdgcn_s_memrealtime(); }
__device__ __forceinline__ unsigned f2bf(float f) { unsigned u = __builtin_bit_cast(unsigned, f); return (u + 0x7fffu + ((u >> 16) & 1u)) >> 16; }
__device__ __forceinline__ unsigned pk2(float lo, float hi) { return f2bf(lo) | (f2bf(hi) << 16); }

#define XB_TMO      128
#define XB_XCNT(j)  (256  + 64 * (j))
#define XB_XSUB(j)  (1280 + 64 * (j))
#define XB_XGEN(j)  (2304 + 64 * (j))
#define XB_TOP      3328
#define XB_TOPGEN   3392
#define XCD_BAR_WORDS 3456
#define XB_SPIN_CAP (1u << 18)

__device__ __forceinline__ unsigned xb_ld(unsigned* p)              { return __hip_atomic_load(p, __ATOMIC_RELAXED, __HIP_MEMORY_SCOPE_AGENT); }
__device__ __forceinline__ unsigned xb_add(unsigned* p, unsigned v) { return __hip_atomic_fetch_add(p, v, __ATOMIC_RELAXED, __HIP_MEMORY_SCOPE_AGENT); }
__device__ __forceinline__ unsigned xb_xcc_id() { return (unsigned)__builtin_amdgcn_s_getreg((3 << 11) | 20) & 0xFu; }
#define XB_SPIN(cond, bar) do { unsigned _sp = 0; while (cond) { __builtin_amdgcn_s_sleep(1); \
    if ((++_sp & 255u) == 0u) { if (xb_ld(&(bar)[XB_TMO])) break; if (_sp > XB_SPIN_CAP) { atomicAdd(&(bar)[XB_TMO], 1u); break; } } } } while (0)

struct XcdBarrier {
    unsigned* bar; unsigned x;
    volatile LAS unsigned* st;
};

__device__ __forceinline__ XcdBarrier xcd_barrier_post(unsigned* bar, volatile LAS unsigned* st) {
    XcdBarrier b; b.bar = bar; b.x = xb_xcc_id(); b.st = st;
    if (threadIdx.x == 0) (void)xb_add(&bar[XB_XCNT(b.x)], 1u);
    return b;
}
__device__ __forceinline__ void xcd_barrier_complete(unsigned* bar, unsigned x, unsigned& nloc, unsigned& nx) {
    const unsigned G = gridDim.x * gridDim.y * gridDim.z;
    unsigned sum, cnt, mine, sp = 0u;
    for (;;) {
        sum = 0u; cnt = 0u; mine = 0u;
#pragma unroll
        for (unsigned j = 0; j < 16; ++j) { const unsigned c = xb_ld(&bar[XB_XCNT(j)]); sum += c; cnt += (c > 0u) ? 1u : 0u; mine = (j == x) ? c : mine; }
        if (sum == G) break;
        __builtin_amdgcn_s_sleep(1);
        if ((++sp & 255u) == 0u) { if (xb_ld(&bar[XB_TMO])) break; if (sp > XB_SPIN_CAP) { atomicAdd(&bar[XB_TMO], 1u); break; } }
    }
    nloc = mine > 0u ? mine : 1u; nx = cnt > 0u ? cnt : 1u;
}

__device__ __forceinline__ void xcd_barrier(const XcdBarrier& b) {
    asm volatile("s_waitcnt vmcnt(0)" ::: "memory");
    __syncthreads();
    if (threadIdx.x == 0) {
        unsigned* bar = b.bar;
        __builtin_amdgcn_s_waitcnt(0);
        unsigned nloc = b.st[0], nx = b.st[1];
        if (nloc == 0u) { xcd_barrier_complete(bar, b.x, nloc, nx); b.st[0] = nloc; b.st[1] = nx; }
        const unsigned old = xb_add(&bar[XB_XSUB(b.x)], 1u);
        const unsigned gen = old / nloc;
        if (old + 1u == (gen + 1u) * nloc) {
            __builtin_amdgcn_fence(__ATOMIC_RELEASE, "agent");
            asm volatile("s_waitcnt vmcnt(0)" ::: "memory");
            const unsigned og = xb_add(&bar[XB_TOP], 1u);
            const unsigned tg = og / nx;
            if (og + 1u == (tg + 1u) * nx) xb_add(&bar[XB_TOPGEN], 1u);
            else XB_SPIN(xb_ld(&bar[XB_TOPGEN]) == tg, bar);
            __builtin_amdgcn_fence(__ATOMIC_ACQUIRE, "agent");
            xb_add(&bar[XB_XGEN(b.x)], 1u);
            asm volatile("s_waitcnt vmcnt(0)" ::: "memory");
        } else {
            XB_SPIN(xb_ld(&bar[XB_XGEN(b.x)]) == gen, bar);
            __builtin_amdgcn_fence(__ATOMIC_ACQUIRE, "agent");
            asm volatile("s_waitcnt vmcnt(0)" ::: "memory");
        }
    }
    __syncthreads();
}

constexpr int NWAVES = 8;
#ifndef MK_N_LAUNCHES
#define MK_N_LAUNCHES 1
#endif
constexpr int PER_PHASE = 10;
constexpr int N_LAUNCHES = MK_N_LAUNCHES;
#ifndef ATT_FORCE_FALLBACK
#define ATT_FORCE_FALLBACK 0
#endif
constexpr int DM = 1024, NBATCH = 16, SEQ = 4096, CTXL = 256, MLAT = NBATCH * SEQ, MCTX = NBATCH * CTXL, MALL = MLAT + MCTX, INW = 2560, FH = 2816;
constexpr float LN_EPS = 1e-6f, DN_ALPHA = 1.189207115002721f;
constexpr size_t MiB = 1u << 20;
constexpr size_t WS_CTL = 0, CTL_ZERO_BYTES = 64 * 1024;
constexpr size_t WS_MOD = 1 * MiB, WS_ROPEC = WS_MOD + 512 * 1024, WS_ROPES = WS_ROPEC + 4096, WS_SP8 = WS_ROPES + 4096, WS_LAM = WS_SP8 + 4096;
constexpr size_t WS_WIN = 2 * MiB, WS_WOUT = 8 * MiB, WS_W1 = 10 * MiB, WS_W2 = 21 * MiB, WS_WG = 27 * MiB, WS_SUM = 28 * MiB;
constexpr size_t WS_XN = 40 * MiB, WS_Q = 176 * MiB, WS_K = 240 * MiB, WS_V = 308 * MiB, WS_U = 376 * MiB, WS_G = 444 * MiB, WS_AO = 508 * MiB;
constexpr size_t WS_Y = (DBG ? 884 : 176) * MiB, WS_HID = 176 * MiB, WS_F = 528 * MiB, WS_PARK = 656 * MiB, WS_END = 688 * MiB;
static_assert(WS_SUM + (size_t)16 * 68 * 2 * 512 * 8 <= WS_XN && WS_XN + (size_t)MALL * DM * 2 <= WS_Q && WS_HID + (size_t)MLAT * FH * 2 <= WS_F, "d_ws map");
constexpr int CW_BAR = 1024;
constexpr int RING_BYTES = 131072, LDSCTL_OFF = RING_BYTES, MISC_OFF = LDSCTL_OFF + 320, LDS_BYTES = 147456;
static_assert(att::LDS_END <= RING_BYTES && lru::LDS_END <= RING_BYTES, "LDS map");

struct Frame {
    LAS unsigned char* lds; volatile LAS unsigned* MISC; gu32* ctl;
    int tid, lane, wave, vcu, G;
};
__device__ __forceinline__ float wave_sum(float v) {
#pragma unroll
    for (int o = 1; o < 64; o <<= 1) v += __shfl_xor(v, o);
    return v;
}
template <class DEST>
__device__ __forceinline__ void p0_transpose_item(const float* W, int K, int N, bf16* WT, LAS float* scr, int item, int lane, DEST dest) {
    const int nblk = N / 32, kb = item / nblk, nb = item % nblk, k0 = 64 * kb, n0 = 32 * nb;
#pragma unroll 8
    for (int i = 0; i < 32; ++i) { const int kk = 2 * i + (lane >> 5); scr[kk * 33 + (lane & 31)] = W[(size_t)(k0 + kk) * N + n0 + (lane & 31)]; }
    LDS_WAIT(); asm volatile("" ::: "memory");
    const int c = lane & 7;
#pragma unroll
    for (int j = 0; j < 4; ++j) { const int n = (lane >> 3) + 8 * j; const LAS float* s = scr + (8 * c) * 33 + n;
        v4u o; o.x = pk2(s[0 * 33], s[1 * 33]); o.y = pk2(s[2 * 33], s[3 * 33]); o.z = pk2(s[4 * 33], s[5 * 33]); o.w = pk2(s[6 * 33], s[7 * 33]);
        *(GAS v4u*)(WT + (size_t)dest(n0 + n) * K + k0 + 8 * c) = o; }
    LDS_WAIT(); asm volatile("" ::: "memory");
}
struct DestId { __device__ __forceinline__ int operator()(int n) const { return n; } };
struct DestWin { __device__ __forceinline__ int operator()(int n) const { if (n >= 1024) return n; const int d = n & 63; return (n & ~63) + (d & 32) + ((d >> 2) & 3) * 8 + ((d >> 4) & 1) * 4 + (d & 3); } };
struct DestW1 { __device__ __forceinline__ int operator()(int n) const { const int hb = n >= FH, l = hb ? n - FH : n; return (l >> 7) * 256 + hb * 128 + (l & 127); } };

__device__ __forceinline__ void p0_mod_task(int cgp, const float* c, const float* cctx, const float* w_ada, const float* b_ada, float* MOD, LAS unsigned char* lds, int tid, int wave, int lane) {
    LAS float* sc = (LAS float*)lds; LAS float* red = (LAS float*)(lds + 81920);
    for (int idx = tid; idx < 17 * 1024; idx += 512) { const int r = idx >> 10, k = idx & 1023; const float v = r < 16 ? c[r * 1024 + k] : cctx[k]; sc[k * 20 + r] = v / (1.f + __expf(-v)); }
    __syncthreads();
    float acc[17];
#pragma unroll
    for (int r = 0; r < 17; ++r) acc[r] = 0.f;
    const int n = 64 * cgp + lane;
#pragma unroll 4
    for (int kk = 0; kk < 128; ++kk) { const int k = wave * 128 + kk; const float wv = w_ada[(size_t)k * 6144 + n];
        const LAS f32x4* sp = (const LAS f32x4*)(sc + k * 20); const f32x4 s0 = sp[0], s1 = sp[1], s2 = sp[2], s3 = sp[3]; const float s16 = sc[k * 20 + 16];
        acc[0] += s0.x * wv; acc[1] += s0.y * wv; acc[2] += s0.z * wv; acc[3] += s0.w * wv; acc[4] += s1.x * wv; acc[5] += s1.y * wv; acc[6] += s1.z * wv; acc[7] += s1.w * wv;
        acc[8] += s2.x * wv; acc[9] += s2.y * wv; acc[10] += s2.z * wv; acc[11] += s2.w * wv; acc[12] += s3.x * wv; acc[13] += s3.y * wv; acc[14] += s3.z * wv; acc[15] += s3.w * wv; acc[16] += s16 * wv; }
#pragma unroll
    for (int r = 0; r < 17; ++r) red[(wave * 17 + r) * 64 + lane] = acc[r];
    __syncthreads();
    for (int idx = tid; idx < 17 * 64; idx += 512) { const int r = idx >> 6, l = idx & 63; float s = b_ada[64 * cgp + l];
#pragma unroll
        for (int w2 = 0; w2 < 8; ++w2) s += red[(w2 * 17 + r) * 64 + l];
        MOD[r * 6144 + 64 * cgp + l] = s; }
    __syncthreads();
}
__device__ __forceinline__ void ln_stats(f32x4 (&v)[4], float& mean, float& rstd) {
    float s = 0.f;
#pragma unroll
    for (int j = 0; j < 4; ++j) s += (v[j].x + v[j].y) + (v[j].z + v[j].w);
    mean = wave_sum(s) * (1.f / DM); float s2 = 0.f;
#pragma unroll
    for (int j = 0; j < 4; ++j) { v[j] = v[j] - mean; s2 += (v[j].x * v[j].x + v[j].y * v[j].y) + (v[j].z * v[j].z + v[j].w * v[j].w); }
    rstd = 1.f / sqrtf(wave_sum(s2) * (1.f / DM) + LN_EPS);
}
__device__ __forceinline__ void st_bf16x4(bf16* p, f32x4 v) { *(GAS unsigned long long*)p = (unsigned long long)pk2(v.x, v.y) | ((unsigned long long)pk2(v.z, v.w) << 32); }
__device__ __forceinline__ f32x4 ld_bf16x4(const bf16* p) { const unsigned long long w = *(const GAS unsigned long long*)p; const unsigned lo = (unsigned)w, hi = (unsigned)(w >> 32);
    return (f32x4){__uint_as_float(lo << 16), __uint_as_float(lo & 0xffff0000u), __uint_as_float(hi << 16), __uint_as_float(hi & 0xffff0000u)}; }
__device__ __forceinline__ void row_hmod(const float* xrow, const float* sh, const float* sc, bf16* orow, int lane) {
    f32x4 v[4]; float mean, rstd;
#pragma unroll
    for (int j = 0; j < 4; ++j) v[j] = *(const GAS f32x4*)(xrow + 4 * lane + 256 * j);
    ln_stats(v, mean, rstd);
#pragma unroll
    for (int j = 0; j < 4; ++j) { const f32x4 a = *(const f32x4*)(sc + 4 * lane + 256 * j), s = *(const f32x4*)(sh + 4 * lane + 256 * j); st_bf16x4(orow + 4 * lane + 256 * j, v[j] * rstd * (a + 1.f) + s); }
}
__device__ __forceinline__ void row_ln1(const float* xrow, const bf16* yrow, const float* g1, const float* lng, const float* lnb, const float* sh2, const float* sc2, float* x1row, bf16* h2row, int lane) {
    f32x4 v[4]; float mean, rstd;
#pragma unroll
    for (int j = 0; j < 4; ++j) { const int c = 4 * lane + 256 * j; v[j] = *(const GAS f32x4*)(xrow + c) * DN_ALPHA + *(const f32x4*)(g1 + c) * ld_bf16x4(yrow + c); }
    ln_stats(v, mean, rstd);
#pragma unroll
    for (int j = 0; j < 4; ++j) { const int c = 4 * lane + 256 * j; v[j] = v[j] * rstd * *(const f32x4*)(lng + c) + *(const f32x4*)(lnb + c); *(GAS f32x4*)(x1row + c) = v[j]; }
    ln_stats(v, mean, rstd);
#pragma unroll
    for (int j = 0; j < 4; ++j) { const int c = 4 * lane + 256 * j; st_bf16x4(h2row + c, v[j] * rstd * (*(const f32x4*)(sc2 + c) + 1.f) + *(const f32x4*)(sh2 + c)); }
}
__device__ __forceinline__ void row_ln2(float* orow, const bf16* frow, const float* g2, const float* lng, const float* lnb, int lane) {
    f32x4 v[4]; float mean, rstd;
#pragma unroll
    for (int j = 0; j < 4; ++j) { const int c = 4 * lane + 256 * j; v[j] = *(const GAS f32x4*)(orow + c) * DN_ALPHA + *(const f32x4*)(g2 + c) * ld_bf16x4(frow + c); }
    ln_stats(v, mean, rstd);
#pragma unroll
    for (int j = 0; j < 4; ++j) { const int c = 4 * lane + 256 * j; *(GAS f32x4*)(orow + c) = v[j] * rstd * *(const f32x4*)(lng + c) + *(const f32x4*)(lnb + c); }
}

struct Args { const float* in[22]; float* out; unsigned char* ws; int ph_lo, ph_hi, li, pad; };
__global__ void __launch_bounds__(NWAVES * 64, 2) mk_fwd(Args args) {
    extern __shared__ __attribute__((aligned(16))) unsigned char lds[];
    Frame F;
    F.lds = (LAS unsigned char*)lds; F.MISC = (volatile LAS unsigned*)(F.lds + MISC_OFF);
    F.tid = threadIdx.x; F.lane = F.tid & 63; F.wave = __builtin_amdgcn_readfirstlane(F.tid >> 6);
    F.G = gridDim.x; { const int bx = blockIdx.x; F.vcu = (F.G % 8 == 0) ? (bx % 8) * (F.G / 8) + bx / 8 : bx; }
    unsigned char* ws = args.ws;
    F.ctl = (gu32*)(ws + WS_CTL);
    const float* x = args.in[0]; const float* cin = args.in[1]; const float* ctx = args.in[2]; const float* cctx = args.in[3];
    float* MOD = (float*)(ws + WS_MOD); float* ROPEC = (float*)(ws + WS_ROPEC); float* ROPES = (float*)(ws + WS_ROPES); float* SP8 = (float*)(ws + WS_SP8); float* LAMP = (float*)(ws + WS_LAM);
    bf16* WinT = (bf16*)(ws + WS_WIN); bf16* WoutT = (bf16*)(ws + WS_WOUT); bf16* W1T = (bf16*)(ws + WS_W1); bf16* W2T = (bf16*)(ws + WS_W2); bf16* WgT = (bf16*)(ws + WS_WG);
    lru::f32x2* SUM = (lru::f32x2*)(ws + WS_SUM);
    bf16* XN = (bf16*)(ws + WS_XN); bf16* Qb = (bf16*)(ws + WS_Q); bf16* Kb = (bf16*)(ws + WS_K); bf16* Vb = (bf16*)(ws + WS_V); bf16* Ub = (bf16*)(ws + WS_U); bf16* Gb = (bf16*)(ws + WS_G);
    bf16* AO = (bf16*)(ws + WS_AO); bf16* Yb = (bf16*)(ws + WS_Y); bf16* HID = (bf16*)(ws + WS_HID); bf16* Fb = (bf16*)(ws + WS_F);
    for (int u = F.tid; u < (LDS_BYTES - LDSCTL_OFF) / 4; u += NWAVES * 64) ((LAS unsigned*)(F.lds + LDSCTL_OFF))[u] = 0u;
    __syncthreads();
    XcdBarrier bar; bar.bar = (unsigned*)(F.ctl + CW_BAR); bar.x = 0; bar.st = nullptr;
    if (N_LAUNCHES != PER_PHASE) bar = xcd_barrier_post((unsigned*)(F.ctl + CW_BAR), F.MISC + 8);
#define GRID_BAR() do { if (N_LAUNCHES != PER_PHASE) xcd_barrier(bar); } while (0)
    const int lo = args.ph_lo, hi = args.ph_hi;
#define IN(k) (lo <= (k) && (k) < hi)
#define BOTH(k) (IN(k) && IN((k) + 1))
    const int gw = F.vcu * NWAVES + F.wave, NGW = F.G * NWAVES;

    if (IN(0)) {
        if ((int)blockIdx.x < 96) p0_mod_task((int)blockIdx.x, cin, cctx, args.in[4], args.in[5], MOD, F.lds, F.tid, F.wave, F.lane);
        if ((int)blockIdx.x == F.G - 1) {
            for (int i = F.tid; i < 1024; i += 512) { const int pos = i >> 4, f = i & 15; const float inv = powf(10000.f, -(float)f / 16.f); const float ang = (float)pos * inv; ROPEC[i] = cosf(ang); ROPES[i] = sinf(ang); }
            for (int i = F.tid; i < 1024; i += 512) { const float l = args.in[14][i]; const float sp = log1pf(expf(-fabsf(l))) + fmaxf(-l, 0.f); SP8[i] = 8.f * sp * 1.4426950408889634f; }
            if (F.tid == 0) { float a = 0.f, b2 = 0.f; for (int i = 0; i < 64; ++i) { a += args.in[7][i] * args.in[8][i]; b2 += args.in[7][64 + i] * args.in[8][64 + i]; } LAMP[0] = expf(a) - expf(b2) + 0.2f; }
        }
        LAS float* scr = (LAS float*)(F.lds + F.wave * 16384);
        constexpr int I_IN = (DM / 64) * (INW / 32), I_OUT = (DM / 64) * (DM / 32), I_1 = (DM / 64) * (2 * FH / 32), I_2 = (FH / 64) * (DM / 32), I_G = 32 * 2;
        constexpr int NITEMS = I_IN + I_OUT + I_1 + I_2 + I_G;
        for (int it = gw; it < NITEMS; it += NGW) {
            int r = it;
            if (r < I_IN) { p0_transpose_item(args.in[6], DM, INW, WinT, scr, r, F.lane, DestWin{}); continue; } r -= I_IN;
            if (r < I_OUT) { p0_transpose_item(args.in[15], DM, DM, WoutT, scr, r, F.lane, DestId{}); continue; } r -= I_OUT;
            if (r < I_1) { p0_transpose_item(args.in[18], DM, 2 * FH, W1T, scr, r, F.lane, DestW1{}); continue; } r -= I_1;
            if (r < I_2) { p0_transpose_item(args.in[19], FH, DM, W2T, scr, r, F.lane, DestId{}); continue; } r -= I_2;
            { const int mat = r >> 1; p0_transpose_item(args.in[12] + (size_t)mat * 4096, 64, 64, WgT + (size_t)mat * 4096, scr, r & 1, F.lane, DestId{}); }
        }
        if (BOTH(0)) GRID_BAR();
    }
    if (IN(1)) {
        for (int m = gw; m < MALL; m += NGW) {
            if (m < MLAT) row_hmod(x + (size_t)m * DM, MOD + (m >> 12) * 6144, MOD + (m >> 12) * 6144 + 1024, XN + (size_t)m * DM, F.lane);
            else row_hmod(ctx + (size_t)(m - MLAT) * DM, MOD + 16 * 6144, MOD + 16 * 6144 + 1024, XN + (size_t)m * DM, F.lane);
        }
        if (BOTH(1)) GRID_BAR();
    }
    if (IN(2)) {
        { pg8::Gemm g{XN, WinT, MLAT, INW, DM}; pg8::StaticOrder S; S.init(MLAT, INW, F.G, (int)blockIdx.x);
          pg8::EpiInProj E{Qb, Kb, Vb, Ub, Gb, ROPEC, ROPES, 0};
          pg8::gemm_phase<pg8::EpiInProj, pg8::StaticOrder, true, true>(F.lds, g, S, E); }
        { pg8::Gemm g{XN + (size_t)MLAT * DM, WinT + (size_t)512 * DM, MCTX, 1536, DM}; pg8::StaticOrder S; S.init(MCTX, 1536, F.G, (int)blockIdx.x);
          pg8::EpiInProj E{Qb, Kb, Vb, Ub, Gb, ROPEC, ROPES, 1};
          pg8::gemm_phase<pg8::EpiInProj, pg8::StaticOrder, true, true>(F.lds, g, S, E); }
        if (BOTH(2)) GRID_BAR();
    }
    if (IN(3)) {
#ifndef SKIP_ATT
        const float lam = LAMP[0]; float* PARK = (float*)(ws + WS_PARK) + (size_t)blockIdx.x * att::PARK_FLOATS;
        const int xg = F.vcu >> 5, vl = F.vcu & 31;
        if (F.G == 256) {
            for (int i = 0; i < 4; ++i) { const int bh = xg * 8 + i * 2 + (vl >> 4), qb = vl & 15;
                att::attn_unit_safe(bh >> 2, bh & 3, qb, (const short*)Qb, (const short*)Kb, (const short*)Vb, (short*)AO, args.in[9], lam, PARK, (char*)lds, ATT_FORCE_FALLBACK != 0); }
        } else {
            for (int un = (int)blockIdx.x; un < 1024; un += F.G) { const int bh = un >> 4, qb = un & 15;
                att::attn_unit_safe(bh >> 2, bh & 3, qb, (const short*)Qb, (const short*)Kb, (const short*)Vb, (short*)AO, args.in[9], lam, PARK, (char*)lds, ATT_FORCE_FALLBACK != 0); }
        }
#endif
#ifndef SKIP_LRU1
        for (int un = F.vcu; un < NBATCH * lru::NCH; un += F.G)
            lru::lru_unit<false>(un / lru::NCH, un % lru::NCH, Ub, Gb, args.in[10], args.in[11], WgT, args.in[13], SP8, SUM, AO, F.lds);
#endif
        if (BOTH(3)) GRID_BAR();
    }
    if (IN(4)) {
#ifndef SKIP_LRU2
        for (int un = F.vcu; un < NBATCH * 64; un += F.G)
            lru::lru_unit<true>(un >> 6, 4 + (un & 63), Ub, Gb, args.in[10], args.in[11], WgT, args.in[13], SP8, SUM, AO, F.lds);
#endif
        if (BOTH(4)) GRID_BAR();
    }
    if (IN(5)) {
        pg8::Gemm g{AO, WoutT, MLAT, DM, DM}; pg8::StaticOrder S; S.init(MLAT, DM, F.G, (int)blockIdx.x);
        pg8::EpiPlain E{Yb, DM};
        pg8::gemm_phase<pg8::EpiPlain, pg8::StaticOrder, true, true>(F.lds, g, S, E);
        if (BOTH(5)) GRID_BAR();
    }
    if (IN(6)) {
        for (int m = gw; m < MLAT; m += NGW) { const float* md = MOD + (m >> 12) * 6144;
            row_ln1(x + (size_t)m * DM, Yb + (size_t)m * DM, md + 2048, args.in[16], args.in[17], md + 3072, md + 4096, args.out + (size_t)m * DM, XN + (size_t)m * DM, F.lane); }
        if (BOTH(6)) GRID_BAR();
    }
    if (IN(7)) {
        pg8::Gemm g{XN, W1T, MLAT, 2 * FH, DM}; pg8::StaticOrder S; S.init(MLAT, 2 * FH, F.G, (int)blockIdx.x);
        pg8::EpiSwiglu E{HID, FH};
        pg8::gemm_phase<pg8::EpiSwiglu, pg8::StaticOrder, true, true>(F.lds, g, S, E);
        if (BOTH(7)) GRID_BAR();
    }
    if (IN(8)) {
        pg8::Gemm g{HID, W2T, MLAT, DM, FH}; pg8::StaticOrder S; S.init(MLAT, DM, F.G, (int)blockIdx.x);
        pg8::EpiPlain E{Fb, DM};
        pg8::gemm_phase<pg8::EpiPlain, pg8::StaticOrder, true, true>(F.lds, g, S, E);
        if (BOTH(8)) GRID_BAR();
    }
    if (IN(9)) {
        for (int m = gw; m < MLAT; m += NGW) { const float* md = MOD + (m >> 12) * 6144;
            row_ln2(args.out + (size_t)m * DM, Fb + (size_t)m * DM, md + 5120, args.in[20], args.in[21], F.lane); }
    }
#undef IN
#undef BOTH
#undef GRID_BAR
}

#ifndef DBG
#define DBG 0
#endif
#if DBG
constexpr size_t WS_DBGTAB = 32 * 1024, WS_NAIVE = 688 * MiB;
static void dbg_run(void* const* d_in, float* out, unsigned char* ws, hipStream_t st) {
    float* tab = (float*)(ws + WS_DBGTAB);
    nv::Bufs B = nv::carve((char*)ws + WS_NAIVE);
    nv::run_common(d_in, B, st);
    dbg::cmp(st, tab, 1, ws + WS_MOD, 0, 0, 6144, 0, 0, 1.f, B.mod, 0, 6144, 0, 17, 6144);
    using namespace nv;
    for (int b = 0; b < 16; ++b) {
        const float* x = (const float*)d_in[0] + (size_t)b * S * D; const float* ctx = (const float*)d_in[2] + (size_t)b * CT * D;
        const float* mod = B.mod + b * 6144; const float* modc = B.mod + 16 * 6144;
        k_lnmod<<<S, 256, 0, st>>>(x, mod + 0, mod + 1024, B.h);
        k_lnmod<<<CT, 256, 0, st>>>(ctx, modc + 0, modc + 1024, B.h + (size_t)S * D);
        dbg::cmp(st, tab, 2, ws + WS_XN, 1, (size_t)65536 + b * 256, 1024, 0, 0, 1.f, B.h, 4096, 1024, 0, 256, 1024);
        k_gemm<<<dim3(nv::INW / 64, T / 64), 256, 0, st>>>(B.h, (const float*)d_in[6], B.p, T, nv::INW, D);
        k_rope<<<S * 512 / 256, 256, 0, st>>>(B.p);
        dbg::cmp(st, tab, 3, ws + WS_V, 1, (size_t)b * 4352, 512, 0, 0, 1.f, B.p, 0, nv::INW, 1024, 4352, 512);
        dbg::cmp(st, tab, 4, ws + WS_U, 1, (size_t)b * 4096, 512, 0, 0, 1.f, B.p, 0, nv::INW, 1536, 4096, 512);
        dbg::cmp(st, tab, 4, ws + WS_U, 1, (size_t)65536 + b * 256, 512, 0, 0, 1.f, B.p, 4096, nv::INW, 1536, 256, 512);
        dbg::cmp(st, tab, 5, ws + WS_G, 1, (size_t)b * 4096, 512, 0, 0, 1.f, B.p, 0, nv::INW, 2048, 4096, 512);
        dbg::cmp(st, tab, 6, ws + WS_K, 1, (size_t)b * 4352 + 4096, 512, 0, 1, 1.f, B.p, 4096, nv::INW, 512, 256, 512);
        dbg::cmp(st, tab, 7, ws + WS_K, 1, (size_t)b * 4352, 512, 0, 1, 1.f, B.p, 0, nv::INW, 512, 4096, 512);
        dbg::cmp(st, tab, 8, ws + WS_Q, 1, (size_t)b * 4096, 512, 0, 1, 1.f / pg8::QK_C2, B.p, 0, nv::INW, 0, 4096, 512);
        k_attn_stats<<<dim3(S / 256, 4), 256, 0, st>>>(B.p, B.stats);
        k_attn_pv<<<dim3(S / 256, 16), 256, 0, st>>>(B.p, B.stats, B.lam, B.o);
        k_headnorm<<<S * 4 / 256, 256, 0, st>>>(B.o, (const float*)d_in[9], B.ao);
        dbg::cmp(st, tab, 9, ws + WS_AO, 1, (size_t)b * 4096, 1024, 0, 0, 1.f, B.ao, 0, 1024, 0, 4096, 512);
        k_conv<<<S * 512 / 256, 256, 0, st>>>(B.p, 0, S, (const float*)d_in[10], (const float*)d_in[11], B.uc);
        k_conv<<<CT * 512 / 256, 256, 0, st>>>(B.p, S, CT, (const float*)d_in[10], (const float*)d_in[11], B.uc);
        k_gates<<<2 * T * 512 / 256, 256, 0, st>>>(B.uc, (const float*)d_in[12], (const float*)d_in[13], (const float*)d_in[14], B.av, B.bv);
        k_scan<<<4, 256, 0, st>>>(B.av, B.bv, B.hs);
        k_ylru<<<S * 512 / 256, 256, 0, st>>>(B.hs, B.p, B.ao);
        dbg::cmp(st, tab, 10, ws + WS_AO, 1, (size_t)b * 4096, 1024, 512, 0, 1.f, B.ao, 0, 1024, 512, 4096, 512);
        k_gemm<<<dim3(D / 64, S / 64), 256, 0, st>>>(B.ao, (const float*)d_in[15], B.y, S, D, D);
        dbg::cmp(st, tab, 11, ws + WS_Y, 1, (size_t)b * 4096, 1024, 0, 0, 1.f, B.y, 0, 1024, 0, 4096, 1024);
        k_lnres<<<S, 256, 0, st>>>(x, B.y, mod + 2048, (const float*)d_in[16], (const float*)d_in[17], B.x1);
        dbg::cmp(st, tab, 12, out, 0, (size_t)b * 4096, 1024, 0, 0, 1.f, B.x1, 0, 1024, 0, 4096, 1024);
        k_lnmod<<<S, 256, 0, st>>>(B.x1, mod + 3072, mod + 4096, B.h2);
        dbg::cmp(st, tab, 13, ws + WS_XN, 1, (size_t)b * 4096, 1024, 0, 0, 1.f, B.h2, 0, 1024, 0, 4096, 1024);
    }
}
#endif
extern "C" void kernel_launch(void* const* d_in, const int* in_sizes, int n_in, void* d_out, int out_size, void* d_ws, size_t ws_size, hipStream_t stream) {
    static int grid = 0;
    if (grid == 0) {
        if (n_in != 22 || out_size != MLAT * DM || ws_size < (DBG ? (size_t)1012 * MiB : WS_END)) { fprintf(stderr, "kernel_launch: unexpected shapes / workspace (n_in %d out %d ws %zu)\n", n_in, out_size, ws_size); grid = -1; return; }
        int dev = 0, cus = 0, per_cu = 0;
        if (hipGetDevice(&dev) != hipSuccess || hipDeviceGetAttribute(&cus, hipDeviceAttributeMultiprocessorCount, dev) != hipSuccess) { grid = -1; return; }
        if (hipFuncSetAttribute((const void*)mk_fwd, hipFuncAttributeMaxDynamicSharedMemorySize, LDS_BYTES) != hipSuccess) { fprintf(stderr, "kernel_launch: hipFuncSetAttribute failed\n"); grid = -1; return; }
        if (hipOccupancyMaxActiveBlocksPerMultiprocessor(&per_cu, (const void*)mk_fwd, NWAVES * 64, LDS_BYTES) != hipSuccess || per_cu < 1) { fprintf(stderr, "kernel_launch: occupancy query says %d blocks/CU; nothing launched\n", per_cu); (void)hipGetLastError(); grid = -1; return; }
        grid = cus;
    }
    if (grid < 0) return;
    (void)hipMemsetAsync((char*)d_ws + WS_CTL, 0, CTL_ZERO_BYTES, stream);
    Args a{};
    for (int i = 0; i < 22; ++i) a.in[i] = (const float*)d_in[i];
    a.out = (float*)d_out; a.ws = (unsigned char*)d_ws;
#if DBG
    if (N_LAUNCHES == PER_PHASE) { for (int li = 0; li < 7; ++li) { a.ph_lo = li; a.ph_hi = li + 1; a.li = 0; hipLaunchKernelGGL(mk_fwd, dim3(grid), dim3(NWAVES * 64), LDS_BYTES, stream, a); } }
    else { a.ph_lo = 0; a.ph_hi = 7; a.li = 0; hipLaunchKernelGGL(mk_fwd, dim3(grid), dim3(NWAVES * 64), LDS_BYTES, stream, a); }
    dbg_run(d_in, (float*)d_out, (unsigned char*)d_ws, stream);
    if (N_LAUNCHES == PER_PHASE) { for (int li = 7; li < PER_PHASE; ++li) { a.ph_lo = li; a.ph_hi = li + 1; a.li = 0; hipLaunchKernelGGL(mk_fwd, dim3(grid), dim3(NWAVES * 64), LDS_BYTES, stream, a); } }
    else { a.ph_lo = 7; a.ph_hi = PER_PHASE; a.li = 1; hipLaunchKernelGGL(mk_fwd, dim3(grid), dim3(NWAVES * 64), LDS_BYTES, stream, a); }
    dbg::k_verdict<<<(unsigned)(((size_t)MLAT * DM + 255) / 256), 256, 0, stream>>>((const float*)((unsigned char*)d_ws + WS_DBGTAB), (float*)d_out, (size_t)MLAT * DM);
#else
    if (N_LAUNCHES == PER_PHASE) { for (int li = 0; li < PER_PHASE; ++li) { a.ph_lo = li; a.ph_hi = li + 1; a.li = 0; hipLaunchKernelGGL(mk_fwd, dim3(grid), dim3(NWAVES * 64), LDS_BYTES, stream, a); } }
    else { a.ph_lo = 0; a.ph_hi = PER_PHASE; a.li = 0; hipLaunchKernelGGL(mk_fwd, dim3(grid), dim3(NWAVES * 64), LDS_BYTES, stream, a); }
#endif
    const hipError_t le = hipPeekAtLastError();
    if (le != hipSuccess) fprintf(stderr, "kernel_launch: launch failed: %s\n", hipGetErrorName(le));
}
```

```cpp
#include <hip/hip_runtime.h>
#include <hip/hip_bf16.h>
#include <cstdio>
#include <cstdint>
#include <cmath>
#define DBG 0
#define MK_N_LAUNCHES 1
#define FP8_FFN 2

namespace pg8 {
#define PG8_LAS __attribute__((address_space(3)))
typedef unsigned short bf16_t;
typedef short bf16x8 __attribute__((ext_vector_type(8)));
typedef float f32x4 __attribute__((ext_vector_type(4)));
typedef unsigned u32x4 __attribute__((ext_vector_type(4)));
constexpr int BM = 256, BK = 64, HALF = 128, HTB = HALF * BK * 2  , STAGE_BYTES = 8 * HTB, NXCD = 8, WGM = 8;

__host__ __device__ __forceinline__ int lds_byte(int r, int c) { const int st = (r >> 4) * 2 + (c >> 5), rr = r & 15, cc = c & 31, ob = rr * 64 + cc * 2; return st * 1024 + (ob ^ (((ob >> 9) & 1) << 5)); }
__host__ __device__ __forceinline__ void stage_rc(int b, int& R, int& C) { const int st = b / 1024, sb = b % 1024, swz = sb ^ (((sb >> 9) & 1) << 5); R = (st >> 1) * 16 + swz / 64; C = (st & 1) * 32 + (swz % 64) / 2; }
__host__ __device__ __forceinline__ int perm32(int rho) { const int n = rho >> 4, i = rho & 15; return 8 * (i >> 2) + 4 * n + (i & 3); }

struct Unit { int pm, pn; };
struct Gemm { const bf16_t* A; const bf16_t* Bt; int M, N, K; };

struct StaticOrder {
    int nM, nN, nwg, G, c;
    __host__ __device__ void init(int M, int N, int G_, int c_) { nM = M / BM; nN = N / BM; nwg = nM * nN; G = G_; c = c_; }
    __host__ __device__ bool next(int i, Unit& u) const {
        const long L = (long)i * G + c; if (L >= nwg) return false;
        int wgid = (int)L; { const int q = nwg / NXCD, r = nwg % NXCD, xcd = wgid % NXCD, off = wgid / NXCD; wgid = (xcd < r ? xcd * (q + 1) : r * (q + 1) + (xcd - r) * q) + off; }
        const int nig = WGM * nN, gid = wgid / nig, fm = gid * WGM, gsz = (nM - fm) < WGM ? (nM - fm) : WGM;
        u.pm = fm + ((wgid % nig) % gsz); u.pn = (wgid % nig) / gsz; return true;
    }
    __device__ __forceinline__ void a_ready(const Unit&) const {}
    __device__ __forceinline__ void done(const Unit&) const {}
    __device__ __forceinline__ void ab(const Unit& u, const Gemm& g, size_t tstep, const char*& pa, const char*& pb) const { pa = (const char*)g.A + (size_t)u.pm * tstep; pb = (const char*)g.Bt + (size_t)u.pn * tstep; }
};

__device__ __forceinline__ unsigned cvt_pk_bf16(float lo, float hi) { unsigned r; asm volatile("v_cvt_pk_bf16_f32 %0, %1, %2" : "=v"(r) : "v"(lo), "v"(hi)); return r; }
typedef float f32x2 __attribute__((ext_vector_type(2)));
__device__ __forceinline__ f32x2 gelu_pk(f32x2 v) {
    const f32x2 av = __builtin_elementwise_abs(v), d = av * 0.2316418882f + 1.0f;
    f32x2 t; t.x = __builtin_amdgcn_rcpf(d.x); t.y = __builtin_amdgcn_rcpf(d.y);
    f32x2 q = t * 0.5307027145f + (-0.7265760135f); q = q * t + 0.7107068705f; q = q * t + (-0.142248368f); q = q * t + 0.127414796f; q = q * t;
    const f32x2 s = (v * v) * (-0.72134752044f);
    f32x2 e; e.x = __builtin_amdgcn_exp2f(s.x); e.y = __builtin_amdgcn_exp2f(s.y);
    const f32x2 m = v * (q * e), r = v - m;
    f32x2 o; o.x = v.x < 0.f ? m.x : r.x; o.y = v.y < 0.f ? m.y : r.y; return o;
}

template <int ACT  > struct EpiBf16 {
    static constexpr bool PERM = true, AFTER_DRAIN = false; static_assert(ACT == 0 || ACT == 1, "EpiBf16: ACT is 0 (none) or 1 (gelu_pk)");
    bf16_t* O; int ldc; const float* bias; int split_cols; size_t split_stride; float scale0;
    __device__ __forceinline__ void operator()(const f32x4 (&acc)[2][2][4][2], const Unit& u, int wr, int wc, int fr, int fq) const {
        const int row0 = u.pm * BM + wr * 64 + fr; int colt = u.pn * BM; bf16_t* base = O;
        float sc = 1.f; if (split_cols) { const int t = colt / split_cols; base += (size_t)t * split_stride; colt -= t * split_cols; if (t == 0) sc = scale0; }
        const int col0 = colt + wc * 32 + 8 * fq, bcol0 = u.pn * BM + wc * 32 + 8 * fq;
        f32x4 bv[2][2];
#pragma unroll
        for (int bj = 0; bj < 2; ++bj)
#pragma unroll
            for (int n = 0; n < 2; ++n) bv[bj][n] = bias ? *(const f32x4*)(bias + bcol0 + bj * HALF + 4 * n) : (f32x4){0.f, 0.f, 0.f, 0.f};
#pragma unroll
        for (int ai = 0; ai < 2; ++ai)
#pragma unroll
            for (int m = 0; m < 4; ++m) { bf16_t* rowp = base + (size_t)(row0 + ai * HALF + m * 16) * ldc + col0;
#pragma unroll
                for (int bj = 0; bj < 2; ++bj) { f32x4 v0 = acc[ai][bj][m][0] + bv[bj][0], v1 = acc[ai][bj][m][1] + bv[bj][1];
                    if (ACT == 1) { f32x2 a = gelu_pk((f32x2){v0[0], v0[1]}), b = gelu_pk((f32x2){v0[2], v0[3]}), c = gelu_pk((f32x2){v1[0], v1[1]}), d = gelu_pk((f32x2){v1[2], v1[3]});
                        v0 = (f32x4){a.x, a.y, b.x, b.y}; v1 = (f32x4){c.x, c.y, d.x, d.y}; }
                    v0 = v0 * sc; v1 = v1 * sc; u32x4 w; w.x = cvt_pk_bf16(v0[0], v0[1]); w.y = cvt_pk_bf16(v0[2], v0[3]); w.z = cvt_pk_bf16(v1[0], v1[1]); w.w = cvt_pk_bf16(v1[2], v1[3]);
                    *(u32x4*)(rowp + bj * HALF) = w; } }
    }
};

struct PanelStats {
    unsigned* xbuf;
    unsigned* cnt;
    unsigned* tmo;
    int ntn; float eps;
    unsigned code;
    __device__ __forceinline__ bool run(const f32x4 (&v)[2][2][4][2], const Unit& u, int wr, int wc, int fr, int fq, PG8_LAS unsigned char* lds, int wid, int lane) const {
        typedef float f32x2v __attribute__((ext_vector_type(2)));
        PG8_LAS f32x2v* P = (PG8_LAS f32x2v*)lds;
        PG8_LAS f32x2v* S = (PG8_LAS f32x2v*)(lds + 8192);
        PG8_LAS unsigned* flag = (PG8_LAS unsigned*)(lds + 8192 + 2048);
#pragma unroll
        for (int ai = 0; ai < 2; ++ai)
#pragma unroll
            for (int m = 0; m < 4; ++m) {
                float s = 0.f;
#pragma unroll
                for (int bj = 0; bj < 2; ++bj)
#pragma unroll
                    for (int n = 0; n < 2; ++n) { const f32x4 x = v[ai][bj][m][n]; s += (x[0] + x[1]) + (x[2] + x[3]); }
                s += __shfl_xor(s, 16); s += __shfl_xor(s, 32);
                const float mw = s * (1.0f / 64.0f); float q = 0.f;
#pragma unroll
                for (int bj = 0; bj < 2; ++bj)
#pragma unroll
                    for (int n = 0; n < 2; ++n) { const f32x4 d = v[ai][bj][m][n] - mw; q += (d[0] * d[0] + d[1] * d[1]) + (d[2] * d[2] + d[3] * d[3]); }
                q += __shfl_xor(q, 16); q += __shfl_xor(q, 32);
                if (fq == 0) P[(ai * HALF + wr * 64 + m * 16 + fr) * 4 + wc] = (f32x2v){mw, q};
            }
        asm volatile("s_waitcnt lgkmcnt(0)" ::: "memory"); __builtin_amdgcn_s_barrier(); asm volatile("" ::: "memory");
#if defined(BROKEN_EXCHANGE_NO_WAIT)
#warning BROKEN CONTROL BUILD: the row-statistics exchange does not wait; results are wrong by design
        if (blockIdx.x >= 64) { const long long t0_ = clock64(); while (clock64() - t0_ < 60000) __builtin_amdgcn_s_sleep(8); }
#endif
        const int row = wid * 32 + (lane & 31);
        if (lane < 32) {
            const f32x2v a = P[row * 4 + 0], b = P[row * 4 + 1], c = P[row * 4 + 2], d = P[row * 4 + 3];
            const float mt = (a.x + b.x + c.x + d.x) * 0.25f;
            const float da = a.x - mt, db = b.x - mt, dc = c.x - mt, dd = d.x - mt;
            const float m2 = (a.y + b.y) + (c.y + d.y) + 64.0f * ((da * da + db * db) + (dc * dc + dd * dd));
            unsigned long long* slot = (unsigned long long*)xbuf + ((size_t)(u.pm * BM + row) * 4 + u.pn);
            __hip_atomic_store(slot, ((unsigned long long)__float_as_uint(m2) << 32) | __float_as_uint(mt), __ATOMIC_RELAXED, __HIP_MEMORY_SCOPE_AGENT);
        }
        asm volatile("s_waitcnt vmcnt(0)" ::: "memory");
        if (lane == 0) __hip_atomic_fetch_add(cnt + 64 * u.pm, 1u, __ATOMIC_RELAXED, __HIP_MEMORY_SCOPE_AGENT);
        if (wid == 0) {
            bool dead = false; const unsigned long long t0 = __builtin_amdgcn_s_memrealtime(); const unsigned want = 8u * (unsigned)ntn;
            for (;;) {
#if defined(BROKEN_EXCHANGE_NO_WAIT)
                break;
#endif
                if ((unsigned)__builtin_amdgcn_readfirstlane(__hip_atomic_load(cnt + 64 * u.pm, __ATOMIC_RELAXED, __HIP_MEMORY_SCOPE_AGENT)) >= want) break;
                if (__builtin_amdgcn_s_memrealtime() - t0 > 2000000ull) {
                    if (lane == 0) { unsigned expect = 0u; __hip_atomic_compare_exchange_strong(tmo + 1, &expect, code | (unsigned)(u.pm & 0xff), __ATOMIC_RELAXED, __ATOMIC_RELAXED, __HIP_MEMORY_SCOPE_AGENT);
                                     __hip_atomic_store(tmo, 1u, __ATOMIC_RELAXED, __HIP_MEMORY_SCOPE_AGENT); }
                    dead = true; break; }
                __builtin_amdgcn_s_sleep(2);
            }
            __builtin_amdgcn_fence(__ATOMIC_ACQUIRE, "agent");
            if (lane == 0) flag[0] = dead ? 1u : 0u;
        }
        asm volatile("s_waitcnt vmcnt(0) lgkmcnt(0)" ::: "memory"); __builtin_amdgcn_s_barrier(); asm volatile("" ::: "memory");
        const bool bad = flag[0] != 0u;
        if (lane < 32) {
            const unsigned long long* slot = (const unsigned long long*)xbuf + (size_t)(u.pm * BM + row) * 4; float mt[4], m2[4]; float ms = 0.f;
#pragma unroll
            for (int t = 0; t < 4; ++t) { if (t < ntn) { const unsigned long long w = __hip_atomic_load(slot + t, __ATOMIC_RELAXED, __HIP_MEMORY_SCOPE_AGENT); mt[t] = __uint_as_float((unsigned)w); m2[t] = __uint_as_float((unsigned)(w >> 32)); } else { mt[t] = 0.f; m2[t] = 0.f; } ms += mt[t]; }
            const float mean = ms / (float)ntn; float q = 0.f;
#pragma unroll
            for (int t = 0; t < 4; ++t) if (t < ntn) { const float dm = mt[t] - mean; q += m2[t] + 256.0f * dm * dm; }
            S[row] = (f32x2v){mean, 1.0f / sqrtf(q / (256.0f * (float)ntn) + eps)};
        }
        asm volatile("s_waitcnt lgkmcnt(0)" ::: "memory"); __builtin_amdgcn_s_barrier(); asm volatile("" ::: "memory");
        return bad;
    }
};
struct EpiLnRes {
    static constexpr bool PERM = false, AFTER_DRAIN = true;
    const float* base; float* out; int ldc; const float* bias; PanelStats st; unsigned poison;
    __device__ __forceinline__ void fused(f32x4 (&acc)[2][2][4][2], const Unit& u, int wr, int wc, int fr, int fq, PG8_LAS unsigned char* lds, int wid, int lane) const {
        typedef float f32x2v __attribute__((ext_vector_type(2)));
        const PG8_LAS f32x2v* S = (const PG8_LAS f32x2v*)(lds + 8192);
        const int col0 = u.pn * BM + wc * 32 + 4 * fq;
#pragma unroll
        for (int bj = 0; bj < 2; ++bj)
#pragma unroll
            for (int n = 0; n < 2; ++n) { const f32x4 bv = bias ? *(const f32x4*)(bias + col0 + bj * HALF + n * 16) : (f32x4){0.f, 0.f, 0.f, 0.f};
#pragma unroll
                for (int ai = 0; ai < 2; ++ai)
#pragma unroll
                    for (int m = 0; m < 4; ++m) acc[ai][bj][m][n] += bv; }
        f32x4 pre[4][2][2];
#pragma unroll
        for (int m = 0; m < 4; ++m) { const size_t off = (size_t)(u.pm * BM + wr * 64 + m * 16 + fr) * ldc + col0;
#pragma unroll
            for (int bj = 0; bj < 2; ++bj)
#pragma unroll
                for (int n = 0; n < 2; ++n) pre[m][bj][n] = *(const f32x4*)(base + off + bj * HALF + n * 16); }
        const bool bad = st.run(acc, u, wr, wc, fr, fq, lds, wid, lane) || poison != 0u;
        const float qnan = __builtin_nanf("");
#pragma unroll
        for (int ai = 0; ai < 2; ++ai)
#pragma unroll
            for (int m = 0; m < 4; ++m) { const int r = ai * HALF + wr * 64 + m * 16 + fr; const f32x2v sr = S[r]; const size_t off = (size_t)(u.pm * BM + r) * ldc + col0;
#pragma unroll
                for (int bj = 0; bj < 2; ++bj)
#pragma unroll
                    for (int n = 0; n < 2; ++n) { const f32x4 bs = ai == 0 ? pre[m][bj][n] : *(const f32x4*)(base + off + bj * HALF + n * 16); f32x4 o = bs + (acc[ai][bj][m][n] - sr.x) * sr.y;
                        if (bad) o = (f32x4){qnan, qnan, qnan, qnan}; *(f32x4*)(out + off + bj * HALF + n * 16) = o; }
                if (m & 1) asm volatile("" ::: "memory"); }
    }
};
struct EpiLnResLn {
    static constexpr bool PERM = false, AFTER_DRAIN = true;
    const float* base; float* out; bf16_t* xn; int ldc; const float* bias; PanelStats st1, st2; unsigned poison;
    __device__ __forceinline__ void fused(f32x4 (&acc)[2][2][4][2], const Unit& u, int wr, int wc, int fr, int fq, PG8_LAS unsigned char* lds, int wid, int lane) const {
        typedef float f32x2v __attribute__((ext_vector_type(2))); typedef unsigned u32x2v __attribute__((ext_vector_type(2)));
        const PG8_LAS f32x2v* S = (const PG8_LAS f32x2v*)(lds + 8192);
        const int col0 = u.pn * BM + wc * 32 + 4 * fq;
#pragma unroll
        for (int bj = 0; bj < 2; ++bj)
#pragma unroll
            for (int n = 0; n < 2; ++n) { const f32x4 bv = bias ? *(const f32x4*)(bias + col0 + bj * HALF + n * 16) : (f32x4){0.f, 0.f, 0.f, 0.f};
#pragma unroll
                for (int ai = 0; ai < 2; ++ai)
#pragma unroll
                    for (int m = 0; m < 4; ++m) acc[ai][bj][m][n] += bv; }
        bool bad = st1.run(acc, u, wr, wc, fr, fq, lds, wid, lane) || poison != 0u;
        const float qnan = __builtin_nanf("");
#pragma unroll
        for (int ai = 0; ai < 2; ++ai)
#pragma unroll
            for (int m = 0; m < 4; ++m) { const int r = ai * HALF + wr * 64 + m * 16 + fr; const f32x2v sr = S[r]; const size_t off = (size_t)(u.pm * BM + r) * ldc + col0;
#pragma unroll
                for (int bj = 0; bj < 2; ++bj)
#pragma unroll
                    for (int n = 0; n < 2; ++n) { const f32x4 bs = *(const f32x4*)(base + off + bj * HALF + n * 16); acc[ai][bj][m][n] = bs + (acc[ai][bj][m][n] - sr.x) * sr.y; }
                asm volatile("" : "+v"(acc[ai][0][m][0]), "+v"(acc[ai][0][m][1]), "+v"(acc[ai][1][m][0]), "+v"(acc[ai][1][m][1]));
                if (m & 1) asm volatile("" ::: "memory"); }
        const bool bad1 = bad;
        bad = st2.run(acc, u, wr, wc, fr, fq, lds, wid, lane) || bad;
#pragma unroll
        for (int ai = 0; ai < 2; ++ai)
#pragma unroll
            for (int m = 0; m < 4; ++m) { const int r = ai * HALF + wr * 64 + m * 16 + fr; const f32x2v sr = S[r]; const size_t off = (size_t)(u.pm * BM + r) * ldc + col0;
#pragma unroll
                for (int bj = 0; bj < 2; ++bj)
#pragma unroll
                    for (int n = 0; n < 2; ++n) { const f32x4 x1 = acc[ai][bj][m][n]; *(f32x4*)(out + off + bj * HALF + n * 16) = bad1 ? (f32x4){qnan, qnan, qnan, qnan} : x1;
                        const f32x4 o = (x1 - sr.x) * sr.y; u32x2v w; w.x = cvt_pk_bf16(o[0], o[1]); w.y = cvt_pk_bf16(o[2], o[3]);
                        if (bad) { w.x = 0x7fc07fc0u; w.y = 0x7fc07fc0u; } *(u32x2v*)(xn + off + bj * HALF + n * 16) = w; }
                asm volatile("" ::: "memory"); }
    }
};

typedef int i32x8 __attribute__((ext_vector_type(8)));
typedef int i32x4 __attribute__((ext_vector_type(4)));
template <class Epi, class Sched, bool ALIGN_EPI = false, bool SP2 = false, bool F8 = false>
__device__ __forceinline__ void gemm_phase(PG8_LAS unsigned char* lds, const Gemm g, const Sched& S, const Epi& E) {
    const int tid = threadIdx.x, wid = __builtin_amdgcn_readfirstlane(tid >> 6), lane = tid & 63, wr = wid >> 2, wc = wid & 3, fr = lane & 15, fq = lane >> 4;
    const int K = g.K, nt = K / BK;
    unsigned voffA[2], voffB[2];
#pragma unroll
    for (int i = 0; i < 2; ++i) { int R, C; stage_rc(tid * 16 + i * 8192, R, C); const int Rb = Epi::PERM ? ((R & ~31) + perm32(R & 31)) : R;
        voffA[i] = (unsigned)(R * K + C) * 2u; voffB[i] = (unsigned)(Rb * K + C) * 2u; }
    const size_t kstep = (size_t)(BK * 2);
    const size_t hstep = (size_t)HALF * K * 2;
    const size_t tstep = 2 * hstep;
    const unsigned ldsw = (unsigned)wid * 1024u;
    const int aoff = lds_byte(wr * 64 + fr, F8 ? fq * 16 : fq * 8), boff = lds_byte(wc * 32 + fr, F8 ? fq * 16 : fq * 8);
#define PG8_SA(b, h) (((b) * 2 + (h)) * HTB)
#define PG8_SB(b, h) ((4 + (b) * 2 + (h)) * HTB)
#define PG8_STAGE(bufoff, gbase, voff) do { _Pragma("unroll") for (int _i = 0; _i < 2; ++_i) \
        __builtin_amdgcn_global_load_lds((const unsigned*)((const char*)(gbase) + (voff)[_i]), (PG8_LAS unsigned*)(lds + (bufoff) + ldsw + _i * 8192), 16, 0, 0); } while (0)
#define PG8_LD32(p) __builtin_shufflevector(*(const PG8_LAS i32x4*)((p) + f8o1), *(const PG8_LAS i32x4*)((p) + f8o2), 0, 1, 2, 3, 4, 5, 6, 7)
#define PG8_LDA(dst, b, h) do { if constexpr (F8) { _Pragma("unroll") for (int m = 0; m < 4; ++m) dst##8[m] = PG8_LD32(lds + PG8_SA(b, h) + aoff + m * 2048); } \
        else { _Pragma("unroll") for (int m = 0; m < 4; ++m) _Pragma("unroll") for (int k = 0; k < 2; ++k) dst[m][k] = *(const PG8_LAS bf16x8*)(lds + PG8_SA(b, h) + aoff + m * 2048 + k * 1024); } } while (0)
#define PG8_LDB(dst, b, h) do { if constexpr (F8) { _Pragma("unroll") for (int n = 0; n < 2; ++n) dst##8[n] = PG8_LD32(lds + PG8_SB(b, h) + boff + n * 2048); } \
        else { _Pragma("unroll") for (int n = 0; n < 2; ++n) _Pragma("unroll") for (int k = 0; k < 2; ++k) dst[n][k] = *(const PG8_LAS bf16x8*)(lds + PG8_SB(b, h) + boff + n * 2048 + k * 1024); } } while (0)
#define PG8_MMA(ai, bj, At, Bt) do { __builtin_amdgcn_s_setprio(1); if constexpr (F8) { _Pragma("unroll") for (int m = 0; m < 4; ++m) _Pragma("unroll") for (int n = 0; n < 2; ++n) \
        asm volatile("v_mfma_scale_f32_16x16x128_f8f6f4 %0, %1, %2, %0, %3, %3 op_sel_hi:[0,0,0]" : "+v"(acc[ai][bj][m][n]) : "v"(Bt##8[n]), "v"(At##8[m]), "v"(sc1_)); } \
        else { _Pragma("unroll") for (int m = 0; m < 4; ++m) _Pragma("unroll") for (int n = 0; n < 2; ++n) _Pragma("unroll") for (int k = 0; k < 2; ++k) \
        acc[ai][bj][m][n] = __builtin_amdgcn_mfma_f32_16x16x32_bf16(Bt[n][k], At[m][k], acc[ai][bj][m][n], 0, 0, 0); } __builtin_amdgcn_s_setprio(0); } while (0)
#define PG8_WAIT_V(n) asm volatile("s_waitcnt vmcnt(" #n ")" ::: "memory")
#define PG8_WAIT_L(n) asm volatile("s_waitcnt lgkmcnt(" #n ")" ::: "memory")
#define PG8_BAR __builtin_amdgcn_s_barrier()
#define PG8_SCHED __builtin_amdgcn_sched_barrier(0)
    Unit cur, nxt; int ui = 0;
    if (!S.next(0, cur)) return;
    f32x4 acc[2][2][4][2];
#pragma unroll
    for (int a = 0; a < 2; ++a)
#pragma unroll
        for (int b = 0; b < 2; ++b)
#pragma unroll
            for (int m = 0; m < 4; ++m)
#pragma unroll
                for (int n = 0; n < 2; ++n) acc[a][b][m][n] = (f32x4){0.f, 0.f, 0.f, 0.f};
    bf16x8 At[4][2], B0[2][2], B1[2][2]; i32x8 At8[4], B08[2], B18[2];
    const int f8o1 = (fq & 1) * 16, f8o2 = 16 - f8o1;
    int sc1_ = 0x7f7f7f7f; asm volatile("" : "+v"(sc1_));
    const char* cA; const char* cB; S.ab(cur, g, tstep, cA, cB);
    S.a_ready(cur);
    if constexpr (SP2) {
        PG8_STAGE(PG8_SB(0, 0), cB, voffB); PG8_STAGE(PG8_SB(0, 1), cB + hstep, voffB); PG8_STAGE(PG8_SA(0, 0), cA, voffA); PG8_STAGE(PG8_SA(0, 1), cA + hstep, voffA);
        if (wr == 1) PG8_BAR;
        PG8_WAIT_V(2); PG8_BAR;
        PG8_STAGE(PG8_SB(1, 0), cB + kstep, voffB); PG8_STAGE(PG8_SA(1, 0), cA + kstep, voffA); PG8_STAGE(PG8_SB(1, 1), cB + hstep + kstep, voffB);
        PG8_WAIT_V(6); PG8_BAR;
    } else {
        PG8_STAGE(PG8_SB(0, 0), cB, voffB); PG8_STAGE(PG8_SA(0, 0), cA, voffA); PG8_STAGE(PG8_SB(0, 1), cB + hstep, voffB); PG8_STAGE(PG8_SA(0, 1), cA + hstep, voffA);
        if (wr == 1) PG8_BAR;
        PG8_WAIT_V(4); PG8_BAR;
        PG8_STAGE(PG8_SB(1, 0), cB + kstep, voffB); PG8_STAGE(PG8_SA(1, 0), cA + kstep, voffA); PG8_STAGE(PG8_SB(1, 1), cB + hstep + kstep, voffB);
        PG8_WAIT_V(6); PG8_BAR;
    }
    for (;;) {
        const bool has_next = S.next(ui + 1, nxt);
        const char* nA = cA; const char* nB = cB; if (has_next) S.ab(nxt, g, tstep, nA, nB);
        for (int t = 0; t < nt; t += 2) {
            const bool last = (t == nt - 2);
            const char* a1 = cA + (size_t)(t + 1) * kstep;
            const char* a2 = last ? nA : cA + (size_t)(t + 2) * kstep; const char* b2 = last ? nB : cB + (size_t)(t + 2) * kstep;
            const char* a3 = a2 + kstep; const char* b3 = b2 + kstep;
            if (last && has_next) S.a_ready(nxt);
            if constexpr (SP2) {
            PG8_LDB(B0, 0, 0); PG8_LDB(B1, 0, 1); PG8_SCHED; PG8_LDA(At, 0, 0); PG8_STAGE(PG8_SA(1, 1), a1 + hstep, voffA);
            PG8_WAIT_V(8); PG8_WAIT_L(0); PG8_BAR; PG8_MMA(0, 0, At, B0); PG8_MMA(0, 1, At, B1); PG8_BAR; PG8_SCHED;
            PG8_LDA(At, 0, 1); PG8_STAGE(PG8_SB(0, 0), b2, voffB); PG8_STAGE(PG8_SB(0, 1), b2 + hstep, voffB); PG8_STAGE(PG8_SA(0, 0), a2, voffA);
            PG8_WAIT_V(8); PG8_WAIT_L(0); PG8_BAR; PG8_MMA(1, 0, At, B0); PG8_MMA(1, 1, At, B1); PG8_BAR; PG8_SCHED;
            PG8_LDB(B0, 1, 0); PG8_LDB(B1, 1, 1); PG8_SCHED; PG8_LDA(At, 1, 0); PG8_STAGE(PG8_SA(0, 1), a2 + hstep, voffA);
            PG8_WAIT_V(8); PG8_WAIT_L(0); PG8_BAR; PG8_MMA(0, 0, At, B0); PG8_MMA(0, 1, At, B1); PG8_BAR; PG8_SCHED;
            PG8_LDA(At, 1, 1); PG8_STAGE(PG8_SB(1, 0), b3, voffB); PG8_STAGE(PG8_SB(1, 1), b3 + hstep, voffB); PG8_STAGE(PG8_SA(1, 0), a3, voffA);
            PG8_WAIT_V(8); PG8_WAIT_L(0); PG8_BAR; PG8_MMA(1, 0, At, B0); PG8_MMA(1, 1, At, B1); PG8_BAR; PG8_SCHED;
            } else {
            PG8_LDB(B0, 0, 0); PG8_SCHED; PG8_LDA(At, 0, 0); PG8_STAGE(PG8_SA(1, 1), a1 + hstep, voffA);
            PG8_WAIT_L(8); PG8_BAR; PG8_WAIT_L(0); PG8_MMA(0, 0, At, B0); PG8_BAR; PG8_SCHED;
            PG8_LDB(B1, 0, 1); PG8_STAGE(PG8_SB(0, 0), b2, voffB);
            PG8_BAR; PG8_WAIT_L(0); PG8_MMA(0, 1, At, B1); PG8_BAR;
            PG8_LDA(At, 0, 1); PG8_STAGE(PG8_SA(0, 0), a2, voffA);
            PG8_BAR; PG8_WAIT_L(0); PG8_MMA(1, 0, At, B0); PG8_BAR; PG8_SCHED;
            PG8_STAGE(PG8_SB(0, 1), b2 + hstep, voffB);
            PG8_WAIT_V(6); PG8_BAR; PG8_MMA(1, 1, At, B1); PG8_BAR;
            PG8_LDB(B0, 1, 0); PG8_SCHED; PG8_LDA(At, 1, 0); PG8_STAGE(PG8_SA(0, 1), a2 + hstep, voffA);
            PG8_WAIT_L(8); PG8_BAR; PG8_WAIT_L(0); PG8_MMA(0, 0, At, B0); PG8_BAR; PG8_SCHED;
            PG8_LDB(B1, 1, 1); PG8_STAGE(PG8_SB(1, 0), b3, voffB);
            PG8_BAR; PG8_WAIT_L(0); PG8_MMA(0, 1, At, B1); PG8_BAR;
            PG8_LDA(At, 1, 1); PG8_STAGE(PG8_SA(1, 0), a3, voffA);
            PG8_BAR; PG8_WAIT_L(0); PG8_MMA(1, 0, At, B0); PG8_BAR; PG8_SCHED;
            PG8_STAGE(PG8_SB(1, 1), b3 + hstep, voffB);
            PG8_WAIT_V(6); PG8_BAR; PG8_MMA(1, 1, At, B1); PG8_BAR;
            }
        }
        if constexpr (F8) { asm volatile("s_nop 15\n\ts_nop 15" ::: "memory"); __builtin_amdgcn_sched_barrier(0); }
        if constexpr (ALIGN_EPI) { if (wr == 0) PG8_BAR; }
        if constexpr (!Epi::AFTER_DRAIN) { E(acc, cur, wr, wc, fr, fq); S.done(cur); }
        if (!has_next) break;
#pragma unroll
        for (int a = 0; a < 2; ++a)
#pragma unroll
            for (int b = 0; b < 2; ++b)
#pragma unroll
                for (int m = 0; m < 4; ++m)
#pragma unroll
                    for (int n = 0; n < 2; ++n) acc[a][b][m][n] = (f32x4){0.f, 0.f, 0.f, 0.f};
        cur = nxt; cA = nA; cB = nB; ++ui;
        if constexpr (ALIGN_EPI) { if (wr == 1) PG8_BAR; }
    }
    PG8_WAIT_V(0);
    if constexpr (!ALIGN_EPI) { if (wr == 0) PG8_BAR; }
    PG8_BAR;
    if constexpr (Epi::AFTER_DRAIN) { E.fused(acc, cur, wr, wc, fr, fq, lds, wid, lane); S.done(cur); }
#undef PG8_SA
#undef PG8_SB
#undef PG8_STAGE
#undef PG8_LDA
#undef PG8_LD32
#undef PG8_LDB
#undef PG8_MMA
#undef PG8_WAIT_V
#undef PG8_WAIT_L
#undef PG8_BAR
#undef PG8_SCHED
}
}

namespace pg8 {
constexpr float QK_C2 = 0.125f * 1.4426950408889634f;
__device__ __forceinline__ unsigned pk_fp8x4(float a, float b, float c, float d);
struct InProjOrder {
    static constexpr int NM = 272, NN = 8, NMAIN = NM * NN, NALL = NMAIN + 2 * NM;
    int G, c;
    __host__ __device__ void init(int G_, int c_) { G = G_; c = c_; }
    __host__ __device__ bool next(int i, Unit& u) const {
        const long L = (long)i * G + c; if (L >= NALL) return false;
        if (L < NMAIN) { int wgid = (int)L; { const int q = NMAIN / NXCD, xcd = wgid % NXCD, off = wgid / NXCD; wgid = xcd * q + off; }
            const int nig = WGM * NN, gid = wgid / nig, fm = gid * WGM, gsz = (NM - fm) < WGM ? (NM - fm) : WGM;
            u.pm = fm + ((wgid % nig) % gsz); u.pn = (wgid % nig) / gsz; }
        else { const int v = (int)L - NMAIN; u.pm = v >> 1; u.pn = 8 + (v & 1); }
        return true;
    }
    __device__ __forceinline__ void a_ready(const Unit&) const {}
    __device__ __forceinline__ void done(const Unit&) const {}
    __device__ __forceinline__ void ab(const Unit& u, const Gemm& g, size_t tstep, const char*& pa, const char*& pb) const {
        if (u.pn < 8) { pa = (const char*)g.A + (size_t)u.pm * tstep; pb = (const char*)g.Bt + (size_t)u.pn * tstep; }
        else { pa = (const char*)g.Bt + (size_t)u.pn * tstep; pb = (const char*)g.A + (size_t)u.pm * tstep; }
    }
};
struct EpiInProj {
    static constexpr bool PERM = true, AFTER_DRAIN = false;
    bf16_t *Q, *Kb, *VT, *Ub, *Gb; unsigned char* VT8; const PG8_LAS float* ropec; const PG8_LAS float* ropes;
    __device__ __forceinline__ void operator()(const f32x4 (&acc)[2][2][4][2], const Unit& u, int wr, int wc, int fr, int fq) const {
        const bool ctx = u.pm >= 256;
        if (u.pn >= 8) {
            const int tok0 = u.pm * BM + wc * 32 + 8 * fq;
#pragma unroll
            for (int bj = 0; bj < 2; ++bj) { const int tok = tok0 + bj * HALF; int bidx, key;
                if (ctx) { bidx = (tok - 65536) >> 8; key = 4096 + ((tok - 65536) & 255); } else { bidx = tok >> 12; key = tok & 4095; }
#pragma unroll
                for (int ai = 0; ai < 2; ++ai)
#pragma unroll
                    for (int m = 0; m < 4; ++m) { const int dim = (u.pn - 8) * BM + ai * HALF + wr * 64 + m * 16 + fr;
                        const f32x4 v0 = acc[ai][bj][m][0], v1 = acc[ai][bj][m][1];
                        u32x4 w; w.x = cvt_pk_bf16(v0[0], v0[1]); w.y = cvt_pk_bf16(v0[2], v0[3]); w.z = cvt_pk_bf16(v1[0], v1[1]); w.w = cvt_pk_bf16(v1[2], v1[3]);
                        *(u32x4*)(VT + ((size_t)(bidx * 512 + dim)) * 4352 + key) = w;
                        typedef unsigned u32x2v __attribute__((ext_vector_type(2))); u32x2v w8; w8.x = pk_fp8x4(v0[0], v0[1], v0[2], v0[3]); w8.y = pk_fp8x4(v1[0], v1[1], v1[2], v1[3]);
                        *(u32x2v*)(VT8 + ((size_t)(bidx * 512 + dim)) * 4352 + key) = w8; } }
            return;
        }
        const int seg = u.pn >> 1;
        if (ctx && (seg == 0 || seg == 3)) return;
        const int cs0 = (u.pn & 1) * BM + wc * 32 + 8 * fq;
        const bool rope = (seg < 2) && !ctx; const int a = wc & 1;
#pragma unroll
        for (int ai = 0; ai < 2; ++ai)
#pragma unroll
            for (int m = 0; m < 4; ++m) {
                const int r = u.pm * BM + ai * HALF + wr * 64 + m * 16 + fr;
                int bidx, s; size_t rowkv;
                if (ctx) { bidx = (r - 65536) >> 8; s = (r - 65536) & 255; rowkv = (size_t)bidx * 4352 + 4096 + s; }
                else { bidx = r >> 12; s = r & 4095; rowkv = (size_t)bidx * 4352 + s; }
                f32x4 cs = (f32x4){1.f, 1.f, 1.f, 1.f}, sn = (f32x4){0.f, 0.f, 0.f, 0.f};
                if (rope) { const int pos = a ? (s & 63) : (s >> 6); cs = *(const PG8_LAS f32x4*)(ropec + pos * 16 + 4 * fq); sn = *(const PG8_LAS f32x4*)(ropes + pos * 16 + 4 * fq); }
                bf16_t* dst;
                if (seg == 0) dst = Q + (size_t)r * 512; else if (seg == 1) dst = Kb + rowkv * 512; else if (seg == 2) dst = Ub + (size_t)r * 512; else dst = Gb + (size_t)r * 512;
#pragma unroll
                for (int bj = 0; bj < 2; ++bj) {
                    f32x4 v0 = acc[ai][bj][m][0], v1 = acc[ai][bj][m][1];
                    if (rope) { const f32x4 o1 = v0 * cs - v1 * sn, o2 = v1 * cs + v0 * sn; v0 = o1; v1 = o2; }
                    if (seg == 0) { v0 = v0 * QK_C2; v1 = v1 * QK_C2; }
                    u32x4 w; w.x = cvt_pk_bf16(v0[0], v0[1]); w.y = cvt_pk_bf16(v0[2], v0[3]); w.z = cvt_pk_bf16(v1[0], v1[1]); w.w = cvt_pk_bf16(v1[2], v1[3]);
                    *(u32x4*)(dst + cs0 + bj * HALF) = w;
                }
            }
    }
};
__device__ __forceinline__ unsigned pk_fp8x4(float a, float b, float c, float d) {
    a = __builtin_amdgcn_fmed3f(a, -448.f, 448.f); b = __builtin_amdgcn_fmed3f(b, -448.f, 448.f); c = __builtin_amdgcn_fmed3f(c, -448.f, 448.f); d = __builtin_amdgcn_fmed3f(d, -448.f, 448.f);
    int w = 0; w = __builtin_amdgcn_cvt_pk_fp8_f32(a, b, w, false); w = __builtin_amdgcn_cvt_pk_fp8_f32(c, d, w, true); return (unsigned)w; }
template <bool OUT8> struct EpiSwiglu {
    static constexpr bool PERM = true, AFTER_DRAIN = false;
    bf16_t* H; int ldh; float ascale, oscale;
    __device__ __forceinline__ void operator()(const f32x4 (&acc)[2][2][4][2], const Unit& u, int wr, int wc, int fr, int fq) const {
        const int col0 = u.pn * HALF + wc * 32 + 8 * fq;
#pragma unroll
        for (int ai = 0; ai < 2; ++ai)
#pragma unroll
            for (int m = 0; m < 4; ++m) {
                const size_t r = (size_t)u.pm * BM + ai * HALF + wr * 64 + m * 16 + fr;
                float o[8];
#pragma unroll
                for (int n = 0; n < 2; ++n)
#pragma unroll
                    for (int j = 0; j < 4; ++j) { const float av = acc[ai][0][m][n][j] * ascale, bv = acc[ai][1][m][n][j] * ascale;
                        const float sg = __builtin_amdgcn_rcpf(1.f + __builtin_amdgcn_exp2f(-av * 1.4426950408889634f)); o[4 * n + j] = av * sg * bv; }
                if constexpr (OUT8) { typedef unsigned u32x2v __attribute__((ext_vector_type(2)));
                    u32x2v w; w.x = pk_fp8x4(o[0] * oscale, o[1] * oscale, o[2] * oscale, o[3] * oscale); w.y = pk_fp8x4(o[4] * oscale, o[5] * oscale, o[6] * oscale, o[7] * oscale);
                    *(u32x2v*)((unsigned char*)H + r * ldh + col0) = w;
                } else { u32x4 w; w.x = cvt_pk_bf16(o[0], o[1]); w.y = cvt_pk_bf16(o[2], o[3]); w.z = cvt_pk_bf16(o[4], o[5]); w.w = cvt_pk_bf16(o[6], o[7]);
                    *(u32x4*)(H + r * ldh + col0) = w; }
            }
    }
};
struct EpiPlain {
    static constexpr bool PERM = true, AFTER_DRAIN = false;
    bf16_t* O; int ldc; float scale;
    __device__ __forceinline__ void operator()(const f32x4 (&acc)[2][2][4][2], const Unit& u, int wr, int wc, int fr, int fq) const {
        const int col0 = u.pn * BM + wc * 32 + 8 * fq;
#pragma unroll
        for (int ai = 0; ai < 2; ++ai)
#pragma unroll
            for (int m = 0; m < 4; ++m) {
                bf16_t* rowp = O + ((size_t)u.pm * BM + ai * HALF + wr * 64 + m * 16 + fr) * ldc + col0;
#pragma unroll
                for (int bj = 0; bj < 2; ++bj) { const f32x4 v0 = acc[ai][bj][m][0] * scale, v1 = acc[ai][bj][m][1] * scale;
                    u32x4 w; w.x = cvt_pk_bf16(v0[0], v0[1]); w.y = cvt_pk_bf16(v0[2], v0[3]); w.z = cvt_pk_bf16(v1[0], v1[1]); w.w = cvt_pk_bf16(v1[2], v1[3]);
                    *(u32x4*)(rowp + bj * HALF) = w; }
            }
    }
};
}

#ifndef ATT_F8MAP1
#define ATT_F8MAP1 1
#endif
namespace att {
typedef short bf16x8 __attribute__((ext_vector_type(8)));
typedef short s16x4 __attribute__((ext_vector_type(4)));
typedef short v4i16_t __attribute__((ext_vector_type(4)));
typedef float f32x16 __attribute__((ext_vector_type(16)));
typedef float f32x4 __attribute__((ext_vector_type(4)));
typedef unsigned u32x4 __attribute__((ext_vector_type(4)));
#define ATT_LAS __attribute__((address_space(3)))
typedef ATT_LAS const char* lds_cptr;
constexpr int TKV = 4352, NT = TKV / 64, NS = 3, KSLOT = 8192, VSLOT = 16384;
constexpr int LDS_K = 0, LDS_V = NS * KSLOT, LDS_SCR = LDS_V + 4 * VSLOT, LDS_FLG = LDS_SCR + 8 * 256, LDS_END = LDS_FLG + 64;
constexpr size_t PARK_FLOATS = 64 * 512;
__device__ __forceinline__ int crow(int r, int hi) { return (r & 3) + 8 * (r >> 2) + 4 * hi; }
__device__ __forceinline__ void glds16(const void* gsrc, unsigned lds_dst) { unsigned keep;
    asm volatile("s_mov_b32 %0, m0\n\ts_mov_b32 m0, %2\n\ts_nop 0\n\tglobal_load_lds_dwordx4 %1, off\n\ts_mov_b32 m0, %0" : "=&s"(keep) : "v"(gsrc), "s"(lds_dst) : "memory"); }
__device__ __forceinline__ void glds16s(const void* sbase, unsigned voff, unsigned lds_dst) { unsigned keep;
    asm volatile("s_mov_b32 %0, m0\n\ts_mov_b32 m0, %3\n\ts_nop 0\n\tglobal_load_lds_dwordx4 %1, %2\n\ts_mov_b32 m0, %0" : "=&s"(keep) : "v"(voff), "s"(sbase), "s"(lds_dst) : "memory"); }
typedef float f32x2_t __attribute__((ext_vector_type(2))); typedef __bf16 bf16x2_t __attribute__((ext_vector_type(2)));
__device__ __forceinline__ unsigned cvtpk(float lo, float hi) { f32x2_t v = {lo, hi}; bf16x2_t b = __builtin_convertvector(v, bf16x2_t); return __builtin_bit_cast(unsigned, b); }
__device__ __forceinline__ s16x4 vtr(lds_cptr p) { return __builtin_bit_cast(s16x4, __builtin_amdgcn_ds_read_tr16_b64_v4i16((ATT_LAS v4i16_t*)p)); }
__device__ __forceinline__ bf16x8 ldsb128(lds_cptr p) { return *(const ATT_LAS bf16x8*)p; }
#define ATT_SB() __builtin_amdgcn_sched_barrier(0)
#define ATT_WAITBAR(N) asm volatile("s_waitcnt vmcnt(" #N ") lgkmcnt(0)\n\ts_barrier" ::: "memory")

typedef int i32x8 __attribute__((ext_vector_type(8)));
typedef int i32x4 __attribute__((ext_vector_type(4)));
template <int MODE, bool F8>
__device__ __forceinline__ void attn_pass(int m, const short* Qw, const short* Kh, const short* Vh, const unsigned char* V8h, char* shm, f32x16 (&o)[4], float& l, float& mx) {
    const int tid = threadIdx.x, lane = tid & 63, r32 = lane & 31, hi = lane >> 5; const int wid = __builtin_amdgcn_readfirstlane(tid >> 6);
    const bool late = wid >= 4;
    const unsigned lds0 = (unsigned)(uintptr_t)shm;
    const short* kbase = Kh + m * 64 + wid * 8;
    const unsigned koff = (unsigned)lane * 1024u;
    const int vd_ = F8 ? 16 * wid + (lane >> 2) : 8 * wid + (lane >> 3);
    const short* vbase = F8 ? (const short*)(V8h + (size_t)(16 * wid) * TKV) : Vh + (size_t)(8 * wid) * TKV;
    const unsigned voff = F8 ? (unsigned)((lane >> 2) * TKV + (((lane & 3) ^ ((vd_ >> 2) & 3)) * 16)) : (unsigned)((lane >> 3) * TKV + (((lane & 7) ^ ((vd_ >> 1) & 7)) * 8)) * 2u;
    const unsigned kdst = lds0 + LDS_K + wid * 1024, vdst = lds0 + LDS_V + wid * 1024;
#define ATT_DMAK(t, slot) glds16s((const void*)(kbase + (size_t)(t) * 64 * 512), koff, (unsigned)__builtin_amdgcn_readfirstlane(kdst + (slot)))
#define ATT_DMAV(t, slot) do { if (F8) { glds16s((const void*)((const char*)vbase + (size_t)(t) * 64), voff, (unsigned)__builtin_amdgcn_readfirstlane(vdst + (slot))); } \
        else { const short* vs_ = vbase + (size_t)(t) * 64; glds16s((const void*)vs_, voff, (unsigned)__builtin_amdgcn_readfirstlane(vdst + (slot))); glds16s((const void*)(vs_ + (size_t)64 * TKV), voff, (unsigned)__builtin_amdgcn_readfirstlane(vdst + (slot) + 8192)); } } while (0)
    const lds_cptr shm3 = (lds_cptr)shm;
    const int kpi_ = F8 ? (32 * ((r32 >> 2) & 1) + (r32 & 3) + 4 * (r32 >> 3)) : ((r32 & ~12) | ((r32 & 4) << 1) | ((r32 & 8) >> 1));
    constexpr int KB_OFF = F8 ? 256 : 512;
    const lds_cptr kp0 = shm3 + LDS_K + hi * 1024 + kpi_ * 16;
    const int vf_ = (r32 >> 1) & 7;
    const lds_cptr vq0 = shm3 + LDS_V + r32 * 128 + (((0 + hi) ^ vf_) << 4), vq1 = shm3 + LDS_V + r32 * 128 + (((2 + hi) ^ vf_) << 4);
    const lds_cptr vq2 = shm3 + LDS_V + r32 * 128 + (((4 + hi) ^ vf_) << 4), vq3 = shm3 + LDS_V + r32 * 128 + (((6 + hi) ^ vf_) << 4);
    const lds_cptr v8a = shm3 + LDS_V + r32 * 64 + (((2 * hi) ^ ((r32 >> 2) & 3)) << 4), v8b = shm3 + LDS_V + r32 * 64 + (((2 * hi + 1) ^ ((r32 >> 2) & 3)) << 4);
    int sc1_ = 0x7f7f7f7f, scp_ = 0x82828282; asm volatile("" : "+v"(sc1_), "+v"(scp_));
    bf16x8 qr[4];
#pragma unroll
    for (int d0 = 0; d0 < 4; ++d0) qr[d0] = *(const bf16x8*)(Qw + (size_t)r32 * 512 + m * 64 + d0 * 16 + hi * 8);
    asm volatile("" : "+v"(qr[0]), "+v"(qr[1]), "+v"(qr[2]), "+v"(qr[3]) :: "memory");
    constexpr int NV = F8 ? 1 : 2;
    ATT_DMAK(0, 0); ATT_DMAV(0, 0); ATT_DMAK(1, KSLOT); ATT_DMAK(2, 2 * KSLOT); ATT_DMAV(1, VSLOT);
#pragma unroll
    for (int i = 0; i < 4; ++i) o[i] = f32x16{};
    l = 0.f; float nmx = -INFINITY;
    if (NV == 2) ATT_WAITBAR(3); else ATT_WAITBAR(2);
    bf16x8 ka0, ka1, ka2, ka3, kb0, kb1, kb2, kb3;
#define ATT_LOADK(slot) do { const lds_cptr kp_ = kp0 + (slot); ka0 = ldsb128(kp_); kb0 = ldsb128(kp_ + KB_OFF); ka1 = ldsb128(kp_ + 2048); kb1 = ldsb128(kp_ + 2048 + KB_OFF); \
        ka2 = ldsb128(kp_ + 4096); kb2 = ldsb128(kp_ + 4096 + KB_OFF); ka3 = ldsb128(kp_ + 6144); kb3 = ldsb128(kp_ + 6144 + KB_OFF); } while (0)
    ATT_LOADK(0);
    if (NV == 2) ATT_WAITBAR(3); else ATT_WAITBAR(2);
    int ksl = 0, vsl = 0;
    bf16x8 p0, p1, p2, p3;
    p0 = p1 = p2 = p3 = (bf16x8){0, 0, 0, 0, 0, 0, 0, 0};
#define ATT_VLD(dst, db, ks) dst = ldsb128(vq##ks + vsl_ + (db) * 4096)
#define ATT_MF(acc, a, b) acc = __builtin_amdgcn_mfma_f32_32x32x16_bf16(a, b, acc, 0, 0, 0)
#define ATT_X(HASNEXT, ksn_) do { \
        f32x16 sa = f32x16{}, sb = f32x16{}; \
        ATT_MF(sa, ka0, qr[0]); ATT_MF(sb, kb0, qr[0]); ATT_MF(sa, ka1, qr[1]); ATT_MF(sb, kb1, qr[1]); \
        ATT_MF(sa, ka2, qr[2]); ATT_MF(sb, kb2, qr[2]); ATT_MF(sa, ka3, qr[3]); ATT_MF(sb, kb3, qr[3]); \
        ATT_SB(); \
          \
        if (t + 3 < NT) ATT_DMAK(t + 3, ksl); \
        if (MODE != 1) { if (t + 2 < NT) { const int v2 = (vsl >= 2 * VSLOT) ? vsl - 2 * VSLOT : vsl + 2 * VSLOT; ATT_DMAV(t + 2, v2); } } \
        ATT_SB(); \
        if (HASNEXT) ATT_LOADK(ksn_); \
        if (MODE == 1) { \
            _Pragma("unroll") for (int r = 0; r < 16; ++r) nmx = fmaxf(nmx, fmaxf(sa[r], sb[r])); \
        } else { \
            float sum = 0.f; \
            _Pragma("unroll") for (int r = 0; r < 16; ++r) { sa[r] = __builtin_amdgcn_exp2f(MODE == 2 ? sa[r] - mx : sa[r]); sb[r] = __builtin_amdgcn_exp2f(MODE == 2 ? sb[r] - mx : sb[r]); sum += sa[r] + sb[r]; } \
            l += sum; \
            if (F8) { i32x8 w8_; \
                _Pragma("unroll") for (int j = 0; j < 4; ++j) { int w_ = 0; w_ = __builtin_amdgcn_cvt_pk_fp8_f32(__builtin_fminf(sa[4 * j] * 0.125f, 448.f), __builtin_fminf(sa[4 * j + 1] * 0.125f, 448.f), w_, false); \
                    w_ = __builtin_amdgcn_cvt_pk_fp8_f32(__builtin_fminf(sa[4 * j + 2] * 0.125f, 448.f), __builtin_fminf(sa[4 * j + 3] * 0.125f, 448.f), w_, true); w8_[j] = w_; } \
                _Pragma("unroll") for (int j = 0; j < 4; ++j) { int w_ = 0; w_ = __builtin_amdgcn_cvt_pk_fp8_f32(__builtin_fminf(sb[4 * j] * 0.125f, 448.f), __builtin_fminf(sb[4 * j + 1] * 0.125f, 448.f), w_, false); \
                    w_ = __builtin_amdgcn_cvt_pk_fp8_f32(__builtin_fminf(sb[4 * j + 2] * 0.125f, 448.f), __builtin_fminf(sb[4 * j + 3] * 0.125f, 448.f), w_, true); w8_[4 + j] = w_; } \
                p0 = __builtin_bit_cast(bf16x8, __builtin_shufflevector(w8_, w8_, 0, 1, 2, 3)); p1 = __builtin_bit_cast(bf16x8, __builtin_shufflevector(w8_, w8_, 4, 5, 6, 7)); \
            } else { \
            u32x4 w0, w1, w2, w3; \
            w0.x = cvtpk(sa[0], sa[1]); w0.y = cvtpk(sa[2], sa[3]); w0.z = cvtpk(sa[4], sa[5]); w0.w = cvtpk(sa[6], sa[7]); \
            w1.x = cvtpk(sa[8], sa[9]); w1.y = cvtpk(sa[10], sa[11]); w1.z = cvtpk(sa[12], sa[13]); w1.w = cvtpk(sa[14], sa[15]); \
            w2.x = cvtpk(sb[0], sb[1]); w2.y = cvtpk(sb[2], sb[3]); w2.z = cvtpk(sb[4], sb[5]); w2.w = cvtpk(sb[6], sb[7]); \
            w3.x = cvtpk(sb[8], sb[9]); w3.y = cvtpk(sb[10], sb[11]); w3.z = cvtpk(sb[12], sb[13]); w3.w = cvtpk(sb[14], sb[15]); \
            p0 = __builtin_bit_cast(bf16x8, w0); p1 = __builtin_bit_cast(bf16x8, w1); p2 = __builtin_bit_cast(bf16x8, w2); p3 = __builtin_bit_cast(bf16x8, w3); } \
        } \
        ATT_SB(); } while (0)
#define ATT_LD32(dst, db) dst = __builtin_shufflevector(*(const ATT_LAS i32x4*)(v8a + vsl_ + (db) * 2048), *(const ATT_LAS i32x4*)(v8b + vsl_ + (db) * 2048), 0, 1, 2, 3, 4, 5, 6, 7)
#define ATT_MF8(acc, vfrag) asm volatile("s_nop 1\n\tv_mfma_scale_f32_32x32x64_f8f6f4 %0, %1, %2, %0, %3, %4 op_sel_hi:[0,0,0]" : "+v"(acc) : "v"(pp8_), "v"(vfrag), "v"(scp_), "v"(sc1_))
#define ATT_Y8(vslx) do { const int vsl_ = (vslx); i32x8 wa, wb, wc, wd; const i32x8 pp8_ = __builtin_shufflevector(__builtin_bit_cast(i32x4, p0), __builtin_bit_cast(i32x4, p1), 0, 1, 2, 3, 4, 5, 6, 7); \
        ATT_LD32(wa, 0); ATT_LD32(wb, 1); ATT_SB(); ATT_LD32(wc, 2); ATT_LD32(wd, 3); ATT_SB(); \
        ATT_MF8(o[0], wa); ATT_MF8(o[1], wb); ATT_SB(); ATT_MF8(o[2], wc); ATT_MF8(o[3], wd); ATT_SB(); } while (0)
#define ATT_YB(vslx) do { const int vsl_ = (vslx); bf16x8 va, vb, vc, vd, ve, vf, vg, vh;     \
        ATT_VLD(va, 0, 0); ATT_VLD(vb, 0, 1); ATT_VLD(vc, 0, 2); ATT_VLD(vd, 0, 3); ATT_SB(); \
        ATT_VLD(ve, 1, 0); ATT_VLD(vf, 1, 1); ATT_VLD(vg, 1, 2); ATT_VLD(vh, 1, 3); ATT_SB(); \
        ATT_MF(o[0], p0, va); ATT_MF(o[0], p1, vb); ATT_MF(o[0], p2, vc); ATT_MF(o[0], p3, vd); ATT_SB(); \
        ATT_VLD(va, 2, 0); ATT_VLD(vb, 2, 1); ATT_VLD(vc, 2, 2); ATT_VLD(vd, 2, 3); ATT_SB(); \
        ATT_MF(o[1], p0, ve); ATT_MF(o[1], p1, vf); ATT_MF(o[1], p2, vg); ATT_MF(o[1], p3, vh); ATT_SB(); \
        ATT_VLD(ve, 3, 0); ATT_VLD(vf, 3, 1); ATT_VLD(vg, 3, 2); ATT_VLD(vh, 3, 3); ATT_SB(); \
        ATT_MF(o[2], p0, va); ATT_MF(o[2], p1, vb); ATT_MF(o[2], p2, vc); ATT_MF(o[2], p3, vd); ATT_SB(); \
        ATT_MF(o[3], p0, ve); ATT_MF(o[3], p1, vf); ATT_MF(o[3], p2, vg); ATT_MF(o[3], p3, vh); ATT_SB(); } while (0)
#define ATT_Y(vslx) do { if (F8) ATT_Y8(vslx); else ATT_YB(vslx); } while (0)
#pragma unroll 1
    for (int t = 0; t < NT; ++t) {
        const int ksn = (ksl == 2 * KSLOT) ? 0 : ksl + KSLOT;
        const int vprev = (vsl == 0) ? 3 * VSLOT : vsl - VSLOT;
        if (MODE != 1) { if (late && t >= 1) ATT_Y(vprev); }
        ATT_X(true, ksn);
        if (MODE != 1) { if (!late) ATT_Y(vsl); }
        if (MODE != 1) { if (NV == 2) { if (t + 3 < NT) ATT_WAITBAR(3); else if (t + 2 < NT) ATT_WAITBAR(2); else ATT_WAITBAR(0); }
                         else { if (t + 3 < NT) ATT_WAITBAR(2); else if (t + 2 < NT) ATT_WAITBAR(1); else ATT_WAITBAR(0); } }
        else { if (t + 3 < NT) ATT_WAITBAR(1); else ATT_WAITBAR(0); }
        ksl = ksn; vsl = (vsl == 3 * VSLOT) ? 0 : vsl + VSLOT;
    }
    if (MODE != 1) { if (late) { const int vprev = (vsl == 0) ? 3 * VSLOT : vsl - VSLOT; ATT_Y(vprev); } ATT_WAITBAR(0); }
    if (F8) { asm volatile("s_nop 15\n\ts_nop 15" ::: "memory"); __builtin_amdgcn_sched_barrier(0); }
    if (MODE == 1) mx = fmaxf(nmx, __shfl_xor(nmx, 32));
#undef ATT_X
#undef ATT_Y
#undef ATT_YB
#undef ATT_Y8
#undef ATT_MF8
#undef ATT_LD32
#undef ATT_MF
#undef ATT_VLD
#undef ATT_LOADK
#undef ATT_DMAK
#undef ATT_DMAV
}

template <int MODE>
__device__ __forceinline__ bool attn_unit(int b, int h, int qb, const short* Q, const short* K, const short* V, const unsigned char* V8, short* AO, const float* subg, float lam, float* park, char* shm) {
    const int tid = threadIdx.x, lane = tid & 63, r32 = lane & 31, hi = lane >> 5; const int wid = __builtin_amdgcn_readfirstlane(tid >> 6);
    ATT_LAS float* scr = (ATT_LAS float*)((ATT_LAS char*)shm + LDS_SCR) + wid * 64;
    volatile ATT_LAS unsigned* flgp = (volatile ATT_LAS unsigned*)((ATT_LAS char*)shm + LDS_FLG);
    const size_t qrow = (size_t)b * 4096 + qb * 256 + wid * 32;
    const short* Qw = Q + qrow * 512 + h * 128; const short* Kh = K + (size_t)b * TKV * 512 + h * 128; const short* Vh = V + (size_t)(b * 4 + h) * 128 * TKV; const unsigned char* V8h = V8 + (size_t)(b * 4 + h) * 128 * TKV;
    if (tid == 0) *flgp = 0u;
    f32x16 o[4]; float l, mx = 0.f; bool bad = false;
    if (MODE == 2) { float dummy; attn_pass<1, false>(0, Qw, Kh, Vh, V8h, shm, o, dummy, mx); }
    attn_pass<(MODE == 2 ? 2 : 0), false>(0, Qw, Kh, Vh, V8h, shm, o, l, mx);
    l += __shfl_xor(l, 32); bad = bad || !(l > 0.f && l < 3.0e38f);
    if (hi == 0) scr[r32] = l;
    asm volatile("s_waitcnt lgkmcnt(0)" ::: "memory");
    {   float* pk = park + (size_t)tid * 64;
#pragma unroll
        for (int g = 0; g < 4; ++g) { float il[4];
#pragma unroll
            for (int e = 0; e < 4; ++e) il[e] = __builtin_amdgcn_rcpf(scr[crow(4 * g + e, hi)]);
#pragma unroll
            for (int db = 0; db < 4; ++db) *(f32x4*)(pk + db * 16 + 4 * g) = (f32x4){o[db][4 * g] * il[0], o[db][4 * g + 1] * il[1], o[db][4 * g + 2] * il[2], o[db][4 * g + 3] * il[3]}; } }
    if (MODE == 2) { float dummy; attn_pass<1, false>(1, Qw, Kh, Vh, V8h, shm, o, dummy, mx); }
    attn_pass<(MODE == 2 ? 2 : 0), (MODE == 0) && (ATT_F8MAP1 != 0)>(1, Qw, Kh, Vh, V8h, shm, o, l, mx);
    l += __shfl_xor(l, 32); bad = bad || !(l > 0.f && l < 3.0e38f);
    if (hi == 0) scr[32 + r32] = l;
    asm volatile("s_waitcnt lgkmcnt(0)" ::: "memory");
    float ss[16];
    {   const float* pk = park + (size_t)tid * 64;
#pragma unroll
        for (int r = 0; r < 16; ++r) ss[r] = 0.f;
#pragma unroll
        for (int g = 0; g < 4; ++g) { float il[4];
#pragma unroll
            for (int e = 0; e < 4; ++e) il[e] = lam * __builtin_amdgcn_rcpf(scr[32 + crow(4 * g + e, hi)]);
#pragma unroll
            for (int db = 0; db < 4; ++db) { const f32x4 pv = *(const f32x4*)(pk + db * 16 + 4 * g);
#pragma unroll
                for (int e = 0; e < 4; ++e) { const float v = pv[e] - o[db][4 * g + e] * il[e]; o[db][4 * g + e] = v; ss[4 * g + e] += v * v; } } } }
#pragma unroll
    for (int off = 1; off < 32; off <<= 1)
#pragma unroll
        for (int r = 0; r < 16; ++r) ss[r] += __shfl_xor(ss[r], off);
    float gv[4];
#pragma unroll
    for (int db = 0; db < 4; ++db) gv[db] = subg[32 * db + r32] * 0.8f;
    short* aow = AO + qrow * 1024 + h * 128 + r32;
#pragma unroll
    for (int r = 0; r < 16; ++r) { const float rs = __builtin_amdgcn_rsqf(ss[r] * (1.f / 128.f) + 1e-5f);
#pragma unroll
        for (int db = 0; db < 4; ++db) { const unsigned w = cvtpk(o[db][r] * rs * gv[db], 0.f); aow[(size_t)crow(r, hi) * 1024 + 32 * db] = (short)(w & 0xffffu); } }
    if (MODE == 0) { if (__any(bad)) { if (lane == 0) *flgp = 1u; } }
    asm volatile("s_waitcnt vmcnt(0) lgkmcnt(0)\n\ts_barrier" ::: "memory");
    const unsigned flg = *flgp;
    asm volatile("s_waitcnt lgkmcnt(0)\n\ts_barrier" ::: "memory");
    return __builtin_amdgcn_readfirstlane(flg) != 0u;
}
__device__ __forceinline__ void attn_unit_safe(int b, int h, int qb, const short* Q, const short* K, const short* V, const unsigned char* V8, short* AO, const float* subg, float lam, float* park, char* shm, bool force_fallback) {
    const bool redo = attn_unit<0>(b, h, qb, Q, K, V, V8, AO, subg, lam, park, shm);
    if (redo || force_fallback) (void)attn_unit<2>(b, h, qb, Q, K, V, V8, AO, subg, lam, park, shm);
}
}

namespace lru2 {
typedef short bf16x8 __attribute__((ext_vector_type(8)));
typedef float f32x16 __attribute__((ext_vector_type(16)));
typedef float f32x4 __attribute__((ext_vector_type(4)));
typedef float f32x2 __attribute__((ext_vector_type(2)));
#define LRU2_LAS __attribute__((address_space(3)))
constexpr int TS = 144, TILE = 64 * TS;
constexpr int LDS_TILE = 0, LDS_COMP = 8 * TILE, LDS_CW = LDS_COMP + 2 * 8 * 32 * 8, LDS_BF = LDS_CW + 5 * 64 * 4, LDS_END = LDS_BF + 8192;
__device__ __forceinline__ int crow(int r, int hi) { return (r & 3) + 8 * (r >> 2) + 4 * hi; }
__device__ __forceinline__ float bf2f(unsigned short v) { return __uint_as_float((unsigned)v << 16); }
__device__ __forceinline__ unsigned short f2bf(float f) { unsigned u = __float_as_uint(f); return (unsigned short)((u + 0x7fffu + ((u >> 16) & 1u)) >> 16); }
constexpr float L2E = 1.4426950408889634f;

__device__ __forceinline__ void lru_unit(int b, int w, int nb, const unsigned short* U, const unsigned short* G, const float* convw, const float* convb, const unsigned short* WgT, const float* bg,
                                         const float* sp8, float* HS, unsigned short* AO, LRU2_LAS unsigned char* lds) {
    const int tid = threadIdx.x, lane = tid & 63, r32 = lane & 31, hi = lane >> 5; const int k = __builtin_amdgcn_readfirstlane(tid >> 6);
    LRU2_LAS unsigned char* tile = lds + LDS_TILE + k * TILE;
    LRU2_LAS f32x2* comp = (LRU2_LAS f32x2*)(lds + LDS_COMP);
    const int chn = 64 * w + 32 * nb + r32;
    const int cg = lane & 7, tg = lane >> 3;
    LRU2_LAS float* cw = (LRU2_LAS float*)(lds + LDS_CW);
    if (tid < 320) { const int jj = tid >> 6, c = tid & 63; cw[tid] = jj < 4 ? convw[jj * 512 + 64 * w + c] : convb[64 * w + c]; }
    __syncthreads();
#pragma unroll 1
    for (int dir = 0; dir < 2; ++dir) {
        { const int fi = tid >> 5, o32 = tid & 31;
            const int g = fi >> 3, ks = (fi >> 1) & 3, hi2 = fi & 1;
            *(LRU2_LAS bf16x8*)(lds + LDS_BF + fi * 512 + o32 * 16) = *(const bf16x8*)(WgT + ((size_t)(((dir * 2 + g) * 8 + w) * 64 + 32 * nb + o32)) * 64 + 16 * ks + 8 * hi2); }
        __syncthreads();
        const float br = bg[((dir * 2 + 0) * 8 + w) * 64 + 32 * nb + r32], bi = bg[((dir * 2 + 1) * 8 + w) * 64 + 32 * nb + r32], sp = sp8[dir * 512 + chn];
        float cround = 0.f;
        bf16x8 uu[11];
#define LRU2_CHUNK(p_, chunk_, isctx_, L_, s0_, rowbase_) const int chunk_ = dir == 0 ? (p_) : ((p_) < 4 ? 3 - (p_) : 71 - (p_)); const bool isctx_ = chunk_ < 4; \
        const int L_ = isctx_ ? 256 : 4096, s0_ = isctx_ ? 64 * chunk_ : 64 * (chunk_ - 4); const size_t rowbase_ = isctx_ ? (size_t)65536 + (size_t)b * 256 : (size_t)b * 4096
#define LRU2_LOADU(p_) do { if ((p_) < 68) { LRU2_CHUNK(p_, ch_, ic_, L_, s0_, rb_); _Pragma("unroll") for (int i = 0; i < 11; ++i) { const int s = s0_ + 8 * tg - 2 + i; uu[i] = (bf16x8){0, 0, 0, 0, 0, 0, 0, 0}; \
            if (s >= 0 && s < L_) uu[i] = *(const bf16x8*)(U + (rb_ + s) * 512 + 64 * w + 8 * cg); } } } while (0)
        LRU2_LOADU(k);
#pragma unroll 1
        for (int rd = 0; rd < 9; ++rd) {
            const int p = 8 * rd + k; const bool valid = p < 68;
            LRU2_CHUNK(p, chunk, isctx, L, s0, rowbase);
            (void)L;
            f32x16 z[2][2];
            float atot = 1.f, cend = 0.f, cst[8];
            if (valid) {
                {
                    float wv[4][8], bv[8];
#pragma unroll
                    for (int jj = 0; jj < 4; ++jj) { const f32x4 a = *(const LRU2_LAS f32x4*)(cw + jj * 64 + 8 * cg), c = *(const LRU2_LAS f32x4*)(cw + jj * 64 + 8 * cg + 4);
                        wv[jj][0] = a.x; wv[jj][1] = a.y; wv[jj][2] = a.z; wv[jj][3] = a.w; wv[jj][4] = c.x; wv[jj][5] = c.y; wv[jj][6] = c.z; wv[jj][7] = c.w; }
                    { const f32x4 a = *(const LRU2_LAS f32x4*)(cw + 256 + 8 * cg), c = *(const LRU2_LAS f32x4*)(cw + 256 + 8 * cg + 4); bv[0] = a.x; bv[1] = a.y; bv[2] = a.z; bv[3] = a.w; bv[4] = c.x; bv[5] = c.y; bv[6] = c.z; bv[7] = c.w; }
#pragma unroll
                    for (int tt = 0; tt < 8; ++tt) { bf16x8 o;
#pragma unroll
                        for (int e = 0; e < 8; ++e) { float acc = bv[e];
#pragma unroll
                            for (int jj = 0; jj < 4; ++jj) acc += wv[jj][e] * bf2f((unsigned short)uu[tt + jj][e]);
                            o[e] = (short)f2bf(acc); }
                        *(LRU2_LAS bf16x8*)(tile + (8 * tg + tt) * TS + cg * 16) = o; }
                }
                LRU2_LOADU(p + 8);
                asm volatile("s_waitcnt lgkmcnt(0)" ::: "memory");
#pragma unroll
                for (int g = 0; g < 2; ++g)
#pragma unroll
                    for (int tb = 0; tb < 2; ++tb) { z[g][tb] = f32x16{};
#pragma unroll
                        for (int ks = 0; ks < 4; ++ks) z[g][tb] = __builtin_amdgcn_mfma_f32_32x32x16_bf16(*(const LRU2_LAS bf16x8*)(tile + (32 * tb + r32) * TS + (16 * ks + 8 * hi) * 2), *(const LRU2_LAS bf16x8*)(lds + LDS_BF + ((g * 4 + ks) * 2 + hi) * 512 + r32 * 16), z[g][tb], 0, 0, 0); }
#pragma unroll
                for (int tb = 0; tb < 2; ++tb)
#pragma unroll
                    for (int r = 0; r < 16; ++r) {
                        const float rg = __builtin_amdgcn_rcpf(1.f + __builtin_amdgcn_exp2f(-(z[0][tb][r] + br) * L2E));
                        const float ig = __builtin_amdgcn_rcpf(1.f + __builtin_amdgcn_exp2f(-(z[1][tb][r] + bi) * L2E));
                        const float a = __builtin_amdgcn_exp2f(-rg * sp);
                        const float mult = __builtin_amdgcn_sqrtf(fabsf(1.f - a * a));
                        z[0][tb][r] = a; z[1][tb][r] = mult * ig * bf2f(*(const LRU2_LAS unsigned short*)(tile + (32 * tb + crow(r, hi)) * TS + (32 * nb + r32) * 2));
                    }
                __builtin_amdgcn_sched_barrier(0);
            }
            float Ao[8], Bo[8], Ax[8], Bx[8];
            if (valid) {
#pragma unroll
                for (int q = 0; q < 8; ++q) { const int tb = q >> 2, rb = 4 * (q & 3);
                    const float a0 = z[0][tb][rb], a1 = z[0][tb][rb + 1], a2 = z[0][tb][rb + 2], a3 = z[0][tb][rb + 3];
                    const float b0 = z[1][tb][rb], b1 = z[1][tb][rb + 1], b2 = z[1][tb][rb + 2], b3 = z[1][tb][rb + 3];
                    Ao[q] = (a0 * a1) * (a2 * a3);
                    Bo[q] = dir == 0 ? ((b0 * a1 + b1) * a2 + b2) * a3 + b3 : ((b3 * a2 + b2) * a1 + b1) * a0 + b0;
                    Ax[q] = __shfl_xor(Ao[q], 32); Bx[q] = __shfl_xor(Bo[q], 32); }
                float c = 0.f;
                if (dir == 0) {
#pragma unroll
                    for (int q = 0; q < 8; ++q) { const float Ae = hi ? Ax[q] : Ao[q], Be = hi ? Bx[q] : Bo[q], Aod = hi ? Ao[q] : Ax[q], Bod = hi ? Bo[q] : Bx[q];
                        c = Aod * (Ae * c + Be) + Bod; atot *= Ao[q] * Ax[q]; }
                } else {
#pragma unroll
                    for (int q = 7; q >= 0; --q) { const float Ae = hi ? Ax[q] : Ao[q], Be = hi ? Bx[q] : Bo[q], Aod = hi ? Ao[q] : Ax[q], Bod = hi ? Bo[q] : Bx[q];
                        c = Ae * (Aod * c + Bod) + Be; atot *= Ao[q] * Ax[q]; }
                }
                cend = c;
            }
            if (hi == 0) comp[((rd & 1) * 8 + k) * 32 + r32] = (f32x2){atot, cend};
            __syncthreads();
            float cin = cround, call = cround;
#pragma unroll
            for (int k2 = 0; k2 < 8; ++k2) { const f32x2 cc = comp[((rd & 1) * 8 + k2) * 32 + r32]; call = cc.x * call + cc.y; if (k2 < k) cin = call; }
            cround = call;
            if (valid) {
                float c = cin;
                if (dir == 0) {
#pragma unroll
                    for (int q = 0; q < 8; ++q) { const float Ae = hi ? Ax[q] : Ao[q], Be = hi ? Bx[q] : Bo[q], Aod = hi ? Ao[q] : Ax[q], Bod = hi ? Bo[q] : Bx[q];
                        const float c1 = Ae * c + Be; cst[q] = hi ? c1 : c; c = Aod * c1 + Bod; }
                } else {
#pragma unroll
                    for (int q = 7; q >= 0; --q) { const float Ae = hi ? Ax[q] : Ao[q], Be = hi ? Bx[q] : Bo[q], Aod = hi ? Ao[q] : Ax[q], Bod = hi ? Bo[q] : Bx[q];
                        const float c1 = Aod * c + Bod; cst[q] = hi ? c : c1; c = Ae * c1 + Be; }
                }
                if (!isctx) {
#pragma unroll
                    for (int q = 0; q < 8; ++q) { const int tb = q >> 2, rb = 4 * (q & 3); float hcur = cst[q];
                        if (dir == 0) {
#pragma unroll
                            for (int e = 0; e < 4; ++e) { hcur = z[0][tb][rb + e] * hcur + z[1][tb][rb + e]; z[1][tb][rb + e] = hcur; }
                        } else {
#pragma unroll
                            for (int e = 3; e >= 0; --e) { hcur = z[0][tb][rb + e] * hcur + z[1][tb][rb + e]; z[1][tb][rb + e] = hcur; }
                        } }
                    const size_t row0 = rowbase + s0;
                    const int hoff = hi * 4 * 512 + chn, aoff = hi * 4 * 1024 + 512 + chn;
                    if (dir == 0) {
#pragma unroll
                        for (int tb = 0; tb < 2; ++tb)
#pragma unroll
                            for (int r = 0; r < 16; ++r) { const size_t rowu = row0 + 32 * tb + 8 * (r >> 2) + (r & 3); (HS + rowu * 512)[hoff] = z[1][tb][r]; }
                    } else {
#pragma unroll
                        for (int tb = 0; tb < 2; ++tb) { float hf[16]; unsigned short gg[16];
#pragma unroll
                            for (int r = 0; r < 16; ++r) { const size_t rowu = row0 + 32 * tb + 8 * (r >> 2) + (r & 3); hf[r] = (HS + rowu * 512)[hoff]; gg[r] = (G + rowu * 512)[hoff]; }
#pragma unroll
                            for (int r = 0; r < 16; ++r) { const size_t rowu = row0 + 32 * tb + 8 * (r >> 2) + (r & 3); const float hsum = z[1][tb][r] + hf[r];
                                const float g = bf2f(gg[r]); const float t = 1.5957691216057308f * (g + 0.044715f * g * g * g);
                                const float y = hsum * g * __builtin_amdgcn_rcpf(1.f + __builtin_amdgcn_exp2f(-t * L2E));
                                (AO + rowu * 1024)[aoff] = f2bf(y); } }
                    }
                }
            }
        }
#undef LRU2_LOADU
#undef LRU2_CHUNK
        asm volatile("s_waitcnt vmcnt(0)" ::: "memory");
        __syncthreads();
    }
}
}

#define GAS __attribute__((address_space(1)))
#define LAS __attribute__((address_space(3)))
typedef unsigned short bf16;
typedef unsigned v4u __attribute__((ext_vector_type(4)));
typedef float f32x4 __attribute__((ext_vector_type(4)));
typedef short bf16x8 __attribute__((ext_vector_type(8)));
typedef GAS unsigned gu32;
typedef GAS unsigned long long gu64;
#define RLX_AGENT __ATOMIC_RELAXED, __HIP_MEMORY_SCOPE_AGENT
#define LDS_WAIT() asm volatile("s_waitcnt lgkmcnt(0)" ::: "memory")
#define VM_WAIT() asm volatile("s_waitcnt vmcnt(0)" ::: "memory")
__device__ __forceinline__ unsigned long long rt() { return __builtin_amdgcn_s_memrealtime(); }
__device__ __forceinline__ unsigned f2bf(float f) { unsigned u = __builtin_bit_cast(unsigned, f); return (u + 0x7fffu + ((u >> 16) & 1u)) >> 16; }
__device__ __forceinline__ unsigned pk2(float lo, float hi) { return f2bf(lo) | (f2bf(hi) << 16); }

#define XB_TMO      128
#define XB_XCNT(j)  (256  + 64 * (j))
#define XB_XSUB(j)  (1280 + 64 * (j))
#define XB_XGEN(j)  (2304 + 64 * (j))
#define XB_TOP      3328
#define XB_TOPGEN   3392
#define XCD_BAR_WORDS 3456
#define XB_SPIN_CAP (1u << 18)

__device__ __forceinline__ unsigned xb_ld(unsigned* p)              { return __hip_atomic_load(p, __ATOMIC_RELAXED, __HIP_MEMORY_SCOPE_AGENT); }
__device__ __forceinline__ unsigned xb_add(unsigned* p, unsigned v) { return __hip_atomic_fetch_add(p, v, __ATOMIC_RELAXED, __HIP_MEMORY_SCOPE_AGENT); }
__device__ __forceinline__ unsigned xb_xcc_id() { return (unsigned)__builtin_amdgcn_s_getreg((3 << 11) | 20) & 0xFu; }
#define XB_SPIN(cond, bar) do { unsigned _sp = 0; while (cond) { __builtin_amdgcn_s_sleep(1); \
    if ((++_sp & 255u) == 0u) { if (xb_ld(&(bar)[XB_TMO])) break; if (_sp > XB_SPIN_CAP) { atomicAdd(&(bar)[XB_TMO], 1u); break; } } } } while (0)

struct XcdBarrier {
    unsigned* bar; unsigned x;
    volatile LAS unsigned* st;
};

__device__ __forceinline__ XcdBarrier xcd_barrier_post(unsigned* bar, volatile LAS unsigned* st) {
    XcdBarrier b; b.bar = bar; b.x = xb_xcc_id(); b.st = st;
    if (threadIdx.x == 0) (void)xb_add(&bar[XB_XCNT(b.x)], 1u);
    return b;
}
__device__ __forceinline__ void xcd_barrier_complete(unsigned* bar, unsigned x, unsigned& nloc, unsigned& nx) {
    const unsigned G = gridDim.x * gridDim.y * gridDim.z;
    unsigned sum, cnt, mine, sp = 0u;
    for (;;) {
        sum = 0u; cnt = 0u; mine = 0u;
#pragma unroll
        for (unsigned j = 0; j < 16; ++j) { const unsigned c = xb_ld(&bar[XB_XCNT(j)]); sum += c; cnt += (c > 0u) ? 1u : 0u; mine = (j == x) ? c : mine; }
        if (sum == G) break;
        __builtin_amdgcn_s_sleep(1);
        if ((++sp & 255u) == 0u) { if (xb_ld(&bar[XB_TMO])) break; if (sp > XB_SPIN_CAP) { atomicAdd(&bar[XB_TMO], 1u); break; } }
    }
    nloc = mine > 0u ? mine : 1u; nx = cnt > 0u ? cnt : 1u;
}

__device__ __forceinline__ void xcd_barrier(const XcdBarrier& b) {
    asm volatile("s_waitcnt vmcnt(0)" ::: "memory");
    __syncthreads();
    if (threadIdx.x == 0) {
        unsigned* bar = b.bar;
        __builtin_amdgcn_s_waitcnt(0);
        unsigned nloc = b.st[0], nx = b.st[1];
        if (nloc == 0u) { xcd_barrier_complete(bar, b.x, nloc, nx); b.st[0] = nloc; b.st[1] = nx; }
        const unsigned old = xb_add(&bar[XB_XSUB(b.x)], 1u);
        const unsigned gen = old / nloc;
        if (old + 1u == (gen + 1u) * nloc) {
            __builtin_amdgcn_fence(__ATOMIC_RELEASE, "agent");
            asm volatile("s_waitcnt vmcnt(0)" ::: "memory");
            const unsigned og = xb_add(&bar[XB_TOP], 1u);
            const unsigned tg = og / nx;
            if (og + 1u == (tg + 1u) * nx) xb_add(&bar[XB_TOPGEN], 1u);
            else XB_SPIN(xb_ld(&bar[XB_TOPGEN]) == tg, bar);
            __builtin_amdgcn_fence(__ATOMIC_ACQUIRE, "agent");
            xb_add(&bar[XB_XGEN(b.x)], 1u);
            asm volatile("s_waitcnt vmcnt(0)" ::: "memory");
        } else {
            XB_SPIN(xb_ld(&bar[XB_XGEN(b.x)]) == gen, bar);
            __builtin_amdgcn_fence(__ATOMIC_ACQUIRE, "agent");
            asm volatile("s_waitcnt vmcnt(0)" ::: "memory");
        }
    }
    __syncthreads();
}

constexpr int NWAVES = 8;
#ifndef MK_N_LAUNCHES
#define MK_N_LAUNCHES 1
#endif
constexpr int PER_PHASE = 10;
constexpr int N_LAUNCHES = MK_N_LAUNCHES;
#ifndef REPEAT_MASK
#define REPEAT_MASK 0
#endif
#ifndef TSTAMP
#define TSTAMP -1
#endif
#ifndef TS_UNIT
#define TS_UNIT 100.0f
#endif
#ifndef FP8_FFN
#define FP8_FFN 0
#endif
constexpr bool F8_IN = (FP8_FFN & 1) != 0, F8_OUT = (FP8_FFN & 2) != 0;
constexpr float W1_SCALE = 32.f, W2_SCALE = 64.f, HID_SCALE = 8.f;
#ifndef ATT_FORCE_FALLBACK
#define ATT_FORCE_FALLBACK 0
#endif
constexpr int DM = 1024, NBATCH = 16, SEQ = 4096, CTXL = 256, MLAT = NBATCH * SEQ, MCTX = NBATCH * CTXL, MALL = MLAT + MCTX, INW = 2560, FH = 2816;
constexpr float LN_EPS = 1e-6f, DN_ALPHA = 1.189207115002721f;
constexpr size_t MiB = 1u << 20;
constexpr size_t WS_CTL = 0, CTL_ZERO_BYTES = 64 * 1024;
constexpr size_t WS_MOD = 1 * MiB, WS_ROPEC = WS_MOD + 512 * 1024, WS_ROPES = WS_ROPEC + 4096, WS_SP8 = WS_ROPES + 4096, WS_LAM = WS_SP8 + 4096;
constexpr size_t WS_WIN = 2 * MiB, WS_WOUT = 8 * MiB, WS_W1 = 10 * MiB, WS_W2 = 21 * MiB, WS_WG = 27 * MiB, WS_SUM = 28 * MiB;
constexpr size_t WS_XN = 40 * MiB, WS_Q = 176 * MiB, WS_K = 240 * MiB, WS_V = 308 * MiB, WS_U = 376 * MiB, WS_G = 444 * MiB, WS_AO = 508 * MiB;
constexpr size_t WS_Y = (DBG ? 704 : 176) * MiB, WS_HID = 176 * MiB, WS_F = 528 * MiB, WS_VT8 = 636 * MiB, WS_PARK = 670 * MiB, WS_HS = 704 * MiB, WS_END = 832 * MiB;
static_assert(WS_SUM + (size_t)16 * 68 * 2 * 512 * 8 <= WS_XN && WS_XN + (size_t)MALL * DM * 2 <= WS_Q && WS_HID + (size_t)MLAT * FH * 2 <= WS_F, "d_ws map");
constexpr int CW_BAR = 1024;
constexpr int RING_BYTES = 131072, LDSCTL_OFF = RING_BYTES, MISC_OFF = LDSCTL_OFF + 320, ROPE_OFF = RING_BYTES + 1024, LDS_BYTES = 147456;
static_assert(att::LDS_END <= RING_BYTES && lru2::LDS_END <= RING_BYTES, "LDS map");

struct Frame {
    LAS unsigned char* lds; volatile LAS unsigned* MISC; gu32* ctl;
    int tid, lane, wave, vcu, G;
};
__device__ __forceinline__ float wave_sum(float v) {
#pragma unroll
    for (int o = 1; o < 64; o <<= 1) v += __shfl_xor(v, o);
    return v;
}
template <class DEST>
__device__ __forceinline__ void p0_transpose_item(const float* W, int K, int N, bf16* WT, LAS float* scr, int item, int lane, DEST dest) {
    const int nblk = N / 32, kb = item / nblk, nb = item % nblk, k0 = 64 * kb, n0 = 32 * nb;
#pragma unroll 8
    for (int i = 0; i < 32; ++i) { const int kk = 2 * i + (lane >> 5); scr[kk * 33 + (lane & 31)] = W[(size_t)(k0 + kk) * N + n0 + (lane & 31)]; }
    LDS_WAIT(); asm volatile("" ::: "memory");
    const int c = lane & 7;
#pragma unroll
    for (int j = 0; j < 4; ++j) { const int n = (lane >> 3) + 8 * j; const LAS float* s = scr + (8 * c) * 33 + n;
        v4u o; o.x = pk2(s[0 * 33], s[1 * 33]); o.y = pk2(s[2 * 33], s[3 * 33]); o.z = pk2(s[4 * 33], s[5 * 33]); o.w = pk2(s[6 * 33], s[7 * 33]);
        *(GAS v4u*)(WT + (size_t)dest(n0 + n) * K + k0 + 8 * c) = o; }
    LDS_WAIT(); asm volatile("" ::: "memory");
}
template <class DEST>
__device__ __forceinline__ void p0_transpose_item8(const float* W, int K, int N, unsigned char* WT, LAS float* scr, int item, int lane, DEST dest, float scale) {
    const int nblk = N / 32, kb = item / nblk, nb = item % nblk, k0 = 64 * kb, n0 = 32 * nb;
#pragma unroll 8
    for (int i = 0; i < 32; ++i) { const int kk = 2 * i + (lane >> 5); scr[kk * 33 + (lane & 31)] = W[(size_t)(k0 + kk) * N + n0 + (lane & 31)] * scale; }
    LDS_WAIT(); asm volatile("" ::: "memory");
    const int c = lane & 7; typedef unsigned u32x2v __attribute__((ext_vector_type(2)));
#pragma unroll
    for (int j = 0; j < 4; ++j) { const int n = (lane >> 3) + 8 * j; const LAS float* s = scr + (8 * c) * 33 + n;
        u32x2v o; o.x = pg8::pk_fp8x4(s[0 * 33], s[1 * 33], s[2 * 33], s[3 * 33]); o.y = pg8::pk_fp8x4(s[4 * 33], s[5 * 33], s[6 * 33], s[7 * 33]);
        *(GAS u32x2v*)(WT + (size_t)dest(n0 + n) * K + k0 + 8 * c) = o; }
    LDS_WAIT(); asm volatile("" ::: "memory");
}
struct DestId { __device__ __forceinline__ int operator()(int n) const { return n; } };
struct DestWin { __device__ __forceinline__ int operator()(int n) const {
    if (n >= 1536) return n - 512; if (n >= 1024) return n + 1024; const int d = n & 63; return (n & ~63) + (d & 32) + ((d >> 2) & 3) * 8 + ((d >> 4) & 1) * 4 + (d & 3); } };
struct DestW1 { __device__ __forceinline__ int operator()(int n) const { const int hb = n >= FH, l = hb ? n - FH : n; return (l >> 7) * 256 + hb * 128 + (l & 127); } };

__device__ __forceinline__ void p0_mod_task(int cgp, const float* c, const float* cctx, const float* w_ada, const float* b_ada, float* MOD, LAS unsigned char* lds, int tid, int wave, int lane) {
    LAS float* sc = (LAS float*)lds; LAS float* red = (LAS float*)(lds + 81920);
    for (int idx = tid; idx < 17 * 1024; idx += 512) { const int r = idx >> 10, k = idx & 1023; const float v = r < 16 ? c[r * 1024 + k] : cctx[k]; sc[k * 20 + r] = v / (1.f + __expf(-v)); }
    __syncthreads();
    float acc[17];
#pragma unroll
    for (int r = 0; r < 17; ++r) acc[r] = 0.f;
    const int n = 64 * cgp + lane;
#pragma unroll 16
    for (int kk = 0; kk < 128; ++kk) { const int k = wave * 128 + kk; const float wv = __builtin_nontemporal_load(w_ada + (size_t)k * 6144 + n);
        const LAS f32x4* sp = (const LAS f32x4*)(sc + k * 20); const f32x4 s0 = sp[0], s1 = sp[1], s2 = sp[2], s3 = sp[3]; const float s16 = sc[k * 20 + 16];
        acc[0] += s0.x * wv; acc[1] += s0.y * wv; acc[2] += s0.z * wv; acc[3] += s0.w * wv; acc[4] += s1.x * wv; acc[5] += s1.y * wv; acc[6] += s1.z * wv; acc[7] += s1.w * wv;
        acc[8] += s2.x * wv; acc[9] += s2.y * wv; acc[10] += s2.z * wv; acc[11] += s2.w * wv; acc[12] += s3.x * wv; acc[13] += s3.y * wv; acc[14] += s3.z * wv; acc[15] += s3.w * wv; acc[16] += s16 * wv; }
#pragma unroll
    for (int r = 0; r < 17; ++r) red[(wave * 17 + r) * 64 + lane] = acc[r];
    __syncthreads();
    for (int idx = tid; idx < 17 * 64; idx += 512) { const int r = idx >> 6, l = idx & 63; float s = b_ada[64 * cgp + l];
#pragma unroll
        for (int w2 = 0; w2 < 8; ++w2) s += red[(w2 * 17 + r) * 64 + l];
        MOD[r * 6144 + 64 * cgp + l] = s; }
    __syncthreads();
}
__device__ __forceinline__ void ln_stats(f32x4 (&v)[4], float& mean, float& rstd) {
    float s = 0.f;
#pragma unroll
    for (int j = 0; j < 4; ++j) s += (v[j].x + v[j].y) + (v[j].z + v[j].w);
    mean = wave_sum(s) * (1.f / DM); float s2 = 0.f;
#pragma unroll
    for (int j = 0; j < 4; ++j) { v[j] = v[j] - mean; s2 += (v[j].x * v[j].x + v[j].y * v[j].y) + (v[j].z * v[j].z + v[j].w * v[j].w); }
    rstd = 1.f / sqrtf(wave_sum(s2) * (1.f / DM) + LN_EPS);
}
__device__ __forceinline__ void st_bf16x4(bf16* p, f32x4 v) { *(GAS unsigned long long*)p = (unsigned long long)pk2(v.x, v.y) | ((unsigned long long)pk2(v.z, v.w) << 32); }
__device__ __forceinline__ f32x4 ld_bf16x4(const bf16* p) { const unsigned long long w = *(const GAS unsigned long long*)p; const unsigned lo = (unsigned)w, hi = (unsigned)(w >> 32);
    return (f32x4){__uint_as_float(lo << 16), __uint_as_float(lo & 0xffff0000u), __uint_as_float(hi << 16), __uint_as_float(hi & 0xffff0000u)}; }
__device__ __forceinline__ void ln_stats2(f32x4 (&v)[2][4], float (&mean)[2], float (&rstd)[2]) {
    float s[2];
#pragma unroll
    for (int q = 0; q < 2; ++q) { s[q] = 0.f;
#pragma unroll
        for (int j = 0; j < 4; ++j) s[q] += (v[q][j].x + v[q][j].y) + (v[q][j].z + v[q][j].w); }
#pragma unroll
    for (int o = 1; o < 64; o <<= 1) { s[0] += __shfl_xor(s[0], o); s[1] += __shfl_xor(s[1], o); }
    float s2[2];
#pragma unroll
    for (int q = 0; q < 2; ++q) { mean[q] = s[q] * (1.f / DM); s2[q] = 0.f;
#pragma unroll
        for (int j = 0; j < 4; ++j) { v[q][j] = v[q][j] - mean[q]; s2[q] += (v[q][j].x * v[q][j].x + v[q][j].y * v[q][j].y) + (v[q][j].z * v[q][j].z + v[q][j].w * v[q][j].w); } }
#pragma unroll
    for (int o = 1; o < 64; o <<= 1) { s2[0] += __shfl_xor(s2[0], o); s2[1] += __shfl_xor(s2[1], o); }
#pragma unroll
    for (int q = 0; q < 2; ++q) rstd[q] = 1.f / sqrtf(s2[q] * (1.f / DM) + LN_EPS);
}
__device__ __forceinline__ void row_hmod2(const float* const (&xrow)[2], const float* const (&md)[2], bf16* const (&orow)[2], int lane) {
    f32x4 v[2][4]; float mean[2], rstd[2];
#pragma unroll
    for (int q = 0; q < 2; ++q)
#pragma unroll
        for (int j = 0; j < 4; ++j) v[q][j] = __builtin_nontemporal_load((const GAS f32x4*)(xrow[q] + 4 * lane + 256 * j));
    ln_stats2(v, mean, rstd);
#pragma unroll
    for (int q = 0; q < 2; ++q)
#pragma unroll
        for (int j = 0; j < 4; ++j) { const int c = 4 * lane + 256 * j; const f32x4 a = *(const f32x4*)(md[q] + 1024 + c), s = *(const f32x4*)(md[q] + c); st_bf16x4(orow[q] + c, v[q][j] * rstd[q] * (a + 1.f) + s); }
}
__device__ __forceinline__ void row_ln1_2(const float* const (&xrow)[2], const bf16* const (&yrow)[2], const float* const (&md)[2], const float* lng, const float* lnb, float* const (&x1row)[2], bf16* const (&h2row)[2], int lane) {
    f32x4 v[2][4]; float mean[2], rstd[2];
#pragma unroll
    for (int q = 0; q < 2; ++q)
#pragma unroll
        for (int j = 0; j < 4; ++j) { const int c = 4 * lane + 256 * j; v[q][j] = __builtin_nontemporal_load((const GAS f32x4*)(xrow[q] + c)) * DN_ALPHA + *(const f32x4*)(md[q] + 2048 + c) * ld_bf16x4(yrow[q] + c); }
    ln_stats2(v, mean, rstd);
#pragma unroll
    for (int q = 0; q < 2; ++q)
#pragma unroll
        for (int j = 0; j < 4; ++j) { const int c = 4 * lane + 256 * j; v[q][j] = v[q][j] * rstd[q] * *(const f32x4*)(lng + c) + *(const f32x4*)(lnb + c); *(GAS f32x4*)(x1row[q] + c) = v[q][j]; }
    ln_stats2(v, mean, rstd);
#pragma unroll
    for (int q = 0; q < 2; ++q)
#pragma unroll
        for (int j = 0; j < 4; ++j) { const int c = 4 * lane + 256 * j; const f32x4 hv = v[q][j] * rstd[q] * (*(const f32x4*)(md[q] + 4096 + c) + 1.f) + *(const f32x4*)(md[q] + 3072 + c);
            if (F8_IN) *(GAS unsigned*)((unsigned char*)h2row[q] + c) = pg8::pk_fp8x4(hv.x, hv.y, hv.z, hv.w); else st_bf16x4(h2row[q] + c, hv); }
}
struct Ln1Raw { f32x4 x[2][4]; unsigned long long y[2][4]; };
__device__ __forceinline__ void ln1_load(Ln1Raw& r, const float* x, const bf16* Y, int m, int m2, int lane) {
#pragma unroll
    for (int j = 0; j < 4; ++j) { const int c = 4 * lane + 256 * j;
        r.x[0][j] = __builtin_nontemporal_load((const GAS f32x4*)(x + (size_t)m * DM + c)); r.x[1][j] = __builtin_nontemporal_load((const GAS f32x4*)(x + (size_t)m2 * DM + c));
        r.y[0][j] = *(const GAS unsigned long long*)(Y + (size_t)m * DM + c); r.y[1][j] = *(const GAS unsigned long long*)(Y + (size_t)m2 * DM + c); }
}
__device__ __forceinline__ f32x4 bf16x4_to_f32(unsigned long long w) { const unsigned lo = (unsigned)w, hi = (unsigned)(w >> 32);
    return (f32x4){__uint_as_float(lo << 16), __uint_as_float(lo & 0xffff0000u), __uint_as_float(hi << 16), __uint_as_float(hi & 0xffff0000u)}; }
__device__ __forceinline__ void ln1_process(const Ln1Raw& r, const float* const (&md)[2], const float* lng, const float* lnb, float* const (&x1row)[2], bf16* const (&h2row)[2], int lane) {
    f32x4 v[2][4]; float mean[2], rstd[2];
#pragma unroll
    for (int q = 0; q < 2; ++q)
#pragma unroll
        for (int j = 0; j < 4; ++j) { const int c = 4 * lane + 256 * j; v[q][j] = r.x[q][j] * DN_ALPHA + *(const f32x4*)(md[q] + 2048 + c) * bf16x4_to_f32(r.y[q][j]); }
    ln_stats2(v, mean, rstd);
#pragma unroll
    for (int q = 0; q < 2; ++q)
#pragma unroll
        for (int j = 0; j < 4; ++j) { const int c = 4 * lane + 256 * j; v[q][j] = v[q][j] * rstd[q] * *(const f32x4*)(lng + c) + *(const f32x4*)(lnb + c); *(GAS f32x4*)(x1row[q] + c) = v[q][j]; }
    ln_stats2(v, mean, rstd);
#pragma unroll
    for (int q = 0; q < 2; ++q)
#pragma unroll
        for (int j = 0; j < 4; ++j) { const int c = 4 * lane + 256 * j; const f32x4 hv = v[q][j] * rstd[q] * (*(const f32x4*)(md[q] + 4096 + c) + 1.f) + *(const f32x4*)(md[q] + 3072 + c);
            if (F8_IN) *(GAS unsigned*)((unsigned char*)h2row[q] + c) = pg8::pk_fp8x4(hv.x, hv.y, hv.z, hv.w); else st_bf16x4(h2row[q] + c, hv); }
}
__device__ __forceinline__ void row_ln2_2(float* const (&orow)[2], const bf16* const (&frow)[2], const float* const (&md)[2], const float* lng, const float* lnb, int lane) {
    f32x4 v[2][4]; float mean[2], rstd[2];
#pragma unroll
    for (int q = 0; q < 2; ++q)
#pragma unroll
        for (int j = 0; j < 4; ++j) { const int c = 4 * lane + 256 * j; v[q][j] = *(const GAS f32x4*)(orow[q] + c) * DN_ALPHA + *(const f32x4*)(md[q] + 5120 + c) * ld_bf16x4(frow[q] + c); }
    ln_stats2(v, mean, rstd);
#pragma unroll
    for (int q = 0; q < 2; ++q)
#pragma unroll
        for (int j = 0; j < 4; ++j) { const int c = 4 * lane + 256 * j; __builtin_nontemporal_store(v[q][j] * rstd[q] * *(const f32x4*)(lng + c) + *(const f32x4*)(lnb + c), (GAS f32x4*)(orow[q] + c)); }
}

struct Args { const float* in[22]; float* out; unsigned char* ws; int ph_lo, ph_hi, li, pad; };
__global__ void __launch_bounds__(NWAVES * 64, 2) mk_fwd(Args args) {
    extern __shared__ __attribute__((aligned(16))) unsigned char lds[];
    Frame F;
    F.lds = (LAS unsigned char*)lds; F.MISC = (volatile LAS unsigned*)(F.lds + MISC_OFF);
    F.tid = threadIdx.x; F.lane = F.tid & 63; F.wave = __builtin_amdgcn_readfirstlane(F.tid >> 6);
    F.G = gridDim.x; { const int bx = blockIdx.x; F.vcu = (F.G % 8 == 0) ? (bx % 8) * (F.G / 8) + bx / 8 : bx; }
    unsigned char* ws = args.ws;
    F.ctl = (gu32*)(ws + WS_CTL);
    const float* x = args.in[0]; const float* cin = args.in[1]; const float* ctx = args.in[2]; const float* cctx = args.in[3];
    float* MOD = (float*)(ws + WS_MOD); float* ROPEC = (float*)(ws + WS_ROPEC); float* ROPES = (float*)(ws + WS_ROPES); float* SP8 = (float*)(ws + WS_SP8); float* LAMP = (float*)(ws + WS_LAM);
    bf16* WinT = (bf16*)(ws + WS_WIN); bf16* WoutT = (bf16*)(ws + WS_WOUT); bf16* W1T = (bf16*)(ws + WS_W1); bf16* W2T = (bf16*)(ws + WS_W2); bf16* WgT = (bf16*)(ws + WS_WG);
        bf16* XN = (bf16*)(ws + WS_XN); bf16* Qb = (bf16*)(ws + WS_Q); bf16* Kb = (bf16*)(ws + WS_K); bf16* Vb = (bf16*)(ws + WS_V); bf16* Ub = (bf16*)(ws + WS_U); bf16* Gb = (bf16*)(ws + WS_G);
    bf16* AO = (bf16*)(ws + WS_AO); bf16* Yb = (bf16*)(ws + WS_Y); bf16* HID = (bf16*)(ws + WS_HID); bf16* Fb = (bf16*)(ws + WS_F);
    for (int u = F.tid; u < (LDS_BYTES - LDSCTL_OFF) / 4; u += NWAVES * 64) ((LAS unsigned*)(F.lds + LDSCTL_OFF))[u] = 0u;
    __syncthreads();
    XcdBarrier bar; bar.bar = (unsigned*)(F.ctl + CW_BAR); bar.x = 0; bar.st = nullptr;
    if (N_LAUNCHES != PER_PHASE) bar = xcd_barrier_post((unsigned*)(F.ctl + CW_BAR), F.MISC + 8);
#define GRID_BAR() do { if (N_LAUNCHES != PER_PHASE) xcd_barrier(bar); } while (0)
    const int lo = args.ph_lo, hi = args.ph_hi;
#define IN(k) (lo <= (k) && (k) < hi)
#define BOTH(k) (IN(k) && IN((k) + 1))
    const int gw = F.vcu * NWAVES + F.wave, NGW = F.G * NWAVES;
    unsigned long long* TS = (unsigned long long*)(ws + WS_CTL + 40960);
#define STAMP(k) do { if (TSTAMP >= 0 && blockIdx.x == 0 && F.tid == 0) TS[k] = __builtin_amdgcn_s_memrealtime(); } while (0)
    STAMP(0);

    if (IN(0)) {
        for (int rep_ = 0; rep_ < 1 + ((REPEAT_MASK >> 0) & 1); ++rep_) {
        if ((int)blockIdx.x < 96) p0_mod_task((int)blockIdx.x, cin, cctx, args.in[4], args.in[5], MOD, F.lds, F.tid, F.wave, F.lane);
        if ((int)blockIdx.x == F.G - 1) {
            for (int i = F.tid; i < 1024; i += 512) { const int pos = i >> 4, f = i & 15; const float inv = powf(10000.f, -(float)f / 16.f); const float ang = (float)pos * inv; ROPEC[i] = cosf(ang); ROPES[i] = sinf(ang); }
            for (int i = F.tid; i < 1024; i += 512) { const float l = args.in[14][i]; const float sp = log1pf(expf(-fabsf(l))) + fmaxf(-l, 0.f); SP8[i] = 8.f * sp * 1.4426950408889634f; }
            if (F.tid == 0) { float a = 0.f, b2 = 0.f; for (int i = 0; i < 64; ++i) { a += args.in[7][i] * args.in[8][i]; b2 += args.in[7][64 + i] * args.in[8][64 + i]; } LAMP[0] = expf(a) - expf(b2) + 0.2f; }
        }
        LAS float* scr = (LAS float*)(F.lds + F.wave * 16384);
        constexpr int I_IN = (DM / 64) * (INW / 32), I_OUT = (DM / 64) * (DM / 32), I_1 = (DM / 64) * (2 * FH / 32), I_2 = (FH / 64) * (DM / 32), I_G = 32 * 2;
        constexpr int NITEMS = I_IN + I_OUT + I_1 + I_2 + I_G;
        const bool modwg = (int)blockIdx.x < 96 && F.G > 96;
        const int gw0 = modwg ? NITEMS : ((F.G > 96 ? (int)blockIdx.x - 96 : (int)blockIdx.x) * NWAVES + F.wave), ngw0 = (F.G > 96 ? F.G - 96 : F.G) * NWAVES;
        for (int it = gw0; it < NITEMS; it += ngw0) {
            int r = it;
            if (r < I_IN) { p0_transpose_item(args.in[6], DM, INW, WinT, scr, r, F.lane, DestWin{}); continue; } r -= I_IN;
            if (r < I_OUT) { p0_transpose_item(args.in[15], DM, DM, WoutT, scr, r, F.lane, DestId{}); continue; } r -= I_OUT;
            if (r < I_1) { if (F8_IN) p0_transpose_item8(args.in[18], DM, 2 * FH, (unsigned char*)W1T, scr, r, F.lane, DestW1{}, W1_SCALE); else p0_transpose_item(args.in[18], DM, 2 * FH, W1T, scr, r, F.lane, DestW1{}); continue; } r -= I_1;
            if (r < I_2) { if (F8_OUT) p0_transpose_item8(args.in[19], FH, DM, (unsigned char*)W2T, scr, r, F.lane, DestId{}, W2_SCALE); else p0_transpose_item(args.in[19], FH, DM, W2T, scr, r, F.lane, DestId{}); continue; } r -= I_2;
            { const int mat = r >> 1; p0_transpose_item(args.in[12] + (size_t)mat * 4096, 64, 64, WgT + (size_t)mat * 4096, scr, r & 1, F.lane, DestId{}); }
        }
        }
        if (BOTH(0)) GRID_BAR();
        STAMP(1);
    }
    if (IN(1)) {
        for (int rep_ = 0; rep_ < 1 + ((REPEAT_MASK >> 1) & 1); ++rep_) {
        for (int m = gw; m < MALL; m += 2 * NGW) { const int m2 = m + NGW;
            const float* const xr[2] = {m < MLAT ? x + (size_t)m * DM : ctx + (size_t)(m - MLAT) * DM, m2 < MLAT ? x + (size_t)m2 * DM : ctx + (size_t)(m2 - MLAT) * DM};
            const float* const md[2] = {MOD + (m < MLAT ? (m >> 12) : 16) * 6144, MOD + (m2 < MLAT ? (m2 >> 12) : 16) * 6144};
            bf16* const orow[2] = {XN + (size_t)m * DM, XN + (size_t)m2 * DM};
            row_hmod2(xr, md, orow, F.lane);
        }
        }
        if (BOTH(1)) GRID_BAR();
        STAMP(2);
    }
    if (IN(2)) {
        {
        LAS float* ropeL = (LAS float*)(F.lds + ROPE_OFF);
        for (int i = F.tid; i < 2048; i += NWAVES * 64) ropeL[i] = ROPEC[i];
        __syncthreads();
        { pg8::Gemm g{XN, WinT, MALL, INW, DM}; pg8::InProjOrder S; S.init(F.G, (int)blockIdx.x);
          pg8::EpiInProj E{Qb, Kb, Vb, Ub, Gb, (unsigned char*)(ws + WS_VT8), ropeL, ropeL + 1024};
          pg8::gemm_phase<pg8::EpiInProj, pg8::InProjOrder, true, true>(F.lds, g, S, E); }
        }
#if (REPEAT_MASK >> 2) & 1
        {
        LAS float* ropeL = (LAS float*)(F.lds + ROPE_OFF);
        for (int i = F.tid; i < 2048; i += NWAVES * 64) ropeL[i] = ROPEC[i];
        __syncthreads();
        { pg8::Gemm g{XN, WinT, MALL, INW, DM}; pg8::InProjOrder S; S.init(F.G, (int)blockIdx.x);
          pg8::EpiInProj E{Qb, Kb, Vb, Ub, Gb, (unsigned char*)(ws + WS_VT8), ropeL, ropeL + 1024};
          pg8::gemm_phase<pg8::EpiInProj, pg8::InProjOrder, true, true>(F.lds, g, S, E); }
        }
#endif
        if (BOTH(2)) GRID_BAR();
        STAMP(3);
    }
    if (IN(3)) {
        for (int rep_ = 0; rep_ < 1 + ((REPEAT_MASK >> 3) & 1); ++rep_) {
#ifndef SKIP_ATT
        const float lam = LAMP[0]; float* PARK = (float*)(ws + WS_PARK) + (size_t)blockIdx.x * att::PARK_FLOATS;
        const int xg = F.vcu >> 5, vl = F.vcu & 31;
        for (int ra_ = 0; ra_ < 1 + ((REPEAT_MASK >> 9) & 1); ++ra_)
        if (F.G == 256) {
            for (int i = 0; i < 4; ++i) { const int bh = xg * 8 + i * 2 + (vl >> 4), qb = vl & 15;
                att::attn_unit_safe(bh >> 2, bh & 3, qb, (const short*)Qb, (const short*)Kb, (const short*)Vb, (const unsigned char*)(ws + WS_VT8), (short*)AO, args.in[9], lam, PARK, (char*)lds, ATT_FORCE_FALLBACK != 0); }
        } else {
            for (int un = (int)blockIdx.x; un < 1024; un += F.G) { const int bh = un >> 4, qb = un & 15;
                att::attn_unit_safe(bh >> 2, bh & 3, qb, (const short*)Qb, (const short*)Kb, (const short*)Vb, (const unsigned char*)(ws + WS_VT8), (short*)AO, args.in[9], lam, PARK, (char*)lds, ATT_FORCE_FALLBACK != 0); }
        }
#endif
#ifndef SKIP_LRU1
        for (int rl_ = 0; rl_ < 1 + ((REPEAT_MASK >> 10) & 1); ++rl_)
        for (int un = F.vcu; un < 256; un += F.G)
            lru2::lru_unit(un >> 4, (un >> 1) & 7, un & 1, Ub, Gb, args.in[10], args.in[11], WgT, args.in[13], SP8, (float*)(ws + WS_HS), AO, F.lds);
#endif
        }
        if (BOTH(3)) GRID_BAR();
        STAMP(4);
    }
    if (IN(4)) { STAMP(5); }
    if (IN(5)) {
        {
        pg8::Gemm g{AO, WoutT, MLAT, DM, DM}; pg8::StaticOrder S; S.init(MLAT, DM, F.G, (int)blockIdx.x);
        pg8::EpiPlain E{Yb, DM, 1.f};
        pg8::gemm_phase<pg8::EpiPlain, pg8::StaticOrder, true, true>(F.lds, g, S, E);
        }
#if (REPEAT_MASK >> 5) & 1
        {
        pg8::Gemm g{AO, WoutT, MLAT, DM, DM}; pg8::StaticOrder S; S.init(MLAT, DM, F.G, (int)blockIdx.x);
        pg8::EpiPlain E{Yb, DM, 1.f};
        pg8::gemm_phase<pg8::EpiPlain, pg8::StaticOrder, true, true>(F.lds, g, S, E);
        }
#endif
        if (BOTH(5)) GRID_BAR();
        STAMP(6);
    }
    if (IN(6)) {
        for (int rep_ = 0; rep_ < 1 + ((REPEAT_MASK >> 6) & 1); ++rep_) {
        { Ln1Raw cur; ln1_load(cur, x, Yb, gw, gw + NGW, F.lane);
          for (int m = gw; m < MLAT; m += 2 * NGW) { const int m2 = m + NGW, mn = m + 2 * NGW;
            Ln1Raw nxt; if (mn < MLAT) ln1_load(nxt, x, Yb, mn, mn + NGW, F.lane);
            const float* const md[2] = {MOD + (m >> 12) * 6144, MOD + (m2 >> 12) * 6144};
            float* const x1r[2] = {args.out + (size_t)m * DM, args.out + (size_t)m2 * DM};
            bf16* const h2r[2] = {F8_IN ? (bf16*)((unsigned char*)XN + (size_t)m * DM) : XN + (size_t)m * DM, F8_IN ? (bf16*)((unsigned char*)XN + (size_t)m2 * DM) : XN + (size_t)m2 * DM};
            ln1_process(cur, md, args.in[16], args.in[17], x1r, h2r, F.lane);
            if (mn < MLAT) cur = nxt; } }
        }
        if (BOTH(6)) GRID_BAR();
        STAMP(7);
    }
    if (IN(7)) {
        {
        pg8::Gemm g{XN, W1T, MLAT, 2 * FH, F8_IN ? DM / 2 : DM}; pg8::StaticOrder S; S.init(MLAT, 2 * FH, F.G, (int)blockIdx.x);
        pg8::EpiSwiglu<F8_OUT> E{HID, FH, F8_IN ? 1.f / W1_SCALE : 1.f, F8_OUT ? HID_SCALE : 1.f};
        pg8::gemm_phase<pg8::EpiSwiglu<F8_OUT>, pg8::StaticOrder, true, true, F8_IN>(F.lds, g, S, E);
        }
#if (REPEAT_MASK >> 7) & 1
        {
        pg8::Gemm g{XN, W1T, MLAT, 2 * FH, F8_IN ? DM / 2 : DM}; pg8::StaticOrder S; S.init(MLAT, 2 * FH, F.G, (int)blockIdx.x);
        pg8::EpiSwiglu<F8_OUT> E{HID, FH, F8_IN ? 1.f / W1_SCALE : 1.f, F8_OUT ? HID_SCALE : 1.f};
        pg8::gemm_phase<pg8::EpiSwiglu<F8_OUT>, pg8::StaticOrder, true, true, F8_IN>(F.lds, g, S, E);
        }
#endif
        if (BOTH(7)) GRID_BAR();
        STAMP(8);
    }
    if (IN(8)) {
        {
        pg8::Gemm g{HID, W2T, MLAT, DM, F8_OUT ? FH / 2 : FH}; pg8::StaticOrder S; S.init(MLAT, DM, F.G, (int)blockIdx.x);
        pg8::EpiPlain E{Fb, DM, F8_OUT ? 1.f / (W2_SCALE * HID_SCALE) : 1.f};
        pg8::gemm_phase<pg8::EpiPlain, pg8::StaticOrder, true, true, F8_OUT>(F.lds, g, S, E);
        }
#if (REPEAT_MASK >> 8) & 1
        {
        pg8::Gemm g{HID, W2T, MLAT, DM, F8_OUT ? FH / 2 : FH}; pg8::StaticOrder S; S.init(MLAT, DM, F.G, (int)blockIdx.x);
        pg8::EpiPlain E{Fb, DM, F8_OUT ? 1.f / (W2_SCALE * HID_SCALE) : 1.f};
        pg8::gemm_phase<pg8::EpiPlain, pg8::StaticOrder, true, true, F8_OUT>(F.lds, g, S, E);
        }
#endif
        if (BOTH(8)) GRID_BAR();
        STAMP(9);
    }
    if (IN(9)) {
        for (int m = gw; m < MLAT; m += 2 * NGW) { const int m2 = m + NGW;
            float* const orow[2] = {args.out + (size_t)m * DM, args.out + (size_t)m2 * DM}; const bf16* const fr[2] = {Fb + (size_t)m * DM, Fb + (size_t)m2 * DM};
            const float* const md[2] = {MOD + (m >> 12) * 6144, MOD + (m2 >> 12) * 6144};
            row_ln2_2(orow, fr, md, args.in[20], args.in[21], F.lane); }
        STAMP(10);
        if (TSTAMP >= 0) {
            asm volatile("s_waitcnt vmcnt(0)" ::: "memory"); GRID_BAR();
            const unsigned long long t0 = __hip_atomic_load(TS + TSTAMP, __ATOMIC_RELAXED, __HIP_MEMORY_SCOPE_AGENT), t1 = __hip_atomic_load(TS + TSTAMP + 1, __ATOMIC_RELAXED, __HIP_MEMORY_SCOPE_AGENT);
            const float v = (float)(t1 - t0) * 0.01f / (TS_UNIT);
            for (int m = gw; m < MLAT; m += NGW) { GAS f32x4* o = (GAS f32x4*)(args.out + (size_t)m * DM) + F.lane;
#pragma unroll
                for (int j = 0; j < 4; ++j) o[64 * j] = (f32x4){v, v, v, v}; }
        }
    }
#undef IN
#undef BOTH
#undef GRID_BAR
}

#ifndef DBG
#define DBG 0
#endif
#if DBG
constexpr size_t WS_DBGTAB = 32 * 1024, WS_NAIVE = 832 * MiB;
static void dbg_run(void* const* d_in, float* out, unsigned char* ws, hipStream_t st) {
    float* tab = (float*)(ws + WS_DBGTAB);
    nv::Bufs B = nv::carve((char*)ws + WS_NAIVE);
    nv::run_common(d_in, B, st);
    dbg::cmp(st, tab, 1, ws + WS_MOD, 0, 0, 6144, 0, 0, 1.f, B.mod, 0, 6144, 0, 17, 6144);
    using namespace nv;
    for (int b = 0; b < 16; ++b) {
        const float* x = (const float*)d_in[0] + (size_t)b * S * D; const float* ctx = (const float*)d_in[2] + (size_t)b * CT * D;
        const float* mod = B.mod + b * 6144; const float* modc = B.mod + 16 * 6144;
        k_lnmod<<<S, 256, 0, st>>>(x, mod + 0, mod + 1024, B.h);
        k_lnmod<<<CT, 256, 0, st>>>(ctx, modc + 0, modc + 1024, B.h + (size_t)S * D);
        dbg::cmp(st, tab, 2, ws + WS_XN, 1, (size_t)65536 + b * 256, 1024, 0, 0, 1.f, B.h, 4096, 1024, 0, 256, 1024);
        k_gemm<<<dim3(nv::INW / 64, T / 64), 256, 0, st>>>(B.h, (const float*)d_in[6], B.p, T, nv::INW, D);
        k_rope<<<S * 512 / 256, 256, 0, st>>>(B.p);
        dbg::k_cmp_vt<<<(4352 * 512 + 255) / 256, 256, 0, st>>>((const unsigned short*)(ws + WS_V), b, B.p, nv::INW, 1024, tab + 2 * 3);
        dbg::cmp(st, tab, 4, ws + WS_U, 1, (size_t)b * 4096, 512, 0, 0, 1.f, B.p, 0, nv::INW, 1536, 4096, 512);
        dbg::cmp(st, tab, 4, ws + WS_U, 1, (size_t)65536 + b * 256, 512, 0, 0, 1.f, B.p, 4096, nv::INW, 1536, 256, 512);
        dbg::cmp(st, tab, 5, ws + WS_G, 1, (size_t)b * 4096, 512, 0, 0, 1.f, B.p, 0, nv::INW, 2048, 4096, 512);
        dbg::cmp(st, tab, 6, ws + WS_K, 1, (size_t)b * 4352 + 4096, 512, 0, 1, 1.f, B.p, 4096, nv::INW, 512, 256, 512);
        dbg::cmp(st, tab, 7, ws + WS_K, 1, (size_t)b * 4352, 512, 0, 1, 1.f, B.p, 0, nv::INW, 512, 4096, 512);
        dbg::cmp(st, tab, 8, ws + WS_Q, 1, (size_t)b * 4096, 512, 0, 1, 1.f / pg8::QK_C2, B.p, 0, nv::INW, 0, 4096, 512);
        k_attn_stats<<<dim3(S / 256, 4), 256, 0, st>>>(B.p, B.stats);
        k_attn_pv<<<dim3(S / 256, 16), 256, 0, st>>>(B.p, B.stats, B.lam, B.o);
        k_headnorm<<<S * 4 / 256, 256, 0, st>>>(B.o, (const float*)d_in[9], B.ao);
        dbg::cmp(st, tab, 9, ws + WS_AO, 1, (size_t)b * 4096, 1024, 0, 0, 1.f, B.ao, 0, 1024, 0, 4096, 512);
        k_conv<<<S * 512 / 256, 256, 0, st>>>(B.p, 0, S, (const float*)d_in[10], (const float*)d_in[11], B.uc);
        k_conv<<<CT * 512 / 256, 256, 0, st>>>(B.p, S, CT, (const float*)d_in[10], (const float*)d_in[11], B.uc);
        k_gates<<<2 * T * 512 / 256, 256, 0, st>>>(B.uc, (const float*)d_in[12], (const float*)d_in[13], (const float*)d_in[14], B.av, B.bv);
        k_scan<<<4, 256, 0, st>>>(B.av, B.bv, B.hs);
        k_ylru<<<S * 512 / 256, 256, 0, st>>>(B.hs, B.p, B.ao);
        dbg::cmp(st, tab, 10, ws + WS_AO, 1, (size_t)b * 4096, 1024, 512, 0, 1.f, B.ao, 0, 1024, 512, 4096, 512);
        k_gemm<<<dim3(D / 64, S / 64), 256, 0, st>>>(B.ao, (const float*)d_in[15], B.y, S, D, D);
        dbg::cmp(st, tab, 11, ws + WS_Y, 1, (size_t)b * 4096, 1024, 0, 0, 1.f, B.y, 0, 1024, 0, 4096, 1024);
        k_lnres<<<S, 256, 0, st>>>(x, B.y, mod + 2048, (const float*)d_in[16], (const float*)d_in[17], B.x1);
        dbg::cmp(st, tab, 12, out, 0, (size_t)b * 4096, 1024, 0, 0, 1.f, B.x1, 0, 1024, 0, 4096, 1024);
        k_lnmod<<<S, 256, 0, st>>>(B.x1, mod + 3072, mod + 4096, B.h2);
        dbg::cmp(st, tab, 13, ws + WS_XN, 1, (size_t)b * 4096, 1024, 0, 0, 1.f, B.h2, 0, 1024, 0, 4096, 1024);
    }
}
#endif
extern "C" void kernel_launch(void* const* d_in, const int* in_sizes, int n_in, void* d_out, int out_size, void* d_ws, size_t ws_size, hipStream_t stream) {
    static int grid = 0;
    if (grid == 0) {
        if (n_in != 22 || out_size != MLAT * DM || ws_size < (DBG ? (size_t)1012 * MiB : WS_END)) { fprintf(stderr, "kernel_launch: unexpected shapes / workspace (n_in %d out %d ws %zu)\n", n_in, out_size, ws_size); grid = -1; return; }
        int dev = 0, cus = 0, per_cu = 0;
        if (hipGetDevice(&dev) != hipSuccess || hipDeviceGetAttribute(&cus, hipDeviceAttributeMultiprocessorCount, dev) != hipSuccess) { grid = -1; return; }
        if (hipFuncSetAttribute((const void*)mk_fwd, hipFuncAttributeMaxDynamicSharedMemorySize, LDS_BYTES) != hipSuccess) { fprintf(stderr, "kernel_launch: hipFuncSetAttribute failed\n"); grid = -1; return; }
        if (hipOccupancyMaxActiveBlocksPerMultiprocessor(&per_cu, (const void*)mk_fwd, NWAVES * 64, LDS_BYTES) != hipSuccess || per_cu < 1) { fprintf(stderr, "kernel_launch: occupancy query says %d blocks/CU; nothing launched\n", per_cu); (void)hipGetLastError(); grid = -1; return; }
        grid = cus;
    }
    if (grid < 0) return;
    (void)hipMemsetAsync((char*)d_ws + WS_CTL, 0, CTL_ZERO_BYTES, stream);
    Args a{};
    for (int i = 0; i < 22; ++i) a.in[i] = (const float*)d_in[i];
    a.out = (float*)d_out; a.ws = (unsigned char*)d_ws;
#if DBG
    if (N_LAUNCHES == PER_PHASE) { for (int li = 0; li < 7; ++li) { a.ph_lo = li; a.ph_hi = li + 1; a.li = 0; hipLaunchKernelGGL(mk_fwd, dim3(grid), dim3(NWAVES * 64), LDS_BYTES, stream, a); } }
    else { a.ph_lo = 0; a.ph_hi = 7; a.li = 0; hipLaunchKernelGGL(mk_fwd, dim3(grid), dim3(NWAVES * 64), LDS_BYTES, stream, a); }
    dbg_run(d_in, (float*)d_out, (unsigned char*)d_ws, stream);
    if (N_LAUNCHES == PER_PHASE) { for (int li = 7; li < PER_PHASE; ++li) { a.ph_lo = li; a.ph_hi = li + 1; a.li = 0; hipLaunchKernelGGL(mk_fwd, dim3(grid), dim3(NWAVES * 64), LDS_BYTES, stream, a); } }
    else { a.ph_lo = 7; a.ph_hi = PER_PHASE; a.li = 1; hipLaunchKernelGGL(mk_fwd, dim3(grid), dim3(NWAVES * 64), LDS_BYTES, stream, a); }
    dbg::k_verdict<<<(unsigned)(((size_t)MLAT * DM + 255) / 256), 256, 0, stream>>>((const float*)((unsigned char*)d_ws + WS_DBGTAB), (float*)d_out, (size_t)MLAT * DM);
#else
    if (N_LAUNCHES == PER_PHASE) { for (int li = 0; li < PER_PHASE; ++li) { a.ph_lo = li; a.ph_hi = li + 1; a.li = 0; hipLaunchKernelGGL(mk_fwd, dim3(grid), dim3(NWAVES * 64), LDS_BYTES, stream, a); } }
    else { a.ph_lo = 0; a.ph_hi = PER_PHASE; a.li = 0; hipLaunchKernelGGL(mk_fwd, dim3(grid), dim3(NWAVES * 64), LDS_BYTES, stream, a); }
#endif
    const hipError_t le = hipPeekAtLastError();
    if (le != hipSuccess) fprintf(stderr, "kernel_launch: launch failed: %s\n", hipGetErrorName(le));
}
```

```cpp
#include <hip/hip_runtime.h>
#include <hip/hip_bf16.h>
#include <cstdio>
#include <cstdint>
#include <cmath>
#define DBG 0
#define MK_N_LAUNCHES 1
#define FP8_FFN 2

namespace pg8 {
#define PG8_LAS __attribute__((address_space(3)))
typedef unsigned short bf16_t;
typedef short bf16x8 __attribute__((ext_vector_type(8)));
typedef float f32x4 __attribute__((ext_vector_type(4)));
typedef unsigned u32x4 __attribute__((ext_vector_type(4)));
constexpr int BM = 256, BK = 64, HALF = 128, HTB = HALF * BK * 2  , STAGE_BYTES = 8 * HTB, NXCD = 8, WGM = 8;

__host__ __device__ __forceinline__ int lds_byte(int r, int c) { const int st = (r >> 4) * 2 + (c >> 5), rr = r & 15, cc = c & 31, ob = rr * 64 + cc * 2; return st * 1024 + (ob ^ (((ob >> 9) & 1) << 5)); }
__host__ __device__ __forceinline__ void stage_rc(int b, int& R, int& C) { const int st = b / 1024, sb = b % 1024, swz = sb ^ (((sb >> 9) & 1) << 5); R = (st >> 1) * 16 + swz / 64; C = (st & 1) * 32 + (swz % 64) / 2; }
__host__ __device__ __forceinline__ int perm32(int rho) { const int n = rho >> 4, i = rho & 15; return 8 * (i >> 2) + 4 * n + (i & 3); }

struct Unit { int pm, pn; };
struct Gemm { const bf16_t* A; const bf16_t* Bt; int M, N, K; };

struct StaticOrder {
    int nM, nN, nwg, G, c;
    __host__ __device__ void init(int M, int N, int G_, int c_) { nM = M / BM; nN = N / BM; nwg = nM * nN; G = G_; c = c_; }
    __host__ __device__ bool next(int i, Unit& u) const {
        const long L = (long)i * G + c; if (L >= nwg) return false;
        int wgid = (int)L; { const int q = nwg / NXCD, r = nwg % NXCD, xcd = wgid % NXCD, off = wgid / NXCD; wgid = (xcd < r ? xcd * (q + 1) : r * (q + 1) + (xcd - r) * q) + off; }
        const int nig = WGM * nN, gid = wgid / nig, fm = gid * WGM, gsz = (nM - fm) < WGM ? (nM - fm) : WGM;
        u.pm = fm + ((wgid % nig) % gsz); u.pn = (wgid % nig) / gsz; return true;
    }
    __device__ __forceinline__ void a_ready(const Unit&) const {}
    __device__ __forceinline__ void done(const Unit&) const {}
    __device__ __forceinline__ void ab(const Unit& u, const Gemm& g, size_t tstep, const char*& pa, const char*& pb) const { pa = (const char*)g.A + (size_t)u.pm * tstep; pb = (const char*)g.Bt + (size_t)u.pn * tstep; }
};

__device__ __forceinline__ unsigned cvt_pk_bf16(float lo, float hi) { unsigned r; asm volatile("v_cvt_pk_bf16_f32 %0, %1, %2" : "=v"(r) : "v"(lo), "v"(hi)); return r; }
typedef float f32x2 __attribute__((ext_vector_type(2)));
__device__ __forceinline__ f32x2 gelu_pk(f32x2 v) {
    const f32x2 av = __builtin_elementwise_abs(v), d = av * 0.2316418882f + 1.0f;
    f32x2 t; t.x = __builtin_amdgcn_rcpf(d.x); t.y = __builtin_amdgcn_rcpf(d.y);
    f32x2 q = t * 0.5307027145f + (-0.7265760135f); q = q * t + 0.7107068705f; q = q * t + (-0.142248368f); q = q * t + 0.127414796f; q = q * t;
    const f32x2 s = (v * v) * (-0.72134752044f);
    f32x2 e; e.x = __builtin_amdgcn_exp2f(s.x); e.y = __builtin_amdgcn_exp2f(s.y);
    const f32x2 m = v * (q * e), r = v - m;
    f32x2 o; o.x = v.x < 0.f ? m.x : r.x; o.y = v.y < 0.f ? m.y : r.y; return o;
}

template <int ACT  > struct EpiBf16 {
    static constexpr bool PERM = true, AFTER_DRAIN = false; static_assert(ACT == 0 || ACT == 1, "EpiBf16: ACT is 0 (none) or 1 (gelu_pk)");
    bf16_t* O; int ldc; const float* bias; int split_cols; size_t split_stride; float scale0;
    __device__ __forceinline__ void operator()(const f32x4 (&acc)[2][2][4][2], const Unit& u, int wr, int wc, int fr, int fq) const {
        const int row0 = u.pm * BM + wr * 64 + fr; int colt = u.pn * BM; bf16_t* base = O;
        float sc = 1.f; if (split_cols) { const int t = colt / split_cols; base += (size_t)t * split_stride; colt -= t * split_cols; if (t == 0) sc = scale0; }
        const int col0 = colt + wc * 32 + 8 * fq, bcol0 = u.pn * BM + wc * 32 + 8 * fq;
        f32x4 bv[2][2];
#pragma unroll
        for (int bj = 0; bj < 2; ++bj)
#pragma unroll
            for (int n = 0; n < 2; ++n) bv[bj][n] = bias ? *(const f32x4*)(bias + bcol0 + bj * HALF + 4 * n) : (f32x4){0.f, 0.f, 0.f, 0.f};
#pragma unroll
        for (int ai = 0; ai < 2; ++ai)
#pragma unroll
            for (int m = 0; m < 4; ++m) { bf16_t* rowp = base + (size_t)(row0 + ai * HALF + m * 16) * ldc + col0;
#pragma unroll
                for (int bj = 0; bj < 2; ++bj) { f32x4 v0 = acc[ai][bj][m][0] + bv[bj][0], v1 = acc[ai][bj][m][1] + bv[bj][1];
                    if (ACT == 1) { f32x2 a = gelu_pk((f32x2){v0[0], v0[1]}), b = gelu_pk((f32x2){v0[2], v0[3]}), c = gelu_pk((f32x2){v1[0], v1[1]}), d = gelu_pk((f32x2){v1[2], v1[3]});
                        v0 = (f32x4){a.x, a.y, b.x, b.y}; v1 = (f32x4){c.x, c.y, d.x, d.y}; }
                    v0 = v0 * sc; v1 = v1 * sc; u32x4 w; w.x = cvt_pk_bf16(v0[0], v0[1]); w.y = cvt_pk_bf16(v0[2], v0[3]); w.z = cvt_pk_bf16(v1[0], v1[1]); w.w = cvt_pk_bf16(v1[2], v1[3]);
                    *(u32x4*)(rowp + bj * HALF) = w; } }
    }
};

struct PanelStats {
    unsigned* xbuf;
    unsigned* cnt;
    unsigned* tmo;
    int ntn; float eps;
    unsigned code;
    __device__ __forceinline__ bool run(const f32x4 (&v)[2][2][4][2], const Unit& u, int wr, int wc, int fr, int fq, PG8_LAS unsigned char* lds, int wid, int lane) const {
        typedef float f32x2v __attribute__((ext_vector_type(2)));
        PG8_LAS f32x2v* P = (PG8_LAS f32x2v*)lds;
        PG8_LAS f32x2v* S = (PG8_LAS f32x2v*)(lds + 8192);
        PG8_LAS unsigned* flag = (PG8_LAS unsigned*)(lds + 8192 + 2048);
#pragma unroll
        for (int ai = 0; ai < 2; ++ai)
#pragma unroll
            for (int m = 0; m < 4; ++m) {
                float s = 0.f;
#pragma unroll
                for (int bj = 0; bj < 2; ++bj)
#pragma unroll
                    for (int n = 0; n < 2; ++n) { const f32x4 x = v[ai][bj][m][n]; s += (x[0] + x[1]) + (x[2] + x[3]); }
                s += __shfl_xor(s, 16); s += __shfl_xor(s, 32);
                const float mw = s * (1.0f / 64.0f); float q = 0.f;
#pragma unroll
                for (int bj = 0; bj < 2; ++bj)
#pragma unroll
                    for (int n = 0; n < 2; ++n) { const f32x4 d = v[ai][bj][m][n] - mw; q += (d[0] * d[0] + d[1] * d[1]) + (d[2] * d[2] + d[3] * d[3]); }
                q += __shfl_xor(q, 16); q += __shfl_xor(q, 32);
                if (fq == 0) P[(ai * HALF + wr * 64 + m * 16 + fr) * 4 + wc] = (f32x2v){mw, q};
            }
        asm volatile("s_waitcnt lgkmcnt(0)" ::: "memory"); __builtin_amdgcn_s_barrier(); asm volatile("" ::: "memory");
#if defined(BROKEN_EXCHANGE_NO_WAIT)
#warning BROKEN CONTROL BUILD: the row-statistics exchange does not wait; results are wrong by design
        if (blockIdx.x >= 64) { const long long t0_ = clock64(); while (clock64() - t0_ < 60000) __builtin_amdgcn_s_sleep(8); }
#endif
        const int row = wid * 32 + (lane & 31);
        if (lane < 32) {
            const f32x2v a = P[row * 4 + 0], b = P[row * 4 + 1], c = P[row * 4 + 2], d = P[row * 4 + 3];
            const float mt = (a.x + b.x + c.x + d.x) * 0.25f;
            const float da = a.x - mt, db = b.x - mt, dc = c.x - mt, dd = d.x - mt;
            const float m2 = (a.y + b.y) + (c.y + d.y) + 64.0f * ((da * da + db * db) + (dc * dc + dd * dd));
            unsigned long long* slot = (unsigned long long*)xbuf + ((size_t)(u.pm * BM + row) * 4 + u.pn);
            __hip_atomic_store(slot, ((unsigned long long)__float_as_uint(m2) << 32) | __float_as_uint(mt), __ATOMIC_RELAXED, __HIP_MEMORY_SCOPE_AGENT);
        }
        asm volatile("s_waitcnt vmcnt(0)" ::: "memory");
        if (lane == 0) __hip_atomic_fetch_add(cnt + 64 * u.pm, 1u, __ATOMIC_RELAXED, __HIP_MEMORY_SCOPE_AGENT);
        if (wid == 0) {
            bool dead = false; const unsigned long long t0 = __builtin_amdgcn_s_memrealtime(); const unsigned want = 8u * (unsigned)ntn;
            for (;;) {
#if defined(BROKEN_EXCHANGE_NO_WAIT)
                break;
#endif
                if ((unsigned)__builtin_amdgcn_readfirstlane(__hip_atomic_load(cnt + 64 * u.pm, __ATOMIC_RELAXED, __HIP_MEMORY_SCOPE_AGENT)) >= want) break;
                if (__builtin_amdgcn_s_memrealtime() - t0 > 2000000ull) {
                    if (lane == 0) { unsigned expect = 0u; __hip_atomic_compare_exchange_strong(tmo + 1, &expect, code | (unsigned)(u.pm & 0xff), __ATOMIC_RELAXED, __ATOMIC_RELAXED, __HIP_MEMORY_SCOPE_AGENT);
                                     __hip_atomic_store(tmo, 1u, __ATOMIC_RELAXED, __HIP_MEMORY_SCOPE_AGENT); }
                    dead = true; break; }
                __builtin_amdgcn_s_sleep(2);
            }
            __builtin_amdgcn_fence(__ATOMIC_ACQUIRE, "agent");
            if (lane == 0) flag[0] = dead ? 1u : 0u;
        }
        asm volatile("s_waitcnt vmcnt(0) lgkmcnt(0)" ::: "memory"); __builtin_amdgcn_s_barrier(); asm volatile("" ::: "memory");
        const bool bad = flag[0] != 0u;
        if (lane < 32) {
            const unsigned long long* slot = (const unsigned long long*)xbuf + (size_t)(u.pm * BM + row) * 4; float mt[4], m2[4]; float ms = 0.f;
#pragma unroll
            for (int t = 0; t < 4; ++t) { if (t < ntn) { const unsigned long long w = __hip_atomic_load(slot + t, __ATOMIC_RELAXED, __HIP_MEMORY_SCOPE_AGENT); mt[t] = __uint_as_float((unsigned)w); m2[t] = __uint_as_float((unsigned)(w >> 32)); } else { mt[t] = 0.f; m2[t] = 0.f; } ms += mt[t]; }
            const float mean = ms / (float)ntn; float q = 0.f;
#pragma unroll
            for (int t = 0; t < 4; ++t) if (t < ntn) { const float dm = mt[t] - mean; q += m2[t] + 256.0f * dm * dm; }
            S[row] = (f32x2v){mean, 1.0f / sqrtf(q / (256.0f * (float)ntn) + eps)};
        }
        asm volatile("s_waitcnt lgkmcnt(0)" ::: "memory"); __builtin_amdgcn_s_barrier(); asm volatile("" ::: "memory");
        return bad;
    }
};
struct EpiLnRes {
    static constexpr bool PERM = false, AFTER_DRAIN = true;
    const float* base; float* out; int ldc; const float* bias; PanelStats st; unsigned poison;
    __device__ __forceinline__ void fused(f32x4 (&acc)[2][2][4][2], const Unit& u, int wr, int wc, int fr, int fq, PG8_LAS unsigned char* lds, int wid, int lane) const {
        typedef float f32x2v __attribute__((ext_vector_type(2)));
        const PG8_LAS f32x2v* S = (const PG8_LAS f32x2v*)(lds + 8192);
        const int col0 = u.pn * BM + wc * 32 + 4 * fq;
#pragma unroll
        for (int bj = 0; bj < 2; ++bj)
#pragma unroll
            for (int n = 0; n < 2; ++n) { const f32x4 bv = bias ? *(const f32x4*)(bias + col0 + bj * HALF + n * 16) : (f32x4){0.f, 0.f, 0.f, 0.f};
#pragma unroll
                for (int ai = 0; ai < 2; ++ai)
#pragma unroll
                    for (int m = 0; m < 4; ++m) acc[ai][bj][m][n] += bv; }
        f32x4 pre[4][2][2];
#pragma unroll
        for (int m = 0; m < 4; ++m) { const size_t off = (size_t)(u.pm * BM + wr * 64 + m * 16 + fr) * ldc + col0;
#pragma unroll
            for (int bj = 0; bj < 2; ++bj)
#pragma unroll
                for (int n = 0; n < 2; ++n) pre[m][bj][n] = *(const f32x4*)(base + off + bj * HALF + n * 16); }
        const bool bad = st.run(acc, u, wr, wc, fr, fq, lds, wid, lane) || poison != 0u;
        const float qnan = __builtin_nanf("");
#pragma unroll
        for (int ai = 0; ai < 2; ++ai)
#pragma unroll
            for (int m = 0; m < 4; ++m) { const int r = ai * HALF + wr * 64 + m * 16 + fr; const f32x2v sr = S[r]; const size_t off = (size_t)(u.pm * BM + r) * ldc + col0;
#pragma unroll
                for (int bj = 0; bj < 2; ++bj)
#pragma unroll
                    for (int n = 0; n < 2; ++n) { const f32x4 bs = ai == 0 ? pre[m][bj][n] : *(const f32x4*)(base + off + bj * HALF + n * 16); f32x4 o = bs + (acc[ai][bj][m][n] - sr.x) * sr.y;
                        if (bad) o = (f32x4){qnan, qnan, qnan, qnan}; *(f32x4*)(out + off + bj * HALF + n * 16) = o; }
                if (m & 1) asm volatile("" ::: "memory"); }
    }
};
struct EpiLnResLn {
    static constexpr bool PERM = false, AFTER_DRAIN = true;
    const float* base; float* out; bf16_t* xn; int ldc; const float* bias; PanelStats st1, st2; unsigned poison;
    __device__ __forceinline__ void fused(f32x4 (&acc)[2][2][4][2], const Unit& u, int wr, int wc, int fr, int fq, PG8_LAS unsigned char* lds, int wid, int lane) const {
        typedef float f32x2v __attribute__((ext_vector_type(2))); typedef unsigned u32x2v __attribute__((ext_vector_type(2)));
        const PG8_LAS f32x2v* S = (const PG8_LAS f32x2v*)(lds + 8192);
        const int col0 = u.pn * BM + wc * 32 + 4 * fq;
#pragma unroll
        for (int bj = 0; bj < 2; ++bj)
#pragma unroll
            for (int n = 0; n < 2; ++n) { const f32x4 bv = bias ? *(const f32x4*)(bias + col0 + bj * HALF + n * 16) : (f32x4){0.f, 0.f, 0.f, 0.f};
#pragma unroll
                for (int ai = 0; ai < 2; ++ai)
#pragma unroll
                    for (int m = 0; m < 4; ++m) acc[ai][bj][m][n] += bv; }
        bool bad = st1.run(acc, u, wr, wc, fr, fq, lds, wid, lane) || poison != 0u;
        const float qnan = __builtin_nanf("");
#pragma unroll
        for (int ai = 0; ai < 2; ++ai)
#pragma unroll
            for (int m = 0; m < 4; ++m) { const int r = ai * HALF + wr * 64 + m * 16 + fr; const f32x2v sr = S[r]; const size_t off = (size_t)(u.pm * BM + r) * ldc + col0;
#pragma unroll
                for (int bj = 0; bj < 2; ++bj)
#pragma unroll
                    for (int n = 0; n < 2; ++n) { const f32x4 bs = *(const f32x4*)(base + off + bj * HALF + n * 16); acc[ai][bj][m][n] = bs + (acc[ai][bj][m][n] - sr.x) * sr.y; }
                asm volatile("" : "+v"(acc[ai][0][m][0]), "+v"(acc[ai][0][m][1]), "+v"(acc[ai][1][m][0]), "+v"(acc[ai][1][m][1]));
                if (m & 1) asm volatile("" ::: "memory"); }
        const bool bad1 = bad;
        bad = st2.run(acc, u, wr, wc, fr, fq, lds, wid, lane) || bad;
#pragma unroll
        for (int ai = 0; ai < 2; ++ai)
#pragma unroll
            for (int m = 0; m < 4; ++m) { const int r = ai * HALF + wr * 64 + m * 16 + fr; const f32x2v sr = S[r]; const size_t off = (size_t)(u.pm * BM + r) * ldc + col0;
#pragma unroll
                for (int bj = 0; bj < 2; ++bj)
#pragma unroll
                    for (int n = 0; n < 2; ++n) { const f32x4 x1 = acc[ai][bj][m][n]; *(f32x4*)(out + off + bj * HALF + n * 16) = bad1 ? (f32x4){qnan, qnan, qnan, qnan} : x1;
                        const f32x4 o = (x1 - sr.x) * sr.y; u32x2v w; w.x = cvt_pk_bf16(o[0], o[1]); w.y = cvt_pk_bf16(o[2], o[3]);
                        if (bad) { w.x = 0x7fc07fc0u; w.y = 0x7fc07fc0u; } *(u32x2v*)(xn + off + bj * HALF + n * 16) = w; }
                asm volatile("" ::: "memory"); }
    }
};

typedef int i32x8 __attribute__((ext_vector_type(8)));
typedef int i32x4 __attribute__((ext_vector_type(4)));
template <class Epi, class Sched, bool ALIGN_EPI = false, bool SP2 = false, bool F8 = false>
__device__ __forceinline__ void gemm_phase(PG8_LAS unsigned char* lds, const Gemm g, const Sched& S, const Epi& E) {
    const int tid = threadIdx.x, wid = __builtin_amdgcn_readfirstlane(tid >> 6), lane = tid & 63, wr = wid >> 2, wc = wid & 3, fr = lane & 15, fq = lane >> 4;
    const int K = g.K, nt = K / BK;
    unsigned voffA[2], voffB[2];
#pragma unroll
    for (int i = 0; i < 2; ++i) { int R, C; stage_rc(tid * 16 + i * 8192, R, C); const int Rb = Epi::PERM ? ((R & ~31) + perm32(R & 31)) : R;
        voffA[i] = (unsigned)(R * K + C) * 2u; voffB[i] = (unsigned)(Rb * K + C) * 2u; }
    const size_t kstep = (size_t)(BK * 2);
    const size_t hstep = (size_t)HALF * K * 2;
    const size_t tstep = 2 * hstep;
    const unsigned ldsw = (unsigned)wid * 1024u;
    const int aoff = lds_byte(wr * 64 + fr, F8 ? fq * 16 : fq * 8), boff = lds_byte(wc * 32 + fr, F8 ? fq * 16 : fq * 8);
#define PG8_SA(b, h) (((b) * 2 + (h)) * HTB)
#define PG8_SB(b, h) ((4 + (b) * 2 + (h)) * HTB)
#define PG8_STAGE(bufoff, gbase, voff) do { _Pragma("unroll") for (int _i = 0; _i < 2; ++_i) \
        __builtin_amdgcn_global_load_lds((const unsigned*)((const char*)(gbase) + (voff)[_i]), (PG8_LAS unsigned*)(lds + (bufoff) + ldsw + _i * 8192), 16, 0, 0); } while (0)
#define PG8_LD32(p) __builtin_shufflevector(*(const PG8_LAS i32x4*)((p) + f8o1), *(const PG8_LAS i32x4*)((p) + f8o2), 0, 1, 2, 3, 4, 5, 6, 7)
#define PG8_LDA(dst, b, h) do { if constexpr (F8) { _Pragma("unroll") for (int m = 0; m < 4; ++m) dst##8[m] = PG8_LD32(lds + PG8_SA(b, h) + aoff + m * 2048); } \
        else { _Pragma("unroll") for (int m = 0; m < 4; ++m) _Pragma("unroll") for (int k = 0; k < 2; ++k) dst[m][k] = *(const PG8_LAS bf16x8*)(lds + PG8_SA(b, h) + aoff + m * 2048 + k * 1024); } } while (0)
#define PG8_LDB(dst, b, h) do { if constexpr (F8) { _Pragma("unroll") for (int n = 0; n < 2; ++n) dst##8[n] = PG8_LD32(lds + PG8_SB(b, h) + boff + n * 2048); } \
        else { _Pragma("unroll") for (int n = 0; n < 2; ++n) _Pragma("unroll") for (int k = 0; k < 2; ++k) dst[n][k] = *(const PG8_LAS bf16x8*)(lds + PG8_SB(b, h) + boff + n * 2048 + k * 1024); } } while (0)
#define PG8_MMA(ai, bj, At, Bt) do { __builtin_amdgcn_s_setprio(1); if constexpr (F8) { _Pragma("unroll") for (int m = 0; m < 4; ++m) _Pragma("unroll") for (int n = 0; n < 2; ++n) \
        asm volatile("v_mfma_scale_f32_16x16x128_f8f6f4 %0, %1, %2, %0, %3, %3 op_sel_hi:[0,0,0]" : "+v"(acc[ai][bj][m][n]) : "v"(Bt##8[n]), "v"(At##8[m]), "v"(sc1_)); } \
        else { _Pragma("unroll") for (int m = 0; m < 4; ++m) _Pragma("unroll") for (int n = 0; n < 2; ++n) _Pragma("unroll") for (int k = 0; k < 2; ++k) \
        acc[ai][bj][m][n] = __builtin_amdgcn_mfma_f32_16x16x32_bf16(Bt[n][k], At[m][k], acc[ai][bj][m][n], 0, 0, 0); } __builtin_amdgcn_s_setprio(0); } while (0)
#define PG8_WAIT_V(n) asm volatile("s_waitcnt vmcnt(" #n ")" ::: "memory")
#define PG8_WAIT_L(n) asm volatile("s_waitcnt lgkmcnt(" #n ")" ::: "memory")
#define PG8_BAR __builtin_amdgcn_s_barrier()
#define PG8_SCHED __builtin_amdgcn_sched_barrier(0)
    Unit cur, nxt; int ui = 0;
    if (!S.next(0, cur)) return;
    f32x4 acc[2][2][4][2];
#pragma unroll
    for (int a = 0; a < 2; ++a)
#pragma unroll
        for (int b = 0; b < 2; ++b)
#pragma unroll
            for (int m = 0; m < 4; ++m)
#pragma unroll
                for (int n = 0; n < 2; ++n) acc[a][b][m][n] = (f32x4){0.f, 0.f, 0.f, 0.f};
    bf16x8 At[4][2], B0[2][2], B1[2][2]; i32x8 At8[4], B08[2], B18[2];
    const int f8o1 = (fq & 1) * 16, f8o2 = 16 - f8o1;
    int sc1_ = 0x7f7f7f7f; asm volatile("" : "+v"(sc1_));
    const char* cA; const char* cB; S.ab(cur, g, tstep, cA, cB);
    S.a_ready(cur);
    if constexpr (SP2) {
        PG8_STAGE(PG8_SB(0, 0), cB, voffB); PG8_STAGE(PG8_SB(0, 1), cB + hstep, voffB); PG8_STAGE(PG8_SA(0, 0), cA, voffA); PG8_STAGE(PG8_SA(0, 1), cA + hstep, voffA);
        if (wr == 1) PG8_BAR;
        PG8_WAIT_V(2); PG8_BAR;
        PG8_STAGE(PG8_SB(1, 0), cB + kstep, voffB); PG8_STAGE(PG8_SA(1, 0), cA + kstep, voffA); PG8_STAGE(PG8_SB(1, 1), cB + hstep + kstep, voffB);
        PG8_WAIT_V(6); PG8_BAR;
    } else {
        PG8_STAGE(PG8_SB(0, 0), cB, voffB); PG8_STAGE(PG8_SA(0, 0), cA, voffA); PG8_STAGE(PG8_SB(0, 1), cB + hstep, voffB); PG8_STAGE(PG8_SA(0, 1), cA + hstep, voffA);
        if (wr == 1) PG8_BAR;
        PG8_WAIT_V(4); PG8_BAR;
        PG8_STAGE(PG8_SB(1, 0), cB + kstep, voffB); PG8_STAGE(PG8_SA(1, 0), cA + kstep, voffA); PG8_STAGE(PG8_SB(1, 1), cB + hstep + kstep, voffB);
        PG8_WAIT_V(6); PG8_BAR;
    }
    for (;;) {
        const bool has_next = S.next(ui + 1, nxt);
        const char* nA = cA; const char* nB = cB; if (has_next) S.ab(nxt, g, tstep, nA, nB);
        for (int t = 0; t < nt; t += 2) {
            const bool last = (t == nt - 2);
            const char* a1 = cA + (size_t)(t + 1) * kstep;
            const char* a2 = last ? nA : cA + (size_t)(t + 2) * kstep; const char* b2 = last ? nB : cB + (size_t)(t + 2) * kstep;
            const char* a3 = a2 + kstep; const char* b3 = b2 + kstep;
            if (last && has_next) S.a_ready(nxt);
            if constexpr (SP2) {
            PG8_LDB(B0, 0, 0); PG8_LDB(B1, 0, 1); PG8_SCHED; PG8_LDA(At, 0, 0); PG8_STAGE(PG8_SA(1, 1), a1 + hstep, voffA);
            PG8_WAIT_V(8); PG8_WAIT_L(0); PG8_BAR; PG8_MMA(0, 0, At, B0); PG8_MMA(0, 1, At, B1); PG8_BAR; PG8_SCHED;
            PG8_LDA(At, 0, 1); PG8_STAGE(PG8_SB(0, 0), b2, voffB); PG8_STAGE(PG8_SB(0, 1), b2 + hstep, voffB); PG8_STAGE(PG8_SA(0, 0), a2, voffA);
            PG8_WAIT_V(8); PG8_WAIT_L(0); PG8_BAR; PG8_MMA(1, 0, At, B0); PG8_MMA(1, 1, At, B1); PG8_BAR; PG8_SCHED;
            PG8_LDB(B0, 1, 0); PG8_LDB(B1, 1, 1); PG8_SCHED; PG8_LDA(At, 1, 0); PG8_STAGE(PG8_SA(0, 1), a2 + hstep, voffA);
            PG8_WAIT_V(8); PG8_WAIT_L(0); PG8_BAR; PG8_MMA(0, 0, At, B0); PG8_MMA(0, 1, At, B1); PG8_BAR; PG8_SCHED;
            PG8_LDA(At, 1, 1); PG8_STAGE(PG8_SB(1, 0), b3, voffB); PG8_STAGE(PG8_SB(1, 1), b3 + hstep, voffB); PG8_STAGE(PG8_SA(1, 0), a3, voffA);
            PG8_WAIT_V(8); PG8_WAIT_L(0); PG8_BAR; PG8_MMA(1, 0, At, B0); PG8_MMA(1, 1, At, B1); PG8_BAR; PG8_SCHED;
            } else {
            PG8_LDB(B0, 0, 0); PG8_SCHED; PG8_LDA(At, 0, 0); PG8_STAGE(PG8_SA(1, 1), a1 + hstep, voffA);
            PG8_WAIT_L(8); PG8_BAR; PG8_WAIT_L(0); PG8_MMA(0, 0, At, B0); PG8_BAR; PG8_SCHED;
            PG8_LDB(B1, 0, 1); PG8_STAGE(PG8_SB(0, 0), b2, voffB);
            PG8_BAR; PG8_WAIT_L(0); PG8_MMA(0, 1, At, B1); PG8_BAR;
            PG8_LDA(At, 0, 1); PG8_STAGE(PG8_SA(0, 0), a2, voffA);
            PG8_BAR; PG8_WAIT_L(0); PG8_MMA(1, 0, At, B0); PG8_BAR; PG8_SCHED;
            PG8_STAGE(PG8_SB(0, 1), b2 + hstep, voffB);
            PG8_WAIT_V(6); PG8_BAR; PG8_MMA(1, 1, At, B1); PG8_BAR;
            PG8_LDB(B0, 1, 0); PG8_SCHED; PG8_LDA(At, 1, 0); PG8_STAGE(PG8_SA(0, 1), a2 + hstep, voffA);
            PG8_WAIT_L(8); PG8_BAR; PG8_WAIT_L(0); PG8_MMA(0, 0, At, B0); PG8_BAR; PG8_SCHED;
            PG8_LDB(B1, 1, 1); PG8_STAGE(PG8_SB(1, 0), b3, voffB);
            PG8_BAR; PG8_WAIT_L(0); PG8_MMA(0, 1, At, B1); PG8_BAR;
            PG8_LDA(At, 1, 1); PG8_STAGE(PG8_SA(1, 0), a3, voffA);
            PG8_BAR; PG8_WAIT_L(0); PG8_MMA(1, 0, At, B0); PG8_BAR; PG8_SCHED;
            PG8_STAGE(PG8_SB(1, 1), b3 + hstep, voffB);
            PG8_WAIT_V(6); PG8_BAR; PG8_MMA(1, 1, At, B1); PG8_BAR;
            }
        }
        if constexpr (F8) { asm volatile("s_nop 15\n\ts_nop 15" ::: "memory"); __builtin_amdgcn_sched_barrier(0); }
        if constexpr (ALIGN_EPI) { if (wr == 0) PG8_BAR; }
        if constexpr (!Epi::AFTER_DRAIN) { E(acc, cur, wr, wc, fr, fq); S.done(cur); }
        if (!has_next) break;
#pragma unroll
        for (int a = 0; a < 2; ++a)
#pragma unroll
            for (int b = 0; b < 2; ++b)
#pragma unroll
                for (int m = 0; m < 4; ++m)
#pragma unroll
                    for (int n = 0; n < 2; ++n) acc[a][b][m][n] = (f32x4){0.f, 0.f, 0.f, 0.f};
        cur = nxt; cA = nA; cB = nB; ++ui;
        if constexpr (ALIGN_EPI) { if (wr == 1) PG8_BAR; }
    }
    PG8_WAIT_V(0);
    if constexpr (!ALIGN_EPI) { if (wr == 0) PG8_BAR; }
    PG8_BAR;
    if constexpr (Epi::AFTER_DRAIN) { E.fused(acc, cur, wr, wc, fr, fq, lds, wid, lane); S.done(cur); }
#undef PG8_SA
#undef PG8_SB
#undef PG8_STAGE
#undef PG8_LDA
#undef PG8_LD32
#undef PG8_LDB
#undef PG8_MMA
#undef PG8_WAIT_V
#undef PG8_WAIT_L
#undef PG8_BAR
#undef PG8_SCHED
}
}

namespace pg8 {
constexpr float QK_C2 = 0.125f * 1.4426950408889634f;
__device__ __forceinline__ unsigned pk_fp8x4(float a, float b, float c, float d);
struct InProjOrder {
    static constexpr int NM = 272, NN = 8, NMAIN = NM * NN, NALL = NMAIN + 2 * NM;
    int G, c;
    __host__ __device__ void init(int G_, int c_) { G = G_; c = c_; }
    __host__ __device__ bool next(int i, Unit& u) const {
        const long L = (long)i * G + c; if (L >= NALL) return false;
        if (L < NMAIN) { int wgid = (int)L; { const int q = NMAIN / NXCD, xcd = wgid % NXCD, off = wgid / NXCD; wgid = xcd * q + off; }
            const int nig = WGM * NN, gid = wgid / nig, fm = gid * WGM, gsz = (NM - fm) < WGM ? (NM - fm) : WGM;
            u.pm = fm + ((wgid % nig) % gsz); u.pn = (wgid % nig) / gsz; }
        else { const int v = (int)L - NMAIN; u.pm = v >> 1; u.pn = 8 + (v & 1); }
        return true;
    }
    __device__ __forceinline__ void a_ready(const Unit&) const {}
    __device__ __forceinline__ void done(const Unit&) const {}
    __device__ __forceinline__ void ab(const Unit& u, const Gemm& g, size_t tstep, const char*& pa, const char*& pb) const {
        if (u.pn < 8) { pa = (const char*)g.A + (size_t)u.pm * tstep; pb = (const char*)g.Bt + (size_t)u.pn * tstep; }
        else { pa = (const char*)g.Bt + (size_t)u.pn * tstep; pb = (const char*)g.A + (size_t)u.pm * tstep; }
    }
};
struct EpiInProj {
    static constexpr bool PERM = true, AFTER_DRAIN = false;
    bf16_t *Q, *Kb, *VT, *Ub, *Gb; unsigned char* VT8; const PG8_LAS float* ropec; const PG8_LAS float* ropes;
    __device__ __forceinline__ void operator()(const f32x4 (&acc)[2][2][4][2], const Unit& u, int wr, int wc, int fr, int fq) const {
        const bool ctx = u.pm >= 256;
        if (u.pn >= 8) {
            const int tok0 = u.pm * BM + wc * 32 + 8 * fq;
#pragma unroll
            for (int bj = 0; bj < 2; ++bj) { const int tok = tok0 + bj * HALF; int bidx, key;
                if (ctx) { bidx = (tok - 65536) >> 8; key = 4096 + ((tok - 65536) & 255); } else { bidx = tok >> 12; key = tok & 4095; }
#pragma unroll
                for (int ai = 0; ai < 2; ++ai)
#pragma unroll
                    for (int m = 0; m < 4; ++m) { const int dim = (u.pn - 8) * BM + ai * HALF + wr * 64 + m * 16 + fr;
                        const f32x4 v0 = acc[ai][bj][m][0], v1 = acc[ai][bj][m][1];
                        u32x4 w; w.x = cvt_pk_bf16(v0[0], v0[1]); w.y = cvt_pk_bf16(v0[2], v0[3]); w.z = cvt_pk_bf16(v1[0], v1[1]); w.w = cvt_pk_bf16(v1[2], v1[3]);
                        *(u32x4*)(VT + ((size_t)(bidx * 512 + dim)) * 4352 + key) = w;
                        typedef unsigned u32x2v __attribute__((ext_vector_type(2))); u32x2v w8; w8.x = pk_fp8x4(v0[0], v0[1], v0[2], v0[3]); w8.y = pk_fp8x4(v1[0], v1[1], v1[2], v1[3]);
                        *(u32x2v*)(VT8 + ((size_t)(bidx * 512 + dim)) * 4352 + key) = w8; } }
            return;
        }
        const int seg = u.pn >> 1;
        if (ctx && (seg == 0 || seg == 3)) return;
        const int cs0 = (u.pn & 1) * BM + wc * 32 + 8 * fq;
        const bool rope = (seg < 2) && !ctx; const int a = wc & 1;
#pragma unroll
        for (int ai = 0; ai < 2; ++ai)
#pragma unroll
            for (int m = 0; m < 4; ++m) {
                const int r = u.pm * BM + ai * HALF + wr * 64 + m * 16 + fr;
                int bidx, s; size_t rowkv;
                if (ctx) { bidx = (r - 65536) >> 8; s = (r - 65536) & 255; rowkv = (size_t)bidx * 4352 + 4096 + s; }
                else { bidx = r >> 12; s = r & 4095; rowkv = (size_t)bidx * 4352 + s; }
                f32x4 cs = (f32x4){1.f, 1.f, 1.f, 1.f}, sn = (f32x4){0.f, 0.f, 0.f, 0.f};
                if (rope) { const int pos = a ? (s & 63) : (s >> 6); cs = *(const PG8_LAS f32x4*)(ropec + pos * 16 + 4 * fq); sn = *(const PG8_LAS f32x4*)(ropes + pos * 16 + 4 * fq); }
                bf16_t* dst;
                if (seg == 0) dst = Q + (size_t)r * 512; else if (seg == 1) dst = Kb + rowkv * 512; else if (seg == 2) dst = Ub + (size_t)r * 512; else dst = Gb + (size_t)r * 512;
#pragma unroll
                for (int bj = 0; bj < 2; ++bj) {
                    f32x4 v0 = acc[ai][bj][m][0], v1 = acc[ai][bj][m][1];
                    if (rope) { const f32x4 o1 = v0 * cs - v1 * sn, o2 = v1 * cs + v0 * sn; v0 = o1; v1 = o2; }
                    if (seg == 0) { v0 = v0 * QK_C2; v1 = v1 * QK_C2; }
                    u32x4 w; w.x = cvt_pk_bf16(v0[0], v0[1]); w.y = cvt_pk_bf16(v0[2], v0[3]); w.z = cvt_pk_bf16(v1[0], v1[1]); w.w = cvt_pk_bf16(v1[2], v1[3]);
                    *(u32x4*)(dst + cs0 + bj * HALF) = w;
                }
            }
    }
};
__device__ __forceinline__ unsigned pk_fp8x4(float a, float b, float c, float d) {
    a = __builtin_amdgcn_fmed3f(a, -448.f, 448.f); b = __builtin_amdgcn_fmed3f(b, -448.f, 448.f); c = __builtin_amdgcn_fmed3f(c, -448.f, 448.f); d = __builtin_amdgcn_fmed3f(d, -448.f, 448.f);
    int w = 0; w = __builtin_amdgcn_cvt_pk_fp8_f32(a, b, w, false); w = __builtin_amdgcn_cvt_pk_fp8_f32(c, d, w, true); return (unsigned)w; }
template <bool OUT8> struct EpiSwiglu {
    static constexpr bool PERM = true, AFTER_DRAIN = false;
    bf16_t* H; int ldh; float ascale, oscale;
    __device__ __forceinline__ void operator()(const f32x4 (&acc)[2][2][4][2], const Unit& u, int wr, int wc, int fr, int fq) const {
        const int col0 = u.pn * HALF + wc * 32 + 8 * fq;
#pragma unroll
        for (int ai = 0; ai < 2; ++ai)
#pragma unroll
            for (int m = 0; m < 4; ++m) {
                const size_t r = (size_t)u.pm * BM + ai * HALF + wr * 64 + m * 16 + fr;
                float o[8];
#pragma unroll
                for (int n = 0; n < 2; ++n)
#pragma unroll
                    for (int j = 0; j < 4; ++j) { const float av = acc[ai][0][m][n][j] * ascale, bv = acc[ai][1][m][n][j] * ascale;
                        const float sg = __builtin_amdgcn_rcpf(1.f + __builtin_amdgcn_exp2f(-av * 1.4426950408889634f)); o[4 * n + j] = av * sg * bv; }
                if constexpr (OUT8) { typedef unsigned u32x2v __attribute__((ext_vector_type(2)));
                    u32x2v w; w.x = pk_fp8x4(o[0] * oscale, o[1] * oscale, o[2] * oscale, o[3] * oscale); w.y = pk_fp8x4(o[4] * oscale, o[5] * oscale, o[6] * oscale, o[7] * oscale);
                    *(u32x2v*)((unsigned char*)H + r * ldh + col0) = w;
                } else { u32x4 w; w.x = cvt_pk_bf16(o[0], o[1]); w.y = cvt_pk_bf16(o[2], o[3]); w.z = cvt_pk_bf16(o[4], o[5]); w.w = cvt_pk_bf16(o[6], o[7]);
                    *(u32x4*)(H + r * ldh + col0) = w; }
            }
    }
};
struct EpiPlain {
    static constexpr bool PERM = true, AFTER_DRAIN = false;
    bf16_t* O; int ldc; float scale;
    __device__ __forceinline__ void operator()(const f32x4 (&acc)[2][2][4][2], const Unit& u, int wr, int wc, int fr, int fq) const {
        const int col0 = u.pn * BM + wc * 32 + 8 * fq;
#pragma unroll
        for (int ai = 0; ai < 2; ++ai)
#pragma unroll
            for (int m = 0; m < 4; ++m) {
                bf16_t* rowp = O + ((size_t)u.pm * BM + ai * HALF + wr * 64 + m * 16 + fr) * ldc + col0;
#pragma unroll
                for (int bj = 0; bj < 2; ++bj) { const f32x4 v0 = acc[ai][bj][m][0] * scale, v1 = acc[ai][bj][m][1] * scale;
                    u32x4 w; w.x = cvt_pk_bf16(v0[0], v0[1]); w.y = cvt_pk_bf16(v0[2], v0[3]); w.z = cvt_pk_bf16(v1[0], v1[1]); w.w = cvt_pk_bf16(v1[2], v1[3]);
                    *(u32x4*)(rowp + bj * HALF) = w; }
            }
    }
};
}

#ifndef ATT_F8MAP1
#define ATT_F8MAP1 1
#endif
namespace att {
typedef short bf16x8 __attribute__((ext_vector_type(8)));
typedef short s16x4 __attribute__((ext_vector_type(4)));
typedef short v4i16_t __attribute__((ext_vector_type(4)));
typedef float f32x16 __attribute__((ext_vector_type(16)));
typedef float f32x4 __attribute__((ext_vector_type(4)));
typedef unsigned u32x4 __attribute__((ext_vector_type(4)));
#define ATT_LAS __attribute__((address_space(3)))
typedef ATT_LAS const char* lds_cptr;
constexpr int TKV = 4352, NT = TKV / 64, NS = 3, KSLOT = 8192, VSLOT = 16384;
constexpr int LDS_K = 0, LDS_V = NS * KSLOT, LDS_SCR = LDS_V + 4 * VSLOT, LDS_FLG = LDS_SCR + 8 * 256, LDS_END = LDS_FLG + 64;
constexpr size_t PARK_FLOATS = 64 * 512;
__device__ __forceinline__ int crow(int r, int hi) { return (r & 3) + 8 * (r >> 2) + 4 * hi; }
__device__ __forceinline__ void glds16(const void* gsrc, unsigned lds_dst) { unsigned keep;
    asm volatile("s_mov_b32 %0, m0\n\ts_mov_b32 m0, %2\n\ts_nop 0\n\tglobal_load_lds_dwordx4 %1, off\n\ts_mov_b32 m0, %0" : "=&s"(keep) : "v"(gsrc), "s"(lds_dst) : "memory"); }
__device__ __forceinline__ void glds16s(const void* sbase, unsigned voff, unsigned lds_dst) { unsigned keep;
    asm volatile("s_mov_b32 %0, m0\n\ts_mov_b32 m0, %3\n\ts_nop 0\n\tglobal_load_lds_dwordx4 %1, %2\n\ts_mov_b32 m0, %0" : "=&s"(keep) : "v"(voff), "s"(sbase), "s"(lds_dst) : "memory"); }
typedef float f32x2_t __attribute__((ext_vector_type(2))); typedef __bf16 bf16x2_t __attribute__((ext_vector_type(2)));
__device__ __forceinline__ unsigned cvtpk(float lo, float hi) { f32x2_t v = {lo, hi}; bf16x2_t b = __builtin_convertvector(v, bf16x2_t); return __builtin_bit_cast(unsigned, b); }
__device__ __forceinline__ s16x4 vtr(lds_cptr p) { return __builtin_bit_cast(s16x4, __builtin_amdgcn_ds_read_tr16_b64_v4i16((ATT_LAS v4i16_t*)p)); }
__device__ __forceinline__ bf16x8 ldsb128(lds_cptr p) { return *(const ATT_LAS bf16x8*)p; }
#define ATT_SB() __builtin_amdgcn_sched_barrier(0)
#define ATT_WAITBAR(N) asm volatile("s_waitcnt vmcnt(" #N ") lgkmcnt(0)\n\ts_barrier" ::: "memory")

typedef int i32x8 __attribute__((ext_vector_type(8)));
typedef int i32x4 __attribute__((ext_vector_type(4)));
template <int MODE, bool F8>
__device__ __forceinline__ void attn_pass(int m, const short* Qw, const short* Kh, const short* Vh, const unsigned char* V8h, char* shm, f32x16 (&o)[4], float& l, float& mx) {
    const int tid = threadIdx.x, lane = tid & 63, r32 = lane & 31, hi = lane >> 5; const int wid = __builtin_amdgcn_readfirstlane(tid >> 6);
    const bool late = wid >= 4;
    const unsigned lds0 = (unsigned)(uintptr_t)shm;
    const short* kbase = Kh + m * 64 + wid * 8;
    const unsigned koff = (unsigned)lane * 1024u;
    const int vd_ = F8 ? 16 * wid + (lane >> 2) : 8 * wid + (lane >> 3);
    const short* vbase = F8 ? (const short*)(V8h + (size_t)(16 * wid) * TKV) : Vh + (size_t)(8 * wid) * TKV;
    const unsigned voff = F8 ? (unsigned)((lane >> 2) * TKV + (((lane & 3) ^ ((vd_ >> 2) & 3)) * 16)) : (unsigned)((lane >> 3) * TKV + (((lane & 7) ^ ((vd_ >> 1) & 7)) * 8)) * 2u;
    const unsigned kdst = lds0 + LDS_K + wid * 1024, vdst = lds0 + LDS_V + wid * 1024;
#define ATT_DMAK(t, slot) glds16s((const void*)(kbase + (size_t)(t) * 64 * 512), koff, (unsigned)__builtin_amdgcn_readfirstlane(kdst + (slot)))
#define ATT_DMAV(t, slot) do { if (F8) { glds16s((const void*)((const char*)vbase + (size_t)(t) * 64), voff, (unsigned)__builtin_amdgcn_readfirstlane(vdst + (slot))); } \
        else { const short* vs_ = vbase + (size_t)(t) * 64; glds16s((const void*)vs_, voff, (unsigned)__builtin_amdgcn_readfirstlane(vdst + (slot))); glds16s((const void*)(vs_ + (size_t)64 * TKV), voff, (unsigned)__builtin_amdgcn_readfirstlane(vdst + (slot) + 8192)); } } while (0)
    const lds_cptr shm3 = (lds_cptr)shm;
    const int kpi_ = F8 ? (32 * ((r32 >> 2) & 1) + (r32 & 3) + 4 * (r32 >> 3)) : ((r32 & ~12) | ((r32 & 4) << 1) | ((r32 & 8) >> 1));
    constexpr int KB_OFF = F8 ? 256 : 512;
    const lds_cptr kp0 = shm3 + LDS_K + hi * 1024 + kpi_ * 16;
    const int vf_ = (r32 >> 1) & 7;
    const lds_cptr vq0 = shm3 + LDS_V + r32 * 128 + (((0 + hi) ^ vf_) << 4), vq1 = shm3 + LDS_V + r32 * 128 + (((2 + hi) ^ vf_) << 4);
    const lds_cptr vq2 = shm3 + LDS_V + r32 * 128 + (((4 + hi) ^ vf_) << 4), vq3 = shm3 + LDS_V + r32 * 128 + (((6 + hi) ^ vf_) << 4);
    const lds_cptr v8a = shm3 + LDS_V + r32 * 64 + (((2 * hi) ^ ((r32 >> 2) & 3)) << 4), v8b = shm3 + LDS_V + r32 * 64 + (((2 * hi + 1) ^ ((r32 >> 2) & 3)) << 4);
    int sc1_ = 0x7f7f7f7f; asm volatile("" : "+v"(sc1_)); int scA = sc1_;
    bf16x8 qr[4];
#pragma unroll
    for (int d0 = 0; d0 < 4; ++d0) qr[d0] = *(const bf16x8*)(Qw + (size_t)r32 * 512 + m * 64 + d0 * 16 + hi * 8);
    asm volatile("" : "+v"(qr[0]), "+v"(qr[1]), "+v"(qr[2]), "+v"(qr[3]) :: "memory");
    constexpr int NV = F8 ? 1 : 2;
    ATT_DMAK(0, 0); ATT_DMAV(0, 0); ATT_DMAK(1, KSLOT); ATT_DMAK(2, 2 * KSLOT); ATT_DMAV(1, VSLOT);
#pragma unroll
    for (int i = 0; i < 4; ++i) o[i] = f32x16{};
    l = 0.f; float nmx = -INFINITY; f32x2_t l2 = {0.f, 0.f};
    if (NV == 2) ATT_WAITBAR(3); else ATT_WAITBAR(2);
    bf16x8 ka0, ka1, ka2, ka3, kb0, kb1, kb2, kb3;
#define ATT_LOADK(slot) do { const lds_cptr kp_ = kp0 + (slot); ka0 = ldsb128(kp_); kb0 = ldsb128(kp_ + KB_OFF); ka1 = ldsb128(kp_ + 2048); kb1 = ldsb128(kp_ + 2048 + KB_OFF); \
        ka2 = ldsb128(kp_ + 4096); kb2 = ldsb128(kp_ + 4096 + KB_OFF); ka3 = ldsb128(kp_ + 6144); kb3 = ldsb128(kp_ + 6144 + KB_OFF); } while (0)
    ATT_LOADK(0);
    if (NV == 2) ATT_WAITBAR(3); else ATT_WAITBAR(2);
    int ksl = 0, vsl = 0;
    bf16x8 p0, p1, p2, p3;
    p0 = p1 = p2 = p3 = (bf16x8){0, 0, 0, 0, 0, 0, 0, 0};
#define ATT_VLD(dst, db, ks) dst = ldsb128(vq##ks + vsl_ + (db) * 4096)
#define ATT_MF(acc, a, b) acc = __builtin_amdgcn_mfma_f32_32x32x16_bf16(a, b, acc, 0, 0, 0)
#define ATT_PACK8(oa_, ob_) do { \
        _Pragma("unroll") for (int j = 0; j < 4; ++j) { int w_ = __builtin_amdgcn_cvt_pk_fp8_f32(sa[4 * j], sa[4 * j + 1], oa_[j], false); w_ = __builtin_amdgcn_cvt_pk_fp8_f32(sa[4 * j + 2], sa[4 * j + 3], w_, true); w8_[j] = w_; } \
        _Pragma("unroll") for (int j = 0; j < 4; ++j) { int w_ = __builtin_amdgcn_cvt_pk_fp8_f32(sb[4 * j], sb[4 * j + 1], ob_[j], false); w_ = __builtin_amdgcn_cvt_pk_fp8_f32(sb[4 * j + 2], sb[4 * j + 3], w_, true); w8_[4 + j] = w_; } } while (0)
#define ATT_X(HASNEXT, ksn_) do { \
        f32x16 sa, sb;     \
        if (F8) { asm volatile("v_mfma_f32_32x32x16_bf16 %0, %1, %2, -4.0" : "=&v"(sa) : "v"(ka0), "v"(qr[0])); asm volatile("v_mfma_f32_32x32x16_bf16 %0, %1, %2, -4.0" : "=&v"(sb) : "v"(kb0), "v"(qr[0])); } \
        else { sa = f32x16{}; sb = f32x16{}; ATT_MF(sa, ka0, qr[0]); ATT_MF(sb, kb0, qr[0]); } \
        ATT_MF(sa, ka1, qr[1]); ATT_MF(sb, kb1, qr[1]); \
        ATT_MF(sa, ka2, qr[2]); ATT_MF(sb, kb2, qr[2]); ATT_MF(sa, ka3, qr[3]); ATT_MF(sb, kb3, qr[3]); \
        ATT_SB(); \
          \
        if (t + 3 < NT) ATT_DMAK(t + 3, ksl); \
        if (MODE != 1) { if (t + 2 < NT) { const int v2 = (vsl >= 2 * VSLOT) ? vsl - 2 * VSLOT : vsl + 2 * VSLOT; ATT_DMAV(t + 2, v2); } } \
        ATT_SB(); \
        if (HASNEXT) ATT_LOADK(ksn_); \
        if (MODE == 1) { \
            _Pragma("unroll") for (int r = 0; r < 16; ++r) nmx = fmaxf(nmx, fmaxf(sa[r], sb[r])); \
        } else { \
            _Pragma("unroll") for (int r = 0; r < 16; ++r) { sa[r] = __builtin_amdgcn_exp2f(MODE == 2 ? sa[r] - mx : sa[r]); sb[r] = __builtin_amdgcn_exp2f(MODE == 2 ? sb[r] - mx : sb[r]); } \
            _Pragma("unroll") for (int r = 0; r < 8; ++r) { l2 += (f32x2_t){sa[2 * r], sa[2 * r + 1]}; l2 += (f32x2_t){sb[2 * r], sb[2 * r + 1]}; }     \
            if (F8) { i32x8 w8_; const i32x4 po0_ = __builtin_bit_cast(i32x4, p0), po1_ = __builtin_bit_cast(i32x4, p1);     \
                int pmt = 0; \
                _Pragma("unroll") for (int r = 0; r < 16; ++r) { const float fa_ = sa[r], fb_ = sb[r]; const int ia_ = __float_as_int(fa_), ib_ = __float_as_int(fb_); pmt = pmt > ia_ ? pmt : ia_; pmt = pmt > ib_ ? pmt : ib_; }     \
                scA = sc1_; ATT_PACK8(po0_, po1_);     \
                if (__builtin_expect(__any(pmt > 0x43e00000), 0)) {     \
                    const int e_ = pmt > 0x43e00000 ? (pmt >> 23) - 134 : 0;     \
                    const float f_ = __int_as_float((127 - e_) << 23); \
                    _Pragma("unroll") for (int r = 0; r < 16; ++r) { sa[r] *= f_; sb[r] *= f_; } \
                    const i32x4 pa_ = __builtin_shufflevector(w8_, w8_, 0, 1, 2, 3), pb_ = __builtin_shufflevector(w8_, w8_, 4, 5, 6, 7); \
                    scA = (127 + e_) * 0x01010101; ATT_PACK8(pa_, pb_); } \
                p0 = __builtin_bit_cast(bf16x8, __builtin_shufflevector(w8_, w8_, 0, 1, 2, 3)); p1 = __builtin_bit_cast(bf16x8, __builtin_shufflevector(w8_, w8_, 4, 5, 6, 7)); \
            } else { \
            u32x4 w0, w1, w2, w3; \
            w0.x = cvtpk(sa[0], sa[1]); w0.y = cvtpk(sa[2], sa[3]); w0.z = cvtpk(sa[4], sa[5]); w0.w = cvtpk(sa[6], sa[7]); \
            w1.x = cvtpk(sa[8], sa[9]); w1.y = cvtpk(sa[10], sa[11]); w1.z = cvtpk(sa[12], sa[13]); w1.w = cvtpk(sa[14], sa[15]); \
            w2.x = cvtpk(sb[0], sb[1]); w2.y = cvtpk(sb[2], sb[3]); w2.z = cvtpk(sb[4], sb[5]); w2.w = cvtpk(sb[6], sb[7]); \
            w3.x = cvtpk(sb[8], sb[9]); w3.y = cvtpk(sb[10], sb[11]); w3.z = cvtpk(sb[12], sb[13]); w3.w = cvtpk(sb[14], sb[15]); \
            p0 = __builtin_bit_cast(bf16x8, w0); p1 = __builtin_bit_cast(bf16x8, w1); p2 = __builtin_bit_cast(bf16x8, w2); p3 = __builtin_bit_cast(bf16x8, w3); } \
        } \
        ATT_SB(); } while (0)
#define ATT_LD32(dst, db) dst = __builtin_shufflevector(*(const ATT_LAS i32x4*)(v8a + vsl_ + (db) * 2048), *(const ATT_LAS i32x4*)(v8b + vsl_ + (db) * 2048), 0, 1, 2, 3, 4, 5, 6, 7)
#define ATT_MF8(acc, vfrag) asm volatile("s_nop 1\n\tv_mfma_scale_f32_32x32x64_f8f6f4 %0, %1, %2, %0, %3, %4 op_sel_hi:[0,0,0]" : "+v"(acc) : "v"(pp8_), "v"(vfrag), "v"(scA), "v"(sc1_))
#define ATT_Y8(vslx) do { const int vsl_ = (vslx); i32x8 wa, wb, wc, wd; const i32x8 pp8_ = __builtin_shufflevector(__builtin_bit_cast(i32x4, p0), __builtin_bit_cast(i32x4, p1), 0, 1, 2, 3, 4, 5, 6, 7); \
        ATT_LD32(wa, 0); ATT_LD32(wb, 1); ATT_SB(); ATT_LD32(wc, 2); ATT_LD32(wd, 3); ATT_SB(); \
        ATT_MF8(o[0], wa); ATT_MF8(o[1], wb); ATT_SB(); ATT_MF8(o[2], wc); ATT_MF8(o[3], wd); ATT_SB(); } while (0)
#define ATT_YB(vslx) do { const int vsl_ = (vslx); bf16x8 va, vb, vc, vd, ve, vf, vg, vh;     \
        ATT_VLD(va, 0, 0); ATT_VLD(vb, 0, 1); ATT_VLD(vc, 0, 2); ATT_VLD(vd, 0, 3); ATT_SB(); \
        ATT_VLD(ve, 1, 0); ATT_VLD(vf, 1, 1); ATT_VLD(vg, 1, 2); ATT_VLD(vh, 1, 3); ATT_SB(); \
        ATT_MF(o[0], p0, va); ATT_MF(o[0], p1, vb); ATT_MF(o[0], p2, vc); ATT_MF(o[0], p3, vd); ATT_SB(); \
        ATT_VLD(va, 2, 0); ATT_VLD(vb, 2, 1); ATT_VLD(vc, 2, 2); ATT_VLD(vd, 2, 3); ATT_SB(); \
        ATT_MF(o[1], p0, ve); ATT_MF(o[1], p1, vf); ATT_MF(o[1], p2, vg); ATT_MF(o[1], p3, vh); ATT_SB(); \
        ATT_VLD(ve, 3, 0); ATT_VLD(vf, 3, 1); ATT_VLD(vg, 3, 2); ATT_VLD(vh, 3, 3); ATT_SB(); \
        ATT_MF(o[2], p0, va); ATT_MF(o[2], p1, vb); ATT_MF(o[2], p2, vc); ATT_MF(o[2], p3, vd); ATT_SB(); \
        ATT_MF(o[3], p0, ve); ATT_MF(o[3], p1, vf); ATT_MF(o[3], p2, vg); ATT_MF(o[3], p3, vh); ATT_SB(); } while (0)
#define ATT_Y(vslx) do { if (F8) ATT_Y8(vslx); else ATT_YB(vslx); } while (0)
#pragma unroll 1
    for (int t = 0; t < NT; ++t) {
        const int ksn = (ksl == 2 * KSLOT) ? 0 : ksl + KSLOT;
        const int vprev = (vsl == 0) ? 3 * VSLOT : vsl - VSLOT;
        if (MODE != 1) { if (late && t >= 1) ATT_Y(vprev); }
        ATT_X(true, ksn);
        if (MODE != 1) { if (!late) ATT_Y(vsl); }
        if (MODE != 1) { if (NV == 2) { if (t + 3 < NT) ATT_WAITBAR(3); else if (t + 2 < NT) ATT_WAITBAR(2); else ATT_WAITBAR(0); }
                         else { if (t + 3 < NT) ATT_WAITBAR(2); else if (t + 2 < NT) ATT_WAITBAR(1); else ATT_WAITBAR(0); } }
        else { if (t + 3 < NT) ATT_WAITBAR(1); else ATT_WAITBAR(0); }
        ksl = ksn; vsl = (vsl == 3 * VSLOT) ? 0 : vsl + VSLOT;
    }
    if (MODE != 1) { if (late) { const int vprev = (vsl == 0) ? 3 * VSLOT : vsl - VSLOT; ATT_Y(vprev); } ATT_WAITBAR(0); }
    if (F8) { asm volatile("s_nop 15\n\ts_nop 15" ::: "memory"); __builtin_amdgcn_sched_barrier(0); }
    if (MODE == 1) mx = fmaxf(nmx, __shfl_xor(nmx, 32)); else l = l2.x + l2.y;
#undef ATT_X
#undef ATT_PACK8
#undef ATT_Y
#undef ATT_YB
#undef ATT_Y8
#undef ATT_MF8
#undef ATT_LD32
#undef ATT_MF
#undef ATT_VLD
#undef ATT_LOADK
#undef ATT_DMAK
#undef ATT_DMAV
}

template <int MODE>
__device__ __forceinline__ bool attn_unit(int b, int h, int qb, const short* Q, const short* K, const short* V, const unsigned char* V8, short* AO, const float* subg, float lam, float* park, char* shm) {
    const int tid = threadIdx.x, lane = tid & 63, r32 = lane & 31, hi = lane >> 5; const int wid = __builtin_amdgcn_readfirstlane(tid >> 6);
    ATT_LAS float* scr = (ATT_LAS float*)((ATT_LAS char*)shm + LDS_SCR) + wid * 64;
    volatile ATT_LAS unsigned* flgp = (volatile ATT_LAS unsigned*)((ATT_LAS char*)shm + LDS_FLG);
    const size_t qrow = (size_t)b * 4096 + qb * 256 + wid * 32;
    const short* Qw = Q + qrow * 512 + h * 128; const short* Kh = K + (size_t)b * TKV * 512 + h * 128; const short* Vh = V + (size_t)(b * 4 + h) * 128 * TKV; const unsigned char* V8h = V8 + (size_t)(b * 4 + h) * 128 * TKV;
    if (tid == 0) *flgp = 0u;
    f32x16 o[4]; float l, mx = 0.f; bool bad = false;
    if (MODE == 2) { float dummy; attn_pass<1, false>(0, Qw, Kh, Vh, V8h, shm, o, dummy, mx); }
    attn_pass<(MODE == 2 ? 2 : 0), false>(0, Qw, Kh, Vh, V8h, shm, o, l, mx);
    l += __shfl_xor(l, 32); bad = bad || !(l > 0.f && l < 3.0e38f);
    if (hi == 0) scr[r32] = l;
    asm volatile("s_waitcnt lgkmcnt(0)" ::: "memory");
    {   float* pk = park + (size_t)tid * 64;
#pragma unroll
        for (int g = 0; g < 4; ++g) { float il[4];
#pragma unroll
            for (int e = 0; e < 4; ++e) il[e] = __builtin_amdgcn_rcpf(scr[crow(4 * g + e, hi)]);
#pragma unroll
            for (int db = 0; db < 4; ++db) *(f32x4*)(pk + db * 16 + 4 * g) = (f32x4){o[db][4 * g] * il[0], o[db][4 * g + 1] * il[1], o[db][4 * g + 2] * il[2], o[db][4 * g + 3] * il[3]}; } }
    if (MODE == 2) { float dummy; attn_pass<1, false>(1, Qw, Kh, Vh, V8h, shm, o, dummy, mx); }
    attn_pass<(MODE == 2 ? 2 : 0), (MODE == 0) && (ATT_F8MAP1 != 0)>(1, Qw, Kh, Vh, V8h, shm, o, l, mx);
    l += __shfl_xor(l, 32); bad = bad || !(l > 0.f && l < 3.0e38f);
    if (hi == 0) scr[32 + r32] = l;
    asm volatile("s_waitcnt lgkmcnt(0)" ::: "memory");
    float ss[16];
    {   const float* pk = park + (size_t)tid * 64;
#pragma unroll
        for (int r = 0; r < 16; ++r) ss[r] = 0.f;
#pragma unroll
        for (int g = 0; g < 4; ++g) { float il[4];
#pragma unroll
            for (int e = 0; e < 4; ++e) il[e] = lam * __builtin_amdgcn_rcpf(scr[32 + crow(4 * g + e, hi)]);
#pragma unroll
            for (int db = 0; db < 4; ++db) { const f32x4 pv = *(const f32x4*)(pk + db * 16 + 4 * g);
#pragma unroll
                for (int e = 0; e < 4; ++e) { const float v = pv[e] - o[db][4 * g + e] * il[e]; o[db][4 * g + e] = v; ss[4 * g + e] += v * v; } } } }
#pragma unroll
    for (int off = 1; off < 32; off <<= 1)
#pragma unroll
        for (int r = 0; r < 16; ++r) ss[r] += __shfl_xor(ss[r], off);
    float gv[4];
#pragma unroll
    for (int db = 0; db < 4; ++db) gv[db] = subg[32 * db + r32] * 0.8f;
    short* aow = AO + qrow * 1024 + h * 128 + r32;
#pragma unroll
    for (int r = 0; r < 16; ++r) { const float rs = __builtin_amdgcn_rsqf(ss[r] * (1.f / 128.f) + 1e-5f);
#pragma unroll
        for (int db = 0; db < 4; ++db) { const unsigned w = cvtpk(o[db][r] * rs * gv[db], 0.f); aow[(size_t)crow(r, hi) * 1024 + 32 * db] = (short)(w & 0xffffu); } }
    if (MODE == 0) { if (__any(bad)) { if (lane == 0) *flgp = 1u; } }
    asm volatile("s_waitcnt vmcnt(0) lgkmcnt(0)\n\ts_barrier" ::: "memory");
    const unsigned flg = *flgp;
    asm volatile("s_waitcnt lgkmcnt(0)\n\ts_barrier" ::: "memory");
    return __builtin_amdgcn_readfirstlane(flg) != 0u;
}
__device__ __forceinline__ void attn_unit_safe(int b, int h, int qb, const short* Q, const short* K, const short* V, const unsigned char* V8, short* AO, const float* subg, float lam, float* park, char* shm, bool force_fallback) {
    const bool redo = attn_unit<0>(b, h, qb, Q, K, V, V8, AO, subg, lam, park, shm);
    if (redo || force_fallback) (void)attn_unit<2>(b, h, qb, Q, K, V, V8, AO, subg, lam, park, shm);
}
}

namespace lru2 {
typedef short bf16x8 __attribute__((ext_vector_type(8)));
typedef float f32x16 __attribute__((ext_vector_type(16)));
typedef float f32x4 __attribute__((ext_vector_type(4)));
typedef float f32x2 __attribute__((ext_vector_type(2)));
#define LRU2_LAS __attribute__((address_space(3)))
constexpr int TS = 144, TILE = 64 * TS;
constexpr int LDS_TILE = 0, LDS_COMP = 8 * TILE, LDS_CW = LDS_COMP + 2 * 8 * 32 * 8, LDS_BF = LDS_CW + 5 * 64 * 4, LDS_END = LDS_BF + 8192;
__device__ __forceinline__ int crow(int r, int hi) { return (r & 3) + 8 * (r >> 2) + 4 * hi; }
__device__ __forceinline__ float bf2f(unsigned short v) { return __uint_as_float((unsigned)v << 16); }
__device__ __forceinline__ unsigned short f2bf(float f) { unsigned u = __float_as_uint(f); return (unsigned short)((u + 0x7fffu + ((u >> 16) & 1u)) >> 16); }
constexpr float L2E = 1.4426950408889634f;

__device__ __forceinline__ void lru_unit(int b, int w, int nb, const unsigned short* U, const unsigned short* G, const float* convw, const float* convb, const unsigned short* WgT, const float* bg,
                                         const float* sp8, float* HS, unsigned short* AO, LRU2_LAS unsigned char* lds) {
    const int tid = threadIdx.x, lane = tid & 63, r32 = lane & 31, hi = lane >> 5; const int k = __builtin_amdgcn_readfirstlane(tid >> 6);
    LRU2_LAS unsigned char* tile = lds + LDS_TILE + k * TILE;
    LRU2_LAS f32x2* comp = (LRU2_LAS f32x2*)(lds + LDS_COMP);
    const int chn = 64 * w + 32 * nb + r32;
    const int cg = lane & 7, tg = lane >> 3;
    LRU2_LAS float* cw = (LRU2_LAS float*)(lds + LDS_CW);
    if (tid < 320) { const int jj = tid >> 6, c = tid & 63; cw[tid] = jj < 4 ? convw[jj * 512 + 64 * w + c] : convb[64 * w + c]; }
    __syncthreads();
#pragma unroll 1
    for (int dir = 0; dir < 2; ++dir) {
        { const int fi = tid >> 5, o32 = tid & 31;
            const int g = fi >> 3, ks = (fi >> 1) & 3, hi2 = fi & 1;
            *(LRU2_LAS bf16x8*)(lds + LDS_BF + fi * 512 + o32 * 16) = *(const bf16x8*)(WgT + ((size_t)(((dir * 2 + g) * 8 + w) * 64 + 32 * nb + o32)) * 64 + 16 * ks + 8 * hi2); }
        __syncthreads();
        const float br = bg[((dir * 2 + 0) * 8 + w) * 64 + 32 * nb + r32], bi = bg[((dir * 2 + 1) * 8 + w) * 64 + 32 * nb + r32], sp = sp8[dir * 512 + chn];
        float cround = 0.f;
        bf16x8 uu[11];
#define LRU2_CHUNK(p_, chunk_, isctx_, L_, s0_, rowbase_) const int chunk_ = dir == 0 ? (p_) : ((p_) < 4 ? 3 - (p_) : 71 - (p_)); const bool isctx_ = chunk_ < 4; \
        const int L_ = isctx_ ? 256 : 4096, s0_ = isctx_ ? 64 * chunk_ : 64 * (chunk_ - 4); const size_t rowbase_ = isctx_ ? (size_t)65536 + (size_t)b * 256 : (size_t)b * 4096
#define LRU2_LOADU(p_) do { if ((p_) < 68) { LRU2_CHUNK(p_, ch_, ic_, L_, s0_, rb_); _Pragma("unroll") for (int i = 0; i < 11; ++i) { const int s = s0_ + 8 * tg - 2 + i; uu[i] = (bf16x8){0, 0, 0, 0, 0, 0, 0, 0}; \
            if (s >= 0 && s < L_) uu[i] = *(const bf16x8*)(U + (rb_ + s) * 512 + 64 * w + 8 * cg); } } } while (0)
        LRU2_LOADU(k);
#pragma unroll 1
        for (int rd = 0; rd < 9; ++rd) {
            const int p = 8 * rd + k; const bool valid = p < 68;
            LRU2_CHUNK(p, chunk, isctx, L, s0, rowbase);
            (void)L;
            f32x16 z[2][2];
            float atot = 1.f, cend = 0.f, cst[8];
            if (valid) {
                {
                    float wv[4][8], bv[8];
#pragma unroll
                    for (int jj = 0; jj < 4; ++jj) { const f32x4 a = *(const LRU2_LAS f32x4*)(cw + jj * 64 + 8 * cg), c = *(const LRU2_LAS f32x4*)(cw + jj * 64 + 8 * cg + 4);
                        wv[jj][0] = a.x; wv[jj][1] = a.y; wv[jj][2] = a.z; wv[jj][3] = a.w; wv[jj][4] = c.x; wv[jj][5] = c.y; wv[jj][6] = c.z; wv[jj][7] = c.w; }
                    { const f32x4 a = *(const LRU2_LAS f32x4*)(cw + 256 + 8 * cg), c = *(const LRU2_LAS f32x4*)(cw + 256 + 8 * cg + 4); bv[0] = a.x; bv[1] = a.y; bv[2] = a.z; bv[3] = a.w; bv[4] = c.x; bv[5] = c.y; bv[6] = c.z; bv[7] = c.w; }
#pragma unroll
                    for (int tt = 0; tt < 8; ++tt) { bf16x8 o;
#pragma unroll
                        for (int e = 0; e < 8; ++e) { float acc = bv[e];
#pragma unroll
                            for (int jj = 0; jj < 4; ++jj) acc += wv[jj][e] * bf2f((unsigned short)uu[tt + jj][e]);
                            o[e] = (short)f2bf(acc); }
                        *(LRU2_LAS bf16x8*)(tile + (8 * tg + tt) * TS + cg * 16) = o; }
                }
                LRU2_LOADU(p + 8);
                asm volatile("s_waitcnt lgkmcnt(0)" ::: "memory");
#pragma unroll
                for (int g = 0; g < 2; ++g)
#pragma unroll
                    for (int tb = 0; tb < 2; ++tb) { z[g][tb] = f32x16{};
#pragma unroll
                        for (int ks = 0; ks < 4; ++ks) z[g][tb] = __builtin_amdgcn_mfma_f32_32x32x16_bf16(*(const LRU2_LAS bf16x8*)(tile + (32 * tb + r32) * TS + (16 * ks + 8 * hi) * 2), *(const LRU2_LAS bf16x8*)(lds + LDS_BF + ((g * 4 + ks) * 2 + hi) * 512 + r32 * 16), z[g][tb], 0, 0, 0); }
#pragma unroll
                for (int tb = 0; tb < 2; ++tb)
#pragma unroll
                    for (int r = 0; r < 16; ++r) {
                        const float rg = __builtin_amdgcn_rcpf(1.f + __builtin_amdgcn_exp2f(-(z[0][tb][r] + br) * L2E));
                        const float ig = __builtin_amdgcn_rcpf(1.f + __builtin_amdgcn_exp2f(-(z[1][tb][r] + bi) * L2E));
                        const float a = __builtin_amdgcn_exp2f(-rg * sp);
                        const float mult = __builtin_amdgcn_sqrtf(fabsf(1.f - a * a));
                        z[0][tb][r] = a; z[1][tb][r] = mult * ig * bf2f(*(const LRU2_LAS unsigned short*)(tile + (32 * tb + crow(r, hi)) * TS + (32 * nb + r32) * 2));
                    }
                __builtin_amdgcn_sched_barrier(0);
            }
            float Ao[8], Bo[8], Ax[8], Bx[8];
            if (valid) {
#pragma unroll
                for (int q = 0; q < 8; ++q) { const int tb = q >> 2, rb = 4 * (q & 3);
                    const float a0 = z[0][tb][rb], a1 = z[0][tb][rb + 1], a2 = z[0][tb][rb + 2], a3 = z[0][tb][rb + 3];
                    const float b0 = z[1][tb][rb], b1 = z[1][tb][rb + 1], b2 = z[1][tb][rb + 2], b3 = z[1][tb][rb + 3];
                    Ao[q] = (a0 * a1) * (a2 * a3);
                    Bo[q] = dir == 0 ? ((b0 * a1 + b1) * a2 + b2) * a3 + b3 : ((b3 * a2 + b2) * a1 + b1) * a0 + b0;
                    Ax[q] = __shfl_xor(Ao[q], 32); Bx[q] = __shfl_xor(Bo[q], 32); }
                float c = 0.f;
                if (dir == 0) {
#pragma unroll
                    for (int q = 0; q < 8; ++q) { const float Ae = hi ? Ax[q] : Ao[q], Be = hi ? Bx[q] : Bo[q], Aod = hi ? Ao[q] : Ax[q], Bod = hi ? Bo[q] : Bx[q];
                        c = Aod * (Ae * c + Be) + Bod; atot *= Ao[q] * Ax[q]; }
                } else {
#pragma unroll
                    for (int q = 7; q >= 0; --q) { const float Ae = hi ? Ax[q] : Ao[q], Be = hi ? Bx[q] : Bo[q], Aod = hi ? Ao[q] : Ax[q], Bod = hi ? Bo[q] : Bx[q];
                        c = Ae * (Aod * c + Bod) + Be; atot *= Ao[q] * Ax[q]; }
                }
                cend = c;
            }
            if (hi == 0) comp[((rd & 1) * 8 + k) * 32 + r32] = (f32x2){atot, cend};
            __syncthreads();
            float cin = cround, call = cround;
#pragma unroll
            for (int k2 = 0; k2 < 8; ++k2) { const f32x2 cc = comp[((rd & 1) * 8 + k2) * 32 + r32]; call = cc.x * call + cc.y; if (k2 < k) cin = call; }
            cround = call;
            if (valid) {
                float c = cin;
                if (dir == 0) {
#pragma unroll
                    for (int q = 0; q < 8; ++q) { const float Ae = hi ? Ax[q] : Ao[q], Be = hi ? Bx[q] : Bo[q], Aod = hi ? Ao[q] : Ax[q], Bod = hi ? Bo[q] : Bx[q];
                        const float c1 = Ae * c + Be; cst[q] = hi ? c1 : c; c = Aod * c1 + Bod; }
                } else {
#pragma unroll
                    for (int q = 7; q >= 0; --q) { const float Ae = hi ? Ax[q] : Ao[q], Be = hi ? Bx[q] : Bo[q], Aod = hi ? Ao[q] : Ax[q], Bod = hi ? Bo[q] : Bx[q];
                        const float c1 = Aod * c + Bod; cst[q] = hi ? c : c1; c = Ae * c1 + Be; }
                }
                if (!isctx) {
#pragma unroll
                    for (int q = 0; q < 8; ++q) { const int tb = q >> 2, rb = 4 * (q & 3); float hcur = cst[q];
                        if (dir == 0) {
#pragma unroll
                            for (int e = 0; e < 4; ++e) { hcur = z[0][tb][rb + e] * hcur + z[1][tb][rb + e]; z[1][tb][rb + e] = hcur; }
                        } else {
#pragma unroll
                            for (int e = 3; e >= 0; --e) { hcur = z[0][tb][rb + e] * hcur + z[1][tb][rb + e]; z[1][tb][rb + e] = hcur; }
                        } }
                    const size_t row0 = rowbase + s0;
                    const int hoff = hi * 4 * 512 + chn, aoff = hi * 4 * 1024 + 512 + chn;
                    if (dir == 0) {
#pragma unroll
                        for (int tb = 0; tb < 2; ++tb)
#pragma unroll
                            for (int r = 0; r < 16; ++r) { const size_t rowu = row0 + 32 * tb + 8 * (r >> 2) + (r & 3); (HS + rowu * 512)[hoff] = z[1][tb][r]; }
                    } else {
#pragma unroll
                        for (int tb = 0; tb < 2; ++tb) { float hf[16]; unsigned short gg[16];
#pragma unroll
                            for (int r = 0; r < 16; ++r) { const size_t rowu = row0 + 32 * tb + 8 * (r >> 2) + (r & 3); hf[r] = (HS + rowu * 512)[hoff]; gg[r] = (G + rowu * 512)[hoff]; }
#pragma unroll
                            for (int r = 0; r < 16; ++r) { const size_t rowu = row0 + 32 * tb + 8 * (r >> 2) + (r & 3); const float hsum = z[1][tb][r] + hf[r];
                                const float g = bf2f(gg[r]); const float t = 1.5957691216057308f * (g + 0.044715f * g * g * g);
                                const float y = hsum * g * __builtin_amdgcn_rcpf(1.f + __builtin_amdgcn_exp2f(-t * L2E));
                                (AO + rowu * 1024)[aoff] = f2bf(y); } }
                    }
                }
            }
        }
#undef LRU2_LOADU
#undef LRU2_CHUNK
        asm volatile("s_waitcnt vmcnt(0)" ::: "memory");
        __syncthreads();
    }
}
}

#define GAS __attribute__((address_space(1)))
#define LAS __attribute__((address_space(3)))
typedef unsigned short bf16;
typedef unsigned v4u __attribute__((ext_vector_type(4)));
typedef float f32x4 __attribute__((ext_vector_type(4)));
typedef short bf16x8 __attribute__((ext_vector_type(8)));
typedef GAS unsigned gu32;
typedef GAS unsigned long long gu64;
#define RLX_AGENT __ATOMIC_RELAXED, __HIP_MEMORY_SCOPE_AGENT
#define LDS_WAIT() asm volatile("s_waitcnt lgkmcnt(0)" ::: "memory")
#define VM_WAIT() asm volatile("s_waitcnt vmcnt(0)" ::: "memory")
__device__ __forceinline__ unsigned long long rt() { return __builtin_amdgcn_s_memrealtime(); }
__device__ __forceinline__ unsigned f2bf(float f) { unsigned u = __builtin_bit_cast(unsigned, f); return (u + 0x7fffu + ((u >> 16) & 1u)) >> 16; }
__device__ __forceinline__ unsigned pk2(float lo, float hi) { return f2bf(lo) | (f2bf(hi) << 16); }

#define XB_TMO      128
#define XB_XCNT(j)  (256  + 64 * (j))
#define XB_XSUB(j)  (1280 + 64 * (j))
#define XB_XGEN(j)  (2304 + 64 * (j))
#define XB_TOP      3328
#define XB_TOPGEN   3392
#define XCD_BAR_WORDS 3456
#define XB_SPIN_CAP (1u << 18)

__device__ __forceinline__ unsigned xb_ld(unsigned* p)              { return __hip_atomic_load(p, __ATOMIC_RELAXED, __HIP_MEMORY_SCOPE_AGENT); }
__device__ __forceinline__ unsigned xb_add(unsigned* p, unsigned v) { return __hip_atomic_fetch_add(p, v, __ATOMIC_RELAXED, __HIP_MEMORY_SCOPE_AGENT); }
__device__ __forceinline__ unsigned xb_xcc_id() { return (unsigned)__builtin_amdgcn_s_getreg((3 << 11) | 20) & 0xFu; }
#define XB_SPIN(cond, bar) do { unsigned _sp = 0; while (cond) { __builtin_amdgcn_s_sleep(1); \
    if ((++_sp & 255u) == 0u) { if (xb_ld(&(bar)[XB_TMO])) break; if (_sp > XB_SPIN_CAP) { atomicAdd(&(bar)[XB_TMO], 1u); break; } } } } while (0)

struct XcdBarrier {
    unsigned* bar; unsigned x;
    volatile LAS unsigned* st;
};

__device__ __forceinline__ XcdBarrier xcd_barrier_post(unsigned* bar, volatile LAS unsigned* st) {
    XcdBarrier b; b.bar = bar; b.x = xb_xcc_id(); b.st = st;
    if (threadIdx.x == 0) (void)xb_add(&bar[XB_XCNT(b.x)], 1u);
    return b;
}
__device__ __forceinline__ void xcd_barrier_complete(unsigned* bar, unsigned x, unsigned& nloc, unsigned& nx) {
    const unsigned G = gridDim.x * gridDim.y * gridDim.z;
    unsigned sum, cnt, mine, sp = 0u;
    for (;;) {
        sum = 0u; cnt = 0u; mine = 0u;
#pragma unroll
        for (unsigned j = 0; j < 16; ++j) { const unsigned c = xb_ld(&bar[XB_XCNT(j)]); sum += c; cnt += (c > 0u) ? 1u : 0u; mine = (j == x) ? c : mine; }
        if (sum == G) break;
        __builtin_amdgcn_s_sleep(1);
        if ((++sp & 255u) == 0u) { if (xb_ld(&bar[XB_TMO])) break; if (sp > XB_SPIN_CAP) { atomicAdd(&bar[XB_TMO], 1u); break; } }
    }
    nloc = mine > 0u ? mine : 1u; nx = cnt > 0u ? cnt : 1u;
}

__device__ __forceinline__ void xcd_barrier(const XcdBarrier& b) {
    asm volatile("s_waitcnt vmcnt(0)" ::: "memory");
    __syncthreads();
    if (threadIdx.x == 0) {
        unsigned* bar = b.bar;
        __builtin_amdgcn_s_waitcnt(0);
        unsigned nloc = b.st[0], nx = b.st[1];
        if (nloc == 0u) { xcd_barrier_complete(bar, b.x, nloc, nx); b.st[0] = nloc; b.st[1] = nx; }
        const unsigned old = xb_add(&bar[XB_XSUB(b.x)], 1u);
        const unsigned gen = old / nloc;
        if (old + 1u == (gen + 1u) * nloc) {
            __builtin_amdgcn_fence(__ATOMIC_RELEASE, "agent");
            asm volatile("s_waitcnt vmcnt(0)" ::: "memory");
            const unsigned og = xb_add(&bar[XB_TOP], 1u);
            const unsigned tg = og / nx;
            if (og + 1u == (tg + 1u) * nx) xb_add(&bar[XB_TOPGEN], 1u);
            else XB_SPIN(xb_ld(&bar[XB_TOPGEN]) == tg, bar);
            __builtin_amdgcn_fence(__ATOMIC_ACQUIRE, "agent");
            xb_add(&bar[XB_XGEN(b.x)], 1u);
            asm volatile("s_waitcnt vmcnt(0)" ::: "memory");
        } else {
            XB_SPIN(xb_ld(&bar[XB_XGEN(b.x)]) == gen, bar);
            __builtin_amdgcn_fence(__ATOMIC_ACQUIRE, "agent");
            asm volatile("s_waitcnt vmcnt(0)" ::: "memory");
        }
    }
    __syncthreads();
}

constexpr int NWAVES = 8;
#ifndef MK_N_LAUNCHES
#define MK_N_LAUNCHES 1
#endif
#ifndef X1_BF16
#define X1_BF16 (DBG ? 0 : 1)
#endif
constexpr int PER_PHASE = 10;
constexpr int N_LAUNCHES = MK_N_LAUNCHES;
#ifndef REPEAT_MASK
#define REPEAT_MASK 0
#endif
#ifndef TSTAMP
#define TSTAMP -1
#endif
#ifndef TS_UNIT
#define TS_UNIT 100.0f
#endif
#ifndef FP8_FFN
#define FP8_FFN 0
#endif
constexpr bool F8_IN = (FP8_FFN & 1) != 0, F8_OUT = (FP8_FFN & 2) != 0;
constexpr float W1_SCALE = 32.f, W2_SCALE = 64.f, HID_SCALE = 8.f;
#ifndef ATT_FORCE_FALLBACK
#define ATT_FORCE_FALLBACK 0
#endif
constexpr int DM = 1024, NBATCH = 16, SEQ = 4096, CTXL = 256, MLAT = NBATCH * SEQ, MCTX = NBATCH * CTXL, MALL = MLAT + MCTX, INW = 2560, FH = 2816;
constexpr float LN_EPS = 1e-6f, DN_ALPHA = 1.189207115002721f;
constexpr size_t MiB = 1u << 20;
constexpr size_t WS_CTL = 0, CTL_ZERO_BYTES = 64 * 1024;
constexpr size_t WS_MOD = 1 * MiB, WS_ROPEC = WS_MOD + 512 * 1024, WS_ROPES = WS_ROPEC + 4096, WS_SP8 = WS_ROPES + 4096, WS_LAM = WS_SP8 + 4096;
constexpr size_t WS_WIN = 2 * MiB, WS_WOUT = 8 * MiB, WS_W1 = 10 * MiB, WS_W2 = 21 * MiB, WS_WG = 27 * MiB, WS_SUM = 28 * MiB;
constexpr size_t WS_XN = 40 * MiB, WS_Q = 176 * MiB, WS_K = 240 * MiB, WS_V = 308 * MiB, WS_U = 376 * MiB, WS_G = 444 * MiB, WS_AO = 508 * MiB;
constexpr size_t WS_Y = (DBG ? 704 : 176) * MiB, WS_HID = 176 * MiB, WS_F = 528 * MiB, WS_VT8 = 636 * MiB, WS_PARK = 670 * MiB, WS_HS = 704 * MiB, WS_END = 832 * MiB;
static_assert(WS_SUM + (size_t)16 * 68 * 2 * 512 * 8 <= WS_XN && WS_XN + (size_t)MALL * DM * 2 <= WS_Q && WS_HID + (size_t)MLAT * FH * 2 <= WS_F, "d_ws map");
constexpr int CW_BAR = 1024;
constexpr int RING_BYTES = 131072, LDSCTL_OFF = RING_BYTES, MISC_OFF = LDSCTL_OFF + 320, ROPE_OFF = RING_BYTES + 1024, LDS_BYTES = 147456;
static_assert(att::LDS_END <= RING_BYTES && lru2::LDS_END <= RING_BYTES, "LDS map");

struct Frame {
    LAS unsigned char* lds; volatile LAS unsigned* MISC; gu32* ctl;
    int tid, lane, wave, vcu, G;
};
__device__ __forceinline__ float wave_sum(float v) {
#pragma unroll
    for (int o = 1; o < 64; o <<= 1) v += __shfl_xor(v, o);
    return v;
}
template <class DEST>
__device__ __forceinline__ void p0_transpose_item(const float* W, int K, int N, bf16* WT, LAS float* scr, int item, int lane, DEST dest) {
    const int nblk = N / 32, kb = item / nblk, nb = item % nblk, k0 = 64 * kb, n0 = 32 * nb;
#pragma unroll 8
    for (int i = 0; i < 32; ++i) { const int kk = 2 * i + (lane >> 5); scr[kk * 33 + (lane & 31)] = W[(size_t)(k0 + kk) * N + n0 + (lane & 31)]; }
    LDS_WAIT(); asm volatile("" ::: "memory");
    const int c = lane & 7;
#pragma unroll
    for (int j = 0; j < 4; ++j) { const int n = (lane >> 3) + 8 * j; const LAS float* s = scr + (8 * c) * 33 + n;
        v4u o; o.x = pk2(s[0 * 33], s[1 * 33]); o.y = pk2(s[2 * 33], s[3 * 33]); o.z = pk2(s[4 * 33], s[5 * 33]); o.w = pk2(s[6 * 33], s[7 * 33]);
        *(GAS v4u*)(WT + (size_t)dest(n0 + n) * K + k0 + 8 * c) = o; }
    LDS_WAIT(); asm volatile("" ::: "memory");
}
template <class DEST>
__device__ __forceinline__ void p0_transpose_item8(const float* W, int K, int N, unsigned char* WT, LAS float* scr, int item, int lane, DEST dest, float scale) {
    const int nblk = N / 32, kb = item / nblk, nb = item % nblk, k0 = 64 * kb, n0 = 32 * nb;
#pragma unroll 8
    for (int i = 0; i < 32; ++i) { const int kk = 2 * i + (lane >> 5); scr[kk * 33 + (lane & 31)] = W[(size_t)(k0 + kk) * N + n0 + (lane & 31)] * scale; }
    LDS_WAIT(); asm volatile("" ::: "memory");
    const int c = lane & 7; typedef unsigned u32x2v __attribute__((ext_vector_type(2)));
#pragma unroll
    for (int j = 0; j < 4; ++j) { const int n = (lane >> 3) + 8 * j; const LAS float* s = scr + (8 * c) * 33 + n;
        u32x2v o; o.x = pg8::pk_fp8x4(s[0 * 33], s[1 * 33], s[2 * 33], s[3 * 33]); o.y = pg8::pk_fp8x4(s[4 * 33], s[5 * 33], s[6 * 33], s[7 * 33]);
        *(GAS u32x2v*)(WT + (size_t)dest(n0 + n) * K + k0 + 8 * c) = o; }
    LDS_WAIT(); asm volatile("" ::: "memory");
}
struct DestId { __device__ __forceinline__ int operator()(int n) const { return n; } };
struct DestWin { __device__ __forceinline__ int operator()(int n) const {
    if (n >= 1536) return n - 512; if (n >= 1024) return n + 1024; const int d = n & 63; return (n & ~63) + (d & 32) + ((d >> 2) & 3) * 8 + ((d >> 4) & 1) * 4 + (d & 3); } };
struct DestW1 { __device__ __forceinline__ int operator()(int n) const { const int hb = n >= FH, l = hb ? n - FH : n; return (l >> 7) * 256 + hb * 128 + (l & 127); } };

__device__ __forceinline__ void p0_mod_task(int cgp, const float* c, const float* cctx, const float* w_ada, const float* b_ada, float* MOD, LAS unsigned char* lds, int tid, int wave, int lane) {
    LAS float* sc = (LAS float*)lds; LAS float* red = (LAS float*)(lds + 81920);
    for (int idx = tid; idx < 17 * 1024; idx += 512) { const int r = idx >> 10, k = idx & 1023; const float v = r < 16 ? c[r * 1024 + k] : cctx[k]; sc[k * 20 + r] = v / (1.f + __expf(-v)); }
    __syncthreads();
    float acc[17];
#pragma unroll
    for (int r = 0; r < 17; ++r) acc[r] = 0.f;
    const int n = 64 * cgp + lane;
#pragma unroll 16
    for (int kk = 0; kk < 128; ++kk) { const int k = wave * 128 + kk; const float wv = __builtin_nontemporal_load(w_ada + (size_t)k * 6144 + n);
        const LAS f32x4* sp = (const LAS f32x4*)(sc + k * 20); const f32x4 s0 = sp[0], s1 = sp[1], s2 = sp[2], s3 = sp[3]; const float s16 = sc[k * 20 + 16];
        acc[0] += s0.x * wv; acc[1] += s0.y * wv; acc[2] += s0.z * wv; acc[3] += s0.w * wv; acc[4] += s1.x * wv; acc[5] += s1.y * wv; acc[6] += s1.z * wv; acc[7] += s1.w * wv;
        acc[8] += s2.x * wv; acc[9] += s2.y * wv; acc[10] += s2.z * wv; acc[11] += s2.w * wv; acc[12] += s3.x * wv; acc[13] += s3.y * wv; acc[14] += s3.z * wv; acc[15] += s3.w * wv; acc[16] += s16 * wv; }
#pragma unroll
    for (int r = 0; r < 17; ++r) red[(wave * 17 + r) * 64 + lane] = acc[r];
    __syncthreads();
    for (int idx = tid; idx < 17 * 64; idx += 512) { const int r = idx >> 6, l = idx & 63; float s = b_ada[64 * cgp + l];
#pragma unroll
        for (int w2 = 0; w2 < 8; ++w2) s += red[(w2 * 17 + r) * 64 + l];
        MOD[r * 6144 + 64 * cgp + l] = s; }
    __syncthreads();
}
__device__ __forceinline__ void ln_stats(f32x4 (&v)[4], float& mean, float& rstd) {
    float s = 0.f;
#pragma unroll
    for (int j = 0; j < 4; ++j) s += (v[j].x + v[j].y) + (v[j].z + v[j].w);
    mean = wave_sum(s) * (1.f / DM); float s2 = 0.f;
#pragma unroll
    for (int j = 0; j < 4; ++j) { v[j] = v[j] - mean; s2 += (v[j].x * v[j].x + v[j].y * v[j].y) + (v[j].z * v[j].z + v[j].w * v[j].w); }
    rstd = 1.f / sqrtf(wave_sum(s2) * (1.f / DM) + LN_EPS);
}
__device__ __forceinline__ void st_bf16x4(bf16* p, f32x4 v) { *(GAS unsigned long long*)p = (unsigned long long)pk2(v.x, v.y) | ((unsigned long long)pk2(v.z, v.w) << 32); }
__device__ __forceinline__ f32x4 ld_bf16x4(const bf16* p) { const unsigned long long w = *(const GAS unsigned long long*)p; const unsigned lo = (unsigned)w, hi = (unsigned)(w >> 32);
    return (f32x4){__uint_as_float(lo << 16), __uint_as_float(lo & 0xffff0000u), __uint_as_float(hi << 16), __uint_as_float(hi & 0xffff0000u)}; }
__device__ __forceinline__ void ln_stats2(f32x4 (&v)[2][4], float (&mean)[2], float (&rstd)[2]) {
    float s[2];
#pragma unroll
    for (int q = 0; q < 2; ++q) { s[q] = 0.f;
#pragma unroll
        for (int j = 0; j < 4; ++j) s[q] += (v[q][j].x + v[q][j].y) + (v[q][j].z + v[q][j].w); }
#pragma unroll
    for (int o = 1; o < 64; o <<= 1) { s[0] += __shfl_xor(s[0], o); s[1] += __shfl_xor(s[1], o); }
    float s2[2];
#pragma unroll
    for (int q = 0; q < 2; ++q) { mean[q] = s[q] * (1.f / DM); s2[q] = 0.f;
#pragma unroll
        for (int j = 0; j < 4; ++j) { v[q][j] = v[q][j] - mean[q]; s2[q] += (v[q][j].x * v[q][j].x + v[q][j].y * v[q][j].y) + (v[q][j].z * v[q][j].z + v[q][j].w * v[q][j].w); } }
#pragma unroll
    for (int o = 1; o < 64; o <<= 1) { s2[0] += __shfl_xor(s2[0], o); s2[1] += __shfl_xor(s2[1], o); }
#pragma unroll
    for (int q = 0; q < 2; ++q) rstd[q] = 1.f / sqrtf(s2[q] * (1.f / DM) + LN_EPS);
}
__device__ __forceinline__ void row_hmod2(const float* const (&xrow)[2], const float* const (&md)[2], bf16* const (&orow)[2], int lane) {
    f32x4 v[2][4]; float mean[2], rstd[2];
#pragma unroll
    for (int q = 0; q < 2; ++q)
#pragma unroll
        for (int j = 0; j < 4; ++j) v[q][j] = __builtin_nontemporal_load((const GAS f32x4*)(xrow[q] + 4 * lane + 256 * j));
    ln_stats2(v, mean, rstd);
#pragma unroll
    for (int q = 0; q < 2; ++q)
#pragma unroll
        for (int j = 0; j < 4; ++j) { const int c = 4 * lane + 256 * j; const f32x4 a = *(const f32x4*)(md[q] + 1024 + c), s = *(const f32x4*)(md[q] + c); st_bf16x4(orow[q] + c, v[q][j] * rstd[q] * (a + 1.f) + s); }
}
__device__ __forceinline__ void row_ln1_2(const float* const (&xrow)[2], const bf16* const (&yrow)[2], const float* const (&md)[2], const float* lng, const float* lnb, float* const (&x1row)[2], bf16* const (&h2row)[2], int lane) {
    f32x4 v[2][4]; float mean[2], rstd[2];
#pragma unroll
    for (int q = 0; q < 2; ++q)
#pragma unroll
        for (int j = 0; j < 4; ++j) { const int c = 4 * lane + 256 * j; v[q][j] = __builtin_nontemporal_load((const GAS f32x4*)(xrow[q] + c)) * DN_ALPHA + *(const f32x4*)(md[q] + 2048 + c) * ld_bf16x4(yrow[q] + c); }
    ln_stats2(v, mean, rstd);
#pragma unroll
    for (int q = 0; q < 2; ++q)
#pragma unroll
        for (int j = 0; j < 4; ++j) { const int c = 4 * lane + 256 * j; v[q][j] = v[q][j] * rstd[q] * *(const f32x4*)(lng + c) + *(const f32x4*)(lnb + c); *(GAS f32x4*)(x1row[q] + c) = v[q][j]; }
    ln_stats2(v, mean, rstd);
#pragma unroll
    for (int q = 0; q < 2; ++q)
#pragma unroll
        for (int j = 0; j < 4; ++j) { const int c = 4 * lane + 256 * j; const f32x4 hv = v[q][j] * rstd[q] * (*(const f32x4*)(md[q] + 4096 + c) + 1.f) + *(const f32x4*)(md[q] + 3072 + c);
            if (F8_IN) *(GAS unsigned*)((unsigned char*)h2row[q] + c) = pg8::pk_fp8x4(hv.x, hv.y, hv.z, hv.w); else st_bf16x4(h2row[q] + c, hv); }
}
struct Ln1Raw { f32x4 x[2][4]; unsigned long long y[2][4]; };
__device__ __forceinline__ void ln1_load(Ln1Raw& r, const float* x, const bf16* Y, int m, int m2, int lane) {
#pragma unroll
    for (int j = 0; j < 4; ++j) { const int c = 4 * lane + 256 * j;
        r.x[0][j] = __builtin_nontemporal_load((const GAS f32x4*)(x + (size_t)m * DM + c)); r.x[1][j] = __builtin_nontemporal_load((const GAS f32x4*)(x + (size_t)m2 * DM + c));
        r.y[0][j] = *(const GAS unsigned long long*)(Y + (size_t)m * DM + c); r.y[1][j] = *(const GAS unsigned long long*)(Y + (size_t)m2 * DM + c); }
}
__device__ __forceinline__ f32x4 bf16x4_to_f32(unsigned long long w) { const unsigned lo = (unsigned)w, hi = (unsigned)(w >> 32);
    return (f32x4){__uint_as_float(lo << 16), __uint_as_float(lo & 0xffff0000u), __uint_as_float(hi << 16), __uint_as_float(hi & 0xffff0000u)}; }
__device__ __forceinline__ void ln1_process(const Ln1Raw& r, const float* const (&md)[2], const float* lng, const float* lnb, float* const (&x1row)[2], bf16* const (&h2row)[2], int lane) {
    f32x4 v[2][4]; float mean[2], rstd[2];
#pragma unroll
    for (int q = 0; q < 2; ++q)
#pragma unroll
        for (int j = 0; j < 4; ++j) { const int c = 4 * lane + 256 * j; v[q][j] = r.x[q][j] * DN_ALPHA + *(const f32x4*)(md[q] + 2048 + c) * bf16x4_to_f32(r.y[q][j]); }
    ln_stats2(v, mean, rstd);
#pragma unroll
    for (int q = 0; q < 2; ++q)
#pragma unroll
        for (int j = 0; j < 4; ++j) { const int c = 4 * lane + 256 * j; v[q][j] = v[q][j] * rstd[q] * *(const f32x4*)(lng + c) + *(const f32x4*)(lnb + c); if (X1_BF16) st_bf16x4((bf16*)x1row[q] + c, v[q][j]); else *(GAS f32x4*)(x1row[q] + c) = v[q][j]; }
    ln_stats2(v, mean, rstd);
#pragma unroll
    for (int q = 0; q < 2; ++q)
#pragma unroll
        for (int j = 0; j < 4; ++j) { const int c = 4 * lane + 256 * j; const f32x4 hv = v[q][j] * rstd[q] * (*(const f32x4*)(md[q] + 4096 + c) + 1.f) + *(const f32x4*)(md[q] + 3072 + c);
            if (F8_IN) *(GAS unsigned*)((unsigned char*)h2row[q] + c) = pg8::pk_fp8x4(hv.x, hv.y, hv.z, hv.w); else st_bf16x4(h2row[q] + c, hv); }
}
__device__ __forceinline__ void row_ln2_2(float* const (&orow)[2], const bf16* const (&x1b)[2], const bf16* const (&frow)[2], const float* const (&md)[2], const float* lng, const float* lnb, int lane) {
    f32x4 v[2][4]; float mean[2], rstd[2];
#pragma unroll
    for (int q = 0; q < 2; ++q)
#pragma unroll
        for (int j = 0; j < 4; ++j) { const int c = 4 * lane + 256 * j; v[q][j] = (X1_BF16 ? ld_bf16x4(x1b[q] + c) : *(const GAS f32x4*)(orow[q] + c)) * DN_ALPHA + *(const f32x4*)(md[q] + 5120 + c) * ld_bf16x4(frow[q] + c); }
    ln_stats2(v, mean, rstd);
#pragma unroll
    for (int q = 0; q < 2; ++q)
#pragma unroll
        for (int j = 0; j < 4; ++j) { const int c = 4 * lane + 256 * j; __builtin_nontemporal_store(v[q][j] * rstd[q] * *(const f32x4*)(lng + c) + *(const f32x4*)(lnb + c), (GAS f32x4*)(orow[q] + c)); }
}

struct Args { const float* in[22]; float* out; unsigned char* ws; int ph_lo, ph_hi, li, pad; };
__global__ void __launch_bounds__(NWAVES * 64, 2) mk_fwd(Args args) {
    extern __shared__ __attribute__((aligned(16))) unsigned char lds[];
    Frame F;
    F.lds = (LAS unsigned char*)lds; F.MISC = (volatile LAS unsigned*)(F.lds + MISC_OFF);
    F.tid = threadIdx.x; F.lane = F.tid & 63; F.wave = __builtin_amdgcn_readfirstlane(F.tid >> 6);
    F.G = gridDim.x; { const int bx = blockIdx.x; F.vcu = (F.G % 8 == 0) ? (bx % 8) * (F.G / 8) + bx / 8 : bx; }
    unsigned char* ws = args.ws;
    F.ctl = (gu32*)(ws + WS_CTL);
    const float* x = args.in[0]; const float* cin = args.in[1]; const float* ctx = args.in[2]; const float* cctx = args.in[3];
    float* MOD = (float*)(ws + WS_MOD); float* ROPEC = (float*)(ws + WS_ROPEC); float* ROPES = (float*)(ws + WS_ROPES); float* SP8 = (float*)(ws + WS_SP8); float* LAMP = (float*)(ws + WS_LAM);
    bf16* WinT = (bf16*)(ws + WS_WIN); bf16* WoutT = (bf16*)(ws + WS_WOUT); bf16* W1T = (bf16*)(ws + WS_W1); bf16* W2T = (bf16*)(ws + WS_W2); bf16* WgT = (bf16*)(ws + WS_WG);
        bf16* XN = (bf16*)(ws + WS_XN); bf16* Qb = (bf16*)(ws + WS_Q); bf16* Kb = (bf16*)(ws + WS_K); bf16* Vb = (bf16*)(ws + WS_V); bf16* Ub = (bf16*)(ws + WS_U); bf16* Gb = (bf16*)(ws + WS_G);
    bf16* AO = (bf16*)(ws + WS_AO); bf16* Yb = (bf16*)(ws + WS_Y); bf16* HID = (bf16*)(ws + WS_HID); bf16* Fb = (bf16*)(ws + WS_F); bf16* X1B = (bf16*)(ws + WS_HS);
    for (int u = F.tid; u < (LDS_BYTES - LDSCTL_OFF) / 4; u += NWAVES * 64) ((LAS unsigned*)(F.lds + LDSCTL_OFF))[u] = 0u;
    __syncthreads();
    XcdBarrier bar; bar.bar = (unsigned*)(F.ctl + CW_BAR); bar.x = 0; bar.st = nullptr;
    if (N_LAUNCHES != PER_PHASE) bar = xcd_barrier_post((unsigned*)(F.ctl + CW_BAR), F.MISC + 8);
#define GRID_BAR() do { if (N_LAUNCHES != PER_PHASE) xcd_barrier(bar); } while (0)
    const int lo = args.ph_lo, hi = args.ph_hi;
#define IN(k) (lo <= (k) && (k) < hi)
#define BOTH(k) (IN(k) && IN((k) + 1))
    const int gw = F.vcu * NWAVES + F.wave, NGW = F.G * NWAVES;
    unsigned long long* TS = (unsigned long long*)(ws + WS_CTL + 40960);
#define STAMP(k) do { if (TSTAMP >= 0 && blockIdx.x == 0 && F.tid == 0) TS[k] = __builtin_amdgcn_s_memrealtime(); } while (0)
    STAMP(0);

    if (IN(0)) {
        for (int rep_ = 0; rep_ < 1 + ((REPEAT_MASK >> 0) & 1); ++rep_) {
        if ((int)blockIdx.x < 96) p0_mod_task((int)blockIdx.x, cin, cctx, args.in[4], args.in[5], MOD, F.lds, F.tid, F.wave, F.lane);
        if ((int)blockIdx.x == F.G - 1) {
            for (int i = F.tid; i < 1024; i += 512) { const int pos = i >> 4, f = i & 15; const float inv = powf(10000.f, -(float)f / 16.f); const float ang = (float)pos * inv; ROPEC[i] = cosf(ang); ROPES[i] = sinf(ang); }
            for (int i = F.tid; i < 1024; i += 512) { const float l = args.in[14][i]; const float sp = log1pf(expf(-fabsf(l))) + fmaxf(-l, 0.f); SP8[i] = 8.f * sp * 1.4426950408889634f; }
            if (F.tid == 0) { float a = 0.f, b2 = 0.f; for (int i = 0; i < 64; ++i) { a += args.in[7][i] * args.in[8][i]; b2 += args.in[7][64 + i] * args.in[8][64 + i]; } LAMP[0] = expf(a) - expf(b2) + 0.2f; }
        }
        LAS float* scr = (LAS float*)(F.lds + F.wave * 16384);
        constexpr int I_IN = (DM / 64) * (INW / 32), I_OUT = (DM / 64) * (DM / 32), I_1 = (DM / 64) * (2 * FH / 32), I_2 = (FH / 64) * (DM / 32), I_G = 32 * 2;
        constexpr int NITEMS = I_IN + I_OUT + I_1 + I_2 + I_G;
        const bool modwg = (int)blockIdx.x < 96 && F.G > 96;
        const int gw0 = modwg ? NITEMS : ((F.G > 96 ? (int)blockIdx.x - 96 : (int)blockIdx.x) * NWAVES + F.wave), ngw0 = (F.G > 96 ? F.G - 96 : F.G) * NWAVES;
        for (int it = gw0; it < NITEMS; it += ngw0) {
            int r = it;
            if (r < I_IN) { p0_transpose_item(args.in[6], DM, INW, WinT, scr, r, F.lane, DestWin{}); continue; } r -= I_IN;
            if (r < I_OUT) { p0_transpose_item(args.in[15], DM, DM, WoutT, scr, r, F.lane, DestId{}); continue; } r -= I_OUT;
            if (r < I_1) { if (F8_IN) p0_transpose_item8(args.in[18], DM, 2 * FH, (unsigned char*)W1T, scr, r, F.lane, DestW1{}, W1_SCALE); else p0_transpose_item(args.in[18], DM, 2 * FH, W1T, scr, r, F.lane, DestW1{}); continue; } r -= I_1;
            if (r < I_2) { if (F8_OUT) p0_transpose_item8(args.in[19], FH, DM, (unsigned char*)W2T, scr, r, F.lane, DestId{}, W2_SCALE); else p0_transpose_item(args.in[19], FH, DM, W2T, scr, r, F.lane, DestId{}); continue; } r -= I_2;
            { const int mat = r >> 1; p0_transpose_item(args.in[12] + (size_t)mat * 4096, 64, 64, WgT + (size_t)mat * 4096, scr, r & 1, F.lane, DestId{}); }
        }
        }
        if (BOTH(0)) GRID_BAR();
        STAMP(1);
    }
    if (IN(1)) {
        for (int rep_ = 0; rep_ < 1 + ((REPEAT_MASK >> 1) & 1); ++rep_) {
        for (int m = gw; m < MALL; m += 2 * NGW) { const int m2 = m + NGW;
            const float* const xr[2] = {m < MLAT ? x + (size_t)m * DM : ctx + (size_t)(m - MLAT) * DM, m2 < MLAT ? x + (size_t)m2 * DM : ctx + (size_t)(m2 - MLAT) * DM};
            const float* const md[2] = {MOD + (m < MLAT ? (m >> 12) : 16) * 6144, MOD + (m2 < MLAT ? (m2 >> 12) : 16) * 6144};
            bf16* const orow[2] = {XN + (size_t)m * DM, XN + (size_t)m2 * DM};
            row_hmod2(xr, md, orow, F.lane);
        }
        }
        if (BOTH(1)) GRID_BAR();
        STAMP(2);
    }
    if (IN(2)) {
        {
        LAS float* ropeL = (LAS float*)(F.lds + ROPE_OFF);
        for (int i = F.tid; i < 2048; i += NWAVES * 64) ropeL[i] = ROPEC[i];
        __syncthreads();
        { pg8::Gemm g{XN, WinT, MALL, INW, DM}; pg8::InProjOrder S; S.init(F.G, (int)blockIdx.x);
          pg8::EpiInProj E{Qb, Kb, Vb, Ub, Gb, (unsigned char*)(ws + WS_VT8), ropeL, ropeL + 1024};
          pg8::gemm_phase<pg8::EpiInProj, pg8::InProjOrder, true, true>(F.lds, g, S, E); }
        }
#if (REPEAT_MASK >> 2) & 1
        {
        LAS float* ropeL = (LAS float*)(F.lds + ROPE_OFF);
        for (int i = F.tid; i < 2048; i += NWAVES * 64) ropeL[i] = ROPEC[i];
        __syncthreads();
        { pg8::Gemm g{XN, WinT, MALL, INW, DM}; pg8::InProjOrder S; S.init(F.G, (int)blockIdx.x);
          pg8::EpiInProj E{Qb, Kb, Vb, Ub, Gb, (unsigned char*)(ws + WS_VT8), ropeL, ropeL + 1024};
          pg8::gemm_phase<pg8::EpiInProj, pg8::InProjOrder, true, true>(F.lds, g, S, E); }
        }
#endif
        if (BOTH(2)) GRID_BAR();
        STAMP(3);
    }
    if (IN(3)) {
        for (int rep_ = 0; rep_ < 1 + ((REPEAT_MASK >> 3) & 1); ++rep_) {
#ifndef SKIP_ATT
        const float lam = LAMP[0]; float* PARK = (float*)(ws + WS_PARK) + (size_t)blockIdx.x * att::PARK_FLOATS;
        const int xg = F.vcu >> 5, vl = F.vcu & 31;
        for (int ra_ = 0; ra_ < 1 + ((REPEAT_MASK >> 9) & 1); ++ra_)
        if (F.G == 256) {
            for (int i = 0; i < 4; ++i) { const int bh = xg * 8 + i * 2 + (vl >> 4), qb = vl & 15;
                att::attn_unit_safe(bh >> 2, bh & 3, qb, (const short*)Qb, (const short*)Kb, (const short*)Vb, (const unsigned char*)(ws + WS_VT8), (short*)AO, args.in[9], lam, PARK, (char*)lds, ATT_FORCE_FALLBACK != 0); }
        } else {
            for (int un = (int)blockIdx.x; un < 1024; un += F.G) { const int bh = un >> 4, qb = un & 15;
                att::attn_unit_safe(bh >> 2, bh & 3, qb, (const short*)Qb, (const short*)Kb, (const short*)Vb, (const unsigned char*)(ws + WS_VT8), (short*)AO, args.in[9], lam, PARK, (char*)lds, ATT_FORCE_FALLBACK != 0); }
        }
#endif
#ifndef SKIP_LRU1
        for (int rl_ = 0; rl_ < 1 + ((REPEAT_MASK >> 10) & 1); ++rl_)
        for (int un = F.vcu; un < 256; un += F.G)
            lru2::lru_unit(un >> 4, (un >> 1) & 7, un & 1, Ub, Gb, args.in[10], args.in[11], WgT, args.in[13], SP8, (float*)(ws + WS_HS), AO, F.lds);
#endif
        }
        if (BOTH(3)) GRID_BAR();
        STAMP(4);
    }
    if (IN(4)) { STAMP(5); }
    if (IN(5)) {
        {
        pg8::Gemm g{AO, WoutT, MLAT, DM, DM}; pg8::StaticOrder S; S.init(MLAT, DM, F.G, (int)blockIdx.x);
        pg8::EpiPlain E{Yb, DM, 1.f};
        pg8::gemm_phase<pg8::EpiPlain, pg8::StaticOrder, true, true>(F.lds, g, S, E);
        }
#if (REPEAT_MASK >> 5) & 1
        {
        pg8::Gemm g{AO, WoutT, MLAT, DM, DM}; pg8::StaticOrder S; S.init(MLAT, DM, F.G, (int)blockIdx.x);
        pg8::EpiPlain E{Yb, DM, 1.f};
        pg8::gemm_phase<pg8::EpiPlain, pg8::StaticOrder, true, true>(F.lds, g, S, E);
        }
#endif
        if (BOTH(5)) GRID_BAR();
        STAMP(6);
    }
    if (IN(6)) {
        for (int rep_ = 0; rep_ < 1 + ((REPEAT_MASK >> 6) & 1); ++rep_) {
        { Ln1Raw cur; ln1_load(cur, x, Yb, gw, gw + NGW, F.lane);
          for (int m = gw; m < MLAT; m += 2 * NGW) { const int m2 = m + NGW, mn = m + 2 * NGW;
            Ln1Raw nxt; if (mn < MLAT) ln1_load(nxt, x, Yb, mn, mn + NGW, F.lane);
            const float* const md[2] = {MOD + (m >> 12) * 6144, MOD + (m2 >> 12) * 6144};
            float* const x1r[2] = {X1_BF16 ? (float*)(X1B + (size_t)m * DM) : args.out + (size_t)m * DM, X1_BF16 ? (float*)(X1B + (size_t)m2 * DM) : args.out + (size_t)m2 * DM};
            bf16* const h2r[2] = {F8_IN ? (bf16*)((unsigned char*)XN + (size_t)m * DM) : XN + (size_t)m * DM, F8_IN ? (bf16*)((unsigned char*)XN + (size_t)m2 * DM) : XN + (size_t)m2 * DM};
            ln1_process(cur, md, args.in[16], args.in[17], x1r, h2r, F.lane);
            if (mn < MLAT) cur = nxt; } }
        }
        if (BOTH(6)) GRID_BAR();
        STAMP(7);
    }
    if (IN(7)) {
        {
        pg8::Gemm g{XN, W1T, MLAT, 2 * FH, F8_IN ? DM / 2 : DM}; pg8::StaticOrder S; S.init(MLAT, 2 * FH, F.G, (int)blockIdx.x);
        pg8::EpiSwiglu<F8_OUT> E{HID, FH, F8_IN ? 1.f / W1_SCALE : 1.f, F8_OUT ? HID_SCALE : 1.f};
        pg8::gemm_phase<pg8::EpiSwiglu<F8_OUT>, pg8::StaticOrder, true, true, F8_IN>(F.lds, g, S, E);
        }
#if (REPEAT_MASK >> 7) & 1
        {
        pg8::Gemm g{XN, W1T, MLAT, 2 * FH, F8_IN ? DM / 2 : DM}; pg8::StaticOrder S; S.init(MLAT, 2 * FH, F.G, (int)blockIdx.x);
        pg8::EpiSwiglu<F8_OUT> E{HID, FH, F8_IN ? 1.f / W1_SCALE : 1.f, F8_OUT ? HID_SCALE : 1.f};
        pg8::gemm_phase<pg8::EpiSwiglu<F8_OUT>, pg8::StaticOrder, true, true, F8_IN>(F.lds, g, S, E);
        }
#endif
        if (BOTH(7)) GRID_BAR();
        STAMP(8);
    }
    if (IN(8)) {
        {
        pg8::Gemm g{HID, W2T, MLAT, DM, F8_OUT ? FH / 2 : FH}; pg8::StaticOrder S; S.init(MLAT, DM, F.G, (int)blockIdx.x);
        pg8::EpiPlain E{Fb, DM, F8_OUT ? 1.f / (W2_SCALE * HID_SCALE) : 1.f};
        pg8::gemm_phase<pg8::EpiPlain, pg8::StaticOrder, true, true, F8_OUT>(F.lds, g, S, E);
        }
#if (REPEAT_MASK >> 8) & 1
        {
        pg8::Gemm g{HID, W2T, MLAT, DM, F8_OUT ? FH / 2 : FH}; pg8::StaticOrder S; S.init(MLAT, DM, F.G, (int)blockIdx.x);
        pg8::EpiPlain E{Fb, DM, F8_OUT ? 1.f / (W2_SCALE * HID_SCALE) : 1.f};
        pg8::gemm_phase<pg8::EpiPlain, pg8::StaticOrder, true, true, F8_OUT>(F.lds, g, S, E);
        }
#endif
        if (BOTH(8)) GRID_BAR();
        STAMP(9);
    }
    if (IN(9)) {
        for (int m = gw; m < MLAT; m += 2 * NGW) { const int m2 = m + NGW;
            float* const orow[2] = {args.out + (size_t)m * DM, args.out + (size_t)m2 * DM}; const bf16* const fr[2] = {Fb + (size_t)m * DM, Fb + (size_t)m2 * DM};
            const float* const md[2] = {MOD + (m >> 12) * 6144, MOD + (m2 >> 12) * 6144};
            const bf16* const x1b[2] = {X1B + (size_t)m * DM, X1B + (size_t)m2 * DM};
            row_ln2_2(orow, x1b, fr, md, args.in[20], args.in[21], F.lane); }
        STAMP(10);
        if (TSTAMP >= 0) {
            asm volatile("s_waitcnt vmcnt(0)" ::: "memory"); GRID_BAR();
            const unsigned long long t0 = __hip_atomic_load(TS + TSTAMP, __ATOMIC_RELAXED, __HIP_MEMORY_SCOPE_AGENT), t1 = __hip_atomic_load(TS + TSTAMP + 1, __ATOMIC_RELAXED, __HIP_MEMORY_SCOPE_AGENT);
            const float v = (float)(t1 - t0) * 0.01f / (TS_UNIT);
            for (int m = gw; m < MLAT; m += NGW) { GAS f32x4* o = (GAS f32x4*)(args.out + (size_t)m * DM) + F.lane;
#pragma unroll
                for (int j = 0; j < 4; ++j) o[64 * j] = (f32x4){v, v, v, v}; }
        }
    }
#undef IN
#undef BOTH
#undef GRID_BAR
}

#ifndef DBG
#define DBG 0
#endif
#if DBG
constexpr size_t WS_DBGTAB = 32 * 1024, WS_NAIVE = 832 * MiB;
static void dbg_run(void* const* d_in, float* out, unsigned char* ws, hipStream_t st) {
    float* tab = (float*)(ws + WS_DBGTAB);
    nv::Bufs B = nv::carve((char*)ws + WS_NAIVE);
    nv::run_common(d_in, B, st);
    dbg::cmp(st, tab, 1, ws + WS_MOD, 0, 0, 6144, 0, 0, 1.f, B.mod, 0, 6144, 0, 17, 6144);
    using namespace nv;
    for (int b = 0; b < 16; ++b) {
        const float* x = (const float*)d_in[0] + (size_t)b * S * D; const float* ctx = (const float*)d_in[2] + (size_t)b * CT * D;
        const float* mod = B.mod + b * 6144; const float* modc = B.mod + 16 * 6144;
        k_lnmod<<<S, 256, 0, st>>>(x, mod + 0, mod + 1024, B.h);
        k_lnmod<<<CT, 256, 0, st>>>(ctx, modc + 0, modc + 1024, B.h + (size_t)S * D);
        dbg::cmp(st, tab, 2, ws + WS_XN, 1, (size_t)65536 + b * 256, 1024, 0, 0, 1.f, B.h, 4096, 1024, 0, 256, 1024);
        k_gemm<<<dim3(nv::INW / 64, T / 64), 256, 0, st>>>(B.h, (const float*)d_in[6], B.p, T, nv::INW, D);
        k_rope<<<S * 512 / 256, 256, 0, st>>>(B.p);
        dbg::k_cmp_vt<<<(4352 * 512 + 255) / 256, 256, 0, st>>>((const unsigned short*)(ws + WS_V), b, B.p, nv::INW, 1024, tab + 2 * 3);
        dbg::cmp(st, tab, 4, ws + WS_U, 1, (size_t)b * 4096, 512, 0, 0, 1.f, B.p, 0, nv::INW, 1536, 4096, 512);
        dbg::cmp(st, tab, 4, ws + WS_U, 1, (size_t)65536 + b * 256, 512, 0, 0, 1.f, B.p, 4096, nv::INW, 1536, 256, 512);
        dbg::cmp(st, tab, 5, ws + WS_G, 1, (size_t)b * 4096, 512, 0, 0, 1.f, B.p, 0, nv::INW, 2048, 4096, 512);
        dbg::cmp(st, tab, 6, ws + WS_K, 1, (size_t)b * 4352 + 4096, 512, 0, 1, 1.f, B.p, 4096, nv::INW, 512, 256, 512);
        dbg::cmp(st, tab, 7, ws + WS_K, 1, (size_t)b * 4352, 512, 0, 1, 1.f, B.p, 0, nv::INW, 512, 4096, 512);
        dbg::cmp(st, tab, 8, ws + WS_Q, 1, (size_t)b * 4096, 512, 0, 1, 1.f / pg8::QK_C2, B.p, 0, nv::INW, 0, 4096, 512);
        k_attn_stats<<<dim3(S / 256, 4), 256, 0, st>>>(B.p, B.stats);
        k_attn_pv<<<dim3(S / 256, 16), 256, 0, st>>>(B.p, B.stats, B.lam, B.o);
        k_headnorm<<<S * 4 / 256, 256, 0, st>>>(B.o, (const float*)d_in[9], B.ao);
        dbg::cmp(st, tab, 9, ws + WS_AO, 1, (size_t)b * 4096, 1024, 0, 0, 1.f, B.ao, 0, 1024, 0, 4096, 512);
        k_conv<<<S * 512 / 256, 256, 0, st>>>(B.p, 0, S, (const float*)d_in[10], (const float*)d_in[11], B.uc);
        k_conv<<<CT * 512 / 256, 256, 0, st>>>(B.p, S, CT, (const float*)d_in[10], (const float*)d_in[11], B.uc);
        k_gates<<<2 * T * 512 / 256, 256, 0, st>>>(B.uc, (const float*)d_in[12], (const float*)d_in[13], (const float*)d_in[14], B.av, B.bv);
        k_scan<<<4, 256, 0, st>>>(B.av, B.bv, B.hs);
        k_ylru<<<S * 512 / 256, 256, 0, st>>>(B.hs, B.p, B.ao);
        dbg::cmp(st, tab, 10, ws + WS_AO, 1, (size_t)b * 4096, 1024, 512, 0, 1.f, B.ao, 0, 1024, 512, 4096, 512);
        k_gemm<<<dim3(D / 64, S / 64), 256, 0, st>>>(B.ao, (const float*)d_in[15], B.y, S, D, D);
        dbg::cmp(st, tab, 11, ws + WS_Y, 1, (size_t)b * 4096, 1024, 0, 0, 1.f, B.y, 0, 1024, 0, 4096, 1024);
        k_lnres<<<S, 256, 0, st>>>(x, B.y, mod + 2048, (const float*)d_in[16], (const float*)d_in[17], B.x1);
        dbg::cmp(st, tab, 12, out, 0, (size_t)b * 4096, 1024, 0, 0, 1.f, B.x1, 0, 1024, 0, 4096, 1024);
        k_lnmod<<<S, 256, 0, st>>>(B.x1, mod + 3072, mod + 4096, B.h2);
        dbg::cmp(st, tab, 13, ws + WS_XN, 1, (size_t)b * 4096, 1024, 0, 0, 1.f, B.h2, 0, 1024, 0, 4096, 1024);
    }
}
#endif
extern "C" void kernel_launch(void* const* d_in, const int* in_sizes, int n_in, void* d_out, int out_size, void* d_ws, size_t ws_size, hipStream_t stream) {
    static int grid = 0;
    if (grid == 0) {
        if (n_in != 22 || out_size != MLAT * DM || ws_size < (DBG ? (size_t)1012 * MiB : WS_END)) { fprintf(stderr, "kernel_launch: unexpected shapes / workspace (n_in %d out %d ws %zu)\n", n_in, out_size, ws_size); grid = -1; return; }
        int dev = 0, cus = 0, per_cu = 0;
        if (hipGetDevice(&dev) != hipSuccess || hipDeviceGetAttribute(&cus, hipDeviceAttributeMultiprocessorCount, dev) != hipSuccess) { grid = -1; return; }
        if (hipFuncSetAttribute((const void*)mk_fwd, hipFuncAttributeMaxDynamicSharedMemorySize, LDS_BYTES) != hipSuccess) { fprintf(stderr, "kernel_launch: hipFuncSetAttribute failed\n"); grid = -1; return; }
        if (hipOccupancyMaxActiveBlocksPerMultiprocessor(&per_cu, (const void*)mk_fwd, NWAVES * 64, LDS_BYTES) != hipSuccess || per_cu < 1) { fprintf(stderr, "kernel_launch: occupancy query says %d blocks/CU; nothing launched\n", per_cu); (void)hipGetLastError(); grid = -1; return; }
        grid = cus;
    }
    if (grid < 0) return;
    (void)hipMemsetAsync((char*)d_ws + WS_CTL, 0, CTL_ZERO_BYTES, stream);
    Args a{};
    for (int i = 0; i < 22; ++i) a.in[i] = (const float*)d_in[i];
    a.out = (float*)d_out; a.ws = (unsigned char*)d_ws;
#if DBG
    if (N_LAUNCHES == PER_PHASE) { for (int li = 0; li < 7; ++li) { a.ph_lo = li; a.ph_hi = li + 1; a.li = 0; hipLaunchKernelGGL(mk_fwd, dim3(grid), dim3(NWAVES * 64), LDS_BYTES, stream, a); } }
    else { a.ph_lo = 0; a.ph_hi = 7; a.li = 0; hipLaunchKernelGGL(mk_fwd, dim3(grid), dim3(NWAVES * 64), LDS_BYTES, stream, a); }
    dbg_run(d_in, (float*)d_out, (unsigned char*)d_ws, stream);
    if (N_LAUNCHES == PER_PHASE) { for (int li = 7; li < PER_PHASE; ++li) { a.ph_lo = li; a.ph_hi = li + 1; a.li = 0; hipLaunchKernelGGL(mk_fwd, dim3(grid), dim3(NWAVES * 64), LDS_BYTES, stream, a); } }
    else { a.ph_lo = 7; a.ph_hi = PER_PHASE; a.li = 1; hipLaunchKernelGGL(mk_fwd, dim3(grid), dim3(NWAVES * 64), LDS_BYTES, stream, a); }
    dbg::k_verdict<<<(unsigned)(((size_t)MLAT * DM + 255) / 256), 256, 0, stream>>>((const float*)((unsigned char*)d_ws + WS_DBGTAB), (float*)d_out, (size_t)MLAT * DM);
#else
    if (N_LAUNCHES == PER_PHASE) { for (int li = 0; li < PER_PHASE; ++li) { a.ph_lo = li; a.ph_hi = li + 1; a.li = 0; hipLaunchKernelGGL(mk_fwd, dim3(grid), dim3(NWAVES * 64), LDS_BYTES, stream, a); } }
    else { a.ph_lo = 0; a.ph_hi = PER_PHASE; a.li = 0; hipLaunchKernelGGL(mk_fwd, dim3(grid), dim3(NWAVES * 64), LDS_BYTES, stream, a); }
#endif
    const hipError_t le = hipPeekAtLastError();
    if (le != hipSuccess) fprintf(stderr, "kernel_launch: launch failed: %s\n", hipGetErrorName(le));
}
```

```cpp
#include <hip/hip_runtime.h>
#include <hip/hip_bf16.h>
#include <cstdio>
#include <cstdint>
#include <cmath>
#define DBG 0
#define MK_N_LAUNCHES 1
#define FP8_FFN 2

namespace pg8 {
#define PG8_LAS __attribute__((address_space(3)))
typedef unsigned short bf16_t;
typedef short bf16x8 __attribute__((ext_vector_type(8)));
typedef float f32x4 __attribute__((ext_vector_type(4)));
typedef unsigned u32x4 __attribute__((ext_vector_type(4)));
constexpr int BM = 256, BK = 64, HALF = 128, HTB = HALF * BK * 2  , STAGE_BYTES = 8 * HTB, NXCD = 8, WGM = 8;

__host__ __device__ __forceinline__ int lds_byte(int r, int c) { const int st = (r >> 4) * 2 + (c >> 5), rr = r & 15, cc = c & 31, ob = rr * 64 + cc * 2; return st * 1024 + (ob ^ (((ob >> 9) & 1) << 5)); }
__host__ __device__ __forceinline__ void stage_rc(int b, int& R, int& C) { const int st = b / 1024, sb = b % 1024, swz = sb ^ (((sb >> 9) & 1) << 5); R = (st >> 1) * 16 + swz / 64; C = (st & 1) * 32 + (swz % 64) / 2; }
__host__ __device__ __forceinline__ int perm32(int rho) { const int n = rho >> 4, i = rho & 15; return 8 * (i >> 2) + 4 * n + (i & 3); }

struct Unit { int pm, pn; };
struct Gemm { const bf16_t* A; const bf16_t* Bt; int M, N, K; };

struct StaticOrder {
    int nM, nN, nwg, G, c;
    __host__ __device__ void init(int M, int N, int G_, int c_) { nM = M / BM; nN = N / BM; nwg = nM * nN; G = G_; c = c_; }
    __host__ __device__ bool next(int i, Unit& u) const {
        const long L = (long)i * G + c; if (L >= nwg) return false;
        int wgid = (int)L; { const int q = nwg / NXCD, r = nwg % NXCD, xcd = wgid % NXCD, off = wgid / NXCD; wgid = (xcd < r ? xcd * (q + 1) : r * (q + 1) + (xcd - r) * q) + off; }
        const int nig = WGM * nN, gid = wgid / nig, fm = gid * WGM, gsz = (nM - fm) < WGM ? (nM - fm) : WGM;
        u.pm = fm + ((wgid % nig) % gsz); u.pn = (wgid % nig) / gsz; return true;
    }
    __device__ __forceinline__ void a_ready(const Unit&) const {}
    __device__ __forceinline__ void done(const Unit&) const {}
    __device__ __forceinline__ void ab(const Unit& u, const Gemm& g, size_t tstep, const char*& pa, const char*& pb) const { pa = (const char*)g.A + (size_t)u.pm * tstep; pb = (const char*)g.Bt + (size_t)u.pn * tstep; }
};

__device__ __forceinline__ unsigned cvt_pk_bf16(float lo, float hi) { unsigned r; asm volatile("v_cvt_pk_bf16_f32 %0, %1, %2" : "=v"(r) : "v"(lo), "v"(hi)); return r; }
typedef float f32x2 __attribute__((ext_vector_type(2)));
__device__ __forceinline__ f32x2 gelu_pk(f32x2 v) {
    const f32x2 av = __builtin_elementwise_abs(v), d = av * 0.2316418882f + 1.0f;
    f32x2 t; t.x = __builtin_amdgcn_rcpf(d.x); t.y = __builtin_amdgcn_rcpf(d.y);
    f32x2 q = t * 0.5307027145f + (-0.7265760135f); q = q * t + 0.7107068705f; q = q * t + (-0.142248368f); q = q * t + 0.127414796f; q = q * t;
    const f32x2 s = (v * v) * (-0.72134752044f);
    f32x2 e; e.x = __builtin_amdgcn_exp2f(s.x); e.y = __builtin_amdgcn_exp2f(s.y);
    const f32x2 m = v * (q * e), r = v - m;
    f32x2 o; o.x = v.x < 0.f ? m.x : r.x; o.y = v.y < 0.f ? m.y : r.y; return o;
}

template <int ACT  > struct EpiBf16 {
    static constexpr bool PERM = true, AFTER_DRAIN = false; static_assert(ACT == 0 || ACT == 1, "EpiBf16: ACT is 0 (none) or 1 (gelu_pk)");
    bf16_t* O; int ldc; const float* bias; int split_cols; size_t split_stride; float scale0;
    __device__ __forceinline__ void operator()(const f32x4 (&acc)[2][2][4][2], const Unit& u, int wr, int wc, int fr, int fq) const {
        const int row0 = u.pm * BM + wr * 64 + fr; int colt = u.pn * BM; bf16_t* base = O;
        float sc = 1.f; if (split_cols) { const int t = colt / split_cols; base += (size_t)t * split_stride; colt -= t * split_cols; if (t == 0) sc = scale0; }
        const int col0 = colt + wc * 32 + 8 * fq, bcol0 = u.pn * BM + wc * 32 + 8 * fq;
        f32x4 bv[2][2];
#pragma unroll
        for (int bj = 0; bj < 2; ++bj)
#pragma unroll
            for (int n = 0; n < 2; ++n) bv[bj][n] = bias ? *(const f32x4*)(bias + bcol0 + bj * HALF + 4 * n) : (f32x4){0.f, 0.f, 0.f, 0.f};
#pragma unroll
        for (int ai = 0; ai < 2; ++ai)
#pragma unroll
            for (int m = 0; m < 4; ++m) { bf16_t* rowp = base + (size_t)(row0 + ai * HALF + m * 16) * ldc + col0;
#pragma unroll
                for (int bj = 0; bj < 2; ++bj) { f32x4 v0 = acc[ai][bj][m][0] + bv[bj][0], v1 = acc[ai][bj][m][1] + bv[bj][1];
                    if (ACT == 1) { f32x2 a = gelu_pk((f32x2){v0[0], v0[1]}), b = gelu_pk((f32x2){v0[2], v0[3]}), c = gelu_pk((f32x2){v1[0], v1[1]}), d = gelu_pk((f32x2){v1[2], v1[3]});
                        v0 = (f32x4){a.x, a.y, b.x, b.y}; v1 = (f32x4){c.x, c.y, d.x, d.y}; }
                    v0 = v0 * sc; v1 = v1 * sc; u32x4 w; w.x = cvt_pk_bf16(v0[0], v0[1]); w.y = cvt_pk_bf16(v0[2], v0[3]); w.z = cvt_pk_bf16(v1[0], v1[1]); w.w = cvt_pk_bf16(v1[2], v1[3]);
                    *(u32x4*)(rowp + bj * HALF) = w; } }
    }
};

struct PanelStats {
    unsigned* xbuf;
    unsigned* cnt;
    unsigned* tmo;
    int ntn; float eps;
    unsigned code;
    __device__ __forceinline__ bool run(const f32x4 (&v)[2][2][4][2], const Unit& u, int wr, int wc, int fr, int fq, PG8_LAS unsigned char* lds, int wid, int lane) const {
        typedef float f32x2v __attribute__((ext_vector_type(2)));
        PG8_LAS f32x2v* P = (PG8_LAS f32x2v*)lds;
        PG8_LAS f32x2v* S = (PG8_LAS f32x2v*)(lds + 8192);
        PG8_LAS unsigned* flag = (PG8_LAS unsigned*)(lds + 8192 + 2048);
#pragma unroll
        for (int ai = 0; ai < 2; ++ai)
#pragma unroll
            for (int m = 0; m < 4; ++m) {
                float s = 0.f;
#pragma unroll
                for (int bj = 0; bj < 2; ++bj)
#pragma unroll
                    for (int n = 0; n < 2; ++n) { const f32x4 x = v[ai][bj][m][n]; s += (x[0] + x[1]) + (x[2] + x[3]); }
                s += __shfl_xor(s, 16); s += __shfl_xor(s, 32);
                const float mw = s * (1.0f / 64.0f); float q = 0.f;
#pragma unroll
                for (int bj = 0; bj < 2; ++bj)
#pragma unroll
                    for (int n = 0; n < 2; ++n) { const f32x4 d = v[ai][bj][m][n] - mw; q += (d[0] * d[0] + d[1] * d[1]) + (d[2] * d[2] + d[3] * d[3]); }
                q += __shfl_xor(q, 16); q += __shfl_xor(q, 32);
                if (fq == 0) P[(ai * HALF + wr * 64 + m * 16 + fr) * 4 + wc] = (f32x2v){mw, q};
            }
        asm volatile("s_waitcnt lgkmcnt(0)" ::: "memory"); __builtin_amdgcn_s_barrier(); asm volatile("" ::: "memory");
#if defined(BROKEN_EXCHANGE_NO_WAIT)
#warning BROKEN CONTROL BUILD: the row-statistics exchange does not wait; results are wrong by design
        if (blockIdx.x >= 64) { const long long t0_ = clock64(); while (clock64() - t0_ < 60000) __builtin_amdgcn_s_sleep(8); }
#endif
        const int row = wid * 32 + (lane & 31);
        if (lane < 32) {
            const f32x2v a = P[row * 4 + 0], b = P[row * 4 + 1], c = P[row * 4 + 2], d = P[row * 4 + 3];
            const float mt = (a.x + b.x + c.x + d.x) * 0.25f;
            const float da = a.x - mt, db = b.x - mt, dc = c.x - mt, dd = d.x - mt;
            const float m2 = (a.y + b.y) + (c.y + d.y) + 64.0f * ((da * da + db * db) + (dc * dc + dd * dd));
            unsigned long long* slot = (unsigned long long*)xbuf + ((size_t)(u.pm * BM + row) * 4 + u.pn);
            __hip_atomic_store(slot, ((unsigned long long)__float_as_uint(m2) << 32) | __float_as_uint(mt), __ATOMIC_RELAXED, __HIP_MEMORY_SCOPE_AGENT);
        }
        asm volatile("s_waitcnt vmcnt(0)" ::: "memory");
        if (lane == 0) __hip_atomic_fetch_add(cnt + 64 * u.pm, 1u, __ATOMIC_RELAXED, __HIP_MEMORY_SCOPE_AGENT);
        if (wid == 0) {
            bool dead = false; const unsigned long long t0 = __builtin_amdgcn_s_memrealtime(); const unsigned want = 8u * (unsigned)ntn;
            for (;;) {
#if defined(BROKEN_EXCHANGE_NO_WAIT)
                break;
#endif
                if ((unsigned)__builtin_amdgcn_readfirstlane(__hip_atomic_load(cnt + 64 * u.pm, __ATOMIC_RELAXED, __HIP_MEMORY_SCOPE_AGENT)) >= want) break;
                if (__builtin_amdgcn_s_memrealtime() - t0 > 2000000ull) {
                    if (lane == 0) { unsigned expect = 0u; __hip_atomic_compare_exchange_strong(tmo + 1, &expect, code | (unsigned)(u.pm & 0xff), __ATOMIC_RELAXED, __ATOMIC_RELAXED, __HIP_MEMORY_SCOPE_AGENT);
                                     __hip_atomic_store(tmo, 1u, __ATOMIC_RELAXED, __HIP_MEMORY_SCOPE_AGENT); }
                    dead = true; break; }
                __builtin_amdgcn_s_sleep(2);
            }
            __builtin_amdgcn_fence(__ATOMIC_ACQUIRE, "agent");
            if (lane == 0) flag[0] = dead ? 1u : 0u;
        }
        asm volatile("s_waitcnt vmcnt(0) lgkmcnt(0)" ::: "memory"); __builtin_amdgcn_s_barrier(); asm volatile("" ::: "memory");
        const bool bad = flag[0] != 0u;
        if (lane < 32) {
            const unsigned long long* slot = (const unsigned long long*)xbuf + (size_t)(u.pm * BM + row) * 4; float mt[4], m2[4]; float ms = 0.f;
#pragma unroll
            for (int t = 0; t < 4; ++t) { if (t < ntn) { const unsigned long long w = __hip_atomic_load(slot + t, __ATOMIC_RELAXED, __HIP_MEMORY_SCOPE_AGENT); mt[t] = __uint_as_float((unsigned)w); m2[t] = __uint_as_float((unsigned)(w >> 32)); } else { mt[t] = 0.f; m2[t] = 0.f; } ms += mt[t]; }
            const float mean = ms / (float)ntn; float q = 0.f;
#pragma unroll
            for (int t = 0; t < 4; ++t) if (t < ntn) { const float dm = mt[t] - mean; q += m2[t] + 256.0f * dm * dm; }
            S[row] = (f32x2v){mean, 1.0f / sqrtf(q / (256.0f * (float)ntn) + eps)};
        }
        asm volatile("s_waitcnt lgkmcnt(0)" ::: "memory"); __builtin_amdgcn_s_barrier(); asm volatile("" ::: "memory");
        return bad;
    }
};
struct EpiLnRes {
    static constexpr bool PERM = false, AFTER_DRAIN = true;
    const float* base; float* out; int ldc; const float* bias; PanelStats st; unsigned poison;
    __device__ __forceinline__ void fused(f32x4 (&acc)[2][2][4][2], const Unit& u, int wr, int wc, int fr, int fq, PG8_LAS unsigned char* lds, int wid, int lane) const {
        typedef float f32x2v __attribute__((ext_vector_type(2)));
        const PG8_LAS f32x2v* S = (const PG8_LAS f32x2v*)(lds + 8192);
        const int col0 = u.pn * BM + wc * 32 + 4 * fq;
#pragma unroll
        for (int bj = 0; bj < 2; ++bj)
#pragma unroll
            for (int n = 0; n < 2; ++n) { const f32x4 bv = bias ? *(const f32x4*)(bias + col0 + bj * HALF + n * 16) : (f32x4){0.f, 0.f, 0.f, 0.f};
#pragma unroll
                for (int ai = 0; ai < 2; ++ai)
#pragma unroll
                    for (int m = 0; m < 4; ++m) acc[ai][bj][m][n] += bv; }
        f32x4 pre[4][2][2];
#pragma unroll
        for (int m = 0; m < 4; ++m) { const size_t off = (size_t)(u.pm * BM + wr * 64 + m * 16 + fr) * ldc + col0;
#pragma unroll
            for (int bj = 0; bj < 2; ++bj)
#pragma unroll
                for (int n = 0; n < 2; ++n) pre[m][bj][n] = *(const f32x4*)(base + off + bj * HALF + n * 16); }
        const bool bad = st.run(acc, u, wr, wc, fr, fq, lds, wid, lane) || poison != 0u;
        const float qnan = __builtin_nanf("");
#pragma unroll
        for (int ai = 0; ai < 2; ++ai)
#pragma unroll
            for (int m = 0; m < 4; ++m) { const int r = ai * HALF + wr * 64 + m * 16 + fr; const f32x2v sr = S[r]; const size_t off = (size_t)(u.pm * BM + r) * ldc + col0;
#pragma unroll
                for (int bj = 0; bj < 2; ++bj)
#pragma unroll
                    for (int n = 0; n < 2; ++n) { const f32x4 bs = ai == 0 ? pre[m][bj][n] : *(const f32x4*)(base + off + bj * HALF + n * 16); f32x4 o = bs + (acc[ai][bj][m][n] - sr.x) * sr.y;
                        if (bad) o = (f32x4){qnan, qnan, qnan, qnan}; *(f32x4*)(out + off + bj * HALF + n * 16) = o; }
                if (m & 1) asm volatile("" ::: "memory"); }
    }
};
struct EpiLnResLn {
    static constexpr bool PERM = false, AFTER_DRAIN = true;
    const float* base; float* out; bf16_t* xn; int ldc; const float* bias; PanelStats st1, st2; unsigned poison;
    __device__ __forceinline__ void fused(f32x4 (&acc)[2][2][4][2], const Unit& u, int wr, int wc, int fr, int fq, PG8_LAS unsigned char* lds, int wid, int lane) const {
        typedef float f32x2v __attribute__((ext_vector_type(2))); typedef unsigned u32x2v __attribute__((ext_vector_type(2)));
        const PG8_LAS f32x2v* S = (const PG8_LAS f32x2v*)(lds + 8192);
        const int col0 = u.pn * BM + wc * 32 + 4 * fq;
#pragma unroll
        for (int bj = 0; bj < 2; ++bj)
#pragma unroll
            for (int n = 0; n < 2; ++n) { const f32x4 bv = bias ? *(const f32x4*)(bias + col0 + bj * HALF + n * 16) : (f32x4){0.f, 0.f, 0.f, 0.f};
#pragma unroll
                for (int ai = 0; ai < 2; ++ai)
#pragma unroll
                    for (int m = 0; m < 4; ++m) acc[ai][bj][m][n] += bv; }
        bool bad = st1.run(acc, u, wr, wc, fr, fq, lds, wid, lane) || poison != 0u;
        const float qnan = __builtin_nanf("");
#pragma unroll
        for (int ai = 0; ai < 2; ++ai)
#pragma unroll
            for (int m = 0; m < 4; ++m) { const int r = ai * HALF + wr * 64 + m * 16 + fr; const f32x2v sr = S[r]; const size_t off = (size_t)(u.pm * BM + r) * ldc + col0;
#pragma unroll
                for (int bj = 0; bj < 2; ++bj)
#pragma unroll
                    for (int n = 0; n < 2; ++n) { const f32x4 bs = *(const f32x4*)(base + off + bj * HALF + n * 16); acc[ai][bj][m][n] = bs + (acc[ai][bj][m][n] - sr.x) * sr.y; }
                asm volatile("" : "+v"(acc[ai][0][m][0]), "+v"(acc[ai][0][m][1]), "+v"(acc[ai][1][m][0]), "+v"(acc[ai][1][m][1]));
                if (m & 1) asm volatile("" ::: "memory"); }
        const bool bad1 = bad;
        bad = st2.run(acc, u, wr, wc, fr, fq, lds, wid, lane) || bad;
#pragma unroll
        for (int ai = 0; ai < 2; ++ai)
#pragma unroll
            for (int m = 0; m < 4; ++m) { const int r = ai * HALF + wr * 64 + m * 16 + fr; const f32x2v sr = S[r]; const size_t off = (size_t)(u.pm * BM + r) * ldc + col0;
#pragma unroll
                for (int bj = 0; bj < 2; ++bj)
#pragma unroll
                    for (int n = 0; n < 2; ++n) { const f32x4 x1 = acc[ai][bj][m][n]; *(f32x4*)(out + off + bj * HALF + n * 16) = bad1 ? (f32x4){qnan, qnan, qnan, qnan} : x1;
                        const f32x4 o = (x1 - sr.x) * sr.y; u32x2v w; w.x = cvt_pk_bf16(o[0], o[1]); w.y = cvt_pk_bf16(o[2], o[3]);
                        if (bad) { w.x = 0x7fc07fc0u; w.y = 0x7fc07fc0u; } *(u32x2v*)(xn + off + bj * HALF + n * 16) = w; }
                asm volatile("" ::: "memory"); }
    }
};

typedef int i32x8 __attribute__((ext_vector_type(8)));
typedef int i32x4 __attribute__((ext_vector_type(4)));
template <class Epi, class Sched, bool ALIGN_EPI = false, bool SP2 = false, bool F8 = false>
__device__ __forceinline__ void gemm_phase(PG8_LAS unsigned char* lds, const Gemm g, const Sched& S, const Epi& E) {
    const int tid = threadIdx.x, wid = __builtin_amdgcn_readfirstlane(tid >> 6), lane = tid & 63, wr = wid >> 2, wc = wid & 3, fr = lane & 15, fq = lane >> 4;
    const int K = g.K, nt = K / BK;
    unsigned voffA[2], voffB[2];
#pragma unroll
    for (int i = 0; i < 2; ++i) { int R, C; stage_rc(tid * 16 + i * 8192, R, C); const int Rb = Epi::PERM ? ((R & ~31) + perm32(R & 31)) : R;
        voffA[i] = (unsigned)(R * K + C) * 2u; voffB[i] = (unsigned)(Rb * K + C) * 2u; }
    const size_t kstep = (size_t)(BK * 2);
    const size_t hstep = (size_t)HALF * K * 2;
    const size_t tstep = 2 * hstep;
    const unsigned ldsw = (unsigned)wid * 1024u;
    const int aoff = lds_byte(wr * 64 + fr, F8 ? fq * 16 : fq * 8), boff = lds_byte(wc * 32 + fr, F8 ? fq * 16 : fq * 8);
#define PG8_SA(b, h) (((b) * 2 + (h)) * HTB)
#define PG8_SB(b, h) ((4 + (b) * 2 + (h)) * HTB)
#define PG8_STAGE(bufoff, gbase, voff) do { _Pragma("unroll") for (int _i = 0; _i < 2; ++_i) \
        __builtin_amdgcn_global_load_lds((const unsigned*)((const char*)(gbase) + (voff)[_i]), (PG8_LAS unsigned*)(lds + (bufoff) + ldsw + _i * 8192), 16, 0, 0); } while (0)
#define PG8_LD32(p) __builtin_shufflevector(*(const PG8_LAS i32x4*)((p) + f8o1), *(const PG8_LAS i32x4*)((p) + f8o2), 0, 1, 2, 3, 4, 5, 6, 7)
#define PG8_LDA(dst, b, h) do { if constexpr (F8) { _Pragma("unroll") for (int m = 0; m < 4; ++m) dst##8[m] = PG8_LD32(lds + PG8_SA(b, h) + aoff + m * 2048); } \
        else { _Pragma("unroll") for (int m = 0; m < 4; ++m) _Pragma("unroll") for (int k = 0; k < 2; ++k) dst[m][k] = *(const PG8_LAS bf16x8*)(lds + PG8_SA(b, h) + aoff + m * 2048 + k * 1024); } } while (0)
#define PG8_LDB(dst, b, h) do { if constexpr (F8) { _Pragma("unroll") for (int n = 0; n < 2; ++n) dst##8[n] = PG8_LD32(lds + PG8_SB(b, h) + boff + n * 2048); } \
        else { _Pragma("unroll") for (int n = 0; n < 2; ++n) _Pragma("unroll") for (int k = 0; k < 2; ++k) dst[n][k] = *(const PG8_LAS bf16x8*)(lds + PG8_SB(b, h) + boff + n * 2048 + k * 1024); } } while (0)
#define PG8_MMA(ai, bj, At, Bt) do { __builtin_amdgcn_s_setprio(1); if constexpr (F8) { _Pragma("unroll") for (int m = 0; m < 4; ++m) _Pragma("unroll") for (int n = 0; n < 2; ++n) \
        asm volatile("v_mfma_scale_f32_16x16x128_f8f6f4 %0, %1, %2, %0, %3, %3 op_sel_hi:[0,0,0]" : "+v"(acc[ai][bj][m][n]) : "v"(Bt##8[n]), "v"(At##8[m]), "v"(sc1_)); } \
        else { _Pragma("unroll") for (int m = 0; m < 4; ++m) _Pragma("unroll") for (int n = 0; n < 2; ++n) _Pragma("unroll") for (int k = 0; k < 2; ++k) \
        acc[ai][bj][m][n] = __builtin_amdgcn_mfma_f32_16x16x32_bf16(Bt[n][k], At[m][k], acc[ai][bj][m][n], 0, 0, 0); } __builtin_amdgcn_s_setprio(0); } while (0)
#define PG8_WAIT_V(n) asm volatile("s_waitcnt vmcnt(" #n ")" ::: "memory")
#define PG8_WAIT_L(n) asm volatile("s_waitcnt lgkmcnt(" #n ")" ::: "memory")
#define PG8_BAR __builtin_amdgcn_s_barrier()
#define PG8_SCHED __builtin_amdgcn_sched_barrier(0)
    Unit cur, nxt; int ui = 0;
    if (!S.next(0, cur)) return;
    f32x4 acc[2][2][4][2];
#pragma unroll
    for (int a = 0; a < 2; ++a)
#pragma unroll
        for (int b = 0; b < 2; ++b)
#pragma unroll
            for (int m = 0; m < 4; ++m)
#pragma unroll
                for (int n = 0; n < 2; ++n) acc[a][b][m][n] = (f32x4){0.f, 0.f, 0.f, 0.f};
    bf16x8 At[4][2], B0[2][2], B1[2][2]; i32x8 At8[4], B08[2], B18[2];
    const int f8o1 = (fq & 1) * 16, f8o2 = 16 - f8o1;
    int sc1_ = 0x7f7f7f7f; asm volatile("" : "+v"(sc1_));
    const char* cA; const char* cB; S.ab(cur, g, tstep, cA, cB);
    S.a_ready(cur);
    if constexpr (SP2) {
        PG8_STAGE(PG8_SB(0, 0), cB, voffB); PG8_STAGE(PG8_SB(0, 1), cB + hstep, voffB); PG8_STAGE(PG8_SA(0, 0), cA, voffA); PG8_STAGE(PG8_SA(0, 1), cA + hstep, voffA);
        if (wr == 1) PG8_BAR;
        PG8_WAIT_V(2); PG8_BAR;
        PG8_STAGE(PG8_SB(1, 0), cB + kstep, voffB); PG8_STAGE(PG8_SA(1, 0), cA + kstep, voffA); PG8_STAGE(PG8_SB(1, 1), cB + hstep + kstep, voffB);
        PG8_WAIT_V(6); PG8_BAR;
    } else {
        PG8_STAGE(PG8_SB(0, 0), cB, voffB); PG8_STAGE(PG8_SA(0, 0), cA, voffA); PG8_STAGE(PG8_SB(0, 1), cB + hstep, voffB); PG8_STAGE(PG8_SA(0, 1), cA + hstep, voffA);
        if (wr == 1) PG8_BAR;
        PG8_WAIT_V(4); PG8_BAR;
        PG8_STAGE(PG8_SB(1, 0), cB + kstep, voffB); PG8_STAGE(PG8_SA(1, 0), cA + kstep, voffA); PG8_STAGE(PG8_SB(1, 1), cB + hstep + kstep, voffB);
        PG8_WAIT_V(6); PG8_BAR;
    }
    for (;;) {
        const bool has_next = S.next(ui + 1, nxt);
        const char* nA = cA; const char* nB = cB; if (has_next) S.ab(nxt, g, tstep, nA, nB);
        for (int t = 0; t < nt; t += 2) {
            const bool last = (t == nt - 2);
            const char* a1 = cA + (size_t)(t + 1) * kstep;
            const char* a2 = last ? nA : cA + (size_t)(t + 2) * kstep; const char* b2 = last ? nB : cB + (size_t)(t + 2) * kstep;
            const char* a3 = a2 + kstep; const char* b3 = b2 + kstep;
            if (last && has_next) S.a_ready(nxt);
            if constexpr (SP2) {
            PG8_LDB(B0, 0, 0); PG8_LDB(B1, 0, 1); PG8_SCHED; PG8_LDA(At, 0, 0); PG8_STAGE(PG8_SA(1, 1), a1 + hstep, voffA);
            PG8_WAIT_V(8); PG8_WAIT_L(0); PG8_BAR; PG8_MMA(0, 0, At, B0); PG8_MMA(0, 1, At, B1); PG8_BAR; PG8_SCHED;
            PG8_LDA(At, 0, 1); PG8_STAGE(PG8_SB(0, 0), b2, voffB); PG8_STAGE(PG8_SB(0, 1), b2 + hstep, voffB); PG8_STAGE(PG8_SA(0, 0), a2, voffA);
            PG8_WAIT_V(8); PG8_WAIT_L(0); PG8_BAR; PG8_MMA(1, 0, At, B0); PG8_MMA(1, 1, At, B1); PG8_BAR; PG8_SCHED;
            PG8_LDB(B0, 1, 0); PG8_LDB(B1, 1, 1); PG8_SCHED; PG8_LDA(At, 1, 0); PG8_STAGE(PG8_SA(0, 1), a2 + hstep, voffA);
            PG8_WAIT_V(8); PG8_WAIT_L(0); PG8_BAR; PG8_MMA(0, 0, At, B0); PG8_MMA(0, 1, At, B1); PG8_BAR; PG8_SCHED;
            PG8_LDA(At, 1, 1); PG8_STAGE(PG8_SB(1, 0), b3, voffB); PG8_STAGE(PG8_SB(1, 1), b3 + hstep, voffB); PG8_STAGE(PG8_SA(1, 0), a3, voffA);
            PG8_WAIT_V(8); PG8_WAIT_L(0); PG8_BAR; PG8_MMA(1, 0, At, B0); PG8_MMA(1, 1, At, B1); PG8_BAR; PG8_SCHED;
            } else {
            PG8_LDB(B0, 0, 0); PG8_SCHED; PG8_LDA(At, 0, 0); PG8_STAGE(PG8_SA(1, 1), a1 + hstep, voffA);
            PG8_WAIT_L(8); PG8_BAR; PG8_WAIT_L(0); PG8_MMA(0, 0, At, B0); PG8_BAR; PG8_SCHED;
            PG8_LDB(B1, 0, 1); PG8_STAGE(PG8_SB(0, 0), b2, voffB);
            PG8_BAR; PG8_WAIT_L(0); PG8_MMA(0, 1, At, B1); PG8_BAR;
            PG8_LDA(At, 0, 1); PG8_STAGE(PG8_SA(0, 0), a2, voffA);
            PG8_BAR; PG8_WAIT_L(0); PG8_MMA(1, 0, At, B0); PG8_BAR; PG8_SCHED;
            PG8_STAGE(PG8_SB(0, 1), b2 + hstep, voffB);
            PG8_WAIT_V(6); PG8_BAR; PG8_MMA(1, 1, At, B1); PG8_BAR;
            PG8_LDB(B0, 1, 0); PG8_SCHED; PG8_LDA(At, 1, 0); PG8_STAGE(PG8_SA(0, 1), a2 + hstep, voffA);
            PG8_WAIT_L(8); PG8_BAR; PG8_WAIT_L(0); PG8_MMA(0, 0, At, B0); PG8_BAR; PG8_SCHED;
            PG8_LDB(B1, 1, 1); PG8_STAGE(PG8_SB(1, 0), b3, voffB);
            PG8_BAR; PG8_WAIT_L(0); PG8_MMA(0, 1, At, B1); PG8_BAR;
            PG8_LDA(At, 1, 1); PG8_STAGE(PG8_SA(1, 0), a3, voffA);
            PG8_BAR; PG8_WAIT_L(0); PG8_MMA(1, 0, At, B0); PG8_BAR; PG8_SCHED;
            PG8_STAGE(PG8_SB(1, 1), b3 + hstep, voffB);
            PG8_WAIT_V(6); PG8_BAR; PG8_MMA(1, 1, At, B1); PG8_BAR;
            }
        }
        if constexpr (F8) { asm volatile("s_nop 15\n\ts_nop 15" ::: "memory"); __builtin_amdgcn_sched_barrier(0); }
        if constexpr (ALIGN_EPI) { if (wr == 0) PG8_BAR; }
        if constexpr (!Epi::AFTER_DRAIN) { E(acc, cur, wr, wc, fr, fq); S.done(cur); }
        if (!has_next) break;
#pragma unroll
        for (int a = 0; a < 2; ++a)
#pragma unroll
            for (int b = 0; b < 2; ++b)
#pragma unroll
                for (int m = 0; m < 4; ++m)
#pragma unroll
                    for (int n = 0; n < 2; ++n) acc[a][b][m][n] = (f32x4){0.f, 0.f, 0.f, 0.f};
        cur = nxt; cA = nA; cB = nB; ++ui;
        if constexpr (ALIGN_EPI) { if (wr == 1) PG8_BAR; }
    }
    PG8_WAIT_V(0);
    if constexpr (!ALIGN_EPI) { if (wr == 0) PG8_BAR; }
    PG8_BAR;
    if constexpr (Epi::AFTER_DRAIN) { E.fused(acc, cur, wr, wc, fr, fq, lds, wid, lane); S.done(cur); }
#undef PG8_SA
#undef PG8_SB
#undef PG8_STAGE
#undef PG8_LDA
#undef PG8_LD32
#undef PG8_LDB
#undef PG8_MMA
#undef PG8_WAIT_V
#undef PG8_WAIT_L
#undef PG8_BAR
#undef PG8_SCHED
}
}

namespace pg8 {
constexpr float QK_C2 = 0.125f * 1.4426950408889634f;
__device__ __forceinline__ unsigned pk_fp8x4(float a, float b, float c, float d);
struct InProjOrder {
    static constexpr int NM = 272, NN = 8, NMAIN = NM * NN, NALL = NMAIN + 2 * NM;
    int G, c;
    __host__ __device__ void init(int G_, int c_) { G = G_; c = c_; }
    __host__ __device__ bool next(int i, Unit& u) const {
        const long L = (long)i * G + c; if (L >= NALL) return false;
        if (L < NMAIN) { int wgid = (int)L; { const int q = NMAIN / NXCD, xcd = wgid % NXCD, off = wgid / NXCD; wgid = xcd * q + off; }
            const int nig = WGM * NN, gid = wgid / nig, fm = gid * WGM, gsz = (NM - fm) < WGM ? (NM - fm) : WGM;
            u.pm = fm + ((wgid % nig) % gsz); u.pn = (wgid % nig) / gsz; }
        else { const int v = (int)L - NMAIN; u.pm = v >> 1; u.pn = 8 + (v & 1); }
        return true;
    }
    __device__ __forceinline__ void a_ready(const Unit&) const {}
    __device__ __forceinline__ void done(const Unit&) const {}
    __device__ __forceinline__ void ab(const Unit& u, const Gemm& g, size_t tstep, const char*& pa, const char*& pb) const {
        if (u.pn < 8) { pa = (const char*)g.A + (size_t)u.pm * tstep; pb = (const char*)g.Bt + (size_t)u.pn * tstep; }
        else { pa = (const char*)g.Bt + (size_t)u.pn * tstep; pb = (const char*)g.A + (size_t)u.pm * tstep; }
    }
};
struct EpiInProj {
    static constexpr bool PERM = true, AFTER_DRAIN = false;
    bf16_t *Q, *Kb, *VT, *Ub, *Gb; unsigned char* VT8; const PG8_LAS float* ropec; const PG8_LAS float* ropes;
    __device__ __forceinline__ void operator()(const f32x4 (&acc)[2][2][4][2], const Unit& u, int wr, int wc, int fr, int fq) const {
        const bool ctx = u.pm >= 256;
        if (u.pn >= 8) {
            const int tok0 = u.pm * BM + wc * 32 + 8 * fq;
#pragma unroll
            for (int bj = 0; bj < 2; ++bj) { const int tok = tok0 + bj * HALF; int bidx, key;
                if (ctx) { bidx = (tok - 65536) >> 8; key = 4096 + ((tok - 65536) & 255); } else { bidx = tok >> 12; key = tok & 4095; }
#pragma unroll
                for (int ai = 0; ai < 2; ++ai)
#pragma unroll
                    for (int m = 0; m < 4; ++m) { const int dim = (u.pn - 8) * BM + ai * HALF + wr * 64 + m * 16 + fr;
                        const f32x4 v0 = acc[ai][bj][m][0], v1 = acc[ai][bj][m][1];
                        u32x4 w; w.x = cvt_pk_bf16(v0[0], v0[1]); w.y = cvt_pk_bf16(v0[2], v0[3]); w.z = cvt_pk_bf16(v1[0], v1[1]); w.w = cvt_pk_bf16(v1[2], v1[3]);
                        *(u32x4*)(VT + ((size_t)(bidx * 512 + dim)) * 4352 + key) = w;
                        typedef unsigned u32x2v __attribute__((ext_vector_type(2))); u32x2v w8; w8.x = pk_fp8x4(v0[0], v0[1], v0[2], v0[3]); w8.y = pk_fp8x4(v1[0], v1[1], v1[2], v1[3]);
                        *(u32x2v*)(VT8 + ((size_t)(bidx * 512 + dim)) * 4352 + key) = w8; } }
            return;
        }
        const int seg = u.pn >> 1;
        if (ctx && (seg == 0 || seg == 3)) return;
        const int cs0 = (u.pn & 1) * BM + wc * 32 + 8 * fq;
        const bool rope = (seg < 2) && !ctx; const int a = wc & 1;
#pragma unroll
        for (int ai = 0; ai < 2; ++ai)
#pragma unroll
            for (int m = 0; m < 4; ++m) {
                const int r = u.pm * BM + ai * HALF + wr * 64 + m * 16 + fr;
                int bidx, s; size_t rowkv;
                if (ctx) { bidx = (r - 65536) >> 8; s = (r - 65536) & 255; rowkv = (size_t)bidx * 4352 + 4096 + s; }
                else { bidx = r >> 12; s = r & 4095; rowkv = (size_t)bidx * 4352 + s; }
                f32x4 cs = (f32x4){1.f, 1.f, 1.f, 1.f}, sn = (f32x4){0.f, 0.f, 0.f, 0.f};
                if (rope) { const int pos = a ? (s & 63) : (s >> 6); cs = *(const PG8_LAS f32x4*)(ropec + pos * 16 + 4 * fq); sn = *(const PG8_LAS f32x4*)(ropes + pos * 16 + 4 * fq); }
                bf16_t* dst;
                if (seg == 0) dst = Q + (size_t)r * 512; else if (seg == 1) dst = Kb + rowkv * 512; else if (seg == 2) dst = Ub + (size_t)r * 512; else dst = Gb + (size_t)r * 512;
#pragma unroll
                for (int bj = 0; bj < 2; ++bj) {
                    f32x4 v0 = acc[ai][bj][m][0], v1 = acc[ai][bj][m][1];
                    if (rope) { const f32x4 o1 = v0 * cs - v1 * sn, o2 = v1 * cs + v0 * sn; v0 = o1; v1 = o2; }
                    if (seg == 0) { v0 = v0 * QK_C2; v1 = v1 * QK_C2; }
                    u32x4 w; w.x = cvt_pk_bf16(v0[0], v0[1]); w.y = cvt_pk_bf16(v0[2], v0[3]); w.z = cvt_pk_bf16(v1[0], v1[1]); w.w = cvt_pk_bf16(v1[2], v1[3]);
                    *(u32x4*)(dst + cs0 + bj * HALF) = w;
                }
            }
    }
};
__device__ __forceinline__ unsigned pk_fp8x4(float a, float b, float c, float d) {
    a = __builtin_amdgcn_fmed3f(a, -448.f, 448.f); b = __builtin_amdgcn_fmed3f(b, -448.f, 448.f); c = __builtin_amdgcn_fmed3f(c, -448.f, 448.f); d = __builtin_amdgcn_fmed3f(d, -448.f, 448.f);
    int w = 0; w = __builtin_amdgcn_cvt_pk_fp8_f32(a, b, w, false); w = __builtin_amdgcn_cvt_pk_fp8_f32(c, d, w, true); return (unsigned)w; }
template <bool OUT8> struct EpiSwiglu {
    static constexpr bool PERM = true, AFTER_DRAIN = false;
    bf16_t* H; int ldh; float ascale, oscale;
    __device__ __forceinline__ void operator()(const f32x4 (&acc)[2][2][4][2], const Unit& u, int wr, int wc, int fr, int fq) const {
        const int col0 = u.pn * HALF + wc * 32 + 8 * fq;
#pragma unroll
        for (int ai = 0; ai < 2; ++ai)
#pragma unroll
            for (int m = 0; m < 4; ++m) {
                const size_t r = (size_t)u.pm * BM + ai * HALF + wr * 64 + m * 16 + fr;
                float o[8];
#pragma unroll
                for (int n = 0; n < 2; ++n)
#pragma unroll
                    for (int j = 0; j < 4; ++j) { const float av = acc[ai][0][m][n][j] * ascale, bv = acc[ai][1][m][n][j] * ascale;
                        const float sg = __builtin_amdgcn_rcpf(1.f + __builtin_amdgcn_exp2f(-av * 1.4426950408889634f)); o[4 * n + j] = av * sg * bv; }
                if constexpr (OUT8) { typedef unsigned u32x2v __attribute__((ext_vector_type(2)));
                    u32x2v w; w.x = pk_fp8x4(o[0] * oscale, o[1] * oscale, o[2] * oscale, o[3] * oscale); w.y = pk_fp8x4(o[4] * oscale, o[5] * oscale, o[6] * oscale, o[7] * oscale);
                    *(u32x2v*)((unsigned char*)H + r * ldh + col0) = w;
                } else { u32x4 w; w.x = cvt_pk_bf16(o[0], o[1]); w.y = cvt_pk_bf16(o[2], o[3]); w.z = cvt_pk_bf16(o[4], o[5]); w.w = cvt_pk_bf16(o[6], o[7]);
                    *(u32x4*)(H + r * ldh + col0) = w; }
            }
    }
};
struct EpiPlain {
    static constexpr bool PERM = true, AFTER_DRAIN = false;
    bf16_t* O; int ldc; float scale;
    __device__ __forceinline__ void operator()(const f32x4 (&acc)[2][2][4][2], const Unit& u, int wr, int wc, int fr, int fq) const {
        const int col0 = u.pn * BM + wc * 32 + 8 * fq;
#pragma unroll
        for (int ai = 0; ai < 2; ++ai)
#pragma unroll
            for (int m = 0; m < 4; ++m) {
                bf16_t* rowp = O + ((size_t)u.pm * BM + ai * HALF + wr * 64 + m * 16 + fr) * ldc + col0;
#pragma unroll
                for (int bj = 0; bj < 2; ++bj) { const f32x4 v0 = acc[ai][bj][m][0] * scale, v1 = acc[ai][bj][m][1] * scale;
                    u32x4 w; w.x = cvt_pk_bf16(v0[0], v0[1]); w.y = cvt_pk_bf16(v0[2], v0[3]); w.z = cvt_pk_bf16(v1[0], v1[1]); w.w = cvt_pk_bf16(v1[2], v1[3]);
                    *(u32x4*)(rowp + bj * HALF) = w; }
            }
    }
};
}

#ifndef ATT_F8MAP1
#define ATT_F8MAP1 1
#endif
namespace att {
typedef short bf16x8 __attribute__((ext_vector_type(8)));
typedef short s16x4 __attribute__((ext_vector_type(4)));
typedef short v4i16_t __attribute__((ext_vector_type(4)));
typedef float f32x16 __attribute__((ext_vector_type(16)));
typedef float f32x4 __attribute__((ext_vector_type(4)));
typedef unsigned u32x4 __attribute__((ext_vector_type(4)));
#define ATT_LAS __attribute__((address_space(3)))
typedef ATT_LAS const char* lds_cptr;
constexpr int TKV = 4352, NT = TKV / 64, NS = 3, KSLOT = 8192, VSLOT = 16384;
constexpr int LDS_K = 0, LDS_V = NS * KSLOT, LDS_SCR = LDS_V + 4 * VSLOT, LDS_FLG = LDS_SCR + 8 * 256, LDS_END = LDS_FLG + 64;
constexpr size_t PARK_FLOATS = 64 * 512;
__device__ __forceinline__ int crow(int r, int hi) { return (r & 3) + 8 * (r >> 2) + 4 * hi; }
__device__ __forceinline__ void glds16(const void* gsrc, unsigned lds_dst) { unsigned keep;
    asm volatile("s_mov_b32 %0, m0\n\ts_mov_b32 m0, %2\n\ts_nop 0\n\tglobal_load_lds_dwordx4 %1, off\n\ts_mov_b32 m0, %0" : "=&s"(keep) : "v"(gsrc), "s"(lds_dst) : "memory"); }
__device__ __forceinline__ void glds16s(const void* sbase, unsigned voff, unsigned lds_dst) { unsigned keep;
    asm volatile("s_mov_b32 %0, m0\n\ts_mov_b32 m0, %3\n\ts_nop 0\n\tglobal_load_lds_dwordx4 %1, %2\n\ts_mov_b32 m0, %0" : "=&s"(keep) : "v"(voff), "s"(sbase), "s"(lds_dst) : "memory"); }
typedef float f32x2_t __attribute__((ext_vector_type(2))); typedef __bf16 bf16x2_t __attribute__((ext_vector_type(2)));
__device__ __forceinline__ unsigned cvtpk(float lo, float hi) { f32x2_t v = {lo, hi}; bf16x2_t b = __builtin_convertvector(v, bf16x2_t); return __builtin_bit_cast(unsigned, b); }
__device__ __forceinline__ s16x4 vtr(lds_cptr p) { return __builtin_bit_cast(s16x4, __builtin_amdgcn_ds_read_tr16_b64_v4i16((ATT_LAS v4i16_t*)p)); }
__device__ __forceinline__ bf16x8 ldsb128(lds_cptr p) { return *(const ATT_LAS bf16x8*)p; }
#define ATT_SB() __builtin_amdgcn_sched_barrier(0)
#define ATT_WAITBAR(N) asm volatile("s_waitcnt vmcnt(" #N ") lgkmcnt(0)\n\ts_barrier" ::: "memory")

typedef int i32x8 __attribute__((ext_vector_type(8)));
typedef int i32x4 __attribute__((ext_vector_type(4)));
template <int MODE, bool F8>
__device__ __forceinline__ void attn_pass(int m, const short* Qw, const short* Kh, const short* Vh, const unsigned char* V8h, char* shm, f32x16 (&o)[4], float& l, float& mx) {
    const int tid = threadIdx.x, lane = tid & 63, r32 = lane & 31, hi = lane >> 5; const int wid = __builtin_amdgcn_readfirstlane(tid >> 6);
    const bool late = wid >= 4;
    const unsigned lds0 = (unsigned)(uintptr_t)shm;
    const short* kbase = Kh + m * 64 + wid * 8;
    const unsigned koff = (unsigned)lane * 1024u;
    const int vd_ = F8 ? 16 * wid + (lane >> 2) : 8 * wid + (lane >> 3);
    const short* vbase = F8 ? (const short*)(V8h + (size_t)(16 * wid) * TKV) : Vh + (size_t)(8 * wid) * TKV;
    const unsigned voff = F8 ? (unsigned)((lane >> 2) * TKV + (((lane & 3) ^ ((vd_ >> 2) & 3)) * 16)) : (unsigned)((lane >> 3) * TKV + (((lane & 7) ^ ((vd_ >> 1) & 7)) * 8)) * 2u;
    const unsigned kdst = lds0 + LDS_K + wid * 1024, vdst = lds0 + LDS_V + wid * 1024;
#define ATT_DMAK(t, slot) glds16s((const void*)(kbase + (size_t)(t) * 64 * 512), koff, (unsigned)__builtin_amdgcn_readfirstlane(kdst + (slot)))
#define ATT_DMAV(t, slot) do { if (F8) { glds16s((const void*)((const char*)vbase + (size_t)(t) * 64), voff, (unsigned)__builtin_amdgcn_readfirstlane(vdst + (slot))); } \
        else { const short* vs_ = vbase + (size_t)(t) * 64; glds16s((const void*)vs_, voff, (unsigned)__builtin_amdgcn_readfirstlane(vdst + (slot))); glds16s((const void*)(vs_ + (size_t)64 * TKV), voff, (unsigned)__builtin_amdgcn_readfirstlane(vdst + (slot) + 8192)); } } while (0)
    const lds_cptr shm3 = (lds_cptr)shm;
    const int kpi_ = F8 ? (32 * ((r32 >> 2) & 1) + (r32 & 3) + 4 * (r32 >> 3)) : ((r32 & ~12) | ((r32 & 4) << 1) | ((r32 & 8) >> 1));
    constexpr int KB_OFF = F8 ? 256 : 512;
    const lds_cptr kp0 = shm3 + LDS_K + hi * 1024 + kpi_ * 16;
    const int vf_ = (r32 >> 1) & 7;
    const lds_cptr vq0 = shm3 + LDS_V + r32 * 128 + (((0 + hi) ^ vf_) << 4), vq1 = shm3 + LDS_V + r32 * 128 + (((2 + hi) ^ vf_) << 4);
    const lds_cptr vq2 = shm3 + LDS_V + r32 * 128 + (((4 + hi) ^ vf_) << 4), vq3 = shm3 + LDS_V + r32 * 128 + (((6 + hi) ^ vf_) << 4);
    const lds_cptr v8a = shm3 + LDS_V + r32 * 64 + (((2 * hi) ^ ((r32 >> 2) & 3)) << 4), v8b = shm3 + LDS_V + r32 * 64 + (((2 * hi + 1) ^ ((r32 >> 2) & 3)) << 4);
    int sc1_ = 0x7f7f7f7f; asm volatile("" : "+v"(sc1_)); int scA = sc1_;
    bf16x8 qr[4];
#pragma unroll
    for (int d0 = 0; d0 < 4; ++d0) qr[d0] = *(const bf16x8*)(Qw + (size_t)r32 * 512 + m * 64 + d0 * 16 + hi * 8);
    asm volatile("" : "+v"(qr[0]), "+v"(qr[1]), "+v"(qr[2]), "+v"(qr[3]) :: "memory");
    constexpr int NV = F8 ? 1 : 2;
    ATT_DMAK(0, 0); ATT_DMAV(0, 0); ATT_DMAK(1, KSLOT); ATT_DMAK(2, 2 * KSLOT); ATT_DMAV(1, VSLOT);
#pragma unroll
    for (int i = 0; i < 4; ++i) o[i] = f32x16{};
    l = 0.f; float nmx = -INFINITY; f32x2_t l2 = {0.f, 0.f};
    if (NV == 2) ATT_WAITBAR(3); else ATT_WAITBAR(2);
    bf16x8 ka0, ka1, ka2, ka3, kb0, kb1, kb2, kb3;
#define ATT_LOADK(slot) do { const lds_cptr kp_ = kp0 + (slot); ka0 = ldsb128(kp_); kb0 = ldsb128(kp_ + KB_OFF); ka1 = ldsb128(kp_ + 2048); kb1 = ldsb128(kp_ + 2048 + KB_OFF); \
        ka2 = ldsb128(kp_ + 4096); kb2 = ldsb128(kp_ + 4096 + KB_OFF); ka3 = ldsb128(kp_ + 6144); kb3 = ldsb128(kp_ + 6144 + KB_OFF); } while (0)
    ATT_LOADK(0);
    if (NV == 2) ATT_WAITBAR(3); else ATT_WAITBAR(2);
    int ksl = 0, vsl = 0;
    bf16x8 p0, p1, p2, p3;
    p0 = p1 = p2 = p3 = (bf16x8){0, 0, 0, 0, 0, 0, 0, 0};
#define ATT_VLD(dst, db, ks) dst = ldsb128(vq##ks + vsl_ + (db) * 4096)
#define ATT_MF(acc, a, b) acc = __builtin_amdgcn_mfma_f32_32x32x16_bf16(a, b, acc, 0, 0, 0)
#define ATT_PACK8(oa_, ob_) do { \
        _Pragma("unroll") for (int j = 0; j < 4; ++j) { int w_ = __builtin_amdgcn_cvt_pk_fp8_f32(sa[4 * j], sa[4 * j + 1], oa_[j], false); w_ = __builtin_amdgcn_cvt_pk_fp8_f32(sa[4 * j + 2], sa[4 * j + 3], w_, true); w8_[j] = w_; } \
        _Pragma("unroll") for (int j = 0; j < 4; ++j) { int w_ = __builtin_amdgcn_cvt_pk_fp8_f32(sb[4 * j], sb[4 * j + 1], ob_[j], false); w_ = __builtin_amdgcn_cvt_pk_fp8_f32(sb[4 * j + 2], sb[4 * j + 3], w_, true); w8_[4 + j] = w_; } } while (0)
#define ATT_X(HASNEXT, ksn_) do { \
        f32x16 sa, sb;     \
        if (F8) { asm volatile("v_mfma_f32_32x32x16_bf16 %0, %1, %2, -4.0" : "=&v"(sa) : "v"(ka0), "v"(qr[0])); asm volatile("v_mfma_f32_32x32x16_bf16 %0, %1, %2, -4.0" : "=&v"(sb) : "v"(kb0), "v"(qr[0])); } \
        else { sa = f32x16{}; sb = f32x16{}; ATT_MF(sa, ka0, qr[0]); ATT_MF(sb, kb0, qr[0]); } \
        ATT_MF(sa, ka1, qr[1]); ATT_MF(sb, kb1, qr[1]); \
        ATT_MF(sa, ka2, qr[2]); ATT_MF(sb, kb2, qr[2]); ATT_MF(sa, ka3, qr[3]); ATT_MF(sb, kb3, qr[3]); \
        ATT_SB(); \
          \
        if (t + 3 < NT) ATT_DMAK(t + 3, ksl); \
        if (MODE != 1) { if (t + 2 < NT) { const int v2 = (vsl >= 2 * VSLOT) ? vsl - 2 * VSLOT : vsl + 2 * VSLOT; ATT_DMAV(t + 2, v2); } } \
        ATT_SB(); \
        if (HASNEXT) ATT_LOADK(ksn_); \
        if (MODE == 1) { \
            _Pragma("unroll") for (int r = 0; r < 16; ++r) nmx = fmaxf(nmx, fmaxf(sa[r], sb[r])); \
        } else { \
            _Pragma("unroll") for (int r = 0; r < 16; ++r) { sa[r] = __builtin_amdgcn_exp2f(MODE == 2 ? sa[r] - mx : sa[r]); sb[r] = __builtin_amdgcn_exp2f(MODE == 2 ? sb[r] - mx : sb[r]); } \
            _Pragma("unroll") for (int r = 0; r < 8; ++r) { l2 += (f32x2_t){sa[2 * r], sa[2 * r + 1]}; l2 += (f32x2_t){sb[2 * r], sb[2 * r + 1]}; }     \
            if (F8) { i32x8 w8_; const i32x4 po0_ = __builtin_bit_cast(i32x4, p0), po1_ = __builtin_bit_cast(i32x4, p1);     \
                int pmt = 0; \
                _Pragma("unroll") for (int r = 0; r < 16; ++r) { const float fa_ = sa[r], fb_ = sb[r]; const int ia_ = __float_as_int(fa_), ib_ = __float_as_int(fb_); pmt = pmt > ia_ ? pmt : ia_; pmt = pmt > ib_ ? pmt : ib_; }     \
                scA = sc1_; ATT_PACK8(po0_, po1_);     \
                if (__builtin_expect(__any(pmt > 0x43e00000), 0)) {     \
                    const int e_ = pmt > 0x43e00000 ? (pmt >> 23) - 134 : 0;     \
                    const float f_ = __int_as_float((127 - e_) << 23); \
                    _Pragma("unroll") for (int r = 0; r < 16; ++r) { sa[r] *= f_; sb[r] *= f_; } \
                    const i32x4 pa_ = __builtin_shufflevector(w8_, w8_, 0, 1, 2, 3), pb_ = __builtin_shufflevector(w8_, w8_, 4, 5, 6, 7); \
                    scA = (127 + e_) * 0x01010101; ATT_PACK8(pa_, pb_); } \
                p0 = __builtin_bit_cast(bf16x8, __builtin_shufflevector(w8_, w8_, 0, 1, 2, 3)); p1 = __builtin_bit_cast(bf16x8, __builtin_shufflevector(w8_, w8_, 4, 5, 6, 7)); \
            } else { \
            u32x4 w0, w1, w2, w3; \
            w0.x = cvtpk(sa[0], sa[1]); w0.y = cvtpk(sa[2], sa[3]); w0.z = cvtpk(sa[4], sa[5]); w0.w = cvtpk(sa[6], sa[7]); \
            w1.x = cvtpk(sa[8], sa[9]); w1.y = cvtpk(sa[10], sa[11]); w1.z = cvtpk(sa[12], sa[13]); w1.w = cvtpk(sa[14], sa[15]); \
            w2.x = cvtpk(sb[0], sb[1]); w2.y = cvtpk(sb[2], sb[3]); w2.z = cvtpk(sb[4], sb[5]); w2.w = cvtpk(sb[6], sb[7]); \
            w3.x = cvtpk(sb[8], sb[9]); w3.y = cvtpk(sb[10], sb[11]); w3.z = cvtpk(sb[12], sb[13]); w3.w = cvtpk(sb[14], sb[15]); \
            p0 = __builtin_bit_cast(bf16x8, w0); p1 = __builtin_bit_cast(bf16x8, w1); p2 = __builtin_bit_cast(bf16x8, w2); p3 = __builtin_bit_cast(bf16x8, w3); } \
        } \
        ATT_SB(); } while (0)
#define ATT_LD32(dst, db) dst = __builtin_shufflevector(*(const ATT_LAS i32x4*)(v8a + vsl_ + (db) * 2048), *(const ATT_LAS i32x4*)(v8b + vsl_ + (db) * 2048), 0, 1, 2, 3, 4, 5, 6, 7)
#define ATT_MF8(acc, vfrag) asm volatile("s_nop 1\n\tv_mfma_scale_f32_32x32x64_f8f6f4 %0, %1, %2, %0, %3, %4 op_sel_hi:[0,0,0]" : "+v"(acc) : "v"(pp8_), "v"(vfrag), "v"(scA), "v"(sc1_))
#define ATT_Y8(vslx) do { const int vsl_ = (vslx); i32x8 wa, wb, wc, wd; const i32x8 pp8_ = __builtin_shufflevector(__builtin_bit_cast(i32x4, p0), __builtin_bit_cast(i32x4, p1), 0, 1, 2, 3, 4, 5, 6, 7); \
        ATT_LD32(wa, 0); ATT_LD32(wb, 1); ATT_SB(); ATT_LD32(wc, 2); ATT_LD32(wd, 3); ATT_SB(); \
        ATT_MF8(o[0], wa); ATT_MF8(o[1], wb); ATT_SB(); ATT_MF8(o[2], wc); ATT_MF8(o[3], wd); ATT_SB(); } while (0)
#define ATT_YB(vslx) do { const int vsl_ = (vslx); bf16x8 va, vb, vc, vd, ve, vf, vg, vh;     \
        ATT_VLD(va, 0, 0); ATT_VLD(vb, 0, 1); ATT_VLD(vc, 0, 2); ATT_VLD(vd, 0, 3); ATT_SB(); \
        ATT_VLD(ve, 1, 0); ATT_VLD(vf, 1, 1); ATT_VLD(vg, 1, 2); ATT_VLD(vh, 1, 3); ATT_SB(); \
        ATT_MF(o[0], p0, va); ATT_MF(o[0], p1, vb); ATT_MF(o[0], p2, vc); ATT_MF(o[0], p3, vd); ATT_SB(); \
        ATT_VLD(va, 2, 0); ATT_VLD(vb, 2, 1); ATT_VLD(vc, 2, 2); ATT_VLD(vd, 2, 3); ATT_SB(); \
        ATT_MF(o[1], p0, ve); ATT_MF(o[1], p1, vf); ATT_MF(o[1], p2, vg); ATT_MF(o[1], p3, vh); ATT_SB(); \
        ATT_VLD(ve, 3, 0); ATT_VLD(vf, 3, 1); ATT_VLD(vg, 3, 2); ATT_VLD(vh, 3, 3); ATT_SB(); \
        ATT_MF(o[2], p0, va); ATT_MF(o[2], p1, vb); ATT_MF(o[2], p2, vc); ATT_MF(o[2], p3, vd); ATT_SB(); \
        ATT_MF(o[3], p0, ve); ATT_MF(o[3], p1, vf); ATT_MF(o[3], p2, vg); ATT_MF(o[3], p3, vh); ATT_SB(); } while (0)
#define ATT_Y(vslx) do { if (F8) ATT_Y8(vslx); else ATT_YB(vslx); } while (0)
#pragma unroll 1
    for (int t = 0; t < NT; ++t) {
        const int ksn = (ksl == 2 * KSLOT) ? 0 : ksl + KSLOT;
        const int vprev = (vsl == 0) ? 3 * VSLOT : vsl - VSLOT;
        if (MODE != 1) { if (late && t >= 1) ATT_Y(vprev); }
        ATT_X(true, ksn);
        if (MODE != 1) { if (!late) ATT_Y(vsl); }
        if (MODE != 1) { if (NV == 2) { if (t + 3 < NT) ATT_WAITBAR(3); else if (t + 2 < NT) ATT_WAITBAR(2); else ATT_WAITBAR(0); }
                         else { if (t + 3 < NT) ATT_WAITBAR(2); else if (t + 2 < NT) ATT_WAITBAR(1); else ATT_WAITBAR(0); } }
        else { if (t + 3 < NT) ATT_WAITBAR(1); else ATT_WAITBAR(0); }
        ksl = ksn; vsl = (vsl == 3 * VSLOT) ? 0 : vsl + VSLOT;
    }
    if (MODE != 1) { if (late) { const int vprev = (vsl == 0) ? 3 * VSLOT : vsl - VSLOT; ATT_Y(vprev); } ATT_WAITBAR(0); }
    if (F8) { asm volatile("s_nop 15\n\ts_nop 15" ::: "memory"); __builtin_amdgcn_sched_barrier(0); }
    if (MODE == 1) mx = fmaxf(nmx, __shfl_xor(nmx, 32)); else l = l2.x + l2.y;
#undef ATT_X
#undef ATT_PACK8
#undef ATT_Y
#undef ATT_YB
#undef ATT_Y8
#undef ATT_MF8
#undef ATT_LD32
#undef ATT_MF
#undef ATT_VLD
#undef ATT_LOADK
#undef ATT_DMAK
#undef ATT_DMAV
}

template <int MODE>
__device__ __forceinline__ bool attn_unit(int b, int h, int qb, const short* Q, const short* K, const short* V, const unsigned char* V8, short* AO, const float* subg, float lam, float* park, char* shm) {
    const int tid = threadIdx.x, lane = tid & 63, r32 = lane & 31, hi = lane >> 5; const int wid = __builtin_amdgcn_readfirstlane(tid >> 6);
    ATT_LAS float* scr = (ATT_LAS float*)((ATT_LAS char*)shm + LDS_SCR) + wid * 64;
    volatile ATT_LAS unsigned* flgp = (volatile ATT_LAS unsigned*)((ATT_LAS char*)shm + LDS_FLG);
    const size_t qrow = (size_t)b * 4096 + qb * 256 + wid * 32;
    const short* Qw = Q + qrow * 512 + h * 128; const short* Kh = K + (size_t)b * TKV * 512 + h * 128; const short* Vh = V + (size_t)(b * 4 + h) * 128 * TKV; const unsigned char* V8h = V8 + (size_t)(b * 4 + h) * 128 * TKV;
    if (tid == 0) *flgp = 0u;
    f32x16 o[4]; float l, mx = 0.f; bool bad = false;
    if (MODE == 2) { float dummy; attn_pass<1, false>(0, Qw, Kh, Vh, V8h, shm, o, dummy, mx); }
    attn_pass<(MODE == 2 ? 2 : 0), false>(0, Qw, Kh, Vh, V8h, shm, o, l, mx);
    l += __shfl_xor(l, 32); bad = bad || !(l > 0.f && l < 3.0e38f);
    if (hi == 0) scr[r32] = l;
    asm volatile("s_waitcnt lgkmcnt(0)" ::: "memory");
    {   float* pk = park + (size_t)tid * 64;
#pragma unroll
        for (int g = 0; g < 4; ++g) { float il[4];
#pragma unroll
            for (int e = 0; e < 4; ++e) il[e] = __builtin_amdgcn_rcpf(scr[crow(4 * g + e, hi)]);
#pragma unroll
            for (int db = 0; db < 4; ++db) *(f32x4*)(pk + db * 16 + 4 * g) = (f32x4){o[db][4 * g] * il[0], o[db][4 * g + 1] * il[1], o[db][4 * g + 2] * il[2], o[db][4 * g + 3] * il[3]}; } }
    if (MODE == 2) { float dummy; attn_pass<1, false>(1, Qw, Kh, Vh, V8h, shm, o, dummy, mx); }
    attn_pass<(MODE == 2 ? 2 : 0), (MODE == 0) && (ATT_F8MAP1 != 0)>(1, Qw, Kh, Vh, V8h, shm, o, l, mx);
    l += __shfl_xor(l, 32); bad = bad || !(l > 0.f && l < 3.0e38f);
    if (hi == 0) scr[32 + r32] = l;
    asm volatile("s_waitcnt lgkmcnt(0)" ::: "memory");
    float ss[16];
    {   const float* pk = park + (size_t)tid * 64;
#pragma unroll
        for (int r = 0; r < 16; ++r) ss[r] = 0.f;
#pragma unroll
        for (int g = 0; g < 4; ++g) { float il[4];
#pragma unroll
            for (int e = 0; e < 4; ++e) il[e] = lam * __builtin_amdgcn_rcpf(scr[32 + crow(4 * g + e, hi)]);
#pragma unroll
            for (int db = 0; db < 4; ++db) { const f32x4 pv = *(const f32x4*)(pk + db * 16 + 4 * g);
#pragma unroll
                for (int e = 0; e < 4; ++e) { const float v = pv[e] - o[db][4 * g + e] * il[e]; o[db][4 * g + e] = v; ss[4 * g + e] += v * v; } } } }
#pragma unroll
    for (int off = 1; off < 32; off <<= 1)
#pragma unroll
        for (int r = 0; r < 16; ++r) ss[r] += __shfl_xor(ss[r], off);
    float gv[4];
#pragma unroll
    for (int db = 0; db < 4; ++db) gv[db] = subg[32 * db + r32] * 0.8f;
    short* aow = AO + qrow * 1024 + h * 128 + r32;
#pragma unroll
    for (int r = 0; r < 16; ++r) { const float rs = __builtin_amdgcn_rsqf(ss[r] * (1.f / 128.f) + 1e-5f);
#pragma unroll
        for (int db = 0; db < 4; ++db) { const unsigned w = cvtpk(o[db][r] * rs * gv[db], 0.f); aow[(size_t)crow(r, hi) * 1024 + 32 * db] = (short)(w & 0xffffu); } }
    if (MODE == 0) { if (__any(bad)) { if (lane == 0) *flgp = 1u; } }
    asm volatile("s_waitcnt vmcnt(0) lgkmcnt(0)\n\ts_barrier" ::: "memory");
    const unsigned flg = *flgp;
    asm volatile("s_waitcnt lgkmcnt(0)\n\ts_barrier" ::: "memory");
    return __builtin_amdgcn_readfirstlane(flg) != 0u;
}
__device__ __forceinline__ void attn_unit_safe(int b, int h, int qb, const short* Q, const short* K, const short* V, const unsigned char* V8, short* AO, const float* subg, float lam, float* park, char* shm, bool force_fallback) {
    const bool redo = attn_unit<0>(b, h, qb, Q, K, V, V8, AO, subg, lam, park, shm);
    if (redo || force_fallback) (void)attn_unit<2>(b, h, qb, Q, K, V, V8, AO, subg, lam, park, shm);
}
}

namespace lru2 {
typedef short bf16x8 __attribute__((ext_vector_type(8)));
typedef float f32x16 __attribute__((ext_vector_type(16)));
typedef float f32x4 __attribute__((ext_vector_type(4)));
typedef float f32x2 __attribute__((ext_vector_type(2)));
#define LRU2_LAS __attribute__((address_space(3)))
constexpr int TS = 144, TILE = 64 * TS;
constexpr int LDS_TILE = 0, LDS_COMP = 8 * TILE, LDS_CW = LDS_COMP + 2 * 8 * 32 * 8, LDS_BF = LDS_CW + 5 * 64 * 4, LDS_END = LDS_BF + 8192;
__device__ __forceinline__ int crow(int r, int hi) { return (r & 3) + 8 * (r >> 2) + 4 * hi; }
__device__ __forceinline__ float bf2f(unsigned short v) { return __uint_as_float((unsigned)v << 16); }
__device__ __forceinline__ unsigned short f2bf(float f) { unsigned u = __float_as_uint(f); return (unsigned short)((u + 0x7fffu + ((u >> 16) & 1u)) >> 16); }
constexpr float L2E = 1.4426950408889634f;

__device__ __forceinline__ void lru_unit(int b, int w, int nb, const unsigned short* U, const unsigned short* G, const float* convw, const float* convb, const unsigned short* WgT, const float* bg,
                                         const float* sp8, float* HS, unsigned short* AO, LRU2_LAS unsigned char* lds) {
    const int tid = threadIdx.x, lane = tid & 63, r32 = lane & 31, hi = lane >> 5; const int k = __builtin_amdgcn_readfirstlane(tid >> 6);
    LRU2_LAS unsigned char* tile = lds + LDS_TILE + k * TILE;
    LRU2_LAS f32x2* comp = (LRU2_LAS f32x2*)(lds + LDS_COMP);
    const int chn = 64 * w + 32 * nb + r32;
    const int cg = lane & 7, tg = lane >> 3;
    LRU2_LAS float* cw = (LRU2_LAS float*)(lds + LDS_CW);
    if (tid < 320) { const int jj = tid >> 6, c = tid & 63; cw[tid] = jj < 4 ? convw[jj * 512 + 64 * w + c] : convb[64 * w + c]; }
    __syncthreads();
#pragma unroll 1
    for (int dir = 0; dir < 2; ++dir) {
        { const int fi = tid >> 5, o32 = tid & 31;
            const int g = fi >> 3, ks = (fi >> 1) & 3, hi2 = fi & 1;
            *(LRU2_LAS bf16x8*)(lds + LDS_BF + fi * 512 + o32 * 16) = *(const bf16x8*)(WgT + ((size_t)(((dir * 2 + g) * 8 + w) * 64 + 32 * nb + o32)) * 64 + 16 * ks + 8 * hi2); }
        __syncthreads();
        const float br = bg[((dir * 2 + 0) * 8 + w) * 64 + 32 * nb + r32], bi = bg[((dir * 2 + 1) * 8 + w) * 64 + 32 * nb + r32], sp = sp8[dir * 512 + chn];
        float cround = 0.f;
        bf16x8 uu[11];
#define LRU2_CHUNK(p_, chunk_, isctx_, L_, s0_, rowbase_) const int chunk_ = dir == 0 ? (p_) : ((p_) < 4 ? 3 - (p_) : 71 - (p_)); const bool isctx_ = chunk_ < 4; \
        const int L_ = isctx_ ? 256 : 4096, s0_ = isctx_ ? 64 * chunk_ : 64 * (chunk_ - 4); const size_t rowbase_ = isctx_ ? (size_t)65536 + (size_t)b * 256 : (size_t)b * 4096
#define LRU2_LOADU(p_) do { if ((p_) < 68) { LRU2_CHUNK(p_, ch_, ic_, L_, s0_, rb_); _Pragma("unroll") for (int i = 0; i < 11; ++i) { const int s = s0_ + 8 * tg - 2 + i; uu[i] = (bf16x8){0, 0, 0, 0, 0, 0, 0, 0}; \
            if (s >= 0 && s < L_) uu[i] = *(const bf16x8*)(U + (rb_ + s) * 512 + 64 * w + 8 * cg); } } } while (0)
        LRU2_LOADU(k);
#pragma unroll 1
        for (int rd = 0; rd < 9; ++rd) {
            const int p = 8 * rd + k; const bool valid = p < 68;
            LRU2_CHUNK(p, chunk, isctx, L, s0, rowbase);
            (void)L;
            f32x16 z[2][2];
            float atot = 1.f, cend = 0.f, cst[8];
            if (valid) {
                {
                    float wv[4][8], bv[8];
#pragma unroll
                    for (int jj = 0; jj < 4; ++jj) { const f32x4 a = *(const LRU2_LAS f32x4*)(cw + jj * 64 + 8 * cg), c = *(const LRU2_LAS f32x4*)(cw + jj * 64 + 8 * cg + 4);
                        wv[jj][0] = a.x; wv[jj][1] = a.y; wv[jj][2] = a.z; wv[jj][3] = a.w; wv[jj][4] = c.x; wv[jj][5] = c.y; wv[jj][6] = c.z; wv[jj][7] = c.w; }
                    { const f32x4 a = *(const LRU2_LAS f32x4*)(cw + 256 + 8 * cg), c = *(const LRU2_LAS f32x4*)(cw + 256 + 8 * cg + 4); bv[0] = a.x; bv[1] = a.y; bv[2] = a.z; bv[3] = a.w; bv[4] = c.x; bv[5] = c.y; bv[6] = c.z; bv[7] = c.w; }
#pragma unroll
                    for (int tt = 0; tt < 8; ++tt) { bf16x8 o;
#pragma unroll
                        for (int e = 0; e < 8; ++e) { float acc = bv[e];
#pragma unroll
                            for (int jj = 0; jj < 4; ++jj) acc += wv[jj][e] * bf2f((unsigned short)uu[tt + jj][e]);
                            o[e] = (short)f2bf(acc); }
                        *(LRU2_LAS bf16x8*)(tile + (8 * tg + tt) * TS + cg * 16) = o; }
                }
                LRU2_LOADU(p + 8);
                asm volatile("s_waitcnt lgkmcnt(0)" ::: "memory");
#pragma unroll
                for (int g = 0; g < 2; ++g)
#pragma unroll
                    for (int tb = 0; tb < 2; ++tb) { z[g][tb] = f32x16{};
#pragma unroll
                        for (int ks = 0; ks < 4; ++ks) z[g][tb] = __builtin_amdgcn_mfma_f32_32x32x16_bf16(*(const LRU2_LAS bf16x8*)(tile + (32 * tb + r32) * TS + (16 * ks + 8 * hi) * 2), *(const LRU2_LAS bf16x8*)(lds + LDS_BF + ((g * 4 + ks) * 2 + hi) * 512 + r32 * 16), z[g][tb], 0, 0, 0); }
#pragma unroll
                for (int tb = 0; tb < 2; ++tb)
#pragma unroll
                    for (int r = 0; r < 16; ++r) {
                        const float rg = __builtin_amdgcn_rcpf(1.f + __builtin_amdgcn_exp2f(-(z[0][tb][r] + br) * L2E));
                        const float ig = __builtin_amdgcn_rcpf(1.f + __builtin_amdgcn_exp2f(-(z[1][tb][r] + bi) * L2E));
                        const float a = __builtin_amdgcn_exp2f(-rg * sp);
                        const float mult = __builtin_amdgcn_sqrtf(fabsf(1.f - a * a));
                        z[0][tb][r] = a; z[1][tb][r] = mult * ig * bf2f(*(const LRU2_LAS unsigned short*)(tile + (32 * tb + crow(r, hi)) * TS + (32 * nb + r32) * 2));
                    }
                __builtin_amdgcn_sched_barrier(0);
            }
            float Ao[8], Bo[8], Ax[8], Bx[8];
            if (valid) {
#pragma unroll
                for (int q = 0; q < 8; ++q) { const int tb = q >> 2, rb = 4 * (q & 3);
                    const float a0 = z[0][tb][rb], a1 = z[0][tb][rb + 1], a2 = z[0][tb][rb + 2], a3 = z[0][tb][rb + 3];
                    const float b0 = z[1][tb][rb], b1 = z[1][tb][rb + 1], b2 = z[1][tb][rb + 2], b3 = z[1][tb][rb + 3];
                    Ao[q] = (a0 * a1) * (a2 * a3);
                    Bo[q] = dir == 0 ? ((b0 * a1 + b1) * a2 + b2) * a3 + b3 : ((b3 * a2 + b2) * a1 + b1) * a0 + b0;
                    Ax[q] = __shfl_xor(Ao[q], 32); Bx[q] = __shfl_xor(Bo[q], 32); }
                float c = 0.f;
                if (dir == 0) {
#pragma unroll
                    for (int q = 0; q < 8; ++q) { const float Ae = hi ? Ax[q] : Ao[q], Be = hi ? Bx[q] : Bo[q], Aod = hi ? Ao[q] : Ax[q], Bod = hi ? Bo[q] : Bx[q];
                        c = Aod * (Ae * c + Be) + Bod; atot *= Ao[q] * Ax[q]; }
                } else {
#pragma unroll
                    for (int q = 7; q >= 0; --q) { const float Ae = hi ? Ax[q] : Ao[q], Be = hi ? Bx[q] : Bo[q], Aod = hi ? Ao[q] : Ax[q], Bod = hi ? Bo[q] : Bx[q];
                        c = Ae * (Aod * c + Bod) + Be; atot *= Ao[q] * Ax[q]; }
                }
                cend = c;
            }
            if (hi == 0) comp[((rd & 1) * 8 + k) * 32 + r32] = (f32x2){atot, cend};
            __syncthreads();
            float cin = cround, call = cround;
#pragma unroll
            for (int k2 = 0; k2 < 8; ++k2) { const f32x2 cc = comp[((rd & 1) * 8 + k2) * 32 + r32]; call = cc.x * call + cc.y; if (k2 < k) cin = call; }
            cround = call;
            if (valid) {
                float c = cin;
                if (dir == 0) {
#pragma unroll
                    for (int q = 0; q < 8; ++q) { const float Ae = hi ? Ax[q] : Ao[q], Be = hi ? Bx[q] : Bo[q], Aod = hi ? Ao[q] : Ax[q], Bod = hi ? Bo[q] : Bx[q];
                        const float c1 = Ae * c + Be; cst[q] = hi ? c1 : c; c = Aod * c1 + Bod; }
                } else {
#pragma unroll
                    for (int q = 7; q >= 0; --q) { const float Ae = hi ? Ax[q] : Ao[q], Be = hi ? Bx[q] : Bo[q], Aod = hi ? Ao[q] : Ax[q], Bod = hi ? Bo[q] : Bx[q];
                        const float c1 = Aod * c + Bod; cst[q] = hi ? c : c1; c = Ae * c1 + Be; }
                }
                if (!isctx) {
#pragma unroll
                    for (int q = 0; q < 8; ++q) { const int tb = q >> 2, rb = 4 * (q & 3); float hcur = cst[q];
                        if (dir == 0) {
#pragma unroll
                            for (int e = 0; e < 4; ++e) { hcur = z[0][tb][rb + e] * hcur + z[1][tb][rb + e]; z[1][tb][rb + e] = hcur; }
                        } else {
#pragma unroll
                            for (int e = 3; e >= 0; --e) { hcur = z[0][tb][rb + e] * hcur + z[1][tb][rb + e]; z[1][tb][rb + e] = hcur; }
                        } }
                    const size_t row0 = rowbase + s0;
                    const int hoff = hi * 4 * 512 + chn, aoff = hi * 4 * 1024 + 512 + chn;
                    if (dir == 0) {
#pragma unroll
                        for (int tb = 0; tb < 2; ++tb)
#pragma unroll
                            for (int r = 0; r < 16; ++r) { const size_t rowu = row0 + 32 * tb + 8 * (r >> 2) + (r & 3); (HS + rowu * 512)[hoff] = z[1][tb][r]; }
                    } else {
#pragma unroll
                        for (int tb = 0; tb < 2; ++tb) { float hf[16]; unsigned short gg[16];
#pragma unroll
                            for (int r = 0; r < 16; ++r) { const size_t rowu = row0 + 32 * tb + 8 * (r >> 2) + (r & 3); hf[r] = (HS + rowu * 512)[hoff]; gg[r] = (G + rowu * 512)[hoff]; }
#pragma unroll
                            for (int r = 0; r < 16; ++r) { const size_t rowu = row0 + 32 * tb + 8 * (r >> 2) + (r & 3); const float hsum = z[1][tb][r] + hf[r];
                                const float g = bf2f(gg[r]); const float t = 1.5957691216057308f * (g + 0.044715f * g * g * g);
                                const float y = hsum * g * __builtin_amdgcn_rcpf(1.f + __builtin_amdgcn_exp2f(-t * L2E));
                                (AO + rowu * 1024)[aoff] = f2bf(y); } }
                    }
                }
            }
        }
#undef LRU2_LOADU
#undef LRU2_CHUNK
        asm volatile("s_waitcnt vmcnt(0)" ::: "memory");
        __syncthreads();
    }
}
}

#define GAS __attribute__((address_space(1)))
#define LAS __attribute__((address_space(3)))
typedef unsigned short bf16;
typedef unsigned v4u __attribute__((ext_vector_type(4)));
typedef float f32x4 __attribute__((ext_vector_type(4)));
typedef short bf16x8 __attribute__((ext_vector_type(8)));
typedef GAS unsigned gu32;
typedef GAS unsigned long long gu64;
#define RLX_AGENT __ATOMIC_RELAXED, __HIP_MEMORY_SCOPE_AGENT
#define LDS_WAIT() asm volatile("s_waitcnt lgkmcnt(0)" ::: "memory")
#define VM_WAIT() asm volatile("s_waitcnt vmcnt(0)" ::: "memory")
__device__ __forceinline__ unsigned long long rt() { return __builtin_amdgcn_s_memrealtime(); }
__device__ __forceinline__ unsigned f2bf(float f) { unsigned u = __builtin_bit_cast(unsigned, f); return (u + 0x7fffu + ((u >> 16) & 1u)) >> 16; }
__device__ __forceinline__ unsigned pk2(float lo, float hi) { return f2bf(lo) | (f2bf(hi) << 16); }

#define XB_TMO      128
#define XB_XCNT(j)  (256  + 64 * (j))
#define XB_XSUB(j)  (1280 + 64 * (j))
#define XB_XGEN(j)  (2304 + 64 * (j))
#define XB_TOP      3328
#define XB_TOPGEN   3392
#define XCD_BAR_WORDS 3456
#define XB_SPIN_CAP (1u << 18)

__device__ __forceinline__ unsigned xb_ld(unsigned* p)              { return __hip_atomic_load(p, __ATOMIC_RELAXED, __HIP_MEMORY_SCOPE_AGENT); }
__device__ __forceinline__ unsigned xb_add(unsigned* p, unsigned v) { return __hip_atomic_fetch_add(p, v, __ATOMIC_RELAXED, __HIP_MEMORY_SCOPE_AGENT); }
__device__ __forceinline__ unsigned xb_xcc_id() { return (unsigned)__builtin_amdgcn_s_getreg((3 << 11) | 20) & 0xFu; }
#define XB_SPIN(cond, bar) do { unsigned _sp = 0; while (cond) { __builtin_amdgcn_s_sleep(1); \
    if ((++_sp & 255u) == 0u) { if (xb_ld(&(bar)[XB_TMO])) break; if (_sp > XB_SPIN_CAP) { atomicAdd(&(bar)[XB_TMO], 1u); break; } } } } while (0)

struct XcdBarrier {
    unsigned* bar; unsigned x;
    volatile LAS unsigned* st;
};

__device__ __forceinline__ XcdBarrier xcd_barrier_post(unsigned* bar, volatile LAS unsigned* st) {
    XcdBarrier b; b.bar = bar; b.x = xb_xcc_id(); b.st = st;
    if (threadIdx.x == 0) (void)xb_add(&bar[XB_XCNT(b.x)], 1u);
    return b;
}
__device__ __forceinline__ void xcd_barrier_complete(unsigned* bar, unsigned x, unsigned& nloc, unsigned& nx) {
    const unsigned G = gridDim.x * gridDim.y * gridDim.z;
    unsigned sum, cnt, mine, sp = 0u;
    for (;;) {
        sum = 0u; cnt = 0u; mine = 0u;
#pragma unroll
        for (unsigned j = 0; j < 16; ++j) { const unsigned c = xb_ld(&bar[XB_XCNT(j)]); sum += c; cnt += (c > 0u) ? 1u : 0u; mine = (j == x) ? c : mine; }
        if (sum == G) break;
        __builtin_amdgcn_s_sleep(1);
        if ((++sp & 255u) == 0u) { if (xb_ld(&bar[XB_TMO])) break; if (sp > XB_SPIN_CAP) { atomicAdd(&bar[XB_TMO], 1u); break; } }
    }
    nloc = mine > 0u ? mine : 1u; nx = cnt > 0u ? cnt : 1u;
}

__device__ __forceinline__ void xcd_barrier(const XcdBarrier& b) {
    asm volatile("s_waitcnt vmcnt(0)" ::: "memory");
    __syncthreads();
    if (threadIdx.x == 0) {
        unsigned* bar = b.bar;
        __builtin_amdgcn_s_waitcnt(0);
        unsigned nloc = b.st[0], nx = b.st[1];
        if (nloc == 0u) { xcd_barrier_complete(bar, b.x, nloc, nx); b.st[0] = nloc; b.st[1] = nx; }
        const unsigned old = xb_add(&bar[XB_XSUB(b.x)], 1u);
        const unsigned gen = old / nloc;
        if (old + 1u == (gen + 1u) * nloc) {
            __builtin_amdgcn_fence(__ATOMIC_RELEASE, "agent");
            asm volatile("s_waitcnt vmcnt(0)" ::: "memory");
            const unsigned og = xb_add(&bar[XB_TOP], 1u);
            const unsigned tg = og / nx;
            if (og + 1u == (tg + 1u) * nx) xb_add(&bar[XB_TOPGEN], 1u);
            else XB_SPIN(xb_ld(&bar[XB_TOPGEN]) == tg, bar);
            __builtin_amdgcn_fence(__ATOMIC_ACQUIRE, "agent");
            xb_add(&bar[XB_XGEN(b.x)], 1u);
            asm volatile("s_waitcnt vmcnt(0)" ::: "memory");
        } else {
            XB_SPIN(xb_ld(&bar[XB_XGEN(b.x)]) == gen, bar);
            __builtin_amdgcn_fence(__ATOMIC_ACQUIRE, "agent");
            asm volatile("s_waitcnt vmcnt(0)" ::: "memory");
        }
    }
    __syncthreads();
}

constexpr int NWAVES = 8;
#ifndef MK_N_LAUNCHES
#define MK_N_LAUNCHES 1
#endif
#ifndef X1_BF16
#define X1_BF16 (DBG ? 0 : 1)
#endif
constexpr int PER_PHASE = 10;
constexpr int N_LAUNCHES = MK_N_LAUNCHES;
#ifndef REPEAT_MASK
#define REPEAT_MASK 0
#endif
#ifndef TSTAMP
#define TSTAMP -1
#endif
#ifndef TS_UNIT
#define TS_UNIT 100.0f
#endif
#ifndef FP8_FFN
#define FP8_FFN 0
#endif
constexpr bool F8_IN = (FP8_FFN & 1) != 0, F8_OUT = (FP8_FFN & 2) != 0;
constexpr float W1_SCALE = 32.f, W2_SCALE = 64.f, HID_SCALE = 8.f;
#ifndef ATT_FORCE_FALLBACK
#define ATT_FORCE_FALLBACK 0
#endif
constexpr int DM = 1024, NBATCH = 16, SEQ = 4096, CTXL = 256, MLAT = NBATCH * SEQ, MCTX = NBATCH * CTXL, MALL = MLAT + MCTX, INW = 2560, FH = 2816;
constexpr float LN_EPS = 1e-6f, DN_ALPHA = 1.189207115002721f;
constexpr size_t MiB = 1u << 20;
constexpr size_t WS_CTL = 0, CTL_ZERO_BYTES = 64 * 1024;
constexpr size_t WS_MOD = 1 * MiB, WS_ROPEC = WS_MOD + 512 * 1024, WS_ROPES = WS_ROPEC + 4096, WS_SP8 = WS_ROPES + 4096, WS_LAM = WS_SP8 + 4096;
constexpr size_t WS_WIN = 2 * MiB, WS_WOUT = 8 * MiB, WS_W1 = 10 * MiB, WS_W2 = 21 * MiB, WS_WG = 27 * MiB, WS_SUM = 28 * MiB;
constexpr size_t WS_XN = 40 * MiB, WS_Q = 176 * MiB, WS_K = 240 * MiB, WS_V = 308 * MiB, WS_U = 376 * MiB, WS_G = 444 * MiB, WS_AO = 508 * MiB;
constexpr size_t WS_Y = (DBG ? 704 : 176) * MiB, WS_HID = 176 * MiB, WS_F = 528 * MiB, WS_VT8 = 636 * MiB, WS_PARK = 670 * MiB, WS_HS = 704 * MiB, WS_END = 832 * MiB;
static_assert(WS_SUM + (size_t)16 * 68 * 2 * 512 * 8 <= WS_XN && WS_XN + (size_t)MALL * DM * 2 <= WS_Q && WS_HID + (size_t)MLAT * FH * 2 <= WS_F, "d_ws map");
constexpr int CW_BAR = 1024;
constexpr int RING_BYTES = 131072, LDSCTL_OFF = RING_BYTES, MISC_OFF = LDSCTL_OFF + 320, ROPE_OFF = RING_BYTES + 1024, LDS_BYTES = 147456;
static_assert(att::LDS_END <= RING_BYTES && lru2::LDS_END <= RING_BYTES, "LDS map");

struct Frame {
    LAS unsigned char* lds; volatile LAS unsigned* MISC; gu32* ctl;
    int tid, lane, wave, vcu, G;
};
__device__ __forceinline__ float wave_sum(float v) {
#pragma unroll
    for (int o = 1; o < 64; o <<= 1) v += __shfl_xor(v, o);
    return v;
}
template <class DEST>
__device__ __forceinline__ void p0_transpose_item(const float* W, int K, int N, bf16* WT, LAS float* scr, int item, int lane, DEST dest) {
    const int nblk = N / 32, kb = item / nblk, nb = item % nblk, k0 = 64 * kb, n0 = 32 * nb;
#pragma unroll 8
    for (int i = 0; i < 32; ++i) { const int kk = 2 * i + (lane >> 5); scr[kk * 33 + (lane & 31)] = W[(size_t)(k0 + kk) * N + n0 + (lane & 31)]; }
    LDS_WAIT(); asm volatile("" ::: "memory");
    const int c = lane & 7;
#pragma unroll
    for (int j = 0; j < 4; ++j) { const int n = (lane >> 3) + 8 * j; const LAS float* s = scr + (8 * c) * 33 + n;
        v4u o; o.x = pk2(s[0 * 33], s[1 * 33]); o.y = pk2(s[2 * 33], s[3 * 33]); o.z = pk2(s[4 * 33], s[5 * 33]); o.w = pk2(s[6 * 33], s[7 * 33]);
        *(GAS v4u*)(WT + (size_t)dest(n0 + n) * K + k0 + 8 * c) = o; }
    LDS_WAIT(); asm volatile("" ::: "memory");
}
template <class DEST>
__device__ __forceinline__ void p0_transpose_item8(const float* W, int K, int N, unsigned char* WT, LAS float* scr, int item, int lane, DEST dest, float scale) {
    const int nblk = N / 32, kb = item / nblk, nb = item % nblk, k0 = 64 * kb, n0 = 32 * nb;
#pragma unroll 8
    for (int i = 0; i < 32; ++i) { const int kk = 2 * i + (lane >> 5); scr[kk * 33 + (lane & 31)] = W[(size_t)(k0 + kk) * N + n0 + (lane & 31)] * scale; }
    LDS_WAIT(); asm volatile("" ::: "memory");
    const int c = lane & 7; typedef unsigned u32x2v __attribute__((ext_vector_type(2)));
#pragma unroll
    for (int j = 0; j < 4; ++j) { const int n = (lane >> 3) + 8 * j; const LAS float* s = scr + (8 * c) * 33 + n;
        u32x2v o; o.x = pg8::pk_fp8x4(s[0 * 33], s[1 * 33], s[2 * 33], s[3 * 33]); o.y = pg8::pk_fp8x4(s[4 * 33], s[5 * 33], s[6 * 33], s[7 * 33]);
        *(GAS u32x2v*)(WT + (size_t)dest(n0 + n) * K + k0 + 8 * c) = o; }
    LDS_WAIT(); asm volatile("" ::: "memory");
}
struct DestId { __device__ __forceinline__ int operator()(int n) const { return n; } };
struct DestWin { __device__ __forceinline__ int operator()(int n) const {
    if (n >= 1536) return n - 512; if (n >= 1024) return n + 1024; const int d = n & 63; return (n & ~63) + (d & 32) + ((d >> 2) & 3) * 8 + ((d >> 4) & 1) * 4 + (d & 3); } };
struct DestW1 { __device__ __forceinline__ int operator()(int n) const { const int hb = n >= FH, l = hb ? n - FH : n; return (l >> 7) * 256 + hb * 128 + (l & 127); } };

__device__ __forceinline__ void p0_mod_task(int cgp, const float* c, const float* cctx, const float* w_ada, const float* b_ada, float* MOD, LAS unsigned char* lds, int tid, int wave, int lane) {
    LAS float* sc = (LAS float*)lds; LAS float* red = (LAS float*)(lds + 81920);
    for (int idx = tid; idx < 17 * 1024; idx += 512) { const int r = idx >> 10, k = idx & 1023; const float v = r < 16 ? c[r * 1024 + k] : cctx[k]; sc[k * 20 + r] = v / (1.f + __expf(-v)); }
    __syncthreads();
    float acc[17];
#pragma unroll
    for (int r = 0; r < 17; ++r) acc[r] = 0.f;
    const int n = 64 * cgp + lane;
#pragma unroll 16
    for (int kk = 0; kk < 128; ++kk) { const int k = wave * 128 + kk; const float wv = __builtin_nontemporal_load(w_ada + (size_t)k * 6144 + n);
        const LAS f32x4* sp = (const LAS f32x4*)(sc + k * 20); const f32x4 s0 = sp[0], s1 = sp[1], s2 = sp[2], s3 = sp[3]; const float s16 = sc[k * 20 + 16];
        acc[0] += s0.x * wv; acc[1] += s0.y * wv; acc[2] += s0.z * wv; acc[3] += s0.w * wv; acc[4] += s1.x * wv; acc[5] += s1.y * wv; acc[6] += s1.z * wv; acc[7] += s1.w * wv;
        acc[8] += s2.x * wv; acc[9] += s2.y * wv; acc[10] += s2.z * wv; acc[11] += s2.w * wv; acc[12] += s3.x * wv; acc[13] += s3.y * wv; acc[14] += s3.z * wv; acc[15] += s3.w * wv; acc[16] += s16 * wv; }
#pragma unroll
    for (int r = 0; r < 17; ++r) red[(wave * 17 + r) * 64 + lane] = acc[r];
    __syncthreads();
    for (int idx = tid; idx < 17 * 64; idx += 512) { const int r = idx >> 6, l = idx & 63; float s = b_ada[64 * cgp + l];
#pragma unroll
        for (int w2 = 0; w2 < 8; ++w2) s += red[(w2 * 17 + r) * 64 + l];
        MOD[r * 6144 + 64 * cgp + l] = s; }
    __syncthreads();
}
__device__ __forceinline__ void ln_stats(f32x4 (&v)[4], float& mean, float& rstd) {
    float s = 0.f;
#pragma unroll
    for (int j = 0; j < 4; ++j) s += (v[j].x + v[j].y) + (v[j].z + v[j].w);
    mean = wave_sum(s) * (1.f / DM); float s2 = 0.f;
#pragma unroll
    for (int j = 0; j < 4; ++j) { v[j] = v[j] - mean; s2 += (v[j].x * v[j].x + v[j].y * v[j].y) + (v[j].z * v[j].z + v[j].w * v[j].w); }
    rstd = 1.f / sqrtf(wave_sum(s2) * (1.f / DM) + LN_EPS);
}
__device__ __forceinline__ void st_bf16x4(bf16* p, f32x4 v) { *(GAS unsigned long long*)p = (unsigned long long)pk2(v.x, v.y) | ((unsigned long long)pk2(v.z, v.w) << 32); }
__device__ __forceinline__ f32x4 ld_bf16x4(const bf16* p) { const unsigned long long w = *(const GAS unsigned long long*)p; const unsigned lo = (unsigned)w, hi = (unsigned)(w >> 32);
    return (f32x4){__uint_as_float(lo << 16), __uint_as_float(lo & 0xffff0000u), __uint_as_float(hi << 16), __uint_as_float(hi & 0xffff0000u)}; }
__device__ __forceinline__ void ln_stats2(f32x4 (&v)[2][4], float (&mean)[2], float (&rstd)[2]) {
    float s[2];
#pragma unroll
    for (int q = 0; q < 2; ++q) { s[q] = 0.f;
#pragma unroll
        for (int j = 0; j < 4; ++j) s[q] += (v[q][j].x + v[q][j].y) + (v[q][j].z + v[q][j].w); }
#pragma unroll
    for (int o = 1; o < 64; o <<= 1) { s[0] += __shfl_xor(s[0], o); s[1] += __shfl_xor(s[1], o); }
    float s2[2];
#pragma unroll
    for (int q = 0; q < 2; ++q) { mean[q] = s[q] * (1.f / DM); s2[q] = 0.f;
#pragma unroll
        for (int j = 0; j < 4; ++j) { v[q][j] = v[q][j] - mean[q]; s2[q] += (v[q][j].x * v[q][j].x + v[q][j].y * v[q][j].y) + (v[q][j].z * v[q][j].z + v[q][j].w * v[q][j].w); } }
#pragma unroll
    for (int o = 1; o < 64; o <<= 1) { s2[0] += __shfl_xor(s2[0], o); s2[1] += __shfl_xor(s2[1], o); }
#pragma unroll
    for (int q = 0; q < 2; ++q) rstd[q] = 1.f / sqrtf(s2[q] * (1.f / DM) + LN_EPS);
}
__device__ __forceinline__ void row_hmod2(const float* const (&xrow)[2], const float* const (&md)[2], bf16* const (&orow)[2], int lane) {
    f32x4 v[2][4]; float mean[2], rstd[2];
#pragma unroll
    for (int q = 0; q < 2; ++q)
#pragma unroll
        for (int j = 0; j < 4; ++j) v[q][j] = __builtin_nontemporal_load((const GAS f32x4*)(xrow[q] + 4 * lane + 256 * j));
    ln_stats2(v, mean, rstd);
#pragma unroll
    for (int q = 0; q < 2; ++q)
#pragma unroll
        for (int j = 0; j < 4; ++j) { const int c = 4 * lane + 256 * j; const f32x4 a = *(const f32x4*)(md[q] + 1024 + c), s = *(const f32x4*)(md[q] + c); st_bf16x4(orow[q] + c, v[q][j] * rstd[q] * (a + 1.f) + s); }
}
__device__ __forceinline__ void row_ln1_2(const float* const (&xrow)[2], const bf16* const (&yrow)[2], const float* const (&md)[2], const float* lng, const float* lnb, float* const (&x1row)[2], bf16* const (&h2row)[2], int lane) {
    f32x4 v[2][4]; float mean[2], rstd[2];
#pragma unroll
    for (int q = 0; q < 2; ++q)
#pragma unroll
        for (int j = 0; j < 4; ++j) { const int c = 4 * lane + 256 * j; v[q][j] = __builtin_nontemporal_load((const GAS f32x4*)(xrow[q] + c)) * DN_ALPHA + *(const f32x4*)(md[q] + 2048 + c) * ld_bf16x4(yrow[q] + c); }
    ln_stats2(v, mean, rstd);
#pragma unroll
    for (int q = 0; q < 2; ++q)
#pragma unroll
        for (int j = 0; j < 4; ++j) { const int c = 4 * lane + 256 * j; v[q][j] = v[q][j] * rstd[q] * *(const f32x4*)(lng + c) + *(const f32x4*)(lnb + c); *(GAS f32x4*)(x1row[q] + c) = v[q][j]; }
    ln_stats2(v, mean, rstd);
#pragma unroll
    for (int q = 0; q < 2; ++q)
#pragma unroll
        for (int j = 0; j < 4; ++j) { const int c = 4 * lane + 256 * j; const f32x4 hv = v[q][j] * rstd[q] * (*(const f32x4*)(md[q] + 4096 + c) + 1.f) + *(const f32x4*)(md[q] + 3072 + c);
            if (F8_IN) *(GAS unsigned*)((unsigned char*)h2row[q] + c) = pg8::pk_fp8x4(hv.x, hv.y, hv.z, hv.w); else st_bf16x4(h2row[q] + c, hv); }
}
struct Ln1Raw { f32x4 x[2][4]; unsigned long long y[2][4]; };
__device__ __forceinline__ void ln1_load(Ln1Raw& r, const float* x, const bf16* Y, int m, int m2, int lane) {
#pragma unroll
    for (int j = 0; j < 4; ++j) { const int c = 4 * lane + 256 * j;
        r.x[0][j] = __builtin_nontemporal_load((const GAS f32x4*)(x + (size_t)m * DM + c)); r.x[1][j] = __builtin_nontemporal_load((const GAS f32x4*)(x + (size_t)m2 * DM + c));
        r.y[0][j] = *(const GAS unsigned long long*)(Y + (size_t)m * DM + c); r.y[1][j] = *(const GAS unsigned long long*)(Y + (size_t)m2 * DM + c); }
}
__device__ __forceinline__ f32x4 bf16x4_to_f32(unsigned long long w) { const unsigned lo = (unsigned)w, hi = (unsigned)(w >> 32);
    return (f32x4){__uint_as_float(lo << 16), __uint_as_float(lo & 0xffff0000u), __uint_as_float(hi << 16), __uint_as_float(hi & 0xffff0000u)}; }
__device__ __forceinline__ void ln1_process(const Ln1Raw& r, const float* const (&md)[2], const float* lng, const float* lnb, float* const (&x1row)[2], bf16* const (&h2row)[2], int lane) {
    f32x4 v[2][4]; float mean[2], rstd[2];
#pragma unroll
    for (int q = 0; q < 2; ++q)
#pragma unroll
        for (int j = 0; j < 4; ++j) { const int c = 4 * lane + 256 * j; v[q][j] = r.x[q][j] * DN_ALPHA + *(const f32x4*)(md[q] + 2048 + c) * bf16x4_to_f32(r.y[q][j]); }
    ln_stats2(v, mean, rstd);
#pragma unroll
    for (int q = 0; q < 2; ++q)
#pragma unroll
        for (int j = 0; j < 4; ++j) { const int c = 4 * lane + 256 * j; v[q][j] = v[q][j] * rstd[q] * *(const f32x4*)(lng + c) + *(const f32x4*)(lnb + c); if (X1_BF16) st_bf16x4((bf16*)x1row[q] + c, v[q][j]); else *(GAS f32x4*)(x1row[q] + c) = v[q][j]; }
    ln_stats2(v, mean, rstd);
#pragma unroll
    for (int q = 0; q < 2; ++q)
#pragma unroll
        for (int j = 0; j < 4; ++j) { const int c = 4 * lane + 256 * j; const f32x4 hv = v[q][j] * rstd[q] * (*(const f32x4*)(md[q] + 4096 + c) + 1.f) + *(const f32x4*)(md[q] + 3072 + c);
            if (F8_IN) *(GAS unsigned*)((unsigned char*)h2row[q] + c) = pg8::pk_fp8x4(hv.x, hv.y, hv.z, hv.w); else st_bf16x4(h2row[q] + c, hv); }
}
__device__ __forceinline__ void row_ln2_2(float* const (&orow)[2], const bf16* const (&x1b)[2], const bf16* const (&frow)[2], const float* const (&md)[2], const float* lng, const float* lnb, int lane) {
    f32x4 v[2][4]; float mean[2], rstd[2];
#pragma unroll
    for (int q = 0; q < 2; ++q)
#pragma unroll
        for (int j = 0; j < 4; ++j) { const int c = 4 * lane + 256 * j; v[q][j] = (X1_BF16 ? ld_bf16x4(x1b[q] + c) : *(const GAS f32x4*)(orow[q] + c)) * DN_ALPHA + *(const f32x4*)(md[q] + 5120 + c) * ld_bf16x4(frow[q] + c); }
    ln_stats2(v, mean, rstd);
#pragma unroll
    for (int q = 0; q < 2; ++q)
#pragma unroll
        for (int j = 0; j < 4; ++j) { const int c = 4 * lane + 256 * j; __builtin_nontemporal_store(v[q][j] * rstd[q] * *(const f32x4*)(lng + c) + *(const f32x4*)(lnb + c), (GAS f32x4*)(orow[q] + c)); }
}

struct Ln2Raw { f32x4 x[2][4]; unsigned long long xb[2][4]; unsigned long long f[2][4]; };
__device__ __forceinline__ void ln2_load(Ln2Raw& r, const float* x1f, const bf16* x1b, const bf16* Fm, int m, int m2, int lane) {
#pragma unroll
    for (int j = 0; j < 4; ++j) { const int c = 4 * lane + 256 * j;
        if (X1_BF16) { r.xb[0][j] = __builtin_nontemporal_load((const GAS unsigned long long*)(x1b + (size_t)m * DM + c)); r.xb[1][j] = __builtin_nontemporal_load((const GAS unsigned long long*)(x1b + (size_t)m2 * DM + c)); }
        else { r.x[0][j] = *(const GAS f32x4*)(x1f + (size_t)m * DM + c); r.x[1][j] = *(const GAS f32x4*)(x1f + (size_t)m2 * DM + c); }
        r.f[0][j] = __builtin_nontemporal_load((const GAS unsigned long long*)(Fm + (size_t)m * DM + c)); r.f[1][j] = __builtin_nontemporal_load((const GAS unsigned long long*)(Fm + (size_t)m2 * DM + c)); }
}
__device__ __forceinline__ void ln2_process(const Ln2Raw& r, float* const (&orow)[2], const float* const (&md)[2], const float* lng, const float* lnb, int lane) {
    f32x4 v[2][4]; float mean[2], rstd[2];
#pragma unroll
    for (int q = 0; q < 2; ++q)
#pragma unroll
        for (int j = 0; j < 4; ++j) { const int c = 4 * lane + 256 * j; v[q][j] = (X1_BF16 ? bf16x4_to_f32(r.xb[q][j]) : r.x[q][j]) * DN_ALPHA + *(const f32x4*)(md[q] + 5120 + c) * bf16x4_to_f32(r.f[q][j]); }
    ln_stats2(v, mean, rstd);
#pragma unroll
    for (int q = 0; q < 2; ++q)
#pragma unroll
        for (int j = 0; j < 4; ++j) { const int c = 4 * lane + 256 * j; __builtin_nontemporal_store(v[q][j] * rstd[q] * *(const f32x4*)(lng + c) + *(const f32x4*)(lnb + c), (GAS f32x4*)(orow[q] + c)); }
}
struct HmRaw { f32x4 x[2][4]; };
__device__ __forceinline__ void hm_load(HmRaw& r, const float* xa, const float* xb, int lane) {
#pragma unroll
    for (int j = 0; j < 4; ++j) { r.x[0][j] = __builtin_nontemporal_load((const GAS f32x4*)(xa + 4 * lane + 256 * j)); r.x[1][j] = __builtin_nontemporal_load((const GAS f32x4*)(xb + 4 * lane + 256 * j)); }
}
__device__ __forceinline__ void hm_process(const HmRaw& r, const float* const (&md)[2], bf16* const (&orow)[2], int lane) {
    f32x4 v[2][4]; float mean[2], rstd[2];
#pragma unroll
    for (int q = 0; q < 2; ++q)
#pragma unroll
        for (int j = 0; j < 4; ++j) v[q][j] = r.x[q][j];
    ln_stats2(v, mean, rstd);
#pragma unroll
    for (int q = 0; q < 2; ++q)
#pragma unroll
        for (int j = 0; j < 4; ++j) { const int c = 4 * lane + 256 * j; const f32x4 a = *(const f32x4*)(md[q] + 1024 + c), s2 = *(const f32x4*)(md[q] + c); st_bf16x4(orow[q] + c, v[q][j] * rstd[q] * (a + 1.f) + s2); }
}
__device__ __forceinline__ void ln1_process_l(const Ln1Raw& r, const LAS f32x4* pv, bf16* const (&x1row)[2], float* const (&x1rowf)[2], bf16* const (&h2row)[2], int lane) {
    f32x4 v[2][4]; float mean[2], rstd[2];
#pragma unroll
    for (int q = 0; q < 2; ++q)
#pragma unroll
        for (int j = 0; j < 4; ++j) v[q][j] = r.x[q][j] * DN_ALPHA + pv[lane + 64 * j] * bf16x4_to_f32(r.y[q][j]);
    ln_stats2(v, mean, rstd);
#pragma unroll
    for (int q = 0; q < 2; ++q)
#pragma unroll
        for (int j = 0; j < 4; ++j) { const int c = 4 * lane + 256 * j; v[q][j] = v[q][j] * rstd[q] * pv[768 + lane + 64 * j] + pv[1024 + lane + 64 * j]; if (X1_BF16) st_bf16x4(x1row[q] + c, v[q][j]); else *(GAS f32x4*)(x1rowf[q] + c) = v[q][j]; }
    ln_stats2(v, mean, rstd);
#pragma unroll
    for (int q = 0; q < 2; ++q)
#pragma unroll
        for (int j = 0; j < 4; ++j) { const int c = 4 * lane + 256 * j; const f32x4 hv = v[q][j] * rstd[q] * (pv[512 + lane + 64 * j] + 1.f) + pv[256 + lane + 64 * j];
            if (F8_IN) *(GAS unsigned*)((unsigned char*)h2row[q] + c) = pg8::pk_fp8x4(hv.x, hv.y, hv.z, hv.w); else st_bf16x4(h2row[q] + c, hv); }
}
__device__ __forceinline__ void ln2_process_l(const Ln2Raw& r, const LAS f32x4* pv, float* const (&orow)[2], int lane) {
    f32x4 v[2][4]; float mean[2], rstd[2];
#pragma unroll
    for (int q = 0; q < 2; ++q)
#pragma unroll
        for (int j = 0; j < 4; ++j) v[q][j] = (X1_BF16 ? bf16x4_to_f32(r.xb[q][j]) : r.x[q][j]) * DN_ALPHA + pv[lane + 64 * j] * bf16x4_to_f32(r.f[q][j]);
    ln_stats2(v, mean, rstd);
#pragma unroll
    for (int q = 0; q < 2; ++q)
#pragma unroll
        for (int j = 0; j < 4; ++j) { const int c = 4 * lane + 256 * j; __builtin_nontemporal_store(v[q][j] * rstd[q] * pv[256 + lane + 64 * j] + pv[512 + lane + 64 * j], (GAS f32x4*)(orow[q] + c)); }
}
__device__ __forceinline__ void hm_process_l(const HmRaw& r, const LAS f32x4* pv, bf16* const (&orow)[2], int lane) {
    f32x4 v[2][4]; float mean[2], rstd[2];
#pragma unroll
    for (int q = 0; q < 2; ++q)
#pragma unroll
        for (int j = 0; j < 4; ++j) v[q][j] = r.x[q][j];
    ln_stats2(v, mean, rstd);
#pragma unroll
    for (int q = 0; q < 2; ++q)
#pragma unroll
        for (int j = 0; j < 4; ++j) { const int c = 4 * lane + 256 * j; st_bf16x4(orow[q] + c, v[q][j] * rstd[q] * (pv[256 + lane + 64 * j] + 1.f) + pv[lane + 64 * j]); }
}
__device__ __forceinline__ void stage_vecs(LAS f32x4* pv, const float* const* src, int nv, int tid) {
    for (int i = tid; i < nv * 256; i += NWAVES * 64) pv[i] = *(const f32x4*)(src[i >> 8] + 4 * (i & 255));
    __syncthreads();
}
struct Args { const float* in[22]; float* out; unsigned char* ws; int ph_lo, ph_hi, li, pad; };
__global__ void __launch_bounds__(NWAVES * 64, 2) mk_fwd(Args args) {
    extern __shared__ __attribute__((aligned(16))) unsigned char lds[];
    Frame F;
    F.lds = (LAS unsigned char*)lds; F.MISC = (volatile LAS unsigned*)(F.lds + MISC_OFF);
    F.tid = threadIdx.x; F.lane = F.tid & 63; F.wave = __builtin_amdgcn_readfirstlane(F.tid >> 6);
    F.G = gridDim.x; { const int bx = blockIdx.x; F.vcu = (F.G % 8 == 0) ? (bx % 8) * (F.G / 8) + bx / 8 : bx; }
    unsigned char* ws = args.ws;
    F.ctl = (gu32*)(ws + WS_CTL);
    const float* x = args.in[0]; const float* cin = args.in[1]; const float* ctx = args.in[2]; const float* cctx = args.in[3];
    float* MOD = (float*)(ws + WS_MOD); float* ROPEC = (float*)(ws + WS_ROPEC); float* ROPES = (float*)(ws + WS_ROPES); float* SP8 = (float*)(ws + WS_SP8); float* LAMP = (float*)(ws + WS_LAM);
    bf16* WinT = (bf16*)(ws + WS_WIN); bf16* WoutT = (bf16*)(ws + WS_WOUT); bf16* W1T = (bf16*)(ws + WS_W1); bf16* W2T = (bf16*)(ws + WS_W2); bf16* WgT = (bf16*)(ws + WS_WG);
        bf16* XN = (bf16*)(ws + WS_XN); bf16* Qb = (bf16*)(ws + WS_Q); bf16* Kb = (bf16*)(ws + WS_K); bf16* Vb = (bf16*)(ws + WS_V); bf16* Ub = (bf16*)(ws + WS_U); bf16* Gb = (bf16*)(ws + WS_G);
    bf16* AO = (bf16*)(ws + WS_AO); bf16* Yb = (bf16*)(ws + WS_Y); bf16* HID = (bf16*)(ws + WS_HID); bf16* Fb = (bf16*)(ws + WS_F); bf16* X1B = (bf16*)(ws + WS_HS);
    for (int u = F.tid; u < (LDS_BYTES - LDSCTL_OFF) / 4; u += NWAVES * 64) ((LAS unsigned*)(F.lds + LDSCTL_OFF))[u] = 0u;
    __syncthreads();
    XcdBarrier bar; bar.bar = (unsigned*)(F.ctl + CW_BAR); bar.x = 0; bar.st = nullptr;
    if (N_LAUNCHES != PER_PHASE) bar = xcd_barrier_post((unsigned*)(F.ctl + CW_BAR), F.MISC + 8);
#define GRID_BAR() do { if (N_LAUNCHES != PER_PHASE) xcd_barrier(bar); } while (0)
    const int lo = args.ph_lo, hi = args.ph_hi;
#define IN(k) (lo <= (k) && (k) < hi)
#define BOTH(k) (IN(k) && IN((k) + 1))
    const int gw = F.vcu * NWAVES + F.wave, NGW = F.G * NWAVES;
    unsigned long long* TS = (unsigned long long*)(ws + WS_CTL + 40960);
#define STAMP(k) do { if (TSTAMP >= 0 && blockIdx.x == 0 && F.tid == 0) TS[k] = __builtin_amdgcn_s_memrealtime(); } while (0)
    STAMP(0);

    if (IN(0)) {
        for (int rep_ = 0; rep_ < 1 + ((REPEAT_MASK >> 0) & 1); ++rep_) {
        if ((int)blockIdx.x < 96) p0_mod_task((int)blockIdx.x, cin, cctx, args.in[4], args.in[5], MOD, F.lds, F.tid, F.wave, F.lane);
        if ((int)blockIdx.x == F.G - 1) {
            for (int i = F.tid; i < 1024; i += 512) { const int pos = i >> 4, f = i & 15; const float inv = powf(10000.f, -(float)f / 16.f); const float ang = (float)pos * inv; ROPEC[i] = cosf(ang); ROPES[i] = sinf(ang); }
            for (int i = F.tid; i < 1024; i += 512) { const float l = args.in[14][i]; const float sp = log1pf(expf(-fabsf(l))) + fmaxf(-l, 0.f); SP8[i] = 8.f * sp * 1.4426950408889634f; }
            if (F.tid == 0) { float a = 0.f, b2 = 0.f; for (int i = 0; i < 64; ++i) { a += args.in[7][i] * args.in[8][i]; b2 += args.in[7][64 + i] * args.in[8][64 + i]; } LAMP[0] = expf(a) - expf(b2) + 0.2f; }
        }
        LAS float* scr = (LAS float*)(F.lds + F.wave * 16384);
        constexpr int I_IN = (DM / 64) * (INW / 32), I_OUT = (DM / 64) * (DM / 32), I_1 = (DM / 64) * (2 * FH / 32), I_2 = (FH / 64) * (DM / 32), I_G = 32 * 2;
        constexpr int NITEMS = I_IN + I_OUT + I_1 + I_2 + I_G;
        const bool modwg = (int)blockIdx.x < 96 && F.G > 96;
        const int gw0 = modwg ? NITEMS : ((F.G > 96 ? (int)blockIdx.x - 96 : (int)blockIdx.x) * NWAVES + F.wave), ngw0 = (F.G > 96 ? F.G - 96 : F.G) * NWAVES;
        for (int it = gw0; it < NITEMS; it += ngw0) {
            int r = it;
            if (r < I_IN) { p0_transpose_item(args.in[6], DM, INW, WinT, scr, r, F.lane, DestWin{}); continue; } r -= I_IN;
            if (r < I_OUT) { p0_transpose_item(args.in[15], DM, DM, WoutT, scr, r, F.lane, DestId{}); continue; } r -= I_OUT;
            if (r < I_1) { if (F8_IN) p0_transpose_item8(args.in[18], DM, 2 * FH, (unsigned char*)W1T, scr, r, F.lane, DestW1{}, W1_SCALE); else p0_transpose_item(args.in[18], DM, 2 * FH, W1T, scr, r, F.lane, DestW1{}); continue; } r -= I_1;
            if (r < I_2) { if (F8_OUT) p0_transpose_item8(args.in[19], FH, DM, (unsigned char*)W2T, scr, r, F.lane, DestId{}, W2_SCALE); else p0_transpose_item(args.in[19], FH, DM, W2T, scr, r, F.lane, DestId{}); continue; } r -= I_2;
            { const int mat = r >> 1; p0_transpose_item(args.in[12] + (size_t)mat * 4096, 64, 64, WgT + (size_t)mat * 4096, scr, r & 1, F.lane, DestId{}); }
        }
        }
        if (BOTH(0)) GRID_BAR();
        STAMP(1);
    }
    if (IN(1)) {
        for (int rep_ = 0; rep_ < 1 + ((REPEAT_MASK >> 1) & 1); ++rep_) {
#define P1_XROW(mm) ((mm) < MLAT ? x + (size_t)(mm) * DM : ctx + (size_t)((mm) - MLAT) * DM)
        if (F.G == 256) {
            const int bq = gw >> 7, r0 = gw & 127; const float* mdp = MOD + bq * 6144;
            LAS f32x4* pv = (LAS f32x4*)F.lds; { const float* const src[2] = {mdp, mdp + 1024}; stage_vecs(pv, src, 2, F.tid); }
#define P1_ROW(k_) (bq * 4096 + r0 + 128 * (k_))
            { HmRaw cur; hm_load(cur, x + (size_t)P1_ROW(0) * DM, x + (size_t)P1_ROW(1) * DM, F.lane);
              for (int k = 0; k < 32; k += 2) { const int m = P1_ROW(k), m2 = P1_ROW(k + 1);
                HmRaw nxt; if (k + 2 < 32) hm_load(nxt, x + (size_t)P1_ROW(k + 2) * DM, x + (size_t)P1_ROW(k + 3) * DM, F.lane);
                bf16* const orow[2] = {XN + (size_t)m * DM, XN + (size_t)m2 * DM};
                hm_process_l(cur, pv, orow, F.lane);
                if (k + 2 < 32) cur = nxt; } }
#undef P1_ROW
            { const int m = MLAT + gw, m2 = m + NGW;
              HmRaw cur; hm_load(cur, P1_XROW(m), P1_XROW(m2), F.lane);
              const float* const md[2] = {MOD + 16 * 6144, MOD + 16 * 6144}; bf16* const orow[2] = {XN + (size_t)m * DM, XN + (size_t)m2 * DM};
              hm_process(cur, md, orow, F.lane); }
            __syncthreads();
        } else
        { HmRaw cur; hm_load(cur, P1_XROW(gw), P1_XROW(gw + NGW), F.lane);
          for (int m = gw; m < MALL; m += 2 * NGW) { const int m2 = m + NGW, mn = m + 2 * NGW;
            HmRaw nxt; if (mn < MALL) hm_load(nxt, P1_XROW(mn), P1_XROW(mn + NGW), F.lane);
            const float* const md[2] = {MOD + (m < MLAT ? (m >> 12) : 16) * 6144, MOD + (m2 < MLAT ? (m2 >> 12) : 16) * 6144};
            bf16* const orow[2] = {XN + (size_t)m * DM, XN + (size_t)m2 * DM};
            hm_process(cur, md, orow, F.lane);
            if (mn < MALL) cur = nxt; } }
#undef P1_XROW
        }
        if (BOTH(1)) GRID_BAR();
        STAMP(2);
    }
    if (IN(2)) {
        {
        LAS float* ropeL = (LAS float*)(F.lds + ROPE_OFF);
        for (int i = F.tid; i < 2048; i += NWAVES * 64) ropeL[i] = ROPEC[i];
        __syncthreads();
        { pg8::Gemm g{XN, WinT, MALL, INW, DM}; pg8::InProjOrder S; S.init(F.G, (int)blockIdx.x);
          pg8::EpiInProj E{Qb, Kb, Vb, Ub, Gb, (unsigned char*)(ws + WS_VT8), ropeL, ropeL + 1024};
          pg8::gemm_phase<pg8::EpiInProj, pg8::InProjOrder, true, true>(F.lds, g, S, E); }
        }
#if (REPEAT_MASK >> 2) & 1
        {
        LAS float* ropeL = (LAS float*)(F.lds + ROPE_OFF);
        for (int i = F.tid; i < 2048; i += NWAVES * 64) ropeL[i] = ROPEC[i];
        __syncthreads();
        { pg8::Gemm g{XN, WinT, MALL, INW, DM}; pg8::InProjOrder S; S.init(F.G, (int)blockIdx.x);
          pg8::EpiInProj E{Qb, Kb, Vb, Ub, Gb, (unsigned char*)(ws + WS_VT8), ropeL, ropeL + 1024};
          pg8::gemm_phase<pg8::EpiInProj, pg8::InProjOrder, true, true>(F.lds, g, S, E); }
        }
#endif
        if (BOTH(2)) GRID_BAR();
        STAMP(3);
    }
    if (IN(3)) {
        for (int rep_ = 0; rep_ < 1 + ((REPEAT_MASK >> 3) & 1); ++rep_) {
#ifndef SKIP_ATT
        const float lam = LAMP[0]; float* PARK = (float*)(ws + WS_PARK) + (size_t)blockIdx.x * att::PARK_FLOATS;
        const int xg = F.vcu >> 5, vl = F.vcu & 31;
        for (int ra_ = 0; ra_ < 1 + ((REPEAT_MASK >> 9) & 1); ++ra_)
        if (F.G == 256) {
            for (int i = 0; i < 4; ++i) { const int bh = xg * 8 + i * 2 + (vl >> 4), qb = vl & 15;
                att::attn_unit_safe(bh >> 2, bh & 3, qb, (const short*)Qb, (const short*)Kb, (const short*)Vb, (const unsigned char*)(ws + WS_VT8), (short*)AO, args.in[9], lam, PARK, (char*)lds, ATT_FORCE_FALLBACK != 0); }
        } else {
            for (int un = (int)blockIdx.x; un < 1024; un += F.G) { const int bh = un >> 4, qb = un & 15;
                att::attn_unit_safe(bh >> 2, bh & 3, qb, (const short*)Qb, (const short*)Kb, (const short*)Vb, (const unsigned char*)(ws + WS_VT8), (short*)AO, args.in[9], lam, PARK, (char*)lds, ATT_FORCE_FALLBACK != 0); }
        }
#endif
#ifndef SKIP_LRU1
        for (int rl_ = 0; rl_ < 1 + ((REPEAT_MASK >> 10) & 1); ++rl_)
        for (int un = F.vcu; un < 256; un += F.G)
            lru2::lru_unit(un >> 4, (un >> 1) & 7, un & 1, Ub, Gb, args.in[10], args.in[11], WgT, args.in[13], SP8, (float*)(ws + WS_HS), AO, F.lds);
#endif
        }
        if (BOTH(3)) GRID_BAR();
        STAMP(4);
    }
    if (IN(4)) { STAMP(5); }
    if (IN(5)) {
        {
        pg8::Gemm g{AO, WoutT, MLAT, DM, DM}; pg8::StaticOrder S; S.init(MLAT, DM, F.G, (int)blockIdx.x);
        pg8::EpiPlain E{Yb, DM, 1.f};
        pg8::gemm_phase<pg8::EpiPlain, pg8::StaticOrder, true, true>(F.lds, g, S, E);
        }
#if (REPEAT_MASK >> 5) & 1
        {
        pg8::Gemm g{AO, WoutT, MLAT, DM, DM}; pg8::StaticOrder S; S.init(MLAT, DM, F.G, (int)blockIdx.x);
        pg8::EpiPlain E{Yb, DM, 1.f};
        pg8::gemm_phase<pg8::EpiPlain, pg8::StaticOrder, true, true>(F.lds, g, S, E);
        }
#endif
        if (BOTH(5)) GRID_BAR();
        STAMP(6);
    }
    if (IN(6)) {
        for (int rep_ = 0; rep_ < 1 + ((REPEAT_MASK >> 6) & 1); ++rep_) {
        if (F.G == 256) {
            const int bq = gw >> 7, r0 = gw & 127; const float* mdp = MOD + bq * 6144;
            LAS f32x4* pv = (LAS f32x4*)F.lds; { const float* const src[5] = {mdp + 2048, mdp + 3072, mdp + 4096, args.in[16], args.in[17]}; stage_vecs(pv, src, 5, F.tid); }
#define P6_ROW(k_) (bq * 4096 + r0 + 128 * (k_))
            { Ln1Raw cur; ln1_load(cur, x, Yb, P6_ROW(0), P6_ROW(1), F.lane);
              for (int k = 0; k < 32; k += 2) { const int m = P6_ROW(k), m2 = P6_ROW(k + 1);
                Ln1Raw nxt; if (k + 2 < 32) ln1_load(nxt, x, Yb, P6_ROW(k + 2), P6_ROW(k + 3), F.lane);
                bf16* const x1r[2] = {X1B + (size_t)m * DM, X1B + (size_t)m2 * DM}; float* const x1f[2] = {args.out + (size_t)m * DM, args.out + (size_t)m2 * DM};
                bf16* const h2r[2] = {F8_IN ? (bf16*)((unsigned char*)XN + (size_t)m * DM) : XN + (size_t)m * DM, F8_IN ? (bf16*)((unsigned char*)XN + (size_t)m2 * DM) : XN + (size_t)m2 * DM};
                ln1_process_l(cur, pv, x1r, x1f, h2r, F.lane);
                if (k + 2 < 32) cur = nxt; } }
#undef P6_ROW
            __syncthreads();
        } else
        { Ln1Raw cur; ln1_load(cur, x, Yb, gw, gw + NGW, F.lane);
          for (int m = gw; m < MLAT; m += 2 * NGW) { const int m2 = m + NGW, mn = m + 2 * NGW;
            Ln1Raw nxt; if (mn < MLAT) ln1_load(nxt, x, Yb, mn, mn + NGW, F.lane);
            const float* const md[2] = {MOD + (m >> 12) * 6144, MOD + (m2 >> 12) * 6144};
            float* const x1r[2] = {X1_BF16 ? (float*)(X1B + (size_t)m * DM) : args.out + (size_t)m * DM, X1_BF16 ? (float*)(X1B + (size_t)m2 * DM) : args.out + (size_t)m2 * DM};
            bf16* const h2r[2] = {F8_IN ? (bf16*)((unsigned char*)XN + (size_t)m * DM) : XN + (size_t)m * DM, F8_IN ? (bf16*)((unsigned char*)XN + (size_t)m2 * DM) : XN + (size_t)m2 * DM};
            ln1_process(cur, md, args.in[16], args.in[17], x1r, h2r, F.lane);
            if (mn < MLAT) cur = nxt; } }
        }
        if (BOTH(6)) GRID_BAR();
        STAMP(7);
    }
    if (IN(7)) {
        {
        pg8::Gemm g{XN, W1T, MLAT, 2 * FH, F8_IN ? DM / 2 : DM}; pg8::StaticOrder S; S.init(MLAT, 2 * FH, F.G, (int)blockIdx.x);
        pg8::EpiSwiglu<F8_OUT> E{HID, FH, F8_IN ? 1.f / W1_SCALE : 1.f, F8_OUT ? HID_SCALE : 1.f};
        pg8::gemm_phase<pg8::EpiSwiglu<F8_OUT>, pg8::StaticOrder, true, true, F8_IN>(F.lds, g, S, E);
        }
#if (REPEAT_MASK >> 7) & 1
        {
        pg8::Gemm g{XN, W1T, MLAT, 2 * FH, F8_IN ? DM / 2 : DM}; pg8::StaticOrder S; S.init(MLAT, 2 * FH, F.G, (int)blockIdx.x);
        pg8::EpiSwiglu<F8_OUT> E{HID, FH, F8_IN ? 1.f / W1_SCALE : 1.f, F8_OUT ? HID_SCALE : 1.f};
        pg8::gemm_phase<pg8::EpiSwiglu<F8_OUT>, pg8::StaticOrder, true, true, F8_IN>(F.lds, g, S, E);
        }
#endif
        if (BOTH(7)) GRID_BAR();
        STAMP(8);
    }
    if (IN(8)) {
        {
        pg8::Gemm g{HID, W2T, MLAT, DM, F8_OUT ? FH / 2 : FH}; pg8::StaticOrder S; S.init(MLAT, DM, F.G, (int)blockIdx.x);
        pg8::EpiPlain E{Fb, DM, F8_OUT ? 1.f / (W2_SCALE * HID_SCALE) : 1.f};
        pg8::gemm_phase<pg8::EpiPlain, pg8::StaticOrder, true, true, F8_OUT>(F.lds, g, S, E);
        }
#if (REPEAT_MASK >> 8) & 1
        {
        pg8::Gemm g{HID, W2T, MLAT, DM, F8_OUT ? FH / 2 : FH}; pg8::StaticOrder S; S.init(MLAT, DM, F.G, (int)blockIdx.x);
        pg8::EpiPlain E{Fb, DM, F8_OUT ? 1.f / (W2_SCALE * HID_SCALE) : 1.f};
        pg8::gemm_phase<pg8::EpiPlain, pg8::StaticOrder, true, true, F8_OUT>(F.lds, g, S, E);
        }
#endif
        if (BOTH(8)) GRID_BAR();
        STAMP(9);
    }
    if (IN(9)) {
        if (F.G == 256) {
            const int bq = gw >> 7, r0 = gw & 127; const float* mdp = MOD + bq * 6144;
            LAS f32x4* pv = (LAS f32x4*)F.lds; { const float* const src[3] = {mdp + 5120, args.in[20], args.in[21]}; stage_vecs(pv, src, 3, F.tid); }
#define P9_ROW(k_) (bq * 4096 + r0 + 128 * (k_))
            { Ln2Raw cur; ln2_load(cur, args.out, X1B, Fb, P9_ROW(0), P9_ROW(1), F.lane);
              for (int k = 0; k < 32; k += 2) { const int m = P9_ROW(k), m2 = P9_ROW(k + 1);
                Ln2Raw nxt; if (k + 2 < 32) ln2_load(nxt, args.out, X1B, Fb, P9_ROW(k + 2), P9_ROW(k + 3), F.lane);
                float* const orow[2] = {args.out + (size_t)m * DM, args.out + (size_t)m2 * DM};
                ln2_process_l(cur, pv, orow, F.lane);
                if (k + 2 < 32) cur = nxt; } }
#undef P9_ROW
        } else
        { Ln2Raw cur; ln2_load(cur, args.out, X1B, Fb, gw, gw + NGW, F.lane);
          for (int m = gw; m < MLAT; m += 2 * NGW) { const int m2 = m + NGW, mn = m + 2 * NGW;
            Ln2Raw nxt; if (mn < MLAT) ln2_load(nxt, args.out, X1B, Fb, mn, mn + NGW, F.lane);
            float* const orow[2] = {args.out + (size_t)m * DM, args.out + (size_t)m2 * DM};
            const float* const md[2] = {MOD + (m >> 12) * 6144, MOD + (m2 >> 12) * 6144};
            ln2_process(cur, orow, md, args.in[20], args.in[21], F.lane);
            if (mn < MLAT) cur = nxt; } }
        STAMP(10);
        if (TSTAMP >= 0) {
            asm volatile("s_waitcnt vmcnt(0)" ::: "memory"); GRID_BAR();
            const unsigned long long t0 = __hip_atomic_load(TS + TSTAMP, __ATOMIC_RELAXED, __HIP_MEMORY_SCOPE_AGENT), t1 = __hip_atomic_load(TS + TSTAMP + 1, __ATOMIC_RELAXED, __HIP_MEMORY_SCOPE_AGENT);
            const float v = (float)(t1 - t0) * 0.01f / (TS_UNIT);
            for (int m = gw; m < MLAT; m += NGW) { GAS f32x4* o = (GAS f32x4*)(args.out + (size_t)m * DM) + F.lane;
#pragma unroll
                for (int j = 0; j < 4; ++j) o[64 * j] = (f32x4){v, v, v, v}; }
        }
    }
#undef IN
#undef BOTH
#undef GRID_BAR
}

#ifndef DBG
#define DBG 0
#endif
#if DBG
constexpr size_t WS_DBGTAB = 32 * 1024, WS_NAIVE = 832 * MiB;
static void dbg_run(void* const* d_in, float* out, unsigned char* ws, hipStream_t st) {
    float* tab = (float*)(ws + WS_DBGTAB);
    nv::Bufs B = nv::carve((char*)ws + WS_NAIVE);
    nv::run_common(d_in, B, st);
    dbg::cmp(st, tab, 1, ws + WS_MOD, 0, 0, 6144, 0, 0, 1.f, B.mod, 0, 6144, 0, 17, 6144);
    using namespace nv;
    for (int b = 0; b < 16; ++b) {
        const float* x = (const float*)d_in[0] + (size_t)b * S * D; const float* ctx = (const float*)d_in[2] + (size_t)b * CT * D;
        const float* mod = B.mod + b * 6144; const float* modc = B.mod + 16 * 6144;
        k_lnmod<<<S, 256, 0, st>>>(x, mod + 0, mod + 1024, B.h);
        k_lnmod<<<CT, 256, 0, st>>>(ctx, modc + 0, modc + 1024, B.h + (size_t)S * D);
        dbg::cmp(st, tab, 2, ws + WS_XN, 1, (size_t)65536 + b * 256, 1024, 0, 0, 1.f, B.h, 4096, 1024, 0, 256, 1024);
        k_gemm<<<dim3(nv::INW / 64, T / 64), 256, 0, st>>>(B.h, (const float*)d_in[6], B.p, T, nv::INW, D);
        k_rope<<<S * 512 / 256, 256, 0, st>>>(B.p);
        dbg::k_cmp_vt<<<(4352 * 512 + 255) / 256, 256, 0, st>>>((const unsigned short*)(ws + WS_V), b, B.p, nv::INW, 1024, tab + 2 * 3);
        dbg::cmp(st, tab, 4, ws + WS_U, 1, (size_t)b * 4096, 512, 0, 0, 1.f, B.p, 0, nv::INW, 1536, 4096, 512);
        dbg::cmp(st, tab, 4, ws + WS_U, 1, (size_t)65536 + b * 256, 512, 0, 0, 1.f, B.p, 4096, nv::INW, 1536, 256, 512);
        dbg::cmp(st, tab, 5, ws + WS_G, 1, (size_t)b * 4096, 512, 0, 0, 1.f, B.p, 0, nv::INW, 2048, 4096, 512);
        dbg::cmp(st, tab, 6, ws + WS_K, 1, (size_t)b * 4352 + 4096, 512, 0, 1, 1.f, B.p, 4096, nv::INW, 512, 256, 512);
        dbg::cmp(st, tab, 7, ws + WS_K, 1, (size_t)b * 4352, 512, 0, 1, 1.f, B.p, 0, nv::INW, 512, 4096, 512);
        dbg::cmp(st, tab, 8, ws + WS_Q, 1, (size_t)b * 4096, 512, 0, 1, 1.f / pg8::QK_C2, B.p, 0, nv::INW, 0, 4096, 512);
        k_attn_stats<<<dim3(S / 256, 4), 256, 0, st>>>(B.p, B.stats);
        k_attn_pv<<<dim3(S / 256, 16), 256, 0, st>>>(B.p, B.stats, B.lam, B.o);
        k_headnorm<<<S * 4 / 256, 256, 0, st>>>(B.o, (const float*)d_in[9], B.ao);
        dbg::cmp(st, tab, 9, ws + WS_AO, 1, (size_t)b * 4096, 1024, 0, 0, 1.f, B.ao, 0, 1024, 0, 4096, 512);
        k_conv<<<S * 512 / 256, 256, 0, st>>>(B.p, 0, S, (const float*)d_in[10], (const float*)d_in[11], B.uc);
        k_conv<<<CT * 512 / 256, 256, 0, st>>>(B.p, S, CT, (const float*)d_in[10], (const float*)d_in[11], B.uc);
        k_gates<<<2 * T * 512 / 256, 256, 0, st>>>(B.uc, (const float*)d_in[12], (const float*)d_in[13], (const float*)d_in[14], B.av, B.bv);
        k_scan<<<4, 256, 0, st>>>(B.av, B.bv, B.hs);
        k_ylru<<<S * 512 / 256, 256, 0, st>>>(B.hs, B.p, B.ao);
        dbg::cmp(st, tab, 10, ws + WS_AO, 1, (size_t)b * 4096, 1024, 512, 0, 1.f, B.ao, 0, 1024, 512, 4096, 512);
        k_gemm<<<dim3(D / 64, S / 64), 256, 0, st>>>(B.ao, (const float*)d_in[15], B.y, S, D, D);
        dbg::cmp(st, tab, 11, ws + WS_Y, 1, (size_t)b * 4096, 1024, 0, 0, 1.f, B.y, 0, 1024, 0, 4096, 1024);
        k_lnres<<<S, 256, 0, st>>>(x, B.y, mod + 2048, (const float*)d_in[16], (const float*)d_in[17], B.x1);
        dbg::cmp(st, tab, 12, out, 0, (size_t)b * 4096, 1024, 0, 0, 1.f, B.x1, 0, 1024, 0, 4096, 1024);
        k_lnmod<<<S, 256, 0, st>>>(B.x1, mod + 3072, mod + 4096, B.h2);
        dbg::cmp(st, tab, 13, ws + WS_XN, 1, (size_t)b * 4096, 1024, 0, 0, 1.f, B.h2, 0, 1024, 0, 4096, 1024);
    }
}
#endif
extern "C" void kernel_launch(void* const* d_in, const int* in_sizes, int n_in, void* d_out, int out_size, void* d_ws, size_t ws_size, hipStream_t stream) {
    static int grid = 0;
    if (grid == 0) {
        if (n_in != 22 || out_size != MLAT * DM || ws_size < (DBG ? (size_t)1012 * MiB : WS_END)) { fprintf(stderr, "kernel_launch: unexpected shapes / workspace (n_in %d out %d ws %zu)\n", n_in, out_size, ws_size); grid = -1; return; }
        int dev = 0, cus = 0, per_cu = 0;
        if (hipGetDevice(&dev) != hipSuccess || hipDeviceGetAttribute(&cus, hipDeviceAttributeMultiprocessorCount, dev) != hipSuccess) { grid = -1; return; }
        if (hipFuncSetAttribute((const void*)mk_fwd, hipFuncAttributeMaxDynamicSharedMemorySize, LDS_BYTES) != hipSuccess) { fprintf(stderr, "kernel_launch: hipFuncSetAttribute failed\n"); grid = -1; return; }
        if (hipOccupancyMaxActiveBlocksPerMultiprocessor(&per_cu, (const void*)mk_fwd, NWAVES * 64, LDS_BYTES) != hipSuccess || per_cu < 1) { fprintf(stderr, "kernel_launch: occupancy query says %d blocks/CU; nothing launched\n", per_cu); (void)hipGetLastError(); grid = -1; return; }
        grid = cus;
    }
    if (grid < 0) return;
    (void)hipMemsetAsync((char*)d_ws + WS_CTL, 0, CTL_ZERO_BYTES, stream);
    Args a{};
    for (int i = 0; i < 22; ++i) a.in[i] = (const float*)d_in[i];
    a.out = (float*)d_out; a.ws = (unsigned char*)d_ws;
#if DBG
    if (N_LAUNCHES == PER_PHASE) { for (int li = 0; li < 7; ++li) { a.ph_lo = li; a.ph_hi = li + 1; a.li = 0; hipLaunchKernelGGL(mk_fwd, dim3(grid), dim3(NWAVES * 64), LDS_BYTES, stream, a); } }
    else { a.ph_lo = 0; a.ph_hi = 7; a.li = 0; hipLaunchKernelGGL(mk_fwd, dim3(grid), dim3(NWAVES * 64), LDS_BYTES, stream, a); }
    dbg_run(d_in, (float*)d_out, (unsigned char*)d_ws, stream);
    if (N_LAUNCHES == PER_PHASE) { for (int li = 7; li < PER_PHASE; ++li) { a.ph_lo = li; a.ph_hi = li + 1; a.li = 0; hipLaunchKernelGGL(mk_fwd, dim3(grid), dim3(NWAVES * 64), LDS_BYTES, stream, a); } }
    else { a.ph_lo = 7; a.ph_hi = PER_PHASE; a.li = 1; hipLaunchKernelGGL(mk_fwd, dim3(grid), dim3(NWAVES * 64), LDS_BYTES, stream, a); }
    dbg::k_verdict<<<(unsigned)(((size_t)MLAT * DM + 255) / 256), 256, 0, stream>>>((const float*)((unsigned char*)d_ws + WS_DBGTAB), (float*)d_out, (size_t)MLAT * DM);
#else
    if (N_LAUNCHES == PER_PHASE) { for (int li = 0; li < PER_PHASE; ++li) { a.ph_lo = li; a.ph_hi = li + 1; a.li = 0; hipLaunchKernelGGL(mk_fwd, dim3(grid), dim3(NWAVES * 64), LDS_BYTES, stream, a); } }
    else { a.ph_lo = 0; a.ph_hi = PER_PHASE; a.li = 0; hipLaunchKernelGGL(mk_fwd, dim3(grid), dim3(NWAVES * 64), LDS_BYTES, stream, a); }
#endif
    const hipError_t le = hipPeekAtLastError();
    if (le != hipSuccess) fprintf(stderr, "kernel_launch: launch failed: %s\n", hipGetErrorName(le));
}
```

```cpp
#include <hip/hip_runtime.h>
#include <hip/hip_bf16.h>
#include <cstdio>
#include <cstdint>
#include <cmath>
#define DBG 0
#define MK_N_LAUNCHES 1
#define FP8_FFN 2

namespace pg8 {
#define PG8_LAS __attribute__((address_space(3)))
typedef unsigned short bf16_t;
typedef short bf16x8 __attribute__((ext_vector_type(8)));
typedef float f32x4 __attribute__((ext_vector_type(4)));
typedef unsigned u32x4 __attribute__((ext_vector_type(4)));
constexpr int BM = 256, BK = 64, HALF = 128, HTB = HALF * BK * 2  , STAGE_BYTES = 8 * HTB, NXCD = 8, WGM = 8;

__host__ __device__ __forceinline__ int lds_byte(int r, int c) { const int st = (r >> 4) * 2 + (c >> 5), rr = r & 15, cc = c & 31, ob = rr * 64 + cc * 2; return st * 1024 + (ob ^ (((ob >> 9) & 1) << 5)); }
__host__ __device__ __forceinline__ void stage_rc(int b, int& R, int& C) { const int st = b / 1024, sb = b % 1024, swz = sb ^ (((sb >> 9) & 1) << 5); R = (st >> 1) * 16 + swz / 64; C = (st & 1) * 32 + (swz % 64) / 2; }
__host__ __device__ __forceinline__ int perm32(int rho) { const int n = rho >> 4, i = rho & 15; return 8 * (i >> 2) + 4 * n + (i & 3); }

struct Unit { int pm, pn; };
struct Gemm { const bf16_t* A; const bf16_t* Bt; int M, N, K; };

struct StaticOrder {
    int nM, nN, nwg, G, c;
    __host__ __device__ void init(int M, int N, int G_, int c_) { nM = M / BM; nN = N / BM; nwg = nM * nN; G = G_; c = c_; }
    __host__ __device__ bool next(int i, Unit& u) const {
        const long L = (long)i * G + c; if (L >= nwg) return false;
        int wgid = (int)L; { const int q = nwg / NXCD, r = nwg % NXCD, xcd = wgid % NXCD, off = wgid / NXCD; wgid = (xcd < r ? xcd * (q + 1) : r * (q + 1) + (xcd - r) * q) + off; }
        const int nig = WGM * nN, gid = wgid / nig, fm = gid * WGM, gsz = (nM - fm) < WGM ? (nM - fm) : WGM;
        u.pm = fm + ((wgid % nig) % gsz); u.pn = (wgid % nig) / gsz; return true;
    }
    __device__ __forceinline__ void a_ready(const Unit&) const {}
    __device__ __forceinline__ void done(const Unit&) const {}
    __device__ __forceinline__ void ab(const Unit& u, const Gemm& g, size_t tstep, const char*& pa, const char*& pb) const { pa = (const char*)g.A + (size_t)u.pm * tstep; pb = (const char*)g.Bt + (size_t)u.pn * tstep; }
};

__device__ __forceinline__ unsigned cvt_pk_bf16(float lo, float hi) { unsigned r; asm volatile("v_cvt_pk_bf16_f32 %0, %1, %2" : "=v"(r) : "v"(lo), "v"(hi)); return r; }
typedef float f32x2 __attribute__((ext_vector_type(2)));
__device__ __forceinline__ f32x2 gelu_pk(f32x2 v) {
    const f32x2 av = __builtin_elementwise_abs(v), d = av * 0.2316418882f + 1.0f;
    f32x2 t; t.x = __builtin_amdgcn_rcpf(d.x); t.y = __builtin_amdgcn_rcpf(d.y);
    f32x2 q = t * 0.5307027145f + (-0.7265760135f); q = q * t + 0.7107068705f; q = q * t + (-0.142248368f); q = q * t + 0.127414796f; q = q * t;
    const f32x2 s = (v * v) * (-0.72134752044f);
    f32x2 e; e.x = __builtin_amdgcn_exp2f(s.x); e.y = __builtin_amdgcn_exp2f(s.y);
    const f32x2 m = v * (q * e), r = v - m;
    f32x2 o; o.x = v.x < 0.f ? m.x : r.x; o.y = v.y < 0.f ? m.y : r.y; return o;
}

template <int ACT  > struct EpiBf16 {
    static constexpr bool PERM = true, AFTER_DRAIN = false; static_assert(ACT == 0 || ACT == 1, "EpiBf16: ACT is 0 (none) or 1 (gelu_pk)");
    bf16_t* O; int ldc; const float* bias; int split_cols; size_t split_stride; float scale0;
    __device__ __forceinline__ void operator()(const f32x4 (&acc)[2][2][4][2], const Unit& u, int wr, int wc, int fr, int fq) const {
        const int row0 = u.pm * BM + wr * 64 + fr; int colt = u.pn * BM; bf16_t* base = O;
        float sc = 1.f; if (split_cols) { const int t = colt / split_cols; base += (size_t)t * split_stride; colt -= t * split_cols; if (t == 0) sc = scale0; }
        const int col0 = colt + wc * 32 + 8 * fq, bcol0 = u.pn * BM + wc * 32 + 8 * fq;
        f32x4 bv[2][2];
#pragma unroll
        for (int bj = 0; bj < 2; ++bj)
#pragma unroll
            for (int n = 0; n < 2; ++n) bv[bj][n] = bias ? *(const f32x4*)(bias + bcol0 + bj * HALF + 4 * n) : (f32x4){0.f, 0.f, 0.f, 0.f};
#pragma unroll
        for (int ai = 0; ai < 2; ++ai)
#pragma unroll
            for (int m = 0; m < 4; ++m) { bf16_t* rowp = base + (size_t)(row0 + ai * HALF + m * 16) * ldc + col0;
#pragma unroll
                for (int bj = 0; bj < 2; ++bj) { f32x4 v0 = acc[ai][bj][m][0] + bv[bj][0], v1 = acc[ai][bj][m][1] + bv[bj][1];
                    if (ACT == 1) { f32x2 a = gelu_pk((f32x2){v0[0], v0[1]}), b = gelu_pk((f32x2){v0[2], v0[3]}), c = gelu_pk((f32x2){v1[0], v1[1]}), d = gelu_pk((f32x2){v1[2], v1[3]});
                        v0 = (f32x4){a.x, a.y, b.x, b.y}; v1 = (f32x4){c.x, c.y, d.x, d.y}; }
                    v0 = v0 * sc; v1 = v1 * sc; u32x4 w; w.x = cvt_pk_bf16(v0[0], v0[1]); w.y = cvt_pk_bf16(v0[2], v0[3]); w.z = cvt_pk_bf16(v1[0], v1[1]); w.w = cvt_pk_bf16(v1[2], v1[3]);
                    *(u32x4*)(rowp + bj * HALF) = w; } }
    }
};

struct PanelStats {
    unsigned* xbuf;
    unsigned* cnt;
    unsigned* tmo;
    int ntn; float eps;
    unsigned code;
    __device__ __forceinline__ bool run(const f32x4 (&v)[2][2][4][2], const Unit& u, int wr, int wc, int fr, int fq, PG8_LAS unsigned char* lds, int wid, int lane) const {
        typedef float f32x2v __attribute__((ext_vector_type(2)));
        PG8_LAS f32x2v* P = (PG8_LAS f32x2v*)lds;
        PG8_LAS f32x2v* S = (PG8_LAS f32x2v*)(lds + 8192);
        PG8_LAS unsigned* flag = (PG8_LAS unsigned*)(lds + 8192 + 2048);
#pragma unroll
        for (int ai = 0; ai < 2; ++ai)
#pragma unroll
            for (int m = 0; m < 4; ++m) {
                float s = 0.f;
#pragma unroll
                for (int bj = 0; bj < 2; ++bj)
#pragma unroll
                    for (int n = 0; n < 2; ++n) { const f32x4 x = v[ai][bj][m][n]; s += (x[0] + x[1]) + (x[2] + x[3]); }
                s += __shfl_xor(s, 16); s += __shfl_xor(s, 32);
                const float mw = s * (1.0f / 64.0f); float q = 0.f;
#pragma unroll
                for (int bj = 0; bj < 2; ++bj)
#pragma unroll
                    for (int n = 0; n < 2; ++n) { const f32x4 d = v[ai][bj][m][n] - mw; q += (d[0] * d[0] + d[1] * d[1]) + (d[2] * d[2] + d[3] * d[3]); }
                q += __shfl_xor(q, 16); q += __shfl_xor(q, 32);
                if (fq == 0) P[(ai * HALF + wr * 64 + m * 16 + fr) * 4 + wc] = (f32x2v){mw, q};
            }
        asm volatile("s_waitcnt lgkmcnt(0)" ::: "memory"); __builtin_amdgcn_s_barrier(); asm volatile("" ::: "memory");
#if defined(BROKEN_EXCHANGE_NO_WAIT)
#warning BROKEN CONTROL BUILD: the row-statistics exchange does not wait; results are wrong by design
        if (blockIdx.x >= 64) { const long long t0_ = clock64(); while (clock64() - t0_ < 60000) __builtin_amdgcn_s_sleep(8); }
#endif
        const int row = wid * 32 + (lane & 31);
        if (lane < 32) {
            const f32x2v a = P[row * 4 + 0], b = P[row * 4 + 1], c = P[row * 4 + 2], d = P[row * 4 + 3];
            const float mt = (a.x + b.x + c.x + d.x) * 0.25f;
            const float da = a.x - mt, db = b.x - mt, dc = c.x - mt, dd = d.x - mt;
            const float m2 = (a.y + b.y) + (c.y + d.y) + 64.0f * ((da * da + db * db) + (dc * dc + dd * dd));
            unsigned long long* slot = (unsigned long long*)xbuf + ((size_t)(u.pm * BM + row) * 4 + u.pn);
            __hip_atomic_store(slot, ((unsigned long long)__float_as_uint(m2) << 32) | __float_as_uint(mt), __ATOMIC_RELAXED, __HIP_MEMORY_SCOPE_AGENT);
        }
        asm volatile("s_waitcnt vmcnt(0)" ::: "memory");
        if (lane == 0) __hip_atomic_fetch_add(cnt + 64 * u.pm, 1u, __ATOMIC_RELAXED, __HIP_MEMORY_SCOPE_AGENT);
        if (wid == 0) {
            bool dead = false; const unsigned long long t0 = __builtin_amdgcn_s_memrealtime(); const unsigned want = 8u * (unsigned)ntn;
            for (;;) {
#if defined(BROKEN_EXCHANGE_NO_WAIT)
                break;
#endif
                if ((unsigned)__builtin_amdgcn_readfirstlane(__hip_atomic_load(cnt + 64 * u.pm, __ATOMIC_RELAXED, __HIP_MEMORY_SCOPE_AGENT)) >= want) break;
                if (__builtin_amdgcn_s_memrealtime() - t0 > 2000000ull) {
                    if (lane == 0) { unsigned expect = 0u; __hip_atomic_compare_exchange_strong(tmo + 1, &expect, code | (unsigned)(u.pm & 0xff), __ATOMIC_RELAXED, __ATOMIC_RELAXED, __HIP_MEMORY_SCOPE_AGENT);
                                     __hip_atomic_store(tmo, 1u, __ATOMIC_RELAXED, __HIP_MEMORY_SCOPE_AGENT); }
                    dead = true; break; }
                __builtin_amdgcn_s_sleep(2);
            }
            __builtin_amdgcn_fence(__ATOMIC_ACQUIRE, "agent");
            if (lane == 0) flag[0] = dead ? 1u : 0u;
        }
        asm volatile("s_waitcnt vmcnt(0) lgkmcnt(0)" ::: "memory"); __builtin_amdgcn_s_barrier(); asm volatile("" ::: "memory");
        const bool bad = flag[0] != 0u;
        if (lane < 32) {
            const unsigned long long* slot = (const unsigned long long*)xbuf + (size_t)(u.pm * BM + row) * 4; float mt[4], m2[4]; float ms = 0.f;
#pragma unroll
            for (int t = 0; t < 4; ++t) { if (t < ntn) { const unsigned long long w = __hip_atomic_load(slot + t, __ATOMIC_RELAXED, __HIP_MEMORY_SCOPE_AGENT); mt[t] = __uint_as_float((unsigned)w); m2[t] = __uint_as_float((unsigned)(w >> 32)); } else { mt[t] = 0.f; m2[t] = 0.f; } ms += mt[t]; }
            const float mean = ms / (float)ntn; float q = 0.f;
#pragma unroll
            for (int t = 0; t < 4; ++t) if (t < ntn) { const float dm = mt[t] - mean; q += m2[t] + 256.0f * dm * dm; }
            S[row] = (f32x2v){mean, 1.0f / sqrtf(q / (256.0f * (float)ntn) + eps)};
        }
        asm volatile("s_waitcnt lgkmcnt(0)" ::: "memory"); __builtin_amdgcn_s_barrier(); asm volatile("" ::: "memory");
        return bad;
    }
};
struct EpiLnRes {
    static constexpr bool PERM = false, AFTER_DRAIN = true;
    const float* base; float* out; int ldc; const float* bias; PanelStats st; unsigned poison;
    __device__ __forceinline__ void fused(f32x4 (&acc)[2][2][4][2], const Unit& u, int wr, int wc, int fr, int fq, PG8_LAS unsigned char* lds, int wid, int lane) const {
        typedef float f32x2v __attribute__((ext_vector_type(2)));
        const PG8_LAS f32x2v* S = (const PG8_LAS f32x2v*)(lds + 8192);
        const int col0 = u.pn * BM + wc * 32 + 4 * fq;
#pragma unroll
        for (int bj = 0; bj < 2; ++bj)
#pragma unroll
            for (int n = 0; n < 2; ++n) { const f32x4 bv = bias ? *(const f32x4*)(bias + col0 + bj * HALF + n * 16) : (f32x4){0.f, 0.f, 0.f, 0.f};
#pragma unroll
                for (int ai = 0; ai < 2; ++ai)
#pragma unroll
                    for (int m = 0; m < 4; ++m) acc[ai][bj][m][n] += bv; }
        f32x4 pre[4][2][2];
#pragma unroll
        for (int m = 0; m < 4; ++m) { const size_t off = (size_t)(u.pm * BM + wr * 64 + m * 16 + fr) * ldc + col0;
#pragma unroll
            for (int bj = 0; bj < 2; ++bj)
#pragma unroll
                for (int n = 0; n < 2; ++n) pre[m][bj][n] = *(const f32x4*)(base + off + bj * HALF + n * 16); }
        const bool bad = st.run(acc, u, wr, wc, fr, fq, lds, wid, lane) || poison != 0u;
        const float qnan = __builtin_nanf("");
#pragma unroll
        for (int ai = 0; ai < 2; ++ai)
#pragma unroll
            for (int m = 0; m < 4; ++m) { const int r = ai * HALF + wr * 64 + m * 16 + fr; const f32x2v sr = S[r]; const size_t off = (size_t)(u.pm * BM + r) * ldc + col0;
#pragma unroll
                for (int bj = 0; bj < 2; ++bj)
#pragma unroll
                    for (int n = 0; n < 2; ++n) { const f32x4 bs = ai == 0 ? pre[m][bj][n] : *(const f32x4*)(base + off + bj * HALF + n * 16); f32x4 o = bs + (acc[ai][bj][m][n] - sr.x) * sr.y;
                        if (bad) o = (f32x4){qnan, qnan, qnan, qnan}; *(f32x4*)(out + off + bj * HALF + n * 16) = o; }
                if (m & 1) asm volatile("" ::: "memory"); }
    }
};
struct EpiLnResLn {
    static constexpr bool PERM = false, AFTER_DRAIN = true;
    const float* base; float* out; bf16_t* xn; int ldc; const float* bias; PanelStats st1, st2; unsigned poison;
    __device__ __forceinline__ void fused(f32x4 (&acc)[2][2][4][2], const Unit& u, int wr, int wc, int fr, int fq, PG8_LAS unsigned char* lds, int wid, int lane) const {
        typedef float f32x2v __attribute__((ext_vector_type(2))); typedef unsigned u32x2v __attribute__((ext_vector_type(2)));
        const PG8_LAS f32x2v* S = (const PG8_LAS f32x2v*)(lds + 8192);
        const int col0 = u.pn * BM + wc * 32 + 4 * fq;
#pragma unroll
        for (int bj = 0; bj < 2; ++bj)
#pragma unroll
            for (int n = 0; n < 2; ++n) { const f32x4 bv = bias ? *(const f32x4*)(bias + col0 + bj * HALF + n * 16) : (f32x4){0.f, 0.f, 0.f, 0.f};
#pragma unroll
                for (int ai = 0; ai < 2; ++ai)
#pragma unroll
                    for (int m = 0; m < 4; ++m) acc[ai][bj][m][n] += bv; }
        bool bad = st1.run(acc, u, wr, wc, fr, fq, lds, wid, lane) || poison != 0u;
        const float qnan = __builtin_nanf("");
#pragma unroll
        for (int ai = 0; ai < 2; ++ai)
#pragma unroll
            for (int m = 0; m < 4; ++m) { const int r = ai * HALF + wr * 64 + m * 16 + fr; const f32x2v sr = S[r]; const size_t off = (size_t)(u.pm * BM + r) * ldc + col0;
#pragma unroll
                for (int bj = 0; bj < 2; ++bj)
#pragma unroll
                    for (int n = 0; n < 2; ++n) { const f32x4 bs = *(const f32x4*)(base + off + bj * HALF + n * 16); acc[ai][bj][m][n] = bs + (acc[ai][bj][m][n] - sr.x) * sr.y; }
                asm volatile("" : "+v"(acc[ai][0][m][0]), "+v"(acc[ai][0][m][1]), "+v"(acc[ai][1][m][0]), "+v"(acc[ai][1][m][1]));
                if (m & 1) asm volatile("" ::: "memory"); }
        const bool bad1 = bad;
        bad = st2.run(acc, u, wr, wc, fr, fq, lds, wid, lane) || bad;
#pragma unroll
        for (int ai = 0; ai < 2; ++ai)
#pragma unroll
            for (int m = 0; m < 4; ++m) { const int r = ai * HALF + wr * 64 + m * 16 + fr; const f32x2v sr = S[r]; const size_t off = (size_t)(u.pm * BM + r) * ldc + col0;
#pragma unroll
                for (int bj = 0; bj < 2; ++bj)
#pragma unroll
                    for (int n = 0; n < 2; ++n) { const f32x4 x1 = acc[ai][bj][m][n]; *(f32x4*)(out + off + bj * HALF + n * 16) = bad1 ? (f32x4){qnan, qnan, qnan, qnan} : x1;
                        const f32x4 o = (x1 - sr.x) * sr.y; u32x2v w; w.x = cvt_pk_bf16(o[0], o[1]); w.y = cvt_pk_bf16(o[2], o[3]);
                        if (bad) { w.x = 0x7fc07fc0u; w.y = 0x7fc07fc0u; } *(u32x2v*)(xn + off + bj * HALF + n * 16) = w; }
                asm volatile("" ::: "memory"); }
    }
};

typedef int i32x8 __attribute__((ext_vector_type(8)));
typedef int i32x4 __attribute__((ext_vector_type(4)));
template <class Epi, class Sched, bool ALIGN_EPI = false, bool SP2 = false, bool F8 = false>
__device__ __forceinline__ void gemm_phase(PG8_LAS unsigned char* lds, const Gemm g, const Sched& S, const Epi& E) {
    const int tid = threadIdx.x, wid = __builtin_amdgcn_readfirstlane(tid >> 6), lane = tid & 63, wr = wid >> 2, wc = wid & 3, fr = lane & 15, fq = lane >> 4;
    const int K = g.K, nt = K / BK;
    unsigned voffA[2], voffB[2];
#pragma unroll
    for (int i = 0; i < 2; ++i) { int R, C; stage_rc(tid * 16 + i * 8192, R, C); const int Rb = Epi::PERM ? ((R & ~31) + perm32(R & 31)) : R;
        voffA[i] = (unsigned)(R * K + C) * 2u; voffB[i] = (unsigned)(Rb * K + C) * 2u; }
    const size_t kstep = (size_t)(BK * 2);
    const size_t hstep = (size_t)HALF * K * 2;
    const size_t tstep = 2 * hstep;
    const unsigned ldsw = (unsigned)wid * 1024u;
    const int aoff = lds_byte(wr * 64 + fr, F8 ? fq * 16 : fq * 8), boff = lds_byte(wc * 32 + fr, F8 ? fq * 16 : fq * 8);
#define PG8_SA(b, h) (((b) * 2 + (h)) * HTB)
#define PG8_SB(b, h) ((4 + (b) * 2 + (h)) * HTB)
#define PG8_STAGE(bufoff, gbase, voff) do { _Pragma("unroll") for (int _i = 0; _i < 2; ++_i) \
        __builtin_amdgcn_global_load_lds((const unsigned*)((const char*)(gbase) + (voff)[_i]), (PG8_LAS unsigned*)(lds + (bufoff) + ldsw + _i * 8192), 16, 0, 0); } while (0)
#define PG8_LD32(p) __builtin_shufflevector(*(const PG8_LAS i32x4*)((p) + f8o1), *(const PG8_LAS i32x4*)((p) + f8o2), 0, 1, 2, 3, 4, 5, 6, 7)
#define PG8_LDA(dst, b, h) do { if constexpr (F8) { _Pragma("unroll") for (int m = 0; m < 4; ++m) dst##8[m] = PG8_LD32(lds + PG8_SA(b, h) + aoff + m * 2048); } \
        else { _Pragma("unroll") for (int m = 0; m < 4; ++m) _Pragma("unroll") for (int k = 0; k < 2; ++k) dst[m][k] = *(const PG8_LAS bf16x8*)(lds + PG8_SA(b, h) + aoff + m * 2048 + k * 1024); } } while (0)
#define PG8_LDB(dst, b, h) do { if constexpr (F8) { _Pragma("unroll") for (int n = 0; n < 2; ++n) dst##8[n] = PG8_LD32(lds + PG8_SB(b, h) + boff + n * 2048); } \
        else { _Pragma("unroll") for (int n = 0; n < 2; ++n) _Pragma("unroll") for (int k = 0; k < 2; ++k) dst[n][k] = *(const PG8_LAS bf16x8*)(lds + PG8_SB(b, h) + boff + n * 2048 + k * 1024); } } while (0)
#define PG8_MMA(ai, bj, At, Bt) do { __builtin_amdgcn_s_setprio(1); if constexpr (F8) { _Pragma("unroll") for (int m = 0; m < 4; ++m) _Pragma("unroll") for (int n = 0; n < 2; ++n) \
        asm volatile("v_mfma_scale_f32_16x16x128_f8f6f4 %0, %1, %2, %0, %3, %3 op_sel_hi:[0,0,0]" : "+v"(acc[ai][bj][m][n]) : "v"(Bt##8[n]), "v"(At##8[m]), "v"(sc1_)); } \
        else { _Pragma("unroll") for (int m = 0; m < 4; ++m) _Pragma("unroll") for (int n = 0; n < 2; ++n) _Pragma("unroll") for (int k = 0; k < 2; ++k) \
        acc[ai][bj][m][n] = __builtin_amdgcn_mfma_f32_16x16x32_bf16(Bt[n][k], At[m][k], acc[ai][bj][m][n], 0, 0, 0); } __builtin_amdgcn_s_setprio(0); } while (0)
#define PG8_WAIT_V(n) asm volatile("s_waitcnt vmcnt(" #n ")" ::: "memory")
#define PG8_WAIT_L(n) asm volatile("s_waitcnt lgkmcnt(" #n ")" ::: "memory")
#define PG8_BAR __builtin_amdgcn_s_barrier()
#define PG8_SCHED __builtin_amdgcn_sched_barrier(0)
    Unit cur, nxt; int ui = 0;
    if (!S.next(0, cur)) return;
    f32x4 acc[2][2][4][2];
#pragma unroll
    for (int a = 0; a < 2; ++a)
#pragma unroll
        for (int b = 0; b < 2; ++b)
#pragma unroll
            for (int m = 0; m < 4; ++m)
#pragma unroll
                for (int n = 0; n < 2; ++n) acc[a][b][m][n] = (f32x4){0.f, 0.f, 0.f, 0.f};
    bf16x8 At[4][2], B0[2][2], B1[2][2]; i32x8 At8[4], B08[2], B18[2];
    const int f8o1 = (fq & 1) * 16, f8o2 = 16 - f8o1;
    int sc1_ = 0x7f7f7f7f; asm volatile("" : "+v"(sc1_));
    const char* cA; const char* cB; S.ab(cur, g, tstep, cA, cB);
    S.a_ready(cur);
    if constexpr (SP2) {
        PG8_STAGE(PG8_SB(0, 0), cB, voffB); PG8_STAGE(PG8_SB(0, 1), cB + hstep, voffB); PG8_STAGE(PG8_SA(0, 0), cA, voffA); PG8_STAGE(PG8_SA(0, 1), cA + hstep, voffA);
        if (wr == 1) PG8_BAR;
        PG8_WAIT_V(2); PG8_BAR;
        PG8_STAGE(PG8_SB(1, 0), cB + kstep, voffB); PG8_STAGE(PG8_SA(1, 0), cA + kstep, voffA); PG8_STAGE(PG8_SB(1, 1), cB + hstep + kstep, voffB);
        PG8_WAIT_V(6); PG8_BAR;
    } else {
        PG8_STAGE(PG8_SB(0, 0), cB, voffB); PG8_STAGE(PG8_SA(0, 0), cA, voffA); PG8_STAGE(PG8_SB(0, 1), cB + hstep, voffB); PG8_STAGE(PG8_SA(0, 1), cA + hstep, voffA);
        if (wr == 1) PG8_BAR;
        PG8_WAIT_V(4); PG8_BAR;
        PG8_STAGE(PG8_SB(1, 0), cB + kstep, voffB); PG8_STAGE(PG8_SA(1, 0), cA + kstep, voffA); PG8_STAGE(PG8_SB(1, 1), cB + hstep + kstep, voffB);
        PG8_WAIT_V(6); PG8_BAR;
    }
    for (;;) {
        const bool has_next = S.next(ui + 1, nxt);
        const char* nA = cA; const char* nB = cB; if (has_next) S.ab(nxt, g, tstep, nA, nB);
        for (int t = 0; t < nt; t += 2) {
            const bool last = (t == nt - 2);
            const char* a1 = cA + (size_t)(t + 1) * kstep;
            const char* a2 = last ? nA : cA + (size_t)(t + 2) * kstep; const char* b2 = last ? nB : cB + (size_t)(t + 2) * kstep;
            const char* a3 = a2 + kstep; const char* b3 = b2 + kstep;
            if (last && has_next) S.a_ready(nxt);
            if constexpr (SP2) {
            PG8_LDB(B0, 0, 0); PG8_LDB(B1, 0, 1); PG8_SCHED; PG8_LDA(At, 0, 0); PG8_STAGE(PG8_SA(1, 1), a1 + hstep, voffA);
            PG8_WAIT_V(8); PG8_WAIT_L(0); PG8_BAR; PG8_MMA(0, 0, At, B0); PG8_MMA(0, 1, At, B1); PG8_BAR; PG8_SCHED;
            PG8_LDA(At, 0, 1); PG8_STAGE(PG8_SB(0, 0), b2, voffB); PG8_STAGE(PG8_SB(0, 1), b2 + hstep, voffB); PG8_STAGE(PG8_SA(0, 0), a2, voffA);
            PG8_WAIT_V(8); PG8_WAIT_L(0); PG8_BAR; PG8_MMA(1, 0, At, B0); PG8_MMA(1, 1, At, B1); PG8_BAR; PG8_SCHED;
            PG8_LDB(B0, 1, 0); PG8_LDB(B1, 1, 1); PG8_SCHED; PG8_LDA(At, 1, 0); PG8_STAGE(PG8_SA(0, 1), a2 + hstep, voffA);
            PG8_WAIT_V(8); PG8_WAIT_L(0); PG8_BAR; PG8_MMA(0, 0, At, B0); PG8_MMA(0, 1, At, B1); PG8_BAR; PG8_SCHED;
            PG8_LDA(At, 1, 1); PG8_STAGE(PG8_SB(1, 0), b3, voffB); PG8_STAGE(PG8_SB(1, 1), b3 + hstep, voffB); PG8_STAGE(PG8_SA(1, 0), a3, voffA);
            PG8_WAIT_V(8); PG8_WAIT_L(0); PG8_BAR; PG8_MMA(1, 0, At, B0); PG8_MMA(1, 1, At, B1); PG8_BAR; PG8_SCHED;
            } else {
            PG8_LDB(B0, 0, 0); PG8_SCHED; PG8_LDA(At, 0, 0); PG8_STAGE(PG8_SA(1, 1), a1 + hstep, voffA);
            PG8_WAIT_L(8); PG8_BAR; PG8_WAIT_L(0); PG8_MMA(0, 0, At, B0); PG8_BAR; PG8_SCHED;
            PG8_LDB(B1, 0, 1); PG8_STAGE(PG8_SB(0, 0), b2, voffB);
            PG8_BAR; PG8_WAIT_L(0); PG8_MMA(0, 1, At, B1); PG8_BAR;
            PG8_LDA(At, 0, 1); PG8_STAGE(PG8_SA(0, 0), a2, voffA);
            PG8_BAR; PG8_WAIT_L(0); PG8_MMA(1, 0, At, B0); PG8_BAR; PG8_SCHED;
            PG8_STAGE(PG8_SB(0, 1), b2 + hstep, voffB);
            PG8_WAIT_V(6); PG8_BAR; PG8_MMA(1, 1, At, B1); PG8_BAR;
            PG8_LDB(B0, 1, 0); PG8_SCHED; PG8_LDA(At, 1, 0); PG8_STAGE(PG8_SA(0, 1), a2 + hstep, voffA);
            PG8_WAIT_L(8); PG8_BAR; PG8_WAIT_L(0); PG8_MMA(0, 0, At, B0); PG8_BAR; PG8_SCHED;
            PG8_LDB(B1, 1, 1); PG8_STAGE(PG8_SB(1, 0), b3, voffB);
            PG8_BAR; PG8_WAIT_L(0); PG8_MMA(0, 1, At, B1); PG8_BAR;
            PG8_LDA(At, 1, 1); PG8_STAGE(PG8_SA(1, 0), a3, voffA);
            PG8_BAR; PG8_WAIT_L(0); PG8_MMA(1, 0, At, B0); PG8_BAR; PG8_SCHED;
            PG8_STAGE(PG8_SB(1, 1), b3 + hstep, voffB);
            PG8_WAIT_V(6); PG8_BAR; PG8_MMA(1, 1, At, B1); PG8_BAR;
            }
        }
        if constexpr (F8) { asm volatile("s_nop 15\n\ts_nop 15" ::: "memory"); __builtin_amdgcn_sched_barrier(0); }
        if constexpr (ALIGN_EPI) { if (wr == 0) PG8_BAR; }
        if constexpr (!Epi::AFTER_DRAIN) { E(acc, cur, wr, wc, fr, fq); S.done(cur); }
        if (!has_next) break;
#pragma unroll
        for (int a = 0; a < 2; ++a)
#pragma unroll
            for (int b = 0; b < 2; ++b)
#pragma unroll
                for (int m = 0; m < 4; ++m)
#pragma unroll
                    for (int n = 0; n < 2; ++n) acc[a][b][m][n] = (f32x4){0.f, 0.f, 0.f, 0.f};
        cur = nxt; cA = nA; cB = nB; ++ui;
        if constexpr (ALIGN_EPI) { if (wr == 1) PG8_BAR; }
    }
    PG8_WAIT_V(0);
    if constexpr (!ALIGN_EPI) { if (wr == 0) PG8_BAR; }
    PG8_BAR;
    if constexpr (Epi::AFTER_DRAIN) { E.fused(acc, cur, wr, wc, fr, fq, lds, wid, lane); S.done(cur); }
#undef PG8_SA
#undef PG8_SB
#undef PG8_STAGE
#undef PG8_LDA
#undef PG8_LD32
#undef PG8_LDB
#undef PG8_MMA
#undef PG8_WAIT_V
#undef PG8_WAIT_L
#undef PG8_BAR
#undef PG8_SCHED
}
}

namespace pg8 {
constexpr float QK_C2 = 0.125f * 1.4426950408889634f;
__device__ __forceinline__ unsigned pk_fp8x4(float a, float b, float c, float d);
struct InProjOrder {
    static constexpr int NM = 272, NN = 8, NMAIN = NM * NN, NALL = NMAIN + 2 * NM;
    int G, c;
    __host__ __device__ void init(int G_, int c_) { G = G_; c = c_; }
    __host__ __device__ bool next(int i, Unit& u) const {
        const long L = (long)i * G + c; if (L >= NALL) return false;
        if (L < NMAIN) { int wgid = (int)L; { const int q = NMAIN / NXCD, xcd = wgid % NXCD, off = wgid / NXCD; wgid = xcd * q + off; }
            const int nig = WGM * NN, gid = wgid / nig, fm = gid * WGM, gsz = (NM - fm) < WGM ? (NM - fm) : WGM;
            u.pm = fm + ((wgid % nig) % gsz); u.pn = (wgid % nig) / gsz; }
        else { const int v = (int)L - NMAIN; u.pm = v >> 1; u.pn = 8 + (v & 1); }
        return true;
    }
    __device__ __forceinline__ void a_ready(const Unit&) const {}
    __device__ __forceinline__ void done(const Unit&) const {}
    __device__ __forceinline__ void ab(const Unit& u, const Gemm& g, size_t tstep, const char*& pa, const char*& pb) const {
        if (u.pn < 8) { pa = (const char*)g.A + (size_t)u.pm * tstep; pb = (const char*)g.Bt + (size_t)u.pn * tstep; }
        else { pa = (const char*)g.Bt + (size_t)u.pn * tstep; pb = (const char*)g.A + (size_t)u.pm * tstep; }
    }
};
struct EpiInProj {
    static constexpr bool PERM = true, AFTER_DRAIN = false;
    bf16_t *Q, *Kb, *VT, *Ub, *Gb; unsigned char* VT8; const PG8_LAS float* ropec; const PG8_LAS float* ropes;
    __device__ __forceinline__ void operator()(const f32x4 (&acc)[2][2][4][2], const Unit& u, int wr, int wc, int fr, int fq) const {
        const bool ctx = u.pm >= 256;
        if (u.pn >= 8) {
            const int tok0 = u.pm * BM + wc * 32 + 8 * fq;
#pragma unroll
            for (int bj = 0; bj < 2; ++bj) { const int tok = tok0 + bj * HALF; int bidx, key;
                if (ctx) { bidx = (tok - 65536) >> 8; key = 4096 + ((tok - 65536) & 255); } else { bidx = tok >> 12; key = tok & 4095; }
#pragma unroll
                for (int ai = 0; ai < 2; ++ai)
#pragma unroll
                    for (int m = 0; m < 4; ++m) { const int dim = (u.pn - 8) * BM + ai * HALF + wr * 64 + m * 16 + fr;
                        const f32x4 v0 = acc[ai][bj][m][0], v1 = acc[ai][bj][m][1];
                        u32x4 w; w.x = cvt_pk_bf16(v0[0], v0[1]); w.y = cvt_pk_bf16(v0[2], v0[3]); w.z = cvt_pk_bf16(v1[0], v1[1]); w.w = cvt_pk_bf16(v1[2], v1[3]);
                        *(u32x4*)(VT + ((size_t)(bidx * 512 + dim)) * 4352 + key) = w;
                        typedef unsigned u32x2v __attribute__((ext_vector_type(2))); u32x2v w8; w8.x = pk_fp8x4(v0[0], v0[1], v0[2], v0[3]); w8.y = pk_fp8x4(v1[0], v1[1], v1[2], v1[3]);
                        *(u32x2v*)(VT8 + ((size_t)(bidx * 512 + dim)) * 4352 + key) = w8; } }
            return;
        }
        const int seg = u.pn >> 1;
        if (ctx && (seg == 0 || seg == 3)) return;
        const int cs0 = (u.pn & 1) * BM + wc * 32 + 8 * fq;
        const bool rope = (seg < 2) && !ctx; const int a = wc & 1;
#pragma unroll
        for (int ai = 0; ai < 2; ++ai)
#pragma unroll
            for (int m = 0; m < 4; ++m) {
                const int r = u.pm * BM + ai * HALF + wr * 64 + m * 16 + fr;
                int bidx, s; size_t rowkv;
                if (ctx) { bidx = (r - 65536) >> 8; s = (r - 65536) & 255; rowkv = (size_t)bidx * 4352 + 4096 + s; }
                else { bidx = r >> 12; s = r & 4095; rowkv = (size_t)bidx * 4352 + s; }
                f32x4 cs = (f32x4){1.f, 1.f, 1.f, 1.f}, sn = (f32x4){0.f, 0.f, 0.f, 0.f};
                if (rope) { const int pos = a ? (s & 63) : (s >> 6); cs = *(const PG8_LAS f32x4*)(ropec + pos * 16 + 4 * fq); sn = *(const PG8_LAS f32x4*)(ropes + pos * 16 + 4 * fq); }
                bf16_t* dst;
                if (seg == 0) dst = Q + (size_t)r * 512; else if (seg == 1) dst = Kb + rowkv * 512; else if (seg == 2) dst = Ub + (size_t)r * 512; else dst = Gb + (size_t)r * 512;
#pragma unroll
                for (int bj = 0; bj < 2; ++bj) {
                    f32x4 v0 = acc[ai][bj][m][0], v1 = acc[ai][bj][m][1];
                    if (rope) { const f32x4 o1 = v0 * cs - v1 * sn, o2 = v1 * cs + v0 * sn; v0 = o1; v1 = o2; }
                    if (seg == 0) { v0 = v0 * QK_C2; v1 = v1 * QK_C2; }
                    u32x4 w; w.x = cvt_pk_bf16(v0[0], v0[1]); w.y = cvt_pk_bf16(v0[2], v0[3]); w.z = cvt_pk_bf16(v1[0], v1[1]); w.w = cvt_pk_bf16(v1[2], v1[3]);
                    *(u32x4*)(dst + cs0 + bj * HALF) = w;
                }
            }
    }
};
__device__ __forceinline__ unsigned pk_fp8x4(float a, float b, float c, float d) {
    a = __builtin_amdgcn_fmed3f(a, -448.f, 448.f); b = __builtin_amdgcn_fmed3f(b, -448.f, 448.f); c = __builtin_amdgcn_fmed3f(c, -448.f, 448.f); d = __builtin_amdgcn_fmed3f(d, -448.f, 448.f);
    int w = 0; w = __builtin_amdgcn_cvt_pk_fp8_f32(a, b, w, false); w = __builtin_amdgcn_cvt_pk_fp8_f32(c, d, w, true); return (unsigned)w; }
template <bool OUT8> struct EpiSwiglu {
    static constexpr bool PERM = true, AFTER_DRAIN = false;
    bf16_t* H; int ldh; float ascale, oscale;
    __device__ __forceinline__ void operator()(const f32x4 (&acc)[2][2][4][2], const Unit& u, int wr, int wc, int fr, int fq) const {
        const int col0 = u.pn * HALF + wc * 32 + 8 * fq;
#pragma unroll
        for (int ai = 0; ai < 2; ++ai)
#pragma unroll
            for (int m = 0; m < 4; ++m) {
                const size_t r = (size_t)u.pm * BM + ai * HALF + wr * 64 + m * 16 + fr;
                float o[8];
#pragma unroll
                for (int n = 0; n < 2; ++n)
#pragma unroll
                    for (int j = 0; j < 4; ++j) { const float av = acc[ai][0][m][n][j] * ascale, bv = acc[ai][1][m][n][j] * ascale;
                        const float sg = __builtin_amdgcn_rcpf(1.f + __builtin_amdgcn_exp2f(-av * 1.4426950408889634f)); o[4 * n + j] = av * sg * bv; }
                if constexpr (OUT8) { typedef unsigned u32x2v __attribute__((ext_vector_type(2)));
                    u32x2v w; w.x = pk_fp8x4(o[0] * oscale, o[1] * oscale, o[2] * oscale, o[3] * oscale); w.y = pk_fp8x4(o[4] * oscale, o[5] * oscale, o[6] * oscale, o[7] * oscale);
                    *(u32x2v*)((unsigned char*)H + r * ldh + col0) = w;
                } else { u32x4 w; w.x = cvt_pk_bf16(o[0], o[1]); w.y = cvt_pk_bf16(o[2], o[3]); w.z = cvt_pk_bf16(o[4], o[5]); w.w = cvt_pk_bf16(o[6], o[7]);
                    *(u32x4*)(H + r * ldh + col0) = w; }
            }
    }
};
struct EpiPlain {
    static constexpr bool PERM = true, AFTER_DRAIN = false;
    bf16_t* O; int ldc; float scale;
    __device__ __forceinline__ void operator()(const f32x4 (&acc)[2][2][4][2], const Unit& u, int wr, int wc, int fr, int fq) const {
        const int col0 = u.pn * BM + wc * 32 + 8 * fq;
#pragma unroll
        for (int ai = 0; ai < 2; ++ai)
#pragma unroll
            for (int m = 0; m < 4; ++m) {
                bf16_t* rowp = O + ((size_t)u.pm * BM + ai * HALF + wr * 64 + m * 16 + fr) * ldc + col0;
#pragma unroll
                for (int bj = 0; bj < 2; ++bj) { const f32x4 v0 = acc[ai][bj][m][0] * scale, v1 = acc[ai][bj][m][1] * scale;
                    u32x4 w; w.x = cvt_pk_bf16(v0[0], v0[1]); w.y = cvt_pk_bf16(v0[2], v0[3]); w.z = cvt_pk_bf16(v1[0], v1[1]); w.w = cvt_pk_bf16(v1[2], v1[3]);
                    *(u32x4*)(rowp + bj * HALF) = w; }
            }
    }
};
}

#ifndef ATT_F8MAP1
#define ATT_F8MAP1 1
#endif
#ifndef ATT_F8MAP0
#define ATT_F8MAP0 1
#endif
namespace att {
typedef short bf16x8 __attribute__((ext_vector_type(8)));
typedef short s16x4 __attribute__((ext_vector_type(4)));
typedef short v4i16_t __attribute__((ext_vector_type(4)));
typedef float f32x16 __attribute__((ext_vector_type(16)));
typedef float f32x4 __attribute__((ext_vector_type(4)));
typedef unsigned u32x4 __attribute__((ext_vector_type(4)));
#define ATT_LAS __attribute__((address_space(3)))
typedef ATT_LAS const char* lds_cptr;
constexpr int TKV = 4352, NT = TKV / 64, NS = 3, KSLOT = 8192, VSLOT = 16384;
constexpr int LDS_K = 0, LDS_V = NS * KSLOT, LDS_SCR = LDS_V + 4 * VSLOT, LDS_FLG = LDS_SCR + 8 * 256, LDS_END = LDS_FLG + 64;
constexpr size_t PARK_FLOATS = 64 * 512;
__device__ __forceinline__ int crow(int r, int hi) { return (r & 3) + 8 * (r >> 2) + 4 * hi; }
__device__ __forceinline__ void glds16(const void* gsrc, unsigned lds_dst) { unsigned keep;
    asm volatile("s_mov_b32 %0, m0\n\ts_mov_b32 m0, %2\n\ts_nop 0\n\tglobal_load_lds_dwordx4 %1, off\n\ts_mov_b32 m0, %0" : "=&s"(keep) : "v"(gsrc), "s"(lds_dst) : "memory"); }
__device__ __forceinline__ void glds16s(const void* sbase, unsigned voff, unsigned lds_dst) { unsigned keep;
    asm volatile("s_mov_b32 %0, m0\n\ts_mov_b32 m0, %3\n\ts_nop 0\n\tglobal_load_lds_dwordx4 %1, %2\n\ts_mov_b32 m0, %0" : "=&s"(keep) : "v"(voff), "s"(sbase), "s"(lds_dst) : "memory"); }
typedef float f32x2_t __attribute__((ext_vector_type(2))); typedef __bf16 bf16x2_t __attribute__((ext_vector_type(2)));
__device__ __forceinline__ unsigned cvtpk(float lo, float hi) { f32x2_t v = {lo, hi}; bf16x2_t b = __builtin_convertvector(v, bf16x2_t); return __builtin_bit_cast(unsigned, b); }
__device__ __forceinline__ s16x4 vtr(lds_cptr p) { return __builtin_bit_cast(s16x4, __builtin_amdgcn_ds_read_tr16_b64_v4i16((ATT_LAS v4i16_t*)p)); }
__device__ __forceinline__ bf16x8 ldsb128(lds_cptr p) { return *(const ATT_LAS bf16x8*)p; }
#define ATT_SB() __builtin_amdgcn_sched_barrier(0)
#define ATT_WAITBAR(N) asm volatile("s_waitcnt vmcnt(" #N ") lgkmcnt(0)\n\ts_barrier" ::: "memory")

typedef int i32x8 __attribute__((ext_vector_type(8)));
typedef int i32x4 __attribute__((ext_vector_type(4)));
template <int MODE, bool F8>
__device__ __forceinline__ void attn_pass(int m, const short* Qw, const short* Kh, const short* Vh, const unsigned char* V8h, char* shm, f32x16 (&o)[4], float& l, float& mx) {
    const int tid = threadIdx.x, lane = tid & 63, r32 = lane & 31, hi = lane >> 5; const int wid = __builtin_amdgcn_readfirstlane(tid >> 6);
    const bool late = wid >= 4;
    const unsigned lds0 = (unsigned)(uintptr_t)shm;
    const short* kbase = Kh + m * 64 + wid * 8;
    const unsigned koff = (unsigned)lane * 1024u;
    const int vd_ = F8 ? 16 * wid + (lane >> 2) : 8 * wid + (lane >> 3);
    const short* vbase = F8 ? (const short*)(V8h + (size_t)(16 * wid) * TKV) : Vh + (size_t)(8 * wid) * TKV;
    const unsigned voff = F8 ? (unsigned)((lane >> 2) * TKV + (((lane & 3) ^ ((vd_ >> 2) & 3)) * 16)) : (unsigned)((lane >> 3) * TKV + (((lane & 7) ^ ((vd_ >> 1) & 7)) * 8)) * 2u;
    const unsigned kdst = lds0 + LDS_K + wid * 1024, vdst = lds0 + LDS_V + wid * 1024;
#define ATT_DMAK(t, slot) glds16s((const void*)(kbase + (size_t)(t) * 64 * 512), koff, (unsigned)__builtin_amdgcn_readfirstlane(kdst + (slot)))
#define ATT_DMAV(t, slot) do { if (F8) { glds16s((const void*)((const char*)vbase + (size_t)(t) * 64), voff, (unsigned)__builtin_amdgcn_readfirstlane(vdst + (slot))); } \
        else { const short* vs_ = vbase + (size_t)(t) * 64; glds16s((const void*)vs_, voff, (unsigned)__builtin_amdgcn_readfirstlane(vdst + (slot))); glds16s((const void*)(vs_ + (size_t)64 * TKV), voff, (unsigned)__builtin_amdgcn_readfirstlane(vdst + (slot) + 8192)); } } while (0)
    const lds_cptr shm3 = (lds_cptr)shm;
    const int kpi_ = F8 ? (32 * ((r32 >> 2) & 1) + (r32 & 3) + 4 * (r32 >> 3)) : ((r32 & ~12) | ((r32 & 4) << 1) | ((r32 & 8) >> 1));
    constexpr int KB_OFF = F8 ? 256 : 512;
    const lds_cptr kp0 = shm3 + LDS_K + hi * 1024 + kpi_ * 16;
    const int vf_ = (r32 >> 1) & 7;
    const lds_cptr vq0 = shm3 + LDS_V + r32 * 128 + (((0 + hi) ^ vf_) << 4), vq1 = shm3 + LDS_V + r32 * 128 + (((2 + hi) ^ vf_) << 4);
    const lds_cptr vq2 = shm3 + LDS_V + r32 * 128 + (((4 + hi) ^ vf_) << 4), vq3 = shm3 + LDS_V + r32 * 128 + (((6 + hi) ^ vf_) << 4);
    const lds_cptr v8a = shm3 + LDS_V + r32 * 64 + (((2 * hi) ^ ((r32 >> 2) & 3)) << 4), v8b = shm3 + LDS_V + r32 * 64 + (((2 * hi + 1) ^ ((r32 >> 2) & 3)) << 4);
    int sc1_ = 0x7f7f7f7f; asm volatile("" : "+v"(sc1_)); int scA = sc1_;
    bf16x8 qr[4];
#pragma unroll
    for (int d0 = 0; d0 < 4; ++d0) qr[d0] = *(const bf16x8*)(Qw + (size_t)r32 * 512 + m * 64 + d0 * 16 + hi * 8);
    asm volatile("" : "+v"(qr[0]), "+v"(qr[1]), "+v"(qr[2]), "+v"(qr[3]) :: "memory");
    constexpr int NV = F8 ? 1 : 2;
    ATT_DMAK(0, 0); ATT_DMAV(0, 0); ATT_DMAK(1, KSLOT); ATT_DMAK(2, 2 * KSLOT); ATT_DMAV(1, VSLOT);
#pragma unroll
    for (int i = 0; i < 4; ++i) o[i] = f32x16{};
    l = 0.f; float nmx = -INFINITY; f32x2_t l2 = {0.f, 0.f};
    if (NV == 2) ATT_WAITBAR(3); else ATT_WAITBAR(2);
    bf16x8 ka0, ka1, ka2, ka3, kb0, kb1, kb2, kb3;
#define ATT_LOADK(slot) do { const lds_cptr kp_ = kp0 + (slot); ka0 = ldsb128(kp_); kb0 = ldsb128(kp_ + KB_OFF); ka1 = ldsb128(kp_ + 2048); kb1 = ldsb128(kp_ + 2048 + KB_OFF); \
        ka2 = ldsb128(kp_ + 4096); kb2 = ldsb128(kp_ + 4096 + KB_OFF); ka3 = ldsb128(kp_ + 6144); kb3 = ldsb128(kp_ + 6144 + KB_OFF); } while (0)
    ATT_LOADK(0);
    if (NV == 2) ATT_WAITBAR(3); else ATT_WAITBAR(2);
    int ksl = 0, vsl = 0;
    bf16x8 p0, p1, p2, p3;
    p0 = p1 = p2 = p3 = (bf16x8){0, 0, 0, 0, 0, 0, 0, 0};
#define ATT_VLD(dst, db, ks) dst = ldsb128(vq##ks + vsl_ + (db) * 4096)
#define ATT_MF(acc, a, b) acc = __builtin_amdgcn_mfma_f32_32x32x16_bf16(a, b, acc, 0, 0, 0)
#define ATT_PACK8(oa_, ob_) do { \
        _Pragma("unroll") for (int j = 0; j < 4; ++j) { int w_ = __builtin_amdgcn_cvt_pk_fp8_f32(sa[4 * j], sa[4 * j + 1], oa_[j], false); w_ = __builtin_amdgcn_cvt_pk_fp8_f32(sa[4 * j + 2], sa[4 * j + 3], w_, true); w8_[j] = w_; } \
        _Pragma("unroll") for (int j = 0; j < 4; ++j) { int w_ = __builtin_amdgcn_cvt_pk_fp8_f32(sb[4 * j], sb[4 * j + 1], ob_[j], false); w_ = __builtin_amdgcn_cvt_pk_fp8_f32(sb[4 * j + 2], sb[4 * j + 3], w_, true); w8_[4 + j] = w_; } } while (0)
#define ATT_X(HASNEXT, ksn_) do { \
        f32x16 sa, sb;     \
        if (F8) { asm volatile("v_mfma_f32_32x32x16_bf16 %0, %1, %2, -4.0" : "=&v"(sa) : "v"(ka0), "v"(qr[0])); asm volatile("v_mfma_f32_32x32x16_bf16 %0, %1, %2, -4.0" : "=&v"(sb) : "v"(kb0), "v"(qr[0])); } \
        else { sa = f32x16{}; sb = f32x16{}; ATT_MF(sa, ka0, qr[0]); ATT_MF(sb, kb0, qr[0]); } \
        ATT_MF(sa, ka1, qr[1]); ATT_MF(sb, kb1, qr[1]); \
        ATT_MF(sa, ka2, qr[2]); ATT_MF(sb, kb2, qr[2]); ATT_MF(sa, ka3, qr[3]); ATT_MF(sb, kb3, qr[3]); \
        ATT_SB(); \
          \
        if (t + 3 < NT) ATT_DMAK(t + 3, ksl); \
        if (MODE != 1) { if (t + 2 < NT) { const int v2 = (vsl >= 2 * VSLOT) ? vsl - 2 * VSLOT : vsl + 2 * VSLOT; ATT_DMAV(t + 2, v2); } } \
        ATT_SB(); \
        if (HASNEXT) ATT_LOADK(ksn_); \
        if (MODE == 1) { \
            _Pragma("unroll") for (int r = 0; r < 16; ++r) nmx = fmaxf(nmx, fmaxf(sa[r], sb[r])); \
        } else { \
            _Pragma("unroll") for (int r = 0; r < 16; ++r) { sa[r] = __builtin_amdgcn_exp2f(MODE == 2 ? sa[r] - mx : sa[r]); sb[r] = __builtin_amdgcn_exp2f(MODE == 2 ? sb[r] - mx : sb[r]); } \
            _Pragma("unroll") for (int r = 0; r < 8; ++r) { l2 += (f32x2_t){sa[2 * r], sa[2 * r + 1]}; l2 += (f32x2_t){sb[2 * r], sb[2 * r + 1]}; }     \
            if (F8) { i32x8 w8_; const i32x4 po0_ = __builtin_bit_cast(i32x4, p0), po1_ = __builtin_bit_cast(i32x4, p1);     \
                int pmt = 0; \
                _Pragma("unroll") for (int r = 0; r < 16; ++r) { const float fa_ = sa[r], fb_ = sb[r]; const int ia_ = __float_as_int(fa_), ib_ = __float_as_int(fb_); pmt = pmt > ia_ ? pmt : ia_; pmt = pmt > ib_ ? pmt : ib_; }     \
                scA = sc1_; ATT_PACK8(po0_, po1_);     \
                if (__builtin_expect(__any(pmt > 0x43e00000), 0)) {     \
                    const int e_ = pmt > 0x43e00000 ? (pmt >> 23) - 134 : 0;     \
                    const float f_ = __int_as_float((127 - e_) << 23); \
                    _Pragma("unroll") for (int r = 0; r < 16; ++r) { sa[r] *= f_; sb[r] *= f_; } \
                    const i32x4 pa_ = __builtin_shufflevector(w8_, w8_, 0, 1, 2, 3), pb_ = __builtin_shufflevector(w8_, w8_, 4, 5, 6, 7); \
                    scA = (127 + e_) * 0x01010101; ATT_PACK8(pa_, pb_); } \
                p0 = __builtin_bit_cast(bf16x8, __builtin_shufflevector(w8_, w8_, 0, 1, 2, 3)); p1 = __builtin_bit_cast(bf16x8, __builtin_shufflevector(w8_, w8_, 4, 5, 6, 7)); \
            } else { \
            u32x4 w0, w1, w2, w3; \
            w0.x = cvtpk(sa[0], sa[1]); w0.y = cvtpk(sa[2], sa[3]); w0.z = cvtpk(sa[4], sa[5]); w0.w = cvtpk(sa[6], sa[7]); \
            w1.x = cvtpk(sa[8], sa[9]); w1.y = cvtpk(sa[10], sa[11]); w1.z = cvtpk(sa[12], sa[13]); w1.w = cvtpk(sa[14], sa[15]); \
            w2.x = cvtpk(sb[0], sb[1]); w2.y = cvtpk(sb[2], sb[3]); w2.z = cvtpk(sb[4], sb[5]); w2.w = cvtpk(sb[6], sb[7]); \
            w3.x = cvtpk(sb[8], sb[9]); w3.y = cvtpk(sb[10], sb[11]); w3.z = cvtpk(sb[12], sb[13]); w3.w = cvtpk(sb[14], sb[15]); \
            p0 = __builtin_bit_cast(bf16x8, w0); p1 = __builtin_bit_cast(bf16x8, w1); p2 = __builtin_bit_cast(bf16x8, w2); p3 = __builtin_bit_cast(bf16x8, w3); } \
        } \
        ATT_SB(); } while (0)
#define ATT_LD32(dst, db) dst = __builtin_shufflevector(*(const ATT_LAS i32x4*)(v8a + vsl_ + (db) * 2048), *(const ATT_LAS i32x4*)(v8b + vsl_ + (db) * 2048), 0, 1, 2, 3, 4, 5, 6, 7)
#define ATT_MF8(acc, vfrag) asm volatile("s_nop 1\n\tv_mfma_scale_f32_32x32x64_f8f6f4 %0, %1, %2, %0, %3, %4 op_sel_hi:[0,0,0]" : "+v"(acc) : "v"(pp8_), "v"(vfrag), "v"(scA), "v"(sc1_))
#define ATT_Y8(vslx) do { const int vsl_ = (vslx); i32x8 wa, wb, wc, wd; const i32x8 pp8_ = __builtin_shufflevector(__builtin_bit_cast(i32x4, p0), __builtin_bit_cast(i32x4, p1), 0, 1, 2, 3, 4, 5, 6, 7); \
        ATT_LD32(wa, 0); ATT_LD32(wb, 1); ATT_SB(); ATT_LD32(wc, 2); ATT_LD32(wd, 3); ATT_SB(); \
        ATT_MF8(o[0], wa); ATT_MF8(o[1], wb); ATT_SB(); ATT_MF8(o[2], wc); ATT_MF8(o[3], wd); ATT_SB(); } while (0)
#define ATT_YB(vslx) do { const int vsl_ = (vslx); bf16x8 va, vb, vc, vd, ve, vf, vg, vh;     \
        ATT_VLD(va, 0, 0); ATT_VLD(vb, 0, 1); ATT_VLD(vc, 0, 2); ATT_VLD(vd, 0, 3); ATT_SB(); \
        ATT_VLD(ve, 1, 0); ATT_VLD(vf, 1, 1); ATT_VLD(vg, 1, 2); ATT_VLD(vh, 1, 3); ATT_SB(); \
        ATT_MF(o[0], p0, va); ATT_MF(o[0], p1, vb); ATT_MF(o[0], p2, vc); ATT_MF(o[0], p3, vd); ATT_SB(); \
        ATT_VLD(va, 2, 0); ATT_VLD(vb, 2, 1); ATT_VLD(vc, 2, 2); ATT_VLD(vd, 2, 3); ATT_SB(); \
        ATT_MF(o[1], p0, ve); ATT_MF(o[1], p1, vf); ATT_MF(o[1], p2, vg); ATT_MF(o[1], p3, vh); ATT_SB(); \
        ATT_VLD(ve, 3, 0); ATT_VLD(vf, 3, 1); ATT_VLD(vg, 3, 2); ATT_VLD(vh, 3, 3); ATT_SB(); \
        ATT_MF(o[2], p0, va); ATT_MF(o[2], p1, vb); ATT_MF(o[2], p2, vc); ATT_MF(o[2], p3, vd); ATT_SB(); \
        ATT_MF(o[3], p0, ve); ATT_MF(o[3], p1, vf); ATT_MF(o[3], p2, vg); ATT_MF(o[3], p3, vh); ATT_SB(); } while (0)
#define ATT_Y(vslx) do { if (F8) ATT_Y8(vslx); else ATT_YB(vslx); } while (0)
#pragma unroll 1
    for (int t = 0; t < NT; ++t) {
        const int ksn = (ksl == 2 * KSLOT) ? 0 : ksl + KSLOT;
        const int vprev = (vsl == 0) ? 3 * VSLOT : vsl - VSLOT;
        if (MODE != 1) { if (late && t >= 1) ATT_Y(vprev); }
        ATT_X(true, ksn);
        if (MODE != 1) { if (!late) ATT_Y(vsl); }
        if (MODE != 1) { if (NV == 2) { if (t + 3 < NT) ATT_WAITBAR(3); else if (t + 2 < NT) ATT_WAITBAR(2); else ATT_WAITBAR(0); }
                         else { if (t + 3 < NT) ATT_WAITBAR(2); else if (t + 2 < NT) ATT_WAITBAR(1); else ATT_WAITBAR(0); } }
        else { if (t + 3 < NT) ATT_WAITBAR(1); else ATT_WAITBAR(0); }
        ksl = ksn; vsl = (vsl == 3 * VSLOT) ? 0 : vsl + VSLOT;
    }
    if (MODE != 1) { if (late) { const int vprev = (vsl == 0) ? 3 * VSLOT : vsl - VSLOT; ATT_Y(vprev); } ATT_WAITBAR(0); }
    if (F8) { asm volatile("s_nop 15\n\ts_nop 15" ::: "memory"); __builtin_amdgcn_sched_barrier(0); }
    if (MODE == 1) mx = fmaxf(nmx, __shfl_xor(nmx, 32)); else l = l2.x + l2.y;
#undef ATT_X
#undef ATT_PACK8
#undef ATT_Y
#undef ATT_YB
#undef ATT_Y8
#undef ATT_MF8
#undef ATT_LD32
#undef ATT_MF
#undef ATT_VLD
#undef ATT_LOADK
#undef ATT_DMAK
#undef ATT_DMAV
}

template <int MODE>
__device__ __forceinline__ bool attn_unit(int b, int h, int qb, const short* Q, const short* K, const short* V, const unsigned char* V8, short* AO, const float* subg, float lam, float* park, char* shm) {
    const int tid = threadIdx.x, lane = tid & 63, r32 = lane & 31, hi = lane >> 5; const int wid = __builtin_amdgcn_readfirstlane(tid >> 6);
    ATT_LAS float* scr = (ATT_LAS float*)((ATT_LAS char*)shm + LDS_SCR) + wid * 64;
    volatile ATT_LAS unsigned* flgp = (volatile ATT_LAS unsigned*)((ATT_LAS char*)shm + LDS_FLG);
    const size_t qrow = (size_t)b * 4096 + qb * 256 + wid * 32;
    const short* Qw = Q + qrow * 512 + h * 128; const short* Kh = K + (size_t)b * TKV * 512 + h * 128; const short* Vh = V + (size_t)(b * 4 + h) * 128 * TKV; const unsigned char* V8h = V8 + (size_t)(b * 4 + h) * 128 * TKV;
    if (tid == 0) *flgp = 0u;
    f32x16 o[4]; float l, mx = 0.f; bool bad = false;
    if (MODE == 2) { float dummy; attn_pass<1, false>(0, Qw, Kh, Vh, V8h, shm, o, dummy, mx); }
    attn_pass<(MODE == 2 ? 2 : 0), (MODE == 0) && (ATT_F8MAP0 != 0)>(0, Qw, Kh, Vh, V8h, shm, o, l, mx);
    l += __shfl_xor(l, 32); bad = bad || !(l > 0.f && l < 3.0e38f);
    if (hi == 0) scr[r32] = l;
    asm volatile("s_waitcnt lgkmcnt(0)" ::: "memory");
    {   float* pk = park + (size_t)tid * 64;
#pragma unroll
        for (int g = 0; g < 4; ++g) { float il[4];
#pragma unroll
            for (int e = 0; e < 4; ++e) il[e] = __builtin_amdgcn_rcpf(scr[crow(4 * g + e, hi)]);
#pragma unroll
            for (int db = 0; db < 4; ++db) *(f32x4*)(pk + db * 16 + 4 * g) = (f32x4){o[db][4 * g] * il[0], o[db][4 * g + 1] * il[1], o[db][4 * g + 2] * il[2], o[db][4 * g + 3] * il[3]}; } }
    if (MODE == 2) { float dummy; attn_pass<1, false>(1, Qw, Kh, Vh, V8h, shm, o, dummy, mx); }
    attn_pass<(MODE == 2 ? 2 : 0), (MODE == 0) && (ATT_F8MAP1 != 0)>(1, Qw, Kh, Vh, V8h, shm, o, l, mx);
    l += __shfl_xor(l, 32); bad = bad || !(l > 0.f && l < 3.0e38f);
    if (hi == 0) scr[32 + r32] = l;
    asm volatile("s_waitcnt lgkmcnt(0)" ::: "memory");
    float ss[16];
    {   const float* pk = park + (size_t)tid * 64;
#pragma unroll
        for (int r = 0; r < 16; ++r) ss[r] = 0.f;
#pragma unroll
        for (int g = 0; g < 4; ++g) { float il[4];
#pragma unroll
            for (int e = 0; e < 4; ++e) il[e] = lam * __builtin_amdgcn_rcpf(scr[32 + crow(4 * g + e, hi)]);
#pragma unroll
            for (int db = 0; db < 4; ++db) { const f32x4 pv = *(const f32x4*)(pk + db * 16 + 4 * g);
#pragma unroll
                for (int e = 0; e < 4; ++e) { const float v = pv[e] - o[db][4 * g + e] * il[e]; o[db][4 * g + e] = v; ss[4 * g + e] += v * v; } } } }
#pragma unroll
    for (int off = 1; off < 32; off <<= 1)
#pragma unroll
        for (int r = 0; r < 16; ++r) ss[r] += __shfl_xor(ss[r], off);
    float gv[4];
#pragma unroll
    for (int db = 0; db < 4; ++db) gv[db] = subg[32 * db + r32] * 0.8f;
    short* aow = AO + qrow * 1024 + h * 128 + r32;
#pragma unroll
    for (int r = 0; r < 16; ++r) { const float rs = __builtin_amdgcn_rsqf(ss[r] * (1.f / 128.f) + 1e-5f);
#pragma unroll
        for (int db = 0; db < 4; ++db) { const unsigned w = cvtpk(o[db][r] * rs * gv[db], 0.f); aow[(size_t)crow(r, hi) * 1024 + 32 * db] = (short)(w & 0xffffu); } }
    if (MODE == 0) { if (__any(bad)) { if (lane == 0) *flgp = 1u; } }
    asm volatile("s_waitcnt vmcnt(0) lgkmcnt(0)\n\ts_barrier" ::: "memory");
    const unsigned flg = *flgp;
    asm volatile("s_waitcnt lgkmcnt(0)\n\ts_barrier" ::: "memory");
    return __builtin_amdgcn_readfirstlane(flg) != 0u;
}
__device__ __forceinline__ void attn_unit_safe(int b, int h, int qb, const short* Q, const short* K, const short* V, const unsigned char* V8, short* AO, const float* subg, float lam, float* park, char* shm, bool force_fallback) {
    const bool redo = attn_unit<0>(b, h, qb, Q, K, V, V8, AO, subg, lam, park, shm);
    if (redo || force_fallback) (void)attn_unit<2>(b, h, qb, Q, K, V, V8, AO, subg, lam, park, shm);
}
}

namespace lru2 {
typedef short bf16x8 __attribute__((ext_vector_type(8)));
typedef float f32x16 __attribute__((ext_vector_type(16)));
typedef float f32x4 __attribute__((ext_vector_type(4)));
typedef float f32x2 __attribute__((ext_vector_type(2)));
#define LRU2_LAS __attribute__((address_space(3)))
constexpr int TS = 144, TILE = 64 * TS;
constexpr int LDS_TILE = 0, LDS_COMP = 8 * TILE, LDS_CW = LDS_COMP + 2 * 8 * 32 * 8, LDS_BF = LDS_CW + 5 * 64 * 4, LDS_END = LDS_BF + 8192;
__device__ __forceinline__ int crow(int r, int hi) { return (r & 3) + 8 * (r >> 2) + 4 * hi; }
__device__ __forceinline__ float bf2f(unsigned short v) { return __uint_as_float((unsigned)v << 16); }
__device__ __forceinline__ unsigned short f2bf(float f) { unsigned u = __float_as_uint(f); return (unsigned short)((u + 0x7fffu + ((u >> 16) & 1u)) >> 16); }
constexpr float L2E = 1.4426950408889634f;

__device__ __forceinline__ void lru_unit(int b, int w, int nb, const unsigned short* U, const unsigned short* G, const float* convw, const float* convb, const unsigned short* WgT, const float* bg,
                                         const float* sp8, float* HS, unsigned short* AO, LRU2_LAS unsigned char* lds) {
    const int tid = threadIdx.x, lane = tid & 63, r32 = lane & 31, hi = lane >> 5; const int k = __builtin_amdgcn_readfirstlane(tid >> 6);
    LRU2_LAS unsigned char* tile = lds + LDS_TILE + k * TILE;
    LRU2_LAS f32x2* comp = (LRU2_LAS f32x2*)(lds + LDS_COMP);
    const int chn = 64 * w + 32 * nb + r32;
    const int cg = lane & 7, tg = lane >> 3;
    LRU2_LAS float* cw = (LRU2_LAS float*)(lds + LDS_CW);
    if (tid < 320) { const int jj = tid >> 6, c = tid & 63; cw[tid] = jj < 4 ? convw[jj * 512 + 64 * w + c] : convb[64 * w + c]; }
    __syncthreads();
#pragma unroll 1
    for (int dir = 0; dir < 2; ++dir) {
        { const int fi = tid >> 5, o32 = tid & 31;
            const int g = fi >> 3, ks = (fi >> 1) & 3, hi2 = fi & 1;
            *(LRU2_LAS bf16x8*)(lds + LDS_BF + fi * 512 + o32 * 16) = *(const bf16x8*)(WgT + ((size_t)(((dir * 2 + g) * 8 + w) * 64 + 32 * nb + o32)) * 64 + 16 * ks + 8 * hi2); }
        __syncthreads();
        const float br = bg[((dir * 2 + 0) * 8 + w) * 64 + 32 * nb + r32], bi = bg[((dir * 2 + 1) * 8 + w) * 64 + 32 * nb + r32], sp = sp8[dir * 512 + chn];
        float cround = 0.f;
        bf16x8 uu[11];
#define LRU2_CHUNK(p_, chunk_, isctx_, L_, s0_, rowbase_) const int chunk_ = dir == 0 ? (p_) : ((p_) < 4 ? 3 - (p_) : 71 - (p_)); const bool isctx_ = chunk_ < 4; \
        const int L_ = isctx_ ? 256 : 4096, s0_ = isctx_ ? 64 * chunk_ : 64 * (chunk_ - 4); const size_t rowbase_ = isctx_ ? (size_t)65536 + (size_t)b * 256 : (size_t)b * 4096
#define LRU2_LOADU(p_) do { if ((p_) < 68) { LRU2_CHUNK(p_, ch_, ic_, L_, s0_, rb_); _Pragma("unroll") for (int i = 0; i < 11; ++i) { const int s = s0_ + 8 * tg - 2 + i; uu[i] = (bf16x8){0, 0, 0, 0, 0, 0, 0, 0}; \
            if (s >= 0 && s < L_) uu[i] = *(const bf16x8*)(U + (rb_ + s) * 512 + 64 * w + 8 * cg); } } } while (0)
        LRU2_LOADU(k);
#pragma unroll 1
        for (int rd = 0; rd < 9; ++rd) {
            const int p = 8 * rd + k; const bool valid = p < 68;
            LRU2_CHUNK(p, chunk, isctx, L, s0, rowbase);
            (void)L;
            f32x16 z[2][2];
            float atot = 1.f, cend = 0.f, cst[8];
            if (valid) {
                {
                    float wv[4][8], bv[8];
#pragma unroll
                    for (int jj = 0; jj < 4; ++jj) { const f32x4 a = *(const LRU2_LAS f32x4*)(cw + jj * 64 + 8 * cg), c = *(const LRU2_LAS f32x4*)(cw + jj * 64 + 8 * cg + 4);
                        wv[jj][0] = a.x; wv[jj][1] = a.y; wv[jj][2] = a.z; wv[jj][3] = a.w; wv[jj][4] = c.x; wv[jj][5] = c.y; wv[jj][6] = c.z; wv[jj][7] = c.w; }
                    { const f32x4 a = *(const LRU2_LAS f32x4*)(cw + 256 + 8 * cg), c = *(const LRU2_LAS f32x4*)(cw + 256 + 8 * cg + 4); bv[0] = a.x; bv[1] = a.y; bv[2] = a.z; bv[3] = a.w; bv[4] = c.x; bv[5] = c.y; bv[6] = c.z; bv[7] = c.w; }
#pragma unroll
                    for (int tt = 0; tt < 8; ++tt) { bf16x8 o;
#pragma unroll
                        for (int e = 0; e < 8; ++e) { float acc = bv[e];
#pragma unroll
                            for (int jj = 0; jj < 4; ++jj) acc += wv[jj][e] * bf2f((unsigned short)uu[tt + jj][e]);
                            o[e] = (short)f2bf(acc); }
                        *(LRU2_LAS bf16x8*)(tile + (8 * tg + tt) * TS + cg * 16) = o; }
                }
                LRU2_LOADU(p + 8);
                asm volatile("s_waitcnt lgkmcnt(0)" ::: "memory");
#pragma unroll
                for (int g = 0; g < 2; ++g)
#pragma unroll
                    for (int tb = 0; tb < 2; ++tb) { z[g][tb] = f32x16{};
#pragma unroll
                        for (int ks = 0; ks < 4; ++ks) z[g][tb] = __builtin_amdgcn_mfma_f32_32x32x16_bf16(*(const LRU2_LAS bf16x8*)(tile + (32 * tb + r32) * TS + (16 * ks + 8 * hi) * 2), *(const LRU2_LAS bf16x8*)(lds + LDS_BF + ((g * 4 + ks) * 2 + hi) * 512 + r32 * 16), z[g][tb], 0, 0, 0); }
#pragma unroll
                for (int tb = 0; tb < 2; ++tb)
#pragma unroll
                    for (int r = 0; r < 16; ++r) {
                        const float rg = __builtin_amdgcn_rcpf(1.f + __builtin_amdgcn_exp2f(-(z[0][tb][r] + br) * L2E));
                        const float ig = __builtin_amdgcn_rcpf(1.f + __builtin_amdgcn_exp2f(-(z[1][tb][r] + bi) * L2E));
                        const float a = __builtin_amdgcn_exp2f(-rg * sp);
                        const float mult = __builtin_amdgcn_sqrtf(fabsf(1.f - a * a));
                        z[0][tb][r] = a; z[1][tb][r] = mult * ig * bf2f(*(const LRU2_LAS unsigned short*)(tile + (32 * tb + crow(r, hi)) * TS + (32 * nb + r32) * 2));
                    }
                __builtin_amdgcn_sched_barrier(0);
            }
            float Ao[8], Bo[8], Ax[8], Bx[8];
            if (valid) {
#pragma unroll
                for (int q = 0; q < 8; ++q) { const int tb = q >> 2, rb = 4 * (q & 3);
                    const float a0 = z[0][tb][rb], a1 = z[0][tb][rb + 1], a2 = z[0][tb][rb + 2], a3 = z[0][tb][rb + 3];
                    const float b0 = z[1][tb][rb], b1 = z[1][tb][rb + 1], b2 = z[1][tb][rb + 2], b3 = z[1][tb][rb + 3];
                    Ao[q] = (a0 * a1) * (a2 * a3);
                    Bo[q] = dir == 0 ? ((b0 * a1 + b1) * a2 + b2) * a3 + b3 : ((b3 * a2 + b2) * a1 + b1) * a0 + b0;
                    Ax[q] = __shfl_xor(Ao[q], 32); Bx[q] = __shfl_xor(Bo[q], 32); }
                float c = 0.f;
                if (dir == 0) {
#pragma unroll
                    for (int q = 0; q < 8; ++q) { const float Ae = hi ? Ax[q] : Ao[q], Be = hi ? Bx[q] : Bo[q], Aod = hi ? Ao[q] : Ax[q], Bod = hi ? Bo[q] : Bx[q];
                        c = Aod * (Ae * c + Be) + Bod; atot *= Ao[q] * Ax[q]; }
                } else {
#pragma unroll
                    for (int q = 7; q >= 0; --q) { const float Ae = hi ? Ax[q] : Ao[q], Be = hi ? Bx[q] : Bo[q], Aod = hi ? Ao[q] : Ax[q], Bod = hi ? Bo[q] : Bx[q];
                        c = Ae * (Aod * c + Bod) + Be; atot *= Ao[q] * Ax[q]; }
                }
                cend = c;
            }
            if (hi == 0) comp[((rd & 1) * 8 + k) * 32 + r32] = (f32x2){atot, cend};
            __syncthreads();
            float cin = cround, call = cround;
#pragma unroll
            for (int k2 = 0; k2 < 8; ++k2) { const f32x2 cc = comp[((rd & 1) * 8 + k2) * 32 + r32]; call = cc.x * call + cc.y; if (k2 < k) cin = call; }
            cround = call;
            if (valid) {
                float c = cin;
                if (dir == 0) {
#pragma unroll
                    for (int q = 0; q < 8; ++q) { const float Ae = hi ? Ax[q] : Ao[q], Be = hi ? Bx[q] : Bo[q], Aod = hi ? Ao[q] : Ax[q], Bod = hi ? Bo[q] : Bx[q];
                        const float c1 = Ae * c + Be; cst[q] = hi ? c1 : c; c = Aod * c1 + Bod; }
                } else {
#pragma unroll
                    for (int q = 7; q >= 0; --q) { const float Ae = hi ? Ax[q] : Ao[q], Be = hi ? Bx[q] : Bo[q], Aod = hi ? Ao[q] : Ax[q], Bod = hi ? Bo[q] : Bx[q];
                        const float c1 = Aod * c + Bod; cst[q] = hi ? c : c1; c = Ae * c1 + Be; }
                }
                if (!isctx) {
#pragma unroll
                    for (int q = 0; q < 8; ++q) { const int tb = q >> 2, rb = 4 * (q & 3); float hcur = cst[q];
                        if (dir == 0) {
#pragma unroll
                            for (int e = 0; e < 4; ++e) { hcur = z[0][tb][rb + e] * hcur + z[1][tb][rb + e]; z[1][tb][rb + e] = hcur; }
                        } else {
#pragma unroll
                            for (int e = 3; e >= 0; --e) { hcur = z[0][tb][rb + e] * hcur + z[1][tb][rb + e]; z[1][tb][rb + e] = hcur; }
                        } }
                    const size_t row0 = rowbase + s0;
                    const int hoff = hi * 4 * 512 + chn, aoff = hi * 4 * 1024 + 512 + chn;
                    if (dir == 0) {
#pragma unroll
                        for (int tb = 0; tb < 2; ++tb)
#pragma unroll
                            for (int r = 0; r < 16; ++r) { const size_t rowu = row0 + 32 * tb + 8 * (r >> 2) + (r & 3); (HS + rowu * 512)[hoff] = z[1][tb][r]; }
                    } else {
#pragma unroll
                        for (int tb = 0; tb < 2; ++tb) { float hf[16]; unsigned short gg[16];
#pragma unroll
                            for (int r = 0; r < 16; ++r) { const size_t rowu = row0 + 32 * tb + 8 * (r >> 2) + (r & 3); hf[r] = (HS + rowu * 512)[hoff]; gg[r] = (G + rowu * 512)[hoff]; }
#pragma unroll
                            for (int r = 0; r < 16; ++r) { const size_t rowu = row0 + 32 * tb + 8 * (r >> 2) + (r & 3); const float hsum = z[1][tb][r] + hf[r];
                                const float g = bf2f(gg[r]); const float t = 1.5957691216057308f * (g + 0.044715f * g * g * g);
                                const float y = hsum * g * __builtin_amdgcn_rcpf(1.f + __builtin_amdgcn_exp2f(-t * L2E));
                                (AO + rowu * 1024)[aoff] = f2bf(y); } }
                    }
                }
            }
        }
#undef LRU2_LOADU
#undef LRU2_CHUNK
        asm volatile("s_waitcnt vmcnt(0)" ::: "memory");
        __syncthreads();
    }
}
}

#define GAS __attribute__((address_space(1)))
#define LAS __attribute__((address_space(3)))
typedef unsigned short bf16;
typedef unsigned v4u __attribute__((ext_vector_type(4)));
typedef float f32x4 __attribute__((ext_vector_type(4)));
typedef short bf16x8 __attribute__((ext_vector_type(8)));
typedef GAS unsigned gu32;
typedef GAS unsigned long long gu64;
#define RLX_AGENT __ATOMIC_RELAXED, __HIP_MEMORY_SCOPE_AGENT
#define LDS_WAIT() asm volatile("s_waitcnt lgkmcnt(0)" ::: "memory")
#define VM_WAIT() asm volatile("s_waitcnt vmcnt(0)" ::: "memory")
__device__ __forceinline__ unsigned long long rt() { return __builtin_amdgcn_s_memrealtime(); }
__device__ __forceinline__ unsigned f2bf(float f) { unsigned u = __builtin_bit_cast(unsigned, f); return (u + 0x7fffu + ((u >> 16) & 1u)) >> 16; }
__device__ __forceinline__ unsigned pk2(float lo, float hi) { return f2bf(lo) | (f2bf(hi) << 16); }

#define XB_TMO      128
#define XB_XCNT(j)  (256  + 64 * (j))
#define XB_XSUB(j)  (1280 + 64 * (j))
#define XB_XGEN(j)  (2304 + 64 * (j))
#define XB_TOP      3328
#define XB_TOPGEN   3392
#define XCD_BAR_WORDS 3456
#define XB_SPIN_CAP (1u << 18)

__device__ __forceinline__ unsigned xb_ld(unsigned* p)              { return __hip_atomic_load(p, __ATOMIC_RELAXED, __HIP_MEMORY_SCOPE_AGENT); }
__device__ __forceinline__ unsigned xb_add(unsigned* p, unsigned v) { return __hip_atomic_fetch_add(p, v, __ATOMIC_RELAXED, __HIP_MEMORY_SCOPE_AGENT); }
__device__ __forceinline__ unsigned xb_xcc_id() { return (unsigned)__builtin_amdgcn_s_getreg((3 << 11) | 20) & 0xFu; }
#define XB_SPIN(cond, bar) do { unsigned _sp = 0; while (cond) { __builtin_amdgcn_s_sleep(1); \
    if ((++_sp & 255u) == 0u) { if (xb_ld(&(bar)[XB_TMO])) break; if (_sp > XB_SPIN_CAP) { atomicAdd(&(bar)[XB_TMO], 1u); break; } } } } while (0)

struct XcdBarrier {
    unsigned* bar; unsigned x;
    volatile LAS unsigned* st;
};

__device__ __forceinline__ XcdBarrier xcd_barrier_post(unsigned* bar, volatile LAS unsigned* st) {
    XcdBarrier b; b.bar = bar; b.x = xb_xcc_id(); b.st = st;
    if (threadIdx.x == 0) (void)xb_add(&bar[XB_XCNT(b.x)], 1u);
    return b;
}
__device__ __forceinline__ void xcd_barrier_complete(unsigned* bar, unsigned x, unsigned& nloc, unsigned& nx) {
    const unsigned G = gridDim.x * gridDim.y * gridDim.z;
    unsigned sum, cnt, mine, sp = 0u;
    for (;;) {
        sum = 0u; cnt = 0u; mine = 0u;
#pragma unroll
        for (unsigned j = 0; j < 16; ++j) { const unsigned c = xb_ld(&bar[XB_XCNT(j)]); sum += c; cnt += (c > 0u) ? 1u : 0u; mine = (j == x) ? c : mine; }
        if (sum == G) break;
        __builtin_amdgcn_s_sleep(1);
        if ((++sp & 255u) == 0u) { if (xb_ld(&bar[XB_TMO])) break; if (sp > XB_SPIN_CAP) { atomicAdd(&bar[XB_TMO], 1u); break; } }
    }
    nloc = mine > 0u ? mine : 1u; nx = cnt > 0u ? cnt : 1u;
}

__device__ __forceinline__ void xcd_barrier(const XcdBarrier& b) {
    asm volatile("s_waitcnt vmcnt(0)" ::: "memory");
    __syncthreads();
    if (threadIdx.x == 0) {
        unsigned* bar = b.bar;
        __builtin_amdgcn_s_waitcnt(0);
        unsigned nloc = b.st[0], nx = b.st[1];
        if (nloc == 0u) { xcd_barrier_complete(bar, b.x, nloc, nx); b.st[0] = nloc; b.st[1] = nx; }
        const unsigned old = xb_add(&bar[XB_XSUB(b.x)], 1u);
        const unsigned gen = old / nloc;
        if (old + 1u == (gen + 1u) * nloc) {
            __builtin_amdgcn_fence(__ATOMIC_RELEASE, "agent");
            asm volatile("s_waitcnt vmcnt(0)" ::: "memory");
            const unsigned og = xb_add(&bar[XB_TOP], 1u);
            const unsigned tg = og / nx;
            if (og + 1u == (tg + 1u) * nx) xb_add(&bar[XB_TOPGEN], 1u);
            else XB_SPIN(xb_ld(&bar[XB_TOPGEN]) == tg, bar);
            __builtin_amdgcn_fence(__ATOMIC_ACQUIRE, "agent");
            xb_add(&bar[XB_XGEN(b.x)], 1u);
            asm volatile("s_waitcnt vmcnt(0)" ::: "memory");
        } else {
            XB_SPIN(xb_ld(&bar[XB_XGEN(b.x)]) == gen, bar);
            __builtin_amdgcn_fence(__ATOMIC_ACQUIRE, "agent");
            asm volatile("s_waitcnt vmcnt(0)" ::: "memory");
        }
    }
    __syncthreads();
}

constexpr int NWAVES = 8;
#ifndef MK_N_LAUNCHES
#define MK_N_LAUNCHES 1
#endif
#ifndef X1_BF16
#define X1_BF16 (DBG ? 0 : 1)
#endif
constexpr int PER_PHASE = 10;
constexpr int N_LAUNCHES = MK_N_LAUNCHES;
#ifndef REPEAT_MASK
#define REPEAT_MASK 0
#endif
#ifndef TSTAMP
#define TSTAMP -1
#endif
#ifndef TS_UNIT
#define TS_UNIT 100.0f
#endif
#ifndef FP8_FFN
#define FP8_FFN 0
#endif
constexpr bool F8_IN = (FP8_FFN & 1) != 0, F8_OUT = (FP8_FFN & 2) != 0;
constexpr float W1_SCALE = 32.f, W2_SCALE = 64.f, HID_SCALE = 8.f;
#ifndef ATT_FORCE_FALLBACK
#define ATT_FORCE_FALLBACK 0
#endif
constexpr int DM = 1024, NBATCH = 16, SEQ = 4096, CTXL = 256, MLAT = NBATCH * SEQ, MCTX = NBATCH * CTXL, MALL = MLAT + MCTX, INW = 2560, FH = 2816;
constexpr float LN_EPS = 1e-6f, DN_ALPHA = 1.189207115002721f;
constexpr size_t MiB = 1u << 20;
constexpr size_t WS_CTL = 0, CTL_ZERO_BYTES = 64 * 1024;
constexpr size_t WS_MOD = 1 * MiB, WS_ROPEC = WS_MOD + 512 * 1024, WS_ROPES = WS_ROPEC + 4096, WS_SP8 = WS_ROPES + 4096, WS_LAM = WS_SP8 + 4096;
constexpr size_t WS_WIN = 2 * MiB, WS_WOUT = 8 * MiB, WS_W1 = 10 * MiB, WS_W2 = 21 * MiB, WS_WG = 27 * MiB, WS_SUM = 28 * MiB;
constexpr size_t WS_XN = 40 * MiB, WS_Q = 176 * MiB, WS_K = 240 * MiB, WS_V = 308 * MiB, WS_U = 376 * MiB, WS_G = 444 * MiB, WS_AO = 508 * MiB;
constexpr size_t WS_Y = (DBG ? 704 : 176) * MiB, WS_HID = 176 * MiB, WS_F = 528 * MiB, WS_VT8 = 636 * MiB, WS_PARK = 670 * MiB, WS_HS = 704 * MiB, WS_END = 832 * MiB;
static_assert(WS_SUM + (size_t)16 * 68 * 2 * 512 * 8 <= WS_XN && WS_XN + (size_t)MALL * DM * 2 <= WS_Q && WS_HID + (size_t)MLAT * FH * 2 <= WS_F, "d_ws map");
constexpr int CW_BAR = 1024;
constexpr int RING_BYTES = 131072, LDSCTL_OFF = RING_BYTES, MISC_OFF = LDSCTL_OFF + 320, ROPE_OFF = RING_BYTES + 1024, LDS_BYTES = 147456;
static_assert(att::LDS_END <= RING_BYTES && lru2::LDS_END <= RING_BYTES, "LDS map");

struct Frame {
    LAS unsigned char* lds; volatile LAS unsigned* MISC; gu32* ctl;
    int tid, lane, wave, vcu, G;
};
__device__ __forceinline__ float wave_sum(float v) {
#pragma unroll
    for (int o = 1; o < 64; o <<= 1) v += __shfl_xor(v, o);
    return v;
}
template <class DEST>
__device__ __forceinline__ void p0_transpose_item(const float* W, int K, int N, bf16* WT, LAS float* scr, int item, int lane, DEST dest) {
    const int nblk = N / 32, kb = item / nblk, nb = item % nblk, k0 = 64 * kb, n0 = 32 * nb;
#pragma unroll 8
    for (int i = 0; i < 32; ++i) { const int kk = 2 * i + (lane >> 5); scr[kk * 33 + (lane & 31)] = W[(size_t)(k0 + kk) * N + n0 + (lane & 31)]; }
    LDS_WAIT(); asm volatile("" ::: "memory");
    const int c = lane & 7;
#pragma unroll
    for (int j = 0; j < 4; ++j) { const int n = (lane >> 3) + 8 * j; const LAS float* s = scr + (8 * c) * 33 + n;
        v4u o; o.x = pk2(s[0 * 33], s[1 * 33]); o.y = pk2(s[2 * 33], s[3 * 33]); o.z = pk2(s[4 * 33], s[5 * 33]); o.w = pk2(s[6 * 33], s[7 * 33]);
        *(GAS v4u*)(WT + (size_t)dest(n0 + n) * K + k0 + 8 * c) = o; }
    LDS_WAIT(); asm volatile("" ::: "memory");
}
template <class DEST>
__device__ __forceinline__ void p0_transpose_item8(const float* W, int K, int N, unsigned char* WT, LAS float* scr, int item, int lane, DEST dest, float scale) {
    const int nblk = N / 32, kb = item / nblk, nb = item % nblk, k0 = 64 * kb, n0 = 32 * nb;
#pragma unroll 8
    for (int i = 0; i < 32; ++i) { const int kk = 2 * i + (lane >> 5); scr[kk * 33 + (lane & 31)] = W[(size_t)(k0 + kk) * N + n0 + (lane & 31)] * scale; }
    LDS_WAIT(); asm volatile("" ::: "memory");
    const int c = lane & 7; typedef unsigned u32x2v __attribute__((ext_vector_type(2)));
#pragma unroll
    for (int j = 0; j < 4; ++j) { const int n = (lane >> 3) + 8 * j; const LAS float* s = scr + (8 * c) * 33 + n;
        u32x2v o; o.x = pg8::pk_fp8x4(s[0 * 33], s[1 * 33], s[2 * 33], s[3 * 33]); o.y = pg8::pk_fp8x4(s[4 * 33], s[5 * 33], s[6 * 33], s[7 * 33]);
        *(GAS u32x2v*)(WT + (size_t)dest(n0 + n) * K + k0 + 8 * c) = o; }
    LDS_WAIT(); asm volatile("" ::: "memory");
}
struct DestId { __device__ __forceinline__ int operator()(int n) const { return n; } };
struct DestWin { __device__ __forceinline__ int operator()(int n) const {
    if (n >= 1536) return n - 512; if (n >= 1024) return n + 1024; const int d = n & 63; return (n & ~63) + (d & 32) + ((d >> 2) & 3) * 8 + ((d >> 4) & 1) * 4 + (d & 3); } };
struct DestW1 { __device__ __forceinline__ int operator()(int n) const { const int hb = n >= FH, l = hb ? n - FH : n; return (l >> 7) * 256 + hb * 128 + (l & 127); } };

__device__ __forceinline__ void p0_mod_task(int cgp, const float* c, const float* cctx, const float* w_ada, const float* b_ada, float* MOD, LAS unsigned char* lds, int tid, int wave, int lane) {
    LAS float* sc = (LAS float*)lds; LAS float* red = (LAS float*)(lds + 81920);
    for (int idx = tid; idx < 17 * 1024; idx += 512) { const int r = idx >> 10, k = idx & 1023; const float v = r < 16 ? c[r * 1024 + k] : cctx[k]; sc[k * 20 + r] = v / (1.f + __expf(-v)); }
    __syncthreads();
    float acc[17];
#pragma unroll
    for (int r = 0; r < 17; ++r) acc[r] = 0.f;
    const int n = 64 * cgp + lane;
#pragma unroll 16
    for (int kk = 0; kk < 128; ++kk) { const int k = wave * 128 + kk; const float wv = __builtin_nontemporal_load(w_ada + (size_t)k * 6144 + n);
        const LAS f32x4* sp = (const LAS f32x4*)(sc + k * 20); const f32x4 s0 = sp[0], s1 = sp[1], s2 = sp[2], s3 = sp[3]; const float s16 = sc[k * 20 + 16];
        acc[0] += s0.x * wv; acc[1] += s0.y * wv; acc[2] += s0.z * wv; acc[3] += s0.w * wv; acc[4] += s1.x * wv; acc[5] += s1.y * wv; acc[6] += s1.z * wv; acc[7] += s1.w * wv;
        acc[8] += s2.x * wv; acc[9] += s2.y * wv; acc[10] += s2.z * wv; acc[11] += s2.w * wv; acc[12] += s3.x * wv; acc[13] += s3.y * wv; acc[14] += s3.z * wv; acc[15] += s3.w * wv; acc[16] += s16 * wv; }
#pragma unroll
    for (int r = 0; r < 17; ++r) red[(wave * 17 + r) * 64 + lane] = acc[r];
    __syncthreads();
    for (int idx = tid; idx < 17 * 64; idx += 512) { const int r = idx >> 6, l = idx & 63; float s = b_ada[64 * cgp + l];
#pragma unroll
        for (int w2 = 0; w2 < 8; ++w2) s += red[(w2 * 17 + r) * 64 + l];
        MOD[r * 6144 + 64 * cgp + l] = s; }
    __syncthreads();
}
__device__ __forceinline__ void ln_stats(f32x4 (&v)[4], float& mean, float& rstd) {
    float s = 0.f;
#pragma unroll
    for (int j = 0; j < 4; ++j) s += (v[j].x + v[j].y) + (v[j].z + v[j].w);
    mean = wave_sum(s) * (1.f / DM); float s2 = 0.f;
#pragma unroll
    for (int j = 0; j < 4; ++j) { v[j] = v[j] - mean; s2 += (v[j].x * v[j].x + v[j].y * v[j].y) + (v[j].z * v[j].z + v[j].w * v[j].w); }
    rstd = 1.f / sqrtf(wave_sum(s2) * (1.f / DM) + LN_EPS);
}
__device__ __forceinline__ void st_bf16x4(bf16* p, f32x4 v) { *(GAS unsigned long long*)p = (unsigned long long)pk2(v.x, v.y) | ((unsigned long long)pk2(v.z, v.w) << 32); }
__device__ __forceinline__ f32x4 ld_bf16x4(const bf16* p) { const unsigned long long w = *(const GAS unsigned long long*)p; const unsigned lo = (unsigned)w, hi = (unsigned)(w >> 32);
    return (f32x4){__uint_as_float(lo << 16), __uint_as_float(lo & 0xffff0000u), __uint_as_float(hi << 16), __uint_as_float(hi & 0xffff0000u)}; }
__device__ __forceinline__ void ln_stats2(f32x4 (&v)[2][4], float (&mean)[2], float (&rstd)[2]) {
    float s[2];
#pragma unroll
    for (int q = 0; q < 2; ++q) { s[q] = 0.f;
#pragma unroll
        for (int j = 0; j < 4; ++j) s[q] += (v[q][j].x + v[q][j].y) + (v[q][j].z + v[q][j].w); }
#pragma unroll
    for (int o = 1; o < 64; o <<= 1) { s[0] += __shfl_xor(s[0], o); s[1] += __shfl_xor(s[1], o); }
    float s2[2];
#pragma unroll
    for (int q = 0; q < 2; ++q) { mean[q] = s[q] * (1.f / DM); s2[q] = 0.f;
#pragma unroll
        for (int j = 0; j < 4; ++j) { v[q][j] = v[q][j] - mean[q]; s2[q] += (v[q][j].x * v[q][j].x + v[q][j].y * v[q][j].y) + (v[q][j].z * v[q][j].z + v[q][j].w * v[q][j].w); } }
#pragma unroll
    for (int o = 1; o < 64; o <<= 1) { s2[0] += __shfl_xor(s2[0], o); s2[1] += __shfl_xor(s2[1], o); }
#pragma unroll
    for (int q = 0; q < 2; ++q) rstd[q] = 1.f / sqrtf(s2[q] * (1.f / DM) + LN_EPS);
}
__device__ __forceinline__ void row_hmod2(const float* const (&xrow)[2], const float* const (&md)[2], bf16* const (&orow)[2], int lane) {
    f32x4 v[2][4]; float mean[2], rstd[2];
#pragma unroll
    for (int q = 0; q < 2; ++q)
#pragma unroll
        for (int j = 0; j < 4; ++j) v[q][j] = __builtin_nontemporal_load((const GAS f32x4*)(xrow[q] + 4 * lane + 256 * j));
    ln_stats2(v, mean, rstd);
#pragma unroll
    for (int q = 0; q < 2; ++q)
#pragma unroll
        for (int j = 0; j < 4; ++j) { const int c = 4 * lane + 256 * j; const f32x4 a = *(const f32x4*)(md[q] + 1024 + c), s = *(const f32x4*)(md[q] + c); st_bf16x4(orow[q] + c, v[q][j] * rstd[q] * (a + 1.f) + s); }
}
__device__ __forceinline__ void row_ln1_2(const float* const (&xrow)[2], const bf16* const (&yrow)[2], const float* const (&md)[2], const float* lng, const float* lnb, float* const (&x1row)[2], bf16* const (&h2row)[2], int lane) {
    f32x4 v[2][4]; float mean[2], rstd[2];
#pragma unroll
    for (int q = 0; q < 2; ++q)
#pragma unroll
        for (int j = 0; j < 4; ++j) { const int c = 4 * lane + 256 * j; v[q][j] = __builtin_nontemporal_load((const GAS f32x4*)(xrow[q] + c)) * DN_ALPHA + *(const f32x4*)(md[q] + 2048 + c) * ld_bf16x4(yrow[q] + c); }
    ln_stats2(v, mean, rstd);
#pragma unroll
    for (int q = 0; q < 2; ++q)
#pragma unroll
        for (int j = 0; j < 4; ++j) { const int c = 4 * lane + 256 * j; v[q][j] = v[q][j] * rstd[q] * *(const f32x4*)(lng + c) + *(const f32x4*)(lnb + c); *(GAS f32x4*)(x1row[q] + c) = v[q][j]; }
    ln_stats2(v, mean, rstd);
#pragma unroll
    for (int q = 0; q < 2; ++q)
#pragma unroll
        for (int j = 0; j < 4; ++j) { const int c = 4 * lane + 256 * j; const f32x4 hv = v[q][j] * rstd[q] * (*(const f32x4*)(md[q] + 4096 + c) + 1.f) + *(const f32x4*)(md[q] + 3072 + c);
            if (F8_IN) *(GAS unsigned*)((unsigned char*)h2row[q] + c) = pg8::pk_fp8x4(hv.x, hv.y, hv.z, hv.w); else st_bf16x4(h2row[q] + c, hv); }
}
struct Ln1Raw { f32x4 x[2][4]; unsigned long long y[2][4]; };
__device__ __forceinline__ void ln1_load(Ln1Raw& r, const float* x, const bf16* Y, int m, int m2, int lane) {
#pragma unroll
    for (int j = 0; j < 4; ++j) { const int c = 4 * lane + 256 * j;
        r.x[0][j] = __builtin_nontemporal_load((const GAS f32x4*)(x + (size_t)m * DM + c)); r.x[1][j] = __builtin_nontemporal_load((const GAS f32x4*)(x + (size_t)m2 * DM + c));
        r.y[0][j] = *(const GAS unsigned long long*)(Y + (size_t)m * DM + c); r.y[1][j] = *(const GAS unsigned long long*)(Y + (size_t)m2 * DM + c); }
}
__device__ __forceinline__ f32x4 bf16x4_to_f32(unsigned long long w) { const unsigned lo = (unsigned)w, hi = (unsigned)(w >> 32);
    return (f32x4){__uint_as_float(lo << 16), __uint_as_float(lo & 0xffff0000u), __uint_as_float(hi << 16), __uint_as_float(hi & 0xffff0000u)}; }
__device__ __forceinline__ void ln1_process(const Ln1Raw& r, const float* const (&md)[2], const float* lng, const float* lnb, float* const (&x1row)[2], bf16* const (&h2row)[2], int lane) {
    f32x4 v[2][4]; float mean[2], rstd[2];
#pragma unroll
    for (int q = 0; q < 2; ++q)
#pragma unroll
        for (int j = 0; j < 4; ++j) { const int c = 4 * lane + 256 * j; v[q][j] = r.x[q][j] * DN_ALPHA + *(const f32x4*)(md[q] + 2048 + c) * bf16x4_to_f32(r.y[q][j]); }
    ln_stats2(v, mean, rstd);
#pragma unroll
    for (int q = 0; q < 2; ++q)
#pragma unroll
        for (int j = 0; j < 4; ++j) { const int c = 4 * lane + 256 * j; v[q][j] = v[q][j] * rstd[q] * *(const f32x4*)(lng + c) + *(const f32x4*)(lnb + c); if (X1_BF16) st_bf16x4((bf16*)x1row[q] + c, v[q][j]); else *(GAS f32x4*)(x1row[q] + c) = v[q][j]; }
    ln_stats2(v, mean, rstd);
#pragma unroll
    for (int q = 0; q < 2; ++q)
#pragma unroll
        for (int j = 0; j < 4; ++j) { const int c = 4 * lane + 256 * j; const f32x4 hv = v[q][j] * rstd[q] * (*(const f32x4*)(md[q] + 4096 + c) + 1.f) + *(const f32x4*)(md[q] + 3072 + c);
            if (F8_IN) *(GAS unsigned*)((unsigned char*)h2row[q] + c) = pg8::pk_fp8x4(hv.x, hv.y, hv.z, hv.w); else st_bf16x4(h2row[q] + c, hv); }
}
__device__ __forceinline__ void row_ln2_2(float* const (&orow)[2], const bf16* const (&x1b)[2], const bf16* const (&frow)[2], const float* const (&md)[2], const float* lng, const float* lnb, int lane) {
    f32x4 v[2][4]; float mean[2], rstd[2];
#pragma unroll
    for (int q = 0; q < 2; ++q)
#pragma unroll
        for (int j = 0; j < 4; ++j) { const int c = 4 * lane + 256 * j; v[q][j] = (X1_BF16 ? ld_bf16x4(x1b[q] + c) : *(const GAS f32x4*)(orow[q] + c)) * DN_ALPHA + *(const f32x4*)(md[q] + 5120 + c) * ld_bf16x4(frow[q] + c); }
    ln_stats2(v, mean, rstd);
#pragma unroll
    for (int q = 0; q < 2; ++q)
#pragma unroll
        for (int j = 0; j < 4; ++j) { const int c = 4 * lane + 256 * j; __builtin_nontemporal_store(v[q][j] * rstd[q] * *(const f32x4*)(lng + c) + *(const f32x4*)(lnb + c), (GAS f32x4*)(orow[q] + c)); }
}

struct Ln2Raw { f32x4 x[2][4]; unsigned long long xb[2][4]; unsigned long long f[2][4]; };
__device__ __forceinline__ void ln2_load(Ln2Raw& r, const float* x1f, const bf16* x1b, const bf16* Fm, int m, int m2, int lane) {
#pragma unroll
    for (int j = 0; j < 4; ++j) { const int c = 4 * lane + 256 * j;
        if (X1_BF16) { r.xb[0][j] = __builtin_nontemporal_load((const GAS unsigned long long*)(x1b + (size_t)m * DM + c)); r.xb[1][j] = __builtin_nontemporal_load((const GAS unsigned long long*)(x1b + (size_t)m2 * DM + c)); }
        else { r.x[0][j] = *(const GAS f32x4*)(x1f + (size_t)m * DM + c); r.x[1][j] = *(const GAS f32x4*)(x1f + (size_t)m2 * DM + c); }
        r.f[0][j] = __builtin_nontemporal_load((const GAS unsigned long long*)(Fm + (size_t)m * DM + c)); r.f[1][j] = __builtin_nontemporal_load((const GAS unsigned long long*)(Fm + (size_t)m2 * DM + c)); }
}
__device__ __forceinline__ void ln2_process(const Ln2Raw& r, float* const (&orow)[2], const float* const (&md)[2], const float* lng, const float* lnb, int lane) {
    f32x4 v[2][4]; float mean[2], rstd[2];
#pragma unroll
    for (int q = 0; q < 2; ++q)
#pragma unroll
        for (int j = 0; j < 4; ++j) { const int c = 4 * lane + 256 * j; v[q][j] = (X1_BF16 ? bf16x4_to_f32(r.xb[q][j]) : r.x[q][j]) * DN_ALPHA + *(const f32x4*)(md[q] + 5120 + c) * bf16x4_to_f32(r.f[q][j]); }
    ln_stats2(v, mean, rstd);
#pragma unroll
    for (int q = 0; q < 2; ++q)
#pragma unroll
        for (int j = 0; j < 4; ++j) { const int c = 4 * lane + 256 * j; __builtin_nontemporal_store(v[q][j] * rstd[q] * *(const f32x4*)(lng + c) + *(const f32x4*)(lnb + c), (GAS f32x4*)(orow[q] + c)); }
}
struct HmRaw { f32x4 x[2][4]; };
__device__ __forceinline__ void hm_load(HmRaw& r, const float* xa, const float* xb, int lane) {
#pragma unroll
    for (int j = 0; j < 4; ++j) { r.x[0][j] = __builtin_nontemporal_load((const GAS f32x4*)(xa + 4 * lane + 256 * j)); r.x[1][j] = __builtin_nontemporal_load((const GAS f32x4*)(xb + 4 * lane + 256 * j)); }
}
__device__ __forceinline__ void hm_process(const HmRaw& r, const float* const (&md)[2], bf16* const (&orow)[2], int lane) {
    f32x4 v[2][4]; float mean[2], rstd[2];
#pragma unroll
    for (int q = 0; q < 2; ++q)
#pragma unroll
        for (int j = 0; j < 4; ++j) v[q][j] = r.x[q][j];
    ln_stats2(v, mean, rstd);
#pragma unroll
    for (int q = 0; q < 2; ++q)
#pragma unroll
        for (int j = 0; j < 4; ++j) { const int c = 4 * lane + 256 * j; const f32x4 a = *(const f32x4*)(md[q] + 1024 + c), s2 = *(const f32x4*)(md[q] + c); st_bf16x4(orow[q] + c, v[q][j] * rstd[q] * (a + 1.f) + s2); }
}
__device__ __forceinline__ void ln1_process_l(const Ln1Raw& r, const LAS f32x4* pv, bf16* const (&x1row)[2], float* const (&x1rowf)[2], bf16* const (&h2row)[2], int lane) {
    f32x4 v[2][4]; float mean[2], rstd[2];
#pragma unroll
    for (int q = 0; q < 2; ++q)
#pragma unroll
        for (int j = 0; j < 4; ++j) v[q][j] = r.x[q][j] * DN_ALPHA + pv[lane + 64 * j] * bf16x4_to_f32(r.y[q][j]);
    ln_stats2(v, mean, rstd);
#pragma unroll
    for (int q = 0; q < 2; ++q)
#pragma unroll
        for (int j = 0; j < 4; ++j) { const int c = 4 * lane + 256 * j; v[q][j] = v[q][j] * rstd[q] * pv[768 + lane + 64 * j] + pv[1024 + lane + 64 * j]; if (X1_BF16) st_bf16x4(x1row[q] + c, v[q][j]); else *(GAS f32x4*)(x1rowf[q] + c) = v[q][j]; }
    ln_stats2(v, mean, rstd);
#pragma unroll
    for (int q = 0; q < 2; ++q)
#pragma unroll
        for (int j = 0; j < 4; ++j) { const int c = 4 * lane + 256 * j; const f32x4 hv = v[q][j] * rstd[q] * (pv[512 + lane + 64 * j] + 1.f) + pv[256 + lane + 64 * j];
            if (F8_IN) *(GAS unsigned*)((unsigned char*)h2row[q] + c) = pg8::pk_fp8x4(hv.x, hv.y, hv.z, hv.w); else st_bf16x4(h2row[q] + c, hv); }
}
__device__ __forceinline__ void ln2_process_l(const Ln2Raw& r, const LAS f32x4* pv, float* const (&orow)[2], int lane) {
    f32x4 v[2][4]; float mean[2], rstd[2];
#pragma unroll
    for (int q = 0; q < 2; ++q)
#pragma unroll
        for (int j = 0; j < 4; ++j) v[q][j] = (X1_BF16 ? bf16x4_to_f32(r.xb[q][j]) : r.x[q][j]) * DN_ALPHA + pv[lane + 64 * j] * bf16x4_to_f32(r.f[q][j]);
    ln_stats2(v, mean, rstd);
#pragma unroll
    for (int q = 0; q < 2; ++q)
#pragma unroll
        for (int j = 0; j < 4; ++j) { const int c = 4 * lane + 256 * j; __builtin_nontemporal_store(v[q][j] * rstd[q] * pv[256 + lane + 64 * j] + pv[512 + lane + 64 * j], (GAS f32x4*)(orow[q] + c)); }
}
__device__ __forceinline__ void hm_process_l(const HmRaw& r, const LAS f32x4* pv, bf16* const (&orow)[2], int lane) {
    f32x4 v[2][4]; float mean[2], rstd[2];
#pragma unroll
    for (int q = 0; q < 2; ++q)
#pragma unroll
        for (int j = 0; j < 4; ++j) v[q][j] = r.x[q][j];
    ln_stats2(v, mean, rstd);
#pragma unroll
    for (int q = 0; q < 2; ++q)
#pragma unroll
        for (int j = 0; j < 4; ++j) { const int c = 4 * lane + 256 * j; st_bf16x4(orow[q] + c, v[q][j] * rstd[q] * (pv[256 + lane + 64 * j] + 1.f) + pv[lane + 64 * j]); }
}
__device__ __forceinline__ void stage_vecs(LAS f32x4* pv, const float* const* src, int nv, int tid) {
    for (int i = tid; i < nv * 256; i += NWAVES * 64) pv[i] = *(const f32x4*)(src[i >> 8] + 4 * (i & 255));
    __syncthreads();
}
struct Args { const float* in[22]; float* out; unsigned char* ws; int ph_lo, ph_hi, li, pad; };
__global__ void __launch_bounds__(NWAVES * 64, 2) mk_fwd(Args args) {
    extern __shared__ __attribute__((aligned(16))) unsigned char lds[];
    Frame F;
    F.lds = (LAS unsigned char*)lds; F.MISC = (volatile LAS unsigned*)(F.lds + MISC_OFF);
    F.tid = threadIdx.x; F.lane = F.tid & 63; F.wave = __builtin_amdgcn_readfirstlane(F.tid >> 6);
    F.G = gridDim.x; { const int bx = blockIdx.x; F.vcu = (F.G % 8 == 0) ? (bx % 8) * (F.G / 8) + bx / 8 : bx; }
    unsigned char* ws = args.ws;
    F.ctl = (gu32*)(ws + WS_CTL);
    const float* x = args.in[0]; const float* cin = args.in[1]; const float* ctx = args.in[2]; const float* cctx = args.in[3];
    float* MOD = (float*)(ws + WS_MOD); float* ROPEC = (float*)(ws + WS_ROPEC); float* ROPES = (float*)(ws + WS_ROPES); float* SP8 = (float*)(ws + WS_SP8); float* LAMP = (float*)(ws + WS_LAM);
    bf16* WinT = (bf16*)(ws + WS_WIN); bf16* WoutT = (bf16*)(ws + WS_WOUT); bf16* W1T = (bf16*)(ws + WS_W1); bf16* W2T = (bf16*)(ws + WS_W2); bf16* WgT = (bf16*)(ws + WS_WG);
        bf16* XN = (bf16*)(ws + WS_XN); bf16* Qb = (bf16*)(ws + WS_Q); bf16* Kb = (bf16*)(ws + WS_K); bf16* Vb = (bf16*)(ws + WS_V); bf16* Ub = (bf16*)(ws + WS_U); bf16* Gb = (bf16*)(ws + WS_G);
    bf16* AO = (bf16*)(ws + WS_AO); bf16* Yb = (bf16*)(ws + WS_Y); bf16* HID = (bf16*)(ws + WS_HID); bf16* Fb = (bf16*)(ws + WS_F); bf16* X1B = (bf16*)(ws + WS_HS);
    for (int u = F.tid; u < (LDS_BYTES - LDSCTL_OFF) / 4; u += NWAVES * 64) ((LAS unsigned*)(F.lds + LDSCTL_OFF))[u] = 0u;
    __syncthreads();
    XcdBarrier bar; bar.bar = (unsigned*)(F.ctl + CW_BAR); bar.x = 0; bar.st = nullptr;
    if (N_LAUNCHES != PER_PHASE) bar = xcd_barrier_post((unsigned*)(F.ctl + CW_BAR), F.MISC + 8);
#define GRID_BAR() do { if (N_LAUNCHES != PER_PHASE) xcd_barrier(bar); } while (0)
    const int lo = args.ph_lo, hi = args.ph_hi;
#define IN(k) (lo <= (k) && (k) < hi)
#define BOTH(k) (IN(k) && IN((k) + 1))
    const int gw = F.vcu * NWAVES + F.wave, NGW = F.G * NWAVES;
    unsigned long long* TS = (unsigned long long*)(ws + WS_CTL + 40960);
#define STAMP(k) do { if (TSTAMP >= 0 && blockIdx.x == 0 && F.tid == 0) TS[k] = __builtin_amdgcn_s_memrealtime(); } while (0)
    STAMP(0);

    if (IN(0)) {
        for (int rep_ = 0; rep_ < 1 + ((REPEAT_MASK >> 0) & 1); ++rep_) {
        if ((int)blockIdx.x < 96) p0_mod_task((int)blockIdx.x, cin, cctx, args.in[4], args.in[5], MOD, F.lds, F.tid, F.wave, F.lane);
        if ((int)blockIdx.x == F.G - 1) {
            for (int i = F.tid; i < 1024; i += 512) { const int pos = i >> 4, f = i & 15; const float inv = powf(10000.f, -(float)f / 16.f); const float ang = (float)pos * inv; ROPEC[i] = cosf(ang); ROPES[i] = sinf(ang); }
            for (int i = F.tid; i < 1024; i += 512) { const float l = args.in[14][i]; const float sp = log1pf(expf(-fabsf(l))) + fmaxf(-l, 0.f); SP8[i] = 8.f * sp * 1.4426950408889634f; }
            if (F.tid == 0) { float a = 0.f, b2 = 0.f; for (int i = 0; i < 64; ++i) { a += args.in[7][i] * args.in[8][i]; b2 += args.in[7][64 + i] * args.in[8][64 + i]; } LAMP[0] = expf(a) - expf(b2) + 0.2f; }
        }
        LAS float* scr = (LAS float*)(F.lds + F.wave * 16384);
        constexpr int I_IN = (DM / 64) * (INW / 32), I_OUT = (DM / 64) * (DM / 32), I_1 = (DM / 64) * (2 * FH / 32), I_2 = (FH / 64) * (DM / 32), I_G = 32 * 2;
        constexpr int NITEMS = I_IN + I_OUT + I_1 + I_2 + I_G;
        const bool modwg = (int)blockIdx.x < 96 && F.G > 96;
        const int gw0 = modwg ? NITEMS : ((F.G > 96 ? (int)blockIdx.x - 96 : (int)blockIdx.x) * NWAVES + F.wave), ngw0 = (F.G > 96 ? F.G - 96 : F.G) * NWAVES;
        for (int it = gw0; it < NITEMS; it += ngw0) {
            int r = it;
            if (r < I_IN) { p0_transpose_item(args.in[6], DM, INW, WinT, scr, r, F.lane, DestWin{}); continue; } r -= I_IN;
            if (r < I_OUT) { p0_transpose_item(args.in[15], DM, DM, WoutT, scr, r, F.lane, DestId{}); continue; } r -= I_OUT;
            if (r < I_1) { if (F8_IN) p0_transpose_item8(args.in[18], DM, 2 * FH, (unsigned char*)W1T, scr, r, F.lane, DestW1{}, W1_SCALE); else p0_transpose_item(args.in[18], DM, 2 * FH, W1T, scr, r, F.lane, DestW1{}); continue; } r -= I_1;
            if (r < I_2) { if (F8_OUT) p0_transpose_item8(args.in[19], FH, DM, (unsigned char*)W2T, scr, r, F.lane, DestId{}, W2_SCALE); else p0_transpose_item(args.in[19], FH, DM, W2T, scr, r, F.lane, DestId{}); continue; } r -= I_2;
            { const int mat = r >> 1; p0_transpose_item(args.in[12] + (size_t)mat * 4096, 64, 64, WgT + (size_t)mat * 4096, scr, r & 1, F.lane, DestId{}); }
        }
        }
        if (BOTH(0)) GRID_BAR();
        STAMP(1);
    }
    if (IN(1)) {
        for (int rep_ = 0; rep_ < 1 + ((REPEAT_MASK >> 1) & 1); ++rep_) {
#define P1_XROW(mm) ((mm) < MLAT ? x + (size_t)(mm) * DM : ctx + (size_t)((mm) - MLAT) * DM)
        if (F.G == 256) {
            const int bq = gw >> 7, r0 = gw & 127; const float* mdp = MOD + bq * 6144;
            LAS f32x4* pv = (LAS f32x4*)F.lds; { const float* const src[2] = {mdp, mdp + 1024}; stage_vecs(pv, src, 2, F.tid); }
#define P1_ROW(k_) (bq * 4096 + r0 + 128 * (k_))
            { HmRaw cur; hm_load(cur, x + (size_t)P1_ROW(0) * DM, x + (size_t)P1_ROW(1) * DM, F.lane);
              for (int k = 0; k < 32; k += 2) { const int m = P1_ROW(k), m2 = P1_ROW(k + 1);
                HmRaw nxt; if (k + 2 < 32) hm_load(nxt, x + (size_t)P1_ROW(k + 2) * DM, x + (size_t)P1_ROW(k + 3) * DM, F.lane);
                bf16* const orow[2] = {XN + (size_t)m * DM, XN + (size_t)m2 * DM};
                hm_process_l(cur, pv, orow, F.lane);
                if (k + 2 < 32) cur = nxt; } }
#undef P1_ROW
            { const int m = MLAT + gw, m2 = m + NGW;
              HmRaw cur; hm_load(cur, P1_XROW(m), P1_XROW(m2), F.lane);
              const float* const md[2] = {MOD + 16 * 6144, MOD + 16 * 6144}; bf16* const orow[2] = {XN + (size_t)m * DM, XN + (size_t)m2 * DM};
              hm_process(cur, md, orow, F.lane); }
            __syncthreads();
        } else
        { HmRaw cur; hm_load(cur, P1_XROW(gw), P1_XROW(gw + NGW), F.lane);
          for (int m = gw; m < MALL; m += 2 * NGW) { const int m2 = m + NGW, mn = m + 2 * NGW;
            HmRaw nxt; if (mn < MALL) hm_load(nxt, P1_XROW(mn), P1_XROW(mn + NGW), F.lane);
            const float* const md[2] = {MOD + (m < MLAT ? (m >> 12) : 16) * 6144, MOD + (m2 < MLAT ? (m2 >> 12) : 16) * 6144};
            bf16* const orow[2] = {XN + (size_t)m * DM, XN + (size_t)m2 * DM};
            hm_process(cur, md, orow, F.lane);
            if (mn < MALL) cur = nxt; } }
#undef P1_XROW
        }
        if (BOTH(1)) GRID_BAR();
        STAMP(2);
    }
    if (IN(2)) {
        {
        LAS float* ropeL = (LAS float*)(F.lds + ROPE_OFF);
        for (int i = F.tid; i < 2048; i += NWAVES * 64) ropeL[i] = ROPEC[i];
        __syncthreads();
        { pg8::Gemm g{XN, WinT, MALL, INW, DM}; pg8::InProjOrder S; S.init(F.G, (int)blockIdx.x);
          pg8::EpiInProj E{Qb, Kb, Vb, Ub, Gb, (unsigned char*)(ws + WS_VT8), ropeL, ropeL + 1024};
          pg8::gemm_phase<pg8::EpiInProj, pg8::InProjOrder, true, true>(F.lds, g, S, E); }
        }
#if (REPEAT_MASK >> 2) & 1
        {
        LAS float* ropeL = (LAS float*)(F.lds + ROPE_OFF);
        for (int i = F.tid; i < 2048; i += NWAVES * 64) ropeL[i] = ROPEC[i];
        __syncthreads();
        { pg8::Gemm g{XN, WinT, MALL, INW, DM}; pg8::InProjOrder S; S.init(F.G, (int)blockIdx.x);
          pg8::EpiInProj E{Qb, Kb, Vb, Ub, Gb, (unsigned char*)(ws + WS_VT8), ropeL, ropeL + 1024};
          pg8::gemm_phase<pg8::EpiInProj, pg8::InProjOrder, true, true>(F.lds, g, S, E); }
        }
#endif
        if (BOTH(2)) GRID_BAR();
        STAMP(3);
    }
    if (IN(3)) {
        for (int rep_ = 0; rep_ < 1 + ((REPEAT_MASK >> 3) & 1); ++rep_) {
#ifndef SKIP_ATT
        const float lam = LAMP[0]; float* PARK = (float*)(ws + WS_PARK) + (size_t)blockIdx.x * att::PARK_FLOATS;
        const int xg = F.vcu >> 5, vl = F.vcu & 31;
        for (int ra_ = 0; ra_ < 1 + ((REPEAT_MASK >> 9) & 1); ++ra_)
        if (F.G == 256) {
            for (int i = 0; i < 4; ++i) { const int bh = xg * 8 + i * 2 + (vl >> 4), qb = vl & 15;
                att::attn_unit_safe(bh >> 2, bh & 3, qb, (const short*)Qb, (const short*)Kb, (const short*)Vb, (const unsigned char*)(ws + WS_VT8), (short*)AO, args.in[9], lam, PARK, (char*)lds, ATT_FORCE_FALLBACK != 0); }
        } else {
            for (int un = (int)blockIdx.x; un < 1024; un += F.G) { const int bh = un >> 4, qb = un & 15;
                att::attn_unit_safe(bh >> 2, bh & 3, qb, (const short*)Qb, (const short*)Kb, (const short*)Vb, (const unsigned char*)(ws + WS_VT8), (short*)AO, args.in[9], lam, PARK, (char*)lds, ATT_FORCE_FALLBACK != 0); }
        }
#endif
#ifndef SKIP_LRU1
        for (int rl_ = 0; rl_ < 1 + ((REPEAT_MASK >> 10) & 1); ++rl_)
        for (int un = F.vcu; un < 256; un += F.G)
            lru2::lru_unit(un >> 4, (un >> 1) & 7, un & 1, Ub, Gb, args.in[10], args.in[11], WgT, args.in[13], SP8, (float*)(ws + WS_HS), AO, F.lds);
#endif
        }
        if (BOTH(3)) GRID_BAR();
        STAMP(4);
    }
    if (IN(4)) { STAMP(5); }
    if (IN(5)) {
        {
        pg8::Gemm g{AO, WoutT, MLAT, DM, DM}; pg8::StaticOrder S; S.init(MLAT, DM, F.G, (int)blockIdx.x);
        pg8::EpiPlain E{Yb, DM, 1.f};
        pg8::gemm_phase<pg8::EpiPlain, pg8::StaticOrder, true, true>(F.lds, g, S, E);
        }
#if (REPEAT_MASK >> 5) & 1
        {
        pg8::Gemm g{AO, WoutT, MLAT, DM, DM}; pg8::StaticOrder S; S.init(MLAT, DM, F.G, (int)blockIdx.x);
        pg8::EpiPlain E{Yb, DM, 1.f};
        pg8::gemm_phase<pg8::EpiPlain, pg8::StaticOrder, true, true>(F.lds, g, S, E);
        }
#endif
        if (BOTH(5)) GRID_BAR();
        STAMP(6);
    }
    if (IN(6)) {
        for (int rep_ = 0; rep_ < 1 + ((REPEAT_MASK >> 6) & 1); ++rep_) {
        if (F.G == 256) {
            const int bq = gw >> 7, r0 = gw & 127; const float* mdp = MOD + bq * 6144;
            LAS f32x4* pv = (LAS f32x4*)F.lds; { const float* const src[5] = {mdp + 2048, mdp + 3072, mdp + 4096, args.in[16], args.in[17]}; stage_vecs(pv, src, 5, F.tid); }
#define P6_ROW(k_) (bq * 4096 + r0 + 128 * (k_))
            { Ln1Raw cur; ln1_load(cur, x, Yb, P6_ROW(0), P6_ROW(1), F.lane);
              for (int k = 0; k < 32; k += 2) { const int m = P6_ROW(k), m2 = P6_ROW(k + 1);
                Ln1Raw nxt; if (k + 2 < 32) ln1_load(nxt, x, Yb, P6_ROW(k + 2), P6_ROW(k + 3), F.lane);
                bf16* const x1r[2] = {X1B + (size_t)m * DM, X1B + (size_t)m2 * DM}; float* const x1f[2] = {args.out + (size_t)m * DM, args.out + (size_t)m2 * DM};
                bf16* const h2r[2] = {F8_IN ? (bf16*)((unsigned char*)XN + (size_t)m * DM) : XN + (size_t)m * DM, F8_IN ? (bf16*)((unsigned char*)XN + (size_t)m2 * DM) : XN + (size_t)m2 * DM};
                ln1_process_l(cur, pv, x1r, x1f, h2r, F.lane);
                if (k + 2 < 32) cur = nxt; } }
#undef P6_ROW
            __syncthreads();
        } else
        { Ln1Raw cur; ln1_load(cur, x, Yb, gw, gw + NGW, F.lane);
          for (int m = gw; m < MLAT; m += 2 * NGW) { const int m2 = m + NGW, mn = m + 2 * NGW;
            Ln1Raw nxt; if (mn < MLAT) ln1_load(nxt, x, Yb, mn, mn + NGW, F.lane);
            const float* const md[2] = {MOD + (m >> 12) * 6144, MOD + (m2 >> 12) * 6144};
            float* const x1r[2] = {X1_BF16 ? (float*)(X1B + (size_t)m * DM) : args.out + (size_t)m * DM, X1_BF16 ? (float*)(X1B + (size_t)m2 * DM) : args.out + (size_t)m2 * DM};
            bf16* const h2r[2] = {F8_IN ? (bf16*)((unsigned char*)XN + (size_t)m * DM) : XN + (size_t)m * DM, F8_IN ? (bf16*)((unsigned char*)XN + (size_t)m2 * DM) : XN + (size_t)m2 * DM};
            ln1_process(cur, md, args.in[16], args.in[17], x1r, h2r, F.lane);
            if (mn < MLAT) cur = nxt; } }
        }
        if (BOTH(6)) GRID_BAR();
        STAMP(7);
    }
    if (IN(7)) {
        {
        pg8::Gemm g{XN, W1T, MLAT, 2 * FH, F8_IN ? DM / 2 : DM}; pg8::StaticOrder S; S.init(MLAT, 2 * FH, F.G, (int)blockIdx.x);
        pg8::EpiSwiglu<F8_OUT> E{HID, FH, F8_IN ? 1.f / W1_SCALE : 1.f, F8_OUT ? HID_SCALE : 1.f};
        pg8::gemm_phase<pg8::EpiSwiglu<F8_OUT>, pg8::StaticOrder, true, true, F8_IN>(F.lds, g, S, E);
        }
#if (REPEAT_MASK >> 7) & 1
        {
        pg8::Gemm g{XN, W1T, MLAT, 2 * FH, F8_IN ? DM / 2 : DM}; pg8::StaticOrder S; S.init(MLAT, 2 * FH, F.G, (int)blockIdx.x);
        pg8::EpiSwiglu<F8_OUT> E{HID, FH, F8_IN ? 1.f / W1_SCALE : 1.f, F8_OUT ? HID_SCALE : 1.f};
        pg8::gemm_phase<pg8::EpiSwiglu<F8_OUT>, pg8::StaticOrder, true, true, F8_IN>(F.lds, g, S, E);
        }
#endif
        if (BOTH(7)) GRID_BAR();
        STAMP(8);
    }
    if (IN(8)) {
        {
        pg8::Gemm g{HID, W2T, MLAT, DM, F8_OUT ? FH / 2 : FH}; pg8::StaticOrder S; S.init(MLAT, DM, F.G, (int)blockIdx.x);
        pg8::EpiPlain E{Fb, DM, F8_OUT ? 1.f / (W2_SCALE * HID_SCALE) : 1.f};
        pg8::gemm_phase<pg8::EpiPlain, pg8::StaticOrder, true, true, F8_OUT>(F.lds, g, S, E);
        }
#if (REPEAT_MASK >> 8) & 1
        {
        pg8::Gemm g{HID, W2T, MLAT, DM, F8_OUT ? FH / 2 : FH}; pg8::StaticOrder S; S.init(MLAT, DM, F.G, (int)blockIdx.x);
        pg8::EpiPlain E{Fb, DM, F8_OUT ? 1.f / (W2_SCALE * HID_SCALE) : 1.f};
        pg8::gemm_phase<pg8::EpiPlain, pg8::StaticOrder, true, true, F8_OUT>(F.lds, g, S, E);
        }
#endif
        if (BOTH(8)) GRID_BAR();
        STAMP(9);
    }
    if (IN(9)) {
        if (F.G == 256) {
            const int bq = gw >> 7, r0 = gw & 127; const float* mdp = MOD + bq * 6144;
            LAS f32x4* pv = (LAS f32x4*)F.lds; { const float* const src[3] = {mdp + 5120, args.in[20], args.in[21]}; stage_vecs(pv, src, 3, F.tid); }
#define P9_ROW(k_) (bq * 4096 + r0 + 128 * (k_))
            { Ln2Raw cur; ln2_load(cur, args.out, X1B, Fb, P9_ROW(0), P9_ROW(1), F.lane);
              for (int k = 0; k < 32; k += 2) { const int m = P9_ROW(k), m2 = P9_ROW(k + 1);
                Ln2Raw nxt; if (k + 2 < 32) ln2_load(nxt, args.out, X1B, Fb, P9_ROW(k + 2), P9_ROW(k + 3), F.lane);
                float* const orow[2] = {args.out + (size_t)m * DM, args.out + (size_t)m2 * DM};
                ln2_process_l(cur, pv, orow, F.lane);
                if (k + 2 < 32) cur = nxt; } }
#undef P9_ROW
        } else
        { Ln2Raw cur; ln2_load(cur, args.out, X1B, Fb, gw, gw + NGW, F.lane);
          for (int m = gw; m < MLAT; m += 2 * NGW) { const int m2 = m + NGW, mn = m + 2 * NGW;
            Ln2Raw nxt; if (mn < MLAT) ln2_load(nxt, args.out, X1B, Fb, mn, mn + NGW, F.lane);
            float* const orow[2] = {args.out + (size_t)m * DM, args.out + (size_t)m2 * DM};
            const float* const md[2] = {MOD + (m >> 12) * 6144, MOD + (m2 >> 12) * 6144};
            ln2_process(cur, orow, md, args.in[20], args.in[21], F.lane);
            if (mn < MLAT) cur = nxt; } }
        STAMP(10);
        if (TSTAMP >= 0) {
            asm volatile("s_waitcnt vmcnt(0)" ::: "memory"); GRID_BAR();
            const unsigned long long t0 = __hip_atomic_load(TS + TSTAMP, __ATOMIC_RELAXED, __HIP_MEMORY_SCOPE_AGENT), t1 = __hip_atomic_load(TS + TSTAMP + 1, __ATOMIC_RELAXED, __HIP_MEMORY_SCOPE_AGENT);
            const float v = (float)(t1 - t0) * 0.01f / (TS_UNIT);
            for (int m = gw; m < MLAT; m += NGW) { GAS f32x4* o = (GAS f32x4*)(args.out + (size_t)m * DM) + F.lane;
#pragma unroll
                for (int j = 0; j < 4; ++j) o[64 * j] = (f32x4){v, v, v, v}; }
        }
    }
#undef IN
#undef BOTH
#undef GRID_BAR
}

#ifndef DBG
#define DBG 0
#endif
#if DBG
constexpr size_t WS_DBGTAB = 32 * 1024, WS_NAIVE = 832 * MiB;
static void dbg_run(void* const* d_in, float* out, unsigned char* ws, hipStream_t st) {
    float* tab = (float*)(ws + WS_DBGTAB);
    nv::Bufs B = nv::carve((char*)ws + WS_NAIVE);
    nv::run_common(d_in, B, st);
    dbg::cmp(st, tab, 1, ws + WS_MOD, 0, 0, 6144, 0, 0, 1.f, B.mod, 0, 6144, 0, 17, 6144);
    using namespace nv;
    for (int b = 0; b < 16; ++b) {
        const float* x = (const float*)d_in[0] + (size_t)b * S * D; const float* ctx = (const float*)d_in[2] + (size_t)b * CT * D;
        const float* mod = B.mod + b * 6144; const float* modc = B.mod + 16 * 6144;
        k_lnmod<<<S, 256, 0, st>>>(x, mod + 0, mod + 1024, B.h);
        k_lnmod<<<CT, 256, 0, st>>>(ctx, modc + 0, modc + 1024, B.h + (size_t)S * D);
        dbg::cmp(st, tab, 2, ws + WS_XN, 1, (size_t)65536 + b * 256, 1024, 0, 0, 1.f, B.h, 4096, 1024, 0, 256, 1024);
        k_gemm<<<dim3(nv::INW / 64, T / 64), 256, 0, st>>>(B.h, (const float*)d_in[6], B.p, T, nv::INW, D);
        k_rope<<<S * 512 / 256, 256, 0, st>>>(B.p);
        dbg::k_cmp_vt<<<(4352 * 512 + 255) / 256, 256, 0, st>>>((const unsigned short*)(ws + WS_V), b, B.p, nv::INW, 1024, tab + 2 * 3);
        dbg::cmp(st, tab, 4, ws + WS_U, 1, (size_t)b * 4096, 512, 0, 0, 1.f, B.p, 0, nv::INW, 1536, 4096, 512);
        dbg::cmp(st, tab, 4, ws + WS_U, 1, (size_t)65536 + b * 256, 512, 0, 0, 1.f, B.p, 4096, nv::INW, 1536, 256, 512);
        dbg::cmp(st, tab, 5, ws + WS_G, 1, (size_t)b * 4096, 512, 0, 0, 1.f, B.p, 0, nv::INW, 2048, 4096, 512);
        dbg::cmp(st, tab, 6, ws + WS_K, 1, (size_t)b * 4352 + 4096, 512, 0, 1, 1.f, B.p, 4096, nv::INW, 512, 256, 512);
        dbg::cmp(st, tab, 7, ws + WS_K, 1, (size_t)b * 4352, 512, 0, 1, 1.f, B.p, 0, nv::INW, 512, 4096, 512);
        dbg::cmp(st, tab, 8, ws + WS_Q, 1, (size_t)b * 4096, 512, 0, 1, 1.f / pg8::QK_C2, B.p, 0, nv::INW, 0, 4096, 512);
        k_attn_stats<<<dim3(S / 256, 4), 256, 0, st>>>(B.p, B.stats);
        k_attn_pv<<<dim3(S / 256, 16), 256, 0, st>>>(B.p, B.stats, B.lam, B.o);
        k_headnorm<<<S * 4 / 256, 256, 0, st>>>(B.o, (const float*)d_in[9], B.ao);
        dbg::cmp(st, tab, 9, ws + WS_AO, 1, (size_t)b * 4096, 1024, 0, 0, 1.f, B.ao, 0, 1024, 0, 4096, 512);
        k_conv<<<S * 512 / 256, 256, 0, st>>>(B.p, 0, S, (const float*)d_in[10], (const float*)d_in[11], B.uc);
        k_conv<<<CT * 512 / 256, 256, 0, st>>>(B.p, S, CT, (const float*)d_in[10], (const float*)d_in[11], B.uc);
        k_gates<<<2 * T * 512 / 256, 256, 0, st>>>(B.uc, (const float*)d_in[12], (const float*)d_in[13], (const float*)d_in[14], B.av, B.bv);
        k_scan<<<4, 256, 0, st>>>(B.av, B.bv, B.hs);
        k_ylru<<<S * 512 / 256, 256, 0, st>>>(B.hs, B.p, B.ao);
        dbg::cmp(st, tab, 10, ws + WS_AO, 1, (size_t)b * 4096, 1024, 512, 0, 1.f, B.ao, 0, 1024, 512, 4096, 512);
        k_gemm<<<dim3(D / 64, S / 64), 256, 0, st>>>(B.ao, (const float*)d_in[15], B.y, S, D, D);
        dbg::cmp(st, tab, 11, ws + WS_Y, 1, (size_t)b * 4096, 1024, 0, 0, 1.f, B.y, 0, 1024, 0, 4096, 1024);
        k_lnres<<<S, 256, 0, st>>>(x, B.y, mod + 2048, (const float*)d_in[16], (const float*)d_in[17], B.x1);
        dbg::cmp(st, tab, 12, out, 0, (size_t)b * 4096, 1024, 0, 0, 1.f, B.x1, 0, 1024, 0, 4096, 1024);
        k_lnmod<<<S, 256, 0, st>>>(B.x1, mod + 3072, mod + 4096, B.h2);
        dbg::cmp(st, tab, 13, ws + WS_XN, 1, (size_t)b * 4096, 1024, 0, 0, 1.f, B.h2, 0, 1024, 0, 4096, 1024);
    }
}
#endif
extern "C" void kernel_launch(void* const* d_in, const int* in_sizes, int n_in, void* d_out, int out_size, void* d_ws, size_t ws_size, hipStream_t stream) {
    static int grid = 0;
    if (grid == 0) {
        if (n_in != 22 || out_size != MLAT * DM || ws_size < (DBG ? (size_t)1012 * MiB : WS_END)) { fprintf(stderr, "kernel_launch: unexpected shapes / workspace (n_in %d out %d ws %zu)\n", n_in, out_size, ws_size); grid = -1; return; }
        int dev = 0, cus = 0, per_cu = 0;
        if (hipGetDevice(&dev) != hipSuccess || hipDeviceGetAttribute(&cus, hipDeviceAttributeMultiprocessorCount, dev) != hipSuccess) { grid = -1; return; }
        if (hipFuncSetAttribute((const void*)mk_fwd, hipFuncAttributeMaxDynamicSharedMemorySize, LDS_BYTES) != hipSuccess) { fprintf(stderr, "kernel_launch: hipFuncSetAttribute failed\n"); grid = -1; return; }
        if (hipOccupancyMaxActiveBlocksPerMultiprocessor(&per_cu, (const void*)mk_fwd, NWAVES * 64, LDS_BYTES) != hipSuccess || per_cu < 1) { fprintf(stderr, "kernel_launch: occupancy query says %d blocks/CU; nothing launched\n", per_cu); (void)hipGetLastError(); grid = -1; return; }
        grid = cus;
    }
    if (grid < 0) return;
    (void)hipMemsetAsync((char*)d_ws + WS_CTL, 0, CTL_ZERO_BYTES, stream);
    Args a{};
    for (int i = 0; i < 22; ++i) a.in[i] = (const float*)d_in[i];
    a.out = (float*)d_out; a.ws = (unsigned char*)d_ws;
#if DBG
    if (N_LAUNCHES == PER_PHASE) { for (int li = 0; li < 7; ++li) { a.ph_lo = li; a.ph_hi = li + 1; a.li = 0; hipLaunchKernelGGL(mk_fwd, dim3(grid), dim3(NWAVES * 64), LDS_BYTES, stream, a); } }
    else { a.ph_lo = 0; a.ph_hi = 7; a.li = 0; hipLaunchKernelGGL(mk_fwd, dim3(grid), dim3(NWAVES * 64), LDS_BYTES, stream, a); }
    dbg_run(d_in, (float*)d_out, (unsigned char*)d_ws, stream);
    if (N_LAUNCHES == PER_PHASE) { for (int li = 7; li < PER_PHASE; ++li) { a.ph_lo = li; a.ph_hi = li + 1; a.li = 0; hipLaunchKernelGGL(mk_fwd, dim3(grid), dim3(NWAVES * 64), LDS_BYTES, stream, a); } }
    else { a.ph_lo = 7; a.ph_hi = PER_PHASE; a.li = 1; hipLaunchKernelGGL(mk_fwd, dim3(grid), dim3(NWAVES * 64), LDS_BYTES, stream, a); }
    dbg::k_verdict<<<(unsigned)(((size_t)MLAT * DM + 255) / 256), 256, 0, stream>>>((const float*)((unsigned char*)d_ws + WS_DBGTAB), (float*)d_out, (size_t)MLAT * DM);
#else
    if (N_LAUNCHES == PER_PHASE) { for (int li = 0; li < PER_PHASE; ++li) { a.ph_lo = li; a.ph_hi = li + 1; a.li = 0; hipLaunchKernelGGL(mk_fwd, dim3(grid), dim3(NWAVES * 64), LDS_BYTES, stream, a); } }
    else { a.ph_lo = 0; a.ph_hi = PER_PHASE; a.li = 0; hipLaunchKernelGGL(mk_fwd, dim3(grid), dim3(NWAVES * 64), LDS_BYTES, stream, a); }
#endif
    const hipError_t le = hipPeekAtLastError();
    if (le != hipSuccess) fprintf(stderr, "kernel_launch: launch failed: %s\n", hipGetErrorName(le));
}
```

```cpp
#include <hip/hip_runtime.h>
#include <hip/hip_bf16.h>
#include <cstdio>
#include <cstdint>
#include <cmath>
#define DBG 0
#define MK_N_LAUNCHES 1
#define FP8_FFN 2

namespace pg8 {
#define PG8_LAS __attribute__((address_space(3)))
typedef unsigned short bf16_t;
typedef short bf16x8 __attribute__((ext_vector_type(8)));
typedef float f32x4 __attribute__((ext_vector_type(4)));
typedef unsigned u32x4 __attribute__((ext_vector_type(4)));
constexpr int BM = 256, BK = 64, HALF = 128, HTB = HALF * BK * 2  , STAGE_BYTES = 8 * HTB, NXCD = 8, WGM = 8;

__host__ __device__ __forceinline__ int lds_byte(int r, int c) { const int st = (r >> 4) * 2 + (c >> 5), rr = r & 15, cc = c & 31, ob = rr * 64 + cc * 2; return st * 1024 + (ob ^ (((ob >> 9) & 1) << 5)); }
__host__ __device__ __forceinline__ void stage_rc(int b, int& R, int& C) { const int st = b / 1024, sb = b % 1024, swz = sb ^ (((sb >> 9) & 1) << 5); R = (st >> 1) * 16 + swz / 64; C = (st & 1) * 32 + (swz % 64) / 2; }
__host__ __device__ __forceinline__ int perm32(int rho) { const int n = rho >> 4, i = rho & 15; return 8 * (i >> 2) + 4 * n + (i & 3); }

struct Unit { int pm, pn; };
struct Gemm { const bf16_t* A; const bf16_t* Bt; int M, N, K; };

struct StaticOrder {
    int nM, nN, nwg, G, c;
    __host__ __device__ void init(int M, int N, int G_, int c_) { nM = M / BM; nN = N / BM; nwg = nM * nN; G = G_; c = c_; }
    __host__ __device__ bool next(int i, Unit& u) const {
        const long L = (long)i * G + c; if (L >= nwg) return false;
        int wgid = (int)L; { const int q = nwg / NXCD, r = nwg % NXCD, xcd = wgid % NXCD, off = wgid / NXCD; wgid = (xcd < r ? xcd * (q + 1) : r * (q + 1) + (xcd - r) * q) + off; }
        const int nig = WGM * nN, gid = wgid / nig, fm = gid * WGM, gsz = (nM - fm) < WGM ? (nM - fm) : WGM;
        u.pm = fm + ((wgid % nig) % gsz); u.pn = (wgid % nig) / gsz; return true;
    }
    __device__ __forceinline__ void a_ready(const Unit&) const {}
    __device__ __forceinline__ void done(const Unit&) const {}
    __device__ __forceinline__ void ab(const Unit& u, const Gemm& g, size_t tstep, const char*& pa, const char*& pb) const { pa = (const char*)g.A + (size_t)u.pm * tstep; pb = (const char*)g.Bt + (size_t)u.pn * tstep; }
};

__device__ __forceinline__ unsigned cvt_pk_bf16(float lo, float hi) { unsigned r; asm volatile("v_cvt_pk_bf16_f32 %0, %1, %2" : "=v"(r) : "v"(lo), "v"(hi)); return r; }
typedef float f32x2 __attribute__((ext_vector_type(2)));
__device__ __forceinline__ f32x2 gelu_pk(f32x2 v) {
    const f32x2 av = __builtin_elementwise_abs(v), d = av * 0.2316418882f + 1.0f;
    f32x2 t; t.x = __builtin_amdgcn_rcpf(d.x); t.y = __builtin_amdgcn_rcpf(d.y);
    f32x2 q = t * 0.5307027145f + (-0.7265760135f); q = q * t + 0.7107068705f; q = q * t + (-0.142248368f); q = q * t + 0.127414796f; q = q * t;
    const f32x2 s = (v * v) * (-0.72134752044f);
    f32x2 e; e.x = __builtin_amdgcn_exp2f(s.x); e.y = __builtin_amdgcn_exp2f(s.y);
    const f32x2 m = v * (q * e), r = v - m;
    f32x2 o; o.x = v.x < 0.f ? m.x : r.x; o.y = v.y < 0.f ? m.y : r.y; return o;
}

template <int ACT  > struct EpiBf16 {
    static constexpr bool PERM = true, AFTER_DRAIN = false; static_assert(ACT == 0 || ACT == 1, "EpiBf16: ACT is 0 (none) or 1 (gelu_pk)");
    bf16_t* O; int ldc; const float* bias; int split_cols; size_t split_stride; float scale0;
    __device__ __forceinline__ void operator()(const f32x4 (&acc)[2][2][4][2], const Unit& u, int wr, int wc, int fr, int fq) const {
        const int row0 = u.pm * BM + wr * 64 + fr; int colt = u.pn * BM; bf16_t* base = O;
        float sc = 1.f; if (split_cols) { const int t = colt / split_cols; base += (size_t)t * split_stride; colt -= t * split_cols; if (t == 0) sc = scale0; }
        const int col0 = colt + wc * 32 + 8 * fq, bcol0 = u.pn * BM + wc * 32 + 8 * fq;
        f32x4 bv[2][2];
#pragma unroll
        for (int bj = 0; bj < 2; ++bj)
#pragma unroll
            for (int n = 0; n < 2; ++n) bv[bj][n] = bias ? *(const f32x4*)(bias + bcol0 + bj * HALF + 4 * n) : (f32x4){0.f, 0.f, 0.f, 0.f};
#pragma unroll
        for (int ai = 0; ai < 2; ++ai)
#pragma unroll
            for (int m = 0; m < 4; ++m) { bf16_t* rowp = base + (size_t)(row0 + ai * HALF + m * 16) * ldc + col0;
#pragma unroll
                for (int bj = 0; bj < 2; ++bj) { f32x4 v0 = acc[ai][bj][m][0] + bv[bj][0], v1 = acc[ai][bj][m][1] + bv[bj][1];
                    if (ACT == 1) { f32x2 a = gelu_pk((f32x2){v0[0], v0[1]}), b = gelu_pk((f32x2){v0[2], v0[3]}), c = gelu_pk((f32x2){v1[0], v1[1]}), d = gelu_pk((f32x2){v1[2], v1[3]});
                        v0 = (f32x4){a.x, a.y, b.x, b.y}; v1 = (f32x4){c.x, c.y, d.x, d.y}; }
                    v0 = v0 * sc; v1 = v1 * sc; u32x4 w; w.x = cvt_pk_bf16(v0[0], v0[1]); w.y = cvt_pk_bf16(v0[2], v0[3]); w.z = cvt_pk_bf16(v1[0], v1[1]); w.w = cvt_pk_bf16(v1[2], v1[3]);
                    *(u32x4*)(rowp + bj * HALF) = w; } }
    }
};

struct PanelStats {
    unsigned* xbuf;
    unsigned* cnt;
    unsigned* tmo;
    int ntn; float eps;
    unsigned code;
    __device__ __forceinline__ bool run(const f32x4 (&v)[2][2][4][2], const Unit& u, int wr, int wc, int fr, int fq, PG8_LAS unsigned char* lds, int wid, int lane) const {
        typedef float f32x2v __attribute__((ext_vector_type(2)));
        PG8_LAS f32x2v* P = (PG8_LAS f32x2v*)lds;
        PG8_LAS f32x2v* S = (PG8_LAS f32x2v*)(lds + 8192);
        PG8_LAS unsigned* flag = (PG8_LAS unsigned*)(lds + 8192 + 2048);
#pragma unroll
        for (int ai = 0; ai < 2; ++ai)
#pragma unroll
            for (int m = 0; m < 4; ++m) {
                float s = 0.f;
#pragma unroll
                for (int bj = 0; bj < 2; ++bj)
#pragma unroll
                    for (int n = 0; n < 2; ++n) { const f32x4 x = v[ai][bj][m][n]; s += (x[0] + x[1]) + (x[2] + x[3]); }
                s += __shfl_xor(s, 16); s += __shfl_xor(s, 32);
                const float mw = s * (1.0f / 64.0f); float q = 0.f;
#pragma unroll
                for (int bj = 0; bj < 2; ++bj)
#pragma unroll
                    for (int n = 0; n < 2; ++n) { const f32x4 d = v[ai][bj][m][n] - mw; q += (d[0] * d[0] + d[1] * d[1]) + (d[2] * d[2] + d[3] * d[3]); }
                q += __shfl_xor(q, 16); q += __shfl_xor(q, 32);
                if (fq == 0) P[(ai * HALF + wr * 64 + m * 16 + fr) * 4 + wc] = (f32x2v){mw, q};
            }
        asm volatile("s_waitcnt lgkmcnt(0)" ::: "memory"); __builtin_amdgcn_s_barrier(); asm volatile("" ::: "memory");
#if defined(BROKEN_EXCHANGE_NO_WAIT)
#warning BROKEN CONTROL BUILD: the row-statistics exchange does not wait; results are wrong by design
        if (blockIdx.x >= 64) { const long long t0_ = clock64(); while (clock64() - t0_ < 60000) __builtin_amdgcn_s_sleep(8); }
#endif
        const int row = wid * 32 + (lane & 31);
        if (lane < 32) {
            const f32x2v a = P[row * 4 + 0], b = P[row * 4 + 1], c = P[row * 4 + 2], d = P[row * 4 + 3];
            const float mt = (a.x + b.x + c.x + d.x) * 0.25f;
            const float da = a.x - mt, db = b.x - mt, dc = c.x - mt, dd = d.x - mt;
            const float m2 = (a.y + b.y) + (c.y + d.y) + 64.0f * ((da * da + db * db) + (dc * dc + dd * dd));
            unsigned long long* slot = (unsigned long long*)xbuf + ((size_t)(u.pm * BM + row) * 4 + u.pn);
            __hip_atomic_store(slot, ((unsigned long long)__float_as_uint(m2) << 32) | __float_as_uint(mt), __ATOMIC_RELAXED, __HIP_MEMORY_SCOPE_AGENT);
        }
        asm volatile("s_waitcnt vmcnt(0)" ::: "memory");
        if (lane == 0) __hip_atomic_fetch_add(cnt + 64 * u.pm, 1u, __ATOMIC_RELAXED, __HIP_MEMORY_SCOPE_AGENT);
        if (wid == 0) {
            bool dead = false; const unsigned long long t0 = __builtin_amdgcn_s_memrealtime(); const unsigned want = 8u * (unsigned)ntn;
            for (;;) {
#if defined(BROKEN_EXCHANGE_NO_WAIT)
                break;
#endif
                if ((unsigned)__builtin_amdgcn_readfirstlane(__hip_atomic_load(cnt + 64 * u.pm, __ATOMIC_RELAXED, __HIP_MEMORY_SCOPE_AGENT)) >= want) break;
                if (__builtin_amdgcn_s_memrealtime() - t0 > 2000000ull) {
                    if (lane == 0) { unsigned expect = 0u; __hip_atomic_compare_exchange_strong(tmo + 1, &expect, code | (unsigned)(u.pm & 0xff), __ATOMIC_RELAXED, __ATOMIC_RELAXED, __HIP_MEMORY_SCOPE_AGENT);
                                     __hip_atomic_store(tmo, 1u, __ATOMIC_RELAXED, __HIP_MEMORY_SCOPE_AGENT); }
                    dead = true; break; }
                __builtin_amdgcn_s_sleep(2);
            }
            __builtin_amdgcn_fence(__ATOMIC_ACQUIRE, "agent");
            if (lane == 0) flag[0] = dead ? 1u : 0u;
        }
        asm volatile("s_waitcnt vmcnt(0) lgkmcnt(0)" ::: "memory"); __builtin_amdgcn_s_barrier(); asm volatile("" ::: "memory");
        const bool bad = flag[0] != 0u;
        if (lane < 32) {
            const unsigned long long* slot = (const unsigned long long*)xbuf + (size_t)(u.pm * BM + row) * 4; float mt[4], m2[4]; float ms = 0.f;
#pragma unroll
            for (int t = 0; t < 4; ++t) { if (t < ntn) { const unsigned long long w = __hip_atomic_load(slot + t, __ATOMIC_RELAXED, __HIP_MEMORY_SCOPE_AGENT); mt[t] = __uint_as_float((unsigned)w); m2[t] = __uint_as_float((unsigned)(w >> 32)); } else { mt[t] = 0.f; m2[t] = 0.f; } ms += mt[t]; }
            const float mean = ms / (float)ntn; float q = 0.f;
#pragma unroll
            for (int t = 0; t < 4; ++t) if (t < ntn) { const float dm = mt[t] - mean; q += m2[t] + 256.0f * dm * dm; }
            S[row] = (f32x2v){mean, 1.0f / sqrtf(q / (256.0f * (float)ntn) + eps)};
        }
        asm volatile("s_waitcnt lgkmcnt(0)" ::: "memory"); __builtin_amdgcn_s_barrier(); asm volatile("" ::: "memory");
        return bad;
    }
};
struct EpiLnRes {
    static constexpr bool PERM = false, AFTER_DRAIN = true;
    const float* base; float* out; int ldc; const float* bias; PanelStats st; unsigned poison;
    __device__ __forceinline__ void fused(f32x4 (&acc)[2][2][4][2], const Unit& u, int wr, int wc, int fr, int fq, PG8_LAS unsigned char* lds, int wid, int lane) const {
        typedef float f32x2v __attribute__((ext_vector_type(2)));
        const PG8_LAS f32x2v* S = (const PG8_LAS f32x2v*)(lds + 8192);
        const int col0 = u.pn * BM + wc * 32 + 4 * fq;
#pragma unroll
        for (int bj = 0; bj < 2; ++bj)
#pragma unroll
            for (int n = 0; n < 2; ++n) { const f32x4 bv = bias ? *(const f32x4*)(bias + col0 + bj * HALF + n * 16) : (f32x4){0.f, 0.f, 0.f, 0.f};
#pragma unroll
                for (int ai = 0; ai < 2; ++ai)
#pragma unroll
                    for (int m = 0; m < 4; ++m) acc[ai][bj][m][n] += bv; }
        f32x4 pre[4][2][2];
#pragma unroll
        for (int m = 0; m < 4; ++m) { const size_t off = (size_t)(u.pm * BM + wr * 64 + m * 16 + fr) * ldc + col0;
#pragma unroll
            for (int bj = 0; bj < 2; ++bj)
#pragma unroll
                for (int n = 0; n < 2; ++n) pre[m][bj][n] = *(const f32x4*)(base + off + bj * HALF + n * 16); }
        const bool bad = st.run(acc, u, wr, wc, fr, fq, lds, wid, lane) || poison != 0u;
        const float qnan = __builtin_nanf("");
#pragma unroll
        for (int ai = 0; ai < 2; ++ai)
#pragma unroll
            for (int m = 0; m < 4; ++m) { const int r = ai * HALF + wr * 64 + m * 16 + fr; const f32x2v sr = S[r]; const size_t off = (size_t)(u.pm * BM + r) * ldc + col0;
#pragma unroll
                for (int bj = 0; bj < 2; ++bj)
#pragma unroll
                    for (int n = 0; n < 2; ++n) { const f32x4 bs = ai == 0 ? pre[m][bj][n] : *(const f32x4*)(base + off + bj * HALF + n * 16); f32x4 o = bs + (acc[ai][bj][m][n] - sr.x) * sr.y;
                        if (bad) o = (f32x4){qnan, qnan, qnan, qnan}; *(f32x4*)(out + off + bj * HALF + n * 16) = o; }
                if (m & 1) asm volatile("" ::: "memory"); }
    }
};
struct EpiLnResLn {
    static constexpr bool PERM = false, AFTER_DRAIN = true;
    const float* base; float* out; bf16_t* xn; int ldc; const float* bias; PanelStats st1, st2; unsigned poison;
    __device__ __forceinline__ void fused(f32x4 (&acc)[2][2][4][2], const Unit& u, int wr, int wc, int fr, int fq, PG8_LAS unsigned char* lds, int wid, int lane) const {
        typedef float f32x2v __attribute__((ext_vector_type(2))); typedef unsigned u32x2v __attribute__((ext_vector_type(2)));
        const PG8_LAS f32x2v* S = (const PG8_LAS f32x2v*)(lds + 8192);
        const int col0 = u.pn * BM + wc * 32 + 4 * fq;
#pragma unroll
        for (int bj = 0; bj < 2; ++bj)
#pragma unroll
            for (int n = 0; n < 2; ++n) { const f32x4 bv = bias ? *(const f32x4*)(bias + col0 + bj * HALF + n * 16) : (f32x4){0.f, 0.f, 0.f, 0.f};
#pragma unroll
                for (int ai = 0; ai < 2; ++ai)
#pragma unroll
                    for (int m = 0; m < 4; ++m) acc[ai][bj][m][n] += bv; }
        bool bad = st1.run(acc, u, wr, wc, fr, fq, lds, wid, lane) || poison != 0u;
        const float qnan = __builtin_nanf("");
#pragma unroll
        for (int ai = 0; ai < 2; ++ai)
#pragma unroll
            for (int m = 0; m < 4; ++m) { const int r = ai * HALF + wr * 64 + m * 16 + fr; const f32x2v sr = S[r]; const size_t off = (size_t)(u.pm * BM + r) * ldc + col0;
#pragma unroll
                for (int bj = 0; bj < 2; ++bj)
#pragma unroll
                    for (int n = 0; n < 2; ++n) { const f32x4 bs = *(const f32x4*)(base + off + bj * HALF + n * 16); acc[ai][bj][m][n] = bs + (acc[ai][bj][m][n] - sr.x) * sr.y; }
                asm volatile("" : "+v"(acc[ai][0][m][0]), "+v"(acc[ai][0][m][1]), "+v"(acc[ai][1][m][0]), "+v"(acc[ai][1][m][1]));
                if (m & 1) asm volatile("" ::: "memory"); }
        const bool bad1 = bad;
        bad = st2.run(acc, u, wr, wc, fr, fq, lds, wid, lane) || bad;
#pragma unroll
        for (int ai = 0; ai < 2; ++ai)
#pragma unroll
            for (int m = 0; m < 4; ++m) { const int r = ai * HALF + wr * 64 + m * 16 + fr; const f32x2v sr = S[r]; const size_t off = (size_t)(u.pm * BM + r) * ldc + col0;
#pragma unroll
                for (int bj = 0; bj < 2; ++bj)
#pragma unroll
                    for (int n = 0; n < 2; ++n) { const f32x4 x1 = acc[ai][bj][m][n]; *(f32x4*)(out + off + bj * HALF + n * 16) = bad1 ? (f32x4){qnan, qnan, qnan, qnan} : x1;
                        const f32x4 o = (x1 - sr.x) * sr.y; u32x2v w; w.x = cvt_pk_bf16(o[0], o[1]); w.y = cvt_pk_bf16(o[2], o[3]);
                        if (bad) { w.x = 0x7fc07fc0u; w.y = 0x7fc07fc0u; } *(u32x2v*)(xn + off + bj * HALF + n * 16) = w; }
                asm volatile("" ::: "memory"); }
    }
};

typedef int i32x8 __attribute__((ext_vector_type(8)));
typedef int i32x4 __attribute__((ext_vector_type(4)));
template <class Epi, class Sched, bool ALIGN_EPI = false, bool SP2 = false, bool F8 = false>
__device__ __forceinline__ void gemm_phase(PG8_LAS unsigned char* lds, const Gemm g, const Sched& S, const Epi& E) {
    const int tid = threadIdx.x, wid = __builtin_amdgcn_readfirstlane(tid >> 6), lane = tid & 63, wr = wid >> 2, wc = wid & 3, fr = lane & 15, fq = lane >> 4;
    const int K = g.K, nt = K / BK;
    unsigned voffA[2], voffB[2];
#pragma unroll
    for (int i = 0; i < 2; ++i) { int R, C; stage_rc(tid * 16 + i * 8192, R, C); const int Rb = Epi::PERM ? ((R & ~31) + perm32(R & 31)) : R;
        voffA[i] = (unsigned)(R * K + C) * 2u; voffB[i] = (unsigned)(Rb * K + C) * 2u; }
    const size_t kstep = (size_t)(BK * 2);
    const size_t hstep = (size_t)HALF * K * 2;
    const size_t tstep = 2 * hstep;
    const unsigned ldsw = (unsigned)wid * 1024u;
    const int aoff = lds_byte(wr * 64 + fr, F8 ? fq * 16 : fq * 8), boff = lds_byte(wc * 32 + fr, F8 ? fq * 16 : fq * 8);
#define PG8_SA(b, h) (((b) * 2 + (h)) * HTB)
#define PG8_SB(b, h) ((4 + (b) * 2 + (h)) * HTB)
#define PG8_STAGE(bufoff, gbase, voff) do { _Pragma("unroll") for (int _i = 0; _i < 2; ++_i) \
        __builtin_amdgcn_global_load_lds((const unsigned*)((const char*)(gbase) + (voff)[_i]), (PG8_LAS unsigned*)(lds + (bufoff) + ldsw + _i * 8192), 16, 0, 0); } while (0)
#define PG8_LD32(p) __builtin_shufflevector(*(const PG8_LAS i32x4*)((p) + f8o1), *(const PG8_LAS i32x4*)((p) + f8o2), 0, 1, 2, 3, 4, 5, 6, 7)
#define PG8_LDA(dst, b, h) do { if constexpr (F8) { _Pragma("unroll") for (int m = 0; m < 4; ++m) dst##8[m] = PG8_LD32(lds + PG8_SA(b, h) + aoff + m * 2048); } \
        else { _Pragma("unroll") for (int m = 0; m < 4; ++m) _Pragma("unroll") for (int k = 0; k < 2; ++k) dst[m][k] = *(const PG8_LAS bf16x8*)(lds + PG8_SA(b, h) + aoff + m * 2048 + k * 1024); } } while (0)
#define PG8_LDB(dst, b, h) do { if constexpr (F8) { _Pragma("unroll") for (int n = 0; n < 2; ++n) dst##8[n] = PG8_LD32(lds + PG8_SB(b, h) + boff + n * 2048); } \
        else { _Pragma("unroll") for (int n = 0; n < 2; ++n) _Pragma("unroll") for (int k = 0; k < 2; ++k) dst[n][k] = *(const PG8_LAS bf16x8*)(lds + PG8_SB(b, h) + boff + n * 2048 + k * 1024); } } while (0)
#define PG8_MMA(ai, bj, At, Bt) do { __builtin_amdgcn_s_setprio(1); if constexpr (F8) { _Pragma("unroll") for (int m = 0; m < 4; ++m) _Pragma("unroll") for (int n = 0; n < 2; ++n) \
        asm volatile("v_mfma_scale_f32_16x16x128_f8f6f4 %0, %1, %2, %0, %3, %3 op_sel_hi:[0,0,0]" : "+v"(acc[ai][bj][m][n]) : "v"(Bt##8[n]), "v"(At##8[m]), "v"(sc1_)); } \
        else { _Pragma("unroll") for (int m = 0; m < 4; ++m) _Pragma("unroll") for (int n = 0; n < 2; ++n) _Pragma("unroll") for (int k = 0; k < 2; ++k) \
        acc[ai][bj][m][n] = __builtin_amdgcn_mfma_f32_16x16x32_bf16(Bt[n][k], At[m][k], acc[ai][bj][m][n], 0, 0, 0); } __builtin_amdgcn_s_setprio(0); } while (0)
#define PG8_WAIT_V(n) asm volatile("s_waitcnt vmcnt(" #n ")" ::: "memory")
#define PG8_WAIT_L(n) asm volatile("s_waitcnt lgkmcnt(" #n ")" ::: "memory")
#define PG8_BAR __builtin_amdgcn_s_barrier()
#define PG8_SCHED __builtin_amdgcn_sched_barrier(0)
    Unit cur, nxt; int ui = 0;
    if (!S.next(0, cur)) return;
    f32x4 acc[2][2][4][2];
#pragma unroll
    for (int a = 0; a < 2; ++a)
#pragma unroll
        for (int b = 0; b < 2; ++b)
#pragma unroll
            for (int m = 0; m < 4; ++m)
#pragma unroll
                for (int n = 0; n < 2; ++n) acc[a][b][m][n] = (f32x4){0.f, 0.f, 0.f, 0.f};
    bf16x8 At[4][2], B0[2][2], B1[2][2]; i32x8 At8[4], B08[2], B18[2];
    const int f8o1 = (fq & 1) * 16, f8o2 = 16 - f8o1;
    int sc1_ = 0x7f7f7f7f; asm volatile("" : "+v"(sc1_));
    const char* cA; const char* cB; S.ab(cur, g, tstep, cA, cB);
    S.a_ready(cur);
    if constexpr (SP2) {
        PG8_STAGE(PG8_SB(0, 0), cB, voffB); PG8_STAGE(PG8_SB(0, 1), cB + hstep, voffB); PG8_STAGE(PG8_SA(0, 0), cA, voffA); PG8_STAGE(PG8_SA(0, 1), cA + hstep, voffA);
        if (wr == 1) PG8_BAR;
        PG8_WAIT_V(2); PG8_BAR;
        PG8_STAGE(PG8_SB(1, 0), cB + kstep, voffB); PG8_STAGE(PG8_SA(1, 0), cA + kstep, voffA); PG8_STAGE(PG8_SB(1, 1), cB + hstep + kstep, voffB);
        PG8_WAIT_V(6); PG8_BAR;
    } else {
        PG8_STAGE(PG8_SB(0, 0), cB, voffB); PG8_STAGE(PG8_SA(0, 0), cA, voffA); PG8_STAGE(PG8_SB(0, 1), cB + hstep, voffB); PG8_STAGE(PG8_SA(0, 1), cA + hstep, voffA);
        if (wr == 1) PG8_BAR;
        PG8_WAIT_V(4); PG8_BAR;
        PG8_STAGE(PG8_SB(1, 0), cB + kstep, voffB); PG8_STAGE(PG8_SA(1, 0), cA + kstep, voffA); PG8_STAGE(PG8_SB(1, 1), cB + hstep + kstep, voffB);
        PG8_WAIT_V(6); PG8_BAR;
    }
    for (;;) {
        const bool has_next = S.next(ui + 1, nxt);
        const char* nA = cA; const char* nB = cB; if (has_next) S.ab(nxt, g, tstep, nA, nB);
        for (int t = 0; t < nt; t += 2) {
            const bool last = (t == nt - 2);
            const char* a1 = cA + (size_t)(t + 1) * kstep;
            const char* a2 = last ? nA : cA + (size_t)(t + 2) * kstep; const char* b2 = last ? nB : cB + (size_t)(t + 2) * kstep;
            const char* a3 = a2 + kstep; const char* b3 = b2 + kstep;
            if (last && has_next) S.a_ready(nxt);
            if constexpr (SP2) {
            PG8_LDB(B0, 0, 0); PG8_LDB(B1, 0, 1); PG8_SCHED; PG8_LDA(At, 0, 0); PG8_STAGE(PG8_SA(1, 1), a1 + hstep, voffA);
            PG8_WAIT_V(8); PG8_WAIT_L(0); PG8_BAR; PG8_MMA(0, 0, At, B0); PG8_MMA(0, 1, At, B1); PG8_BAR; PG8_SCHED;
            PG8_LDA(At, 0, 1); PG8_STAGE(PG8_SB(0, 0), b2, voffB); PG8_STAGE(PG8_SB(0, 1), b2 + hstep, voffB); PG8_STAGE(PG8_SA(0, 0), a2, voffA);
            PG8_WAIT_V(8); PG8_WAIT_L(0); PG8_BAR; PG8_MMA(1, 0, At, B0); PG8_MMA(1, 1, At, B1); PG8_BAR; PG8_SCHED;
            PG8_LDB(B0, 1, 0); PG8_LDB(B1, 1, 1); PG8_SCHED; PG8_LDA(At, 1, 0); PG8_STAGE(PG8_SA(0, 1), a2 + hstep, voffA);
            PG8_WAIT_V(8); PG8_WAIT_L(0); PG8_BAR; PG8_MMA(0, 0, At, B0); PG8_MMA(0, 1, At, B1); PG8_BAR; PG8_SCHED;
            PG8_LDA(At, 1, 1); PG8_STAGE(PG8_SB(1, 0), b3, voffB); PG8_STAGE(PG8_SB(1, 1), b3 + hstep, voffB); PG8_STAGE(PG8_SA(1, 0), a3, voffA);
            PG8_WAIT_V(8); PG8_WAIT_L(0); PG8_BAR; PG8_MMA(1, 0, At, B0); PG8_MMA(1, 1, At, B1); PG8_BAR; PG8_SCHED;
            } else {
            PG8_LDB(B0, 0, 0); PG8_SCHED; PG8_LDA(At, 0, 0); PG8_STAGE(PG8_SA(1, 1), a1 + hstep, voffA);
            PG8_WAIT_L(8); PG8_BAR; PG8_WAIT_L(0); PG8_MMA(0, 0, At, B0); PG8_BAR; PG8_SCHED;
            PG8_LDB(B1, 0, 1); PG8_STAGE(PG8_SB(0, 0), b2, voffB);
            PG8_BAR; PG8_WAIT_L(0); PG8_MMA(0, 1, At, B1); PG8_BAR;
            PG8_LDA(At, 0, 1); PG8_STAGE(PG8_SA(0, 0), a2, voffA);
            PG8_BAR; PG8_WAIT_L(0); PG8_MMA(1, 0, At, B0); PG8_BAR; PG8_SCHED;
            PG8_STAGE(PG8_SB(0, 1), b2 + hstep, voffB);
            PG8_WAIT_V(6); PG8_BAR; PG8_MMA(1, 1, At, B1); PG8_BAR;
            PG8_LDB(B0, 1, 0); PG8_SCHED; PG8_LDA(At, 1, 0); PG8_STAGE(PG8_SA(0, 1), a2 + hstep, voffA);
            PG8_WAIT_L(8); PG8_BAR; PG8_WAIT_L(0); PG8_MMA(0, 0, At, B0); PG8_BAR; PG8_SCHED;
            PG8_LDB(B1, 1, 1); PG8_STAGE(PG8_SB(1, 0), b3, voffB);
            PG8_BAR; PG8_WAIT_L(0); PG8_MMA(0, 1, At, B1); PG8_BAR;
            PG8_LDA(At, 1, 1); PG8_STAGE(PG8_SA(1, 0), a3, voffA);
            PG8_BAR; PG8_WAIT_L(0); PG8_MMA(1, 0, At, B0); PG8_BAR; PG8_SCHED;
            PG8_STAGE(PG8_SB(1, 1), b3 + hstep, voffB);
            PG8_WAIT_V(6); PG8_BAR; PG8_MMA(1, 1, At, B1); PG8_BAR;
            }
        }
        if constexpr (F8) { asm volatile("s_nop 15\n\ts_nop 15" ::: "memory"); __builtin_amdgcn_sched_barrier(0); }
        if constexpr (ALIGN_EPI) { if (wr == 0) PG8_BAR; }
        if constexpr (!Epi::AFTER_DRAIN) { E(acc, cur, wr, wc, fr, fq); S.done(cur); }
        if (!has_next) break;
#pragma unroll
        for (int a = 0; a < 2; ++a)
#pragma unroll
            for (int b = 0; b < 2; ++b)
#pragma unroll
                for (int m = 0; m < 4; ++m)
#pragma unroll
                    for (int n = 0; n < 2; ++n) acc[a][b][m][n] = (f32x4){0.f, 0.f, 0.f, 0.f};
        cur = nxt; cA = nA; cB = nB; ++ui;
        if constexpr (ALIGN_EPI) { if (wr == 1) PG8_BAR; }
    }
    PG8_WAIT_V(0);
    if constexpr (!ALIGN_EPI) { if (wr == 0) PG8_BAR; }
    PG8_BAR;
    if constexpr (Epi::AFTER_DRAIN) { E.fused(acc, cur, wr, wc, fr, fq, lds, wid, lane); S.done(cur); }
#undef PG8_SA
#undef PG8_SB
#undef PG8_STAGE
#undef PG8_LDA
#undef PG8_LD32
#undef PG8_LDB
#undef PG8_MMA
#undef PG8_WAIT_V
#undef PG8_WAIT_L
#undef PG8_BAR
#undef PG8_SCHED
}
}

namespace pg8 {
constexpr float QK_C2 = 0.125f * 1.4426950408889634f;
__device__ __forceinline__ unsigned pk_fp8x4(float a, float b, float c, float d);
struct InProjOrder {
    static constexpr int NM = 272, NN = 8, NMAIN = NM * NN, NALL = NMAIN + 2 * NM;
    int G, c;
    __host__ __device__ void init(int G_, int c_) { G = G_; c = c_; }
    __host__ __device__ bool next(int i, Unit& u) const {
        const long L = (long)i * G + c; if (L >= NALL) return false;
        if (L < NMAIN) { int wgid = (int)L; { const int q = NMAIN / NXCD, xcd = wgid % NXCD, off = wgid / NXCD; wgid = xcd * q + off; }
            const int nig = WGM * NN, gid = wgid / nig, fm = gid * WGM, gsz = (NM - fm) < WGM ? (NM - fm) : WGM;
            u.pm = fm + ((wgid % nig) % gsz); u.pn = (wgid % nig) / gsz; }
        else { const int v = (int)L - NMAIN; u.pm = v >> 1; u.pn = 8 + (v & 1); }
        return true;
    }
    __device__ __forceinline__ void a_ready(const Unit&) const {}
    __device__ __forceinline__ void done(const Unit&) const {}
    __device__ __forceinline__ void ab(const Unit& u, const Gemm& g, size_t tstep, const char*& pa, const char*& pb) const {
        if (u.pn < 8) { pa = (const char*)g.A + (size_t)u.pm * tstep; pb = (const char*)g.Bt + (size_t)u.pn * tstep; }
        else { pa = (const char*)g.Bt + (size_t)u.pn * tstep; pb = (const char*)g.A + (size_t)u.pm * tstep; }
    }
};
struct EpiInProj {
    static constexpr bool PERM = true, AFTER_DRAIN = false;
    bf16_t *Q, *Kb, *VT, *Ub, *Gb; unsigned char* VT8; const PG8_LAS float* ropec; const PG8_LAS float* ropes; unsigned char *Q8, *K8;
    __device__ __forceinline__ void operator()(const f32x4 (&acc)[2][2][4][2], const Unit& u, int wr, int wc, int fr, int fq) const {
        const bool ctx = u.pm >= 256;
        if (u.pn >= 8) {
            const int tok0 = u.pm * BM + wc * 32 + 8 * fq;
#pragma unroll
            for (int bj = 0; bj < 2; ++bj) { const int tok = tok0 + bj * HALF; int bidx, key;
                if (ctx) { bidx = (tok - 65536) >> 8; key = 4096 + ((tok - 65536) & 255); } else { bidx = tok >> 12; key = tok & 4095; }
#pragma unroll
                for (int ai = 0; ai < 2; ++ai)
#pragma unroll
                    for (int m = 0; m < 4; ++m) { const int dim = (u.pn - 8) * BM + ai * HALF + wr * 64 + m * 16 + fr;
                        const f32x4 v0 = acc[ai][bj][m][0], v1 = acc[ai][bj][m][1];
                        u32x4 w; w.x = cvt_pk_bf16(v0[0], v0[1]); w.y = cvt_pk_bf16(v0[2], v0[3]); w.z = cvt_pk_bf16(v1[0], v1[1]); w.w = cvt_pk_bf16(v1[2], v1[3]);
                        *(u32x4*)(VT + ((size_t)(bidx * 512 + dim)) * 4352 + key) = w;
                        typedef unsigned u32x2v __attribute__((ext_vector_type(2))); u32x2v w8; w8.x = pk_fp8x4(v0[0], v0[1], v0[2], v0[3]); w8.y = pk_fp8x4(v1[0], v1[1], v1[2], v1[3]);
                        *(u32x2v*)(VT8 + ((size_t)(bidx * 512 + dim)) * 4352 + key) = w8; } }
            return;
        }
        const int seg = u.pn >> 1;
        if (ctx && (seg == 0 || seg == 3)) return;
        const int cs0 = (u.pn & 1) * BM + wc * 32 + 8 * fq;
        const bool rope = (seg < 2) && !ctx; const int a = wc & 1;
#pragma unroll
        for (int ai = 0; ai < 2; ++ai)
#pragma unroll
            for (int m = 0; m < 4; ++m) {
                const int r = u.pm * BM + ai * HALF + wr * 64 + m * 16 + fr;
                int bidx, s; size_t rowkv;
                if (ctx) { bidx = (r - 65536) >> 8; s = (r - 65536) & 255; rowkv = (size_t)bidx * 4352 + 4096 + s; }
                else { bidx = r >> 12; s = r & 4095; rowkv = (size_t)bidx * 4352 + s; }
                f32x4 cs = (f32x4){1.f, 1.f, 1.f, 1.f}, sn = (f32x4){0.f, 0.f, 0.f, 0.f};
                if (rope) { const int pos = a ? (s & 63) : (s >> 6); cs = *(const PG8_LAS f32x4*)(ropec + pos * 16 + 4 * fq); sn = *(const PG8_LAS f32x4*)(ropes + pos * 16 + 4 * fq); }
                bf16_t* dst; unsigned char* dst8 = nullptr;
                if (seg == 0) { dst = Q + (size_t)r * 512; dst8 = Q8 + (size_t)r * 512; } else if (seg == 1) { dst = Kb + rowkv * 512; dst8 = K8 + rowkv * 512; } else if (seg == 2) dst = Ub + (size_t)r * 512; else dst = Gb + (size_t)r * 512;
                const float f8s = seg == 0 ? 8.f : 2.f;
#pragma unroll
                for (int bj = 0; bj < 2; ++bj) {
                    f32x4 v0 = acc[ai][bj][m][0], v1 = acc[ai][bj][m][1];
                    if (rope) { const f32x4 o1 = v0 * cs - v1 * sn, o2 = v1 * cs + v0 * sn; v0 = o1; v1 = o2; }
                    if (seg == 0) { v0 = v0 * QK_C2; v1 = v1 * QK_C2; }
                    u32x4 w; w.x = cvt_pk_bf16(v0[0], v0[1]); w.y = cvt_pk_bf16(v0[2], v0[3]); w.z = cvt_pk_bf16(v1[0], v1[1]); w.w = cvt_pk_bf16(v1[2], v1[3]);
                    *(u32x4*)(dst + cs0 + bj * HALF) = w;
                    if (seg < 2) { typedef unsigned u32x2v __attribute__((ext_vector_type(2))); u32x2v w8; w8.x = pk_fp8x4(v0[0] * f8s, v0[1] * f8s, v0[2] * f8s, v0[3] * f8s); w8.y = pk_fp8x4(v1[0] * f8s, v1[1] * f8s, v1[2] * f8s, v1[3] * f8s);
                        *(u32x2v*)(dst8 + cs0 + bj * HALF) = w8; }
                }
            }
    }
};
__device__ __forceinline__ unsigned pk_fp8x4(float a, float b, float c, float d) {
    a = __builtin_amdgcn_fmed3f(a, -448.f, 448.f); b = __builtin_amdgcn_fmed3f(b, -448.f, 448.f); c = __builtin_amdgcn_fmed3f(c, -448.f, 448.f); d = __builtin_amdgcn_fmed3f(d, -448.f, 448.f);
    int w = 0; w = __builtin_amdgcn_cvt_pk_fp8_f32(a, b, w, false); w = __builtin_amdgcn_cvt_pk_fp8_f32(c, d, w, true); return (unsigned)w; }
template <bool OUT8> struct EpiSwiglu {
    static constexpr bool PERM = true, AFTER_DRAIN = false;
    bf16_t* H; int ldh; float ascale, oscale;
    __device__ __forceinline__ void operator()(const f32x4 (&acc)[2][2][4][2], const Unit& u, int wr, int wc, int fr, int fq) const {
        const int col0 = u.pn * HALF + wc * 32 + 8 * fq;
#pragma unroll
        for (int ai = 0; ai < 2; ++ai)
#pragma unroll
            for (int m = 0; m < 4; ++m) {
                const size_t r = (size_t)u.pm * BM + ai * HALF + wr * 64 + m * 16 + fr;
                float o[8];
#pragma unroll
                for (int n = 0; n < 2; ++n)
#pragma unroll
                    for (int j = 0; j < 4; ++j) { const float av = acc[ai][0][m][n][j] * ascale, bv = acc[ai][1][m][n][j] * ascale;
                        const float sg = __builtin_amdgcn_rcpf(1.f + __builtin_amdgcn_exp2f(-av * 1.4426950408889634f)); o[4 * n + j] = av * sg * bv; }
                if constexpr (OUT8) { typedef unsigned u32x2v __attribute__((ext_vector_type(2)));
                    u32x2v w; w.x = pk_fp8x4(o[0] * oscale, o[1] * oscale, o[2] * oscale, o[3] * oscale); w.y = pk_fp8x4(o[4] * oscale, o[5] * oscale, o[6] * oscale, o[7] * oscale);
                    *(u32x2v*)((unsigned char*)H + r * ldh + col0) = w;
                } else { u32x4 w; w.x = cvt_pk_bf16(o[0], o[1]); w.y = cvt_pk_bf16(o[2], o[3]); w.z = cvt_pk_bf16(o[4], o[5]); w.w = cvt_pk_bf16(o[6], o[7]);
                    *(u32x4*)(H + r * ldh + col0) = w; }
            }
    }
};
struct EpiPlain {
    static constexpr bool PERM = true, AFTER_DRAIN = false;
    bf16_t* O; int ldc; float scale;
    __device__ __forceinline__ void operator()(const f32x4 (&acc)[2][2][4][2], const Unit& u, int wr, int wc, int fr, int fq) const {
        const int col0 = u.pn * BM + wc * 32 + 8 * fq;
#pragma unroll
        for (int ai = 0; ai < 2; ++ai)
#pragma unroll
            for (int m = 0; m < 4; ++m) {
                bf16_t* rowp = O + ((size_t)u.pm * BM + ai * HALF + wr * 64 + m * 16 + fr) * ldc + col0;
#pragma unroll
                for (int bj = 0; bj < 2; ++bj) { const f32x4 v0 = acc[ai][bj][m][0] * scale, v1 = acc[ai][bj][m][1] * scale;
                    u32x4 w; w.x = cvt_pk_bf16(v0[0], v0[1]); w.y = cvt_pk_bf16(v0[2], v0[3]); w.z = cvt_pk_bf16(v1[0], v1[1]); w.w = cvt_pk_bf16(v1[2], v1[3]);
                    *(u32x4*)(rowp + bj * HALF) = w; }
            }
    }
};
}

#ifndef ATT_F8MAP1
#define ATT_F8MAP1 1
#endif
#ifndef ATT_F8MAP0
#define ATT_F8MAP0 1
#endif
namespace att {
typedef short bf16x8 __attribute__((ext_vector_type(8)));
typedef short s16x4 __attribute__((ext_vector_type(4)));
typedef short v4i16_t __attribute__((ext_vector_type(4)));
typedef float f32x16 __attribute__((ext_vector_type(16)));
typedef float f32x4 __attribute__((ext_vector_type(4)));
typedef unsigned u32x4 __attribute__((ext_vector_type(4)));
#define ATT_LAS __attribute__((address_space(3)))
typedef ATT_LAS const char* lds_cptr;
constexpr int TKV = 4352, NT = TKV / 64, NS = 3, KSLOT = 8192, VSLOT = 16384;
constexpr int LDS_K = 0, LDS_V = NS * KSLOT, LDS_SCR = LDS_V + 4 * VSLOT, LDS_FLG = LDS_SCR + 8 * 256, LDS_END = LDS_FLG + 64;
constexpr size_t PARK_FLOATS = 64 * 512;
__device__ __forceinline__ int crow(int r, int hi) { return (r & 3) + 8 * (r >> 2) + 4 * hi; }
__device__ __forceinline__ void glds16(const void* gsrc, unsigned lds_dst) { unsigned keep;
    asm volatile("s_mov_b32 %0, m0\n\ts_mov_b32 m0, %2\n\ts_nop 0\n\tglobal_load_lds_dwordx4 %1, off\n\ts_mov_b32 m0, %0" : "=&s"(keep) : "v"(gsrc), "s"(lds_dst) : "memory"); }
__device__ __forceinline__ void glds16s(const void* sbase, unsigned voff, unsigned lds_dst) { unsigned keep;
    asm volatile("s_mov_b32 %0, m0\n\ts_mov_b32 m0, %3\n\ts_nop 0\n\tglobal_load_lds_dwordx4 %1, %2\n\ts_mov_b32 m0, %0" : "=&s"(keep) : "v"(voff), "s"(sbase), "s"(lds_dst) : "memory"); }
typedef float f32x2_t __attribute__((ext_vector_type(2))); typedef __bf16 bf16x2_t __attribute__((ext_vector_type(2)));
__device__ __forceinline__ unsigned cvtpk(float lo, float hi) { f32x2_t v = {lo, hi}; bf16x2_t b = __builtin_convertvector(v, bf16x2_t); return __builtin_bit_cast(unsigned, b); }
__device__ __forceinline__ s16x4 vtr(lds_cptr p) { return __builtin_bit_cast(s16x4, __builtin_amdgcn_ds_read_tr16_b64_v4i16((ATT_LAS v4i16_t*)p)); }
__device__ __forceinline__ bf16x8 ldsb128(lds_cptr p) { return *(const ATT_LAS bf16x8*)p; }
#define ATT_SB() __builtin_amdgcn_sched_barrier(0)
#define ATT_WAITBAR(N) asm volatile("s_waitcnt vmcnt(" #N ") lgkmcnt(0)\n\ts_barrier" ::: "memory")

typedef int i32x8 __attribute__((ext_vector_type(8)));
typedef int i32x4 __attribute__((ext_vector_type(4)));
template <int MODE, bool F8>
__device__ __forceinline__ void attn_pass(int m, const short* Qw, const short* Kh, const short* Vh, const unsigned char* V8h, const unsigned char* Q8w, const unsigned char* K8h, char* shm, f32x16 (&o)[4], float& l, float& mx) {
    const int tid = threadIdx.x, lane = tid & 63, r32 = lane & 31, hi = lane >> 5; const int wid = __builtin_amdgcn_readfirstlane(tid >> 6);
    const bool late = wid >= 4;
    const unsigned lds0 = (unsigned)(uintptr_t)shm;
    const char* kbase = F8 ? (const char*)(K8h + wid * 16) : (const char*)(Kh + m * 64 + wid * 8);
    const unsigned koff = (unsigned)lane * (F8 ? 512u : 1024u);
    constexpr size_t KTILE_B = F8 ? 64 * 512 : 64 * 1024;
    const int vd_ = F8 ? 16 * wid + (lane >> 2) : 8 * wid + (lane >> 3);
    const short* vbase = F8 ? (const short*)(V8h + (size_t)(16 * wid) * TKV) : Vh + (size_t)(8 * wid) * TKV;
    const unsigned voff = F8 ? (unsigned)((lane >> 2) * TKV + (((lane & 3) ^ ((vd_ >> 2) & 3)) * 16)) : (unsigned)((lane >> 3) * TKV + (((lane & 7) ^ ((vd_ >> 1) & 7)) * 8)) * 2u;
    const unsigned kdst = lds0 + LDS_K + wid * 1024, vdst = lds0 + LDS_V + wid * 1024;
#define ATT_DMAK(t, slot) glds16s((const void*)(kbase + (size_t)(t) * KTILE_B), koff, (unsigned)__builtin_amdgcn_readfirstlane(kdst + (slot)))
#define ATT_DMAV(t, slot) do { if (F8) { glds16s((const void*)((const char*)vbase + (size_t)(t) * 64), voff, (unsigned)__builtin_amdgcn_readfirstlane(vdst + (slot))); } \
        else { const short* vs_ = vbase + (size_t)(t) * 64; glds16s((const void*)vs_, voff, (unsigned)__builtin_amdgcn_readfirstlane(vdst + (slot))); glds16s((const void*)(vs_ + (size_t)64 * TKV), voff, (unsigned)__builtin_amdgcn_readfirstlane(vdst + (slot) + 8192)); } } while (0)
    const lds_cptr shm3 = (lds_cptr)shm;
    const int kpi_ = F8 ? (32 * ((r32 >> 2) & 1) + (r32 & 3) + 4 * (r32 >> 3)) : ((r32 & ~12) | ((r32 & 4) << 1) | ((r32 & 8) >> 1));
    constexpr int KB_OFF = F8 ? 256 : 512;
    const lds_cptr kp0 = shm3 + LDS_K + (F8 ? (4 * m + 2 * hi) * 1024 : hi * 1024) + kpi_ * 16;
    const int vf_ = (r32 >> 1) & 7;
    const lds_cptr vq0 = shm3 + LDS_V + r32 * 128 + (((0 + hi) ^ vf_) << 4), vq1 = shm3 + LDS_V + r32 * 128 + (((2 + hi) ^ vf_) << 4);
    const lds_cptr vq2 = shm3 + LDS_V + r32 * 128 + (((4 + hi) ^ vf_) << 4), vq3 = shm3 + LDS_V + r32 * 128 + (((6 + hi) ^ vf_) << 4);
    const lds_cptr v8a = shm3 + LDS_V + r32 * 64 + (((2 * hi) ^ ((r32 >> 2) & 3)) << 4), v8b = shm3 + LDS_V + r32 * 64 + (((2 * hi + 1) ^ ((r32 >> 2) & 3)) << 4);
    int sc1_ = 0x7f7f7f7f; asm volatile("" : "+v"(sc1_)); int scA = sc1_; int scK_ = 0x7e7e7e7e, scQ_ = 0x7c7c7c7c; asm volatile("" : "+v"(scK_), "+v"(scQ_));
    bf16x8 qr[4]; i32x8 q8;
    if (F8) { const i32x4 qa_ = *(const i32x4*)(Q8w + (size_t)r32 * 512 + m * 64 + 32 * hi), qb_ = *(const i32x4*)(Q8w + (size_t)r32 * 512 + m * 64 + 32 * hi + 16); q8 = __builtin_shufflevector(qa_, qb_, 0, 1, 2, 3, 4, 5, 6, 7);
        asm volatile("" : "+v"(q8) :: "memory"); }
    else {
#pragma unroll
    for (int d0 = 0; d0 < 4; ++d0) qr[d0] = *(const bf16x8*)(Qw + (size_t)r32 * 512 + m * 64 + d0 * 16 + hi * 8);
    asm volatile("" : "+v"(qr[0]), "+v"(qr[1]), "+v"(qr[2]), "+v"(qr[3]) :: "memory"); }
    constexpr int NV = F8 ? 1 : 2;
    ATT_DMAK(0, 0); ATT_DMAV(0, 0); ATT_DMAK(1, KSLOT); ATT_DMAK(2, 2 * KSLOT); ATT_DMAV(1, VSLOT);
#pragma unroll
    for (int i = 0; i < 4; ++i) o[i] = f32x16{};
    l = 0.f; float nmx = -INFINITY; f32x2_t l2 = {0.f, 0.f};
    if (NV == 2) ATT_WAITBAR(3); else ATT_WAITBAR(2);
    bf16x8 ka0, ka1, ka2, ka3, kb0, kb1, kb2, kb3;
    i32x8 k8a, k8b;
#define ATT_LOADK(slot) do { const lds_cptr kp_ = kp0 + (slot); if (F8) { k8a = __builtin_shufflevector(*(const ATT_LAS i32x4*)kp_, *(const ATT_LAS i32x4*)(kp_ + 1024), 0, 1, 2, 3, 4, 5, 6, 7); k8b = __builtin_shufflevector(*(const ATT_LAS i32x4*)(kp_ + KB_OFF), *(const ATT_LAS i32x4*)(kp_ + KB_OFF + 1024), 0, 1, 2, 3, 4, 5, 6, 7); } else { ka0 = ldsb128(kp_); kb0 = ldsb128(kp_ + KB_OFF); ka1 = ldsb128(kp_ + 2048); kb1 = ldsb128(kp_ + 2048 + KB_OFF); \
        ka2 = ldsb128(kp_ + 4096); kb2 = ldsb128(kp_ + 4096 + KB_OFF); ka3 = ldsb128(kp_ + 6144); kb3 = ldsb128(kp_ + 6144 + KB_OFF); } } while (0)
    ATT_LOADK(0);
    if (NV == 2) ATT_WAITBAR(3); else ATT_WAITBAR(2);
    int ksl = 0, vsl = 0;
    bf16x8 p0, p1, p2, p3;
    p0 = p1 = p2 = p3 = (bf16x8){0, 0, 0, 0, 0, 0, 0, 0};
#define ATT_VLD(dst, db, ks) dst = ldsb128(vq##ks + vsl_ + (db) * 4096)
#define ATT_MF(acc, a, b) acc = __builtin_amdgcn_mfma_f32_32x32x16_bf16(a, b, acc, 0, 0, 0)
#define ATT_PACK8(oa_, ob_) do { \
        _Pragma("unroll") for (int j = 0; j < 4; ++j) { int w_ = __builtin_amdgcn_cvt_pk_fp8_f32(sa[4 * j], sa[4 * j + 1], oa_[j], false); w_ = __builtin_amdgcn_cvt_pk_fp8_f32(sa[4 * j + 2], sa[4 * j + 3], w_, true); w8_[j] = w_; } \
        _Pragma("unroll") for (int j = 0; j < 4; ++j) { int w_ = __builtin_amdgcn_cvt_pk_fp8_f32(sb[4 * j], sb[4 * j + 1], ob_[j], false); w_ = __builtin_amdgcn_cvt_pk_fp8_f32(sb[4 * j + 2], sb[4 * j + 3], w_, true); w8_[4 + j] = w_; } } while (0)
#define ATT_X(HASNEXT, ksn_) do { \
        f32x16 sa, sb;     \
        if (F8) {     \
            asm volatile("v_mfma_scale_f32_32x32x64_f8f6f4 %0, %1, %2, -4.0, %3, %4 op_sel_hi:[0,0,0]" : "=&v"(sa) : "v"(k8a), "v"(q8), "v"(scK_), "v"(scQ_)); \
            asm volatile("v_mfma_scale_f32_32x32x64_f8f6f4 %0, %1, %2, -4.0, %3, %4 op_sel_hi:[0,0,0]" : "=&v"(sb) : "v"(k8b), "v"(q8), "v"(scK_), "v"(scQ_)); } \
        else { sa = f32x16{}; sb = f32x16{}; ATT_MF(sa, ka0, qr[0]); ATT_MF(sb, kb0, qr[0]); \
        ATT_MF(sa, ka1, qr[1]); ATT_MF(sb, kb1, qr[1]); \
        ATT_MF(sa, ka2, qr[2]); ATT_MF(sb, kb2, qr[2]); ATT_MF(sa, ka3, qr[3]); ATT_MF(sb, kb3, qr[3]); } \
        ATT_SB(); \
          \
        if (t + 3 < NT) ATT_DMAK(t + 3, ksl); \
        if (MODE != 1) { if (t + 2 < NT) { const int v2 = (vsl >= 2 * VSLOT) ? vsl - 2 * VSLOT : vsl + 2 * VSLOT; ATT_DMAV(t + 2, v2); } } \
        ATT_SB(); \
        if (HASNEXT) ATT_LOADK(ksn_); \
        if (F8) { asm volatile("s_nop 15\n\ts_nop 3" : "+v"(sa), "+v"(sb)); }     \
        if (MODE == 1) { \
            _Pragma("unroll") for (int r = 0; r < 16; ++r) nmx = fmaxf(nmx, fmaxf(sa[r], sb[r])); \
        } else { \
            _Pragma("unroll") for (int r = 0; r < 16; ++r) { sa[r] = __builtin_amdgcn_exp2f(MODE == 2 ? sa[r] - mx : sa[r]); sb[r] = __builtin_amdgcn_exp2f(MODE == 2 ? sb[r] - mx : sb[r]); } \
            _Pragma("unroll") for (int r = 0; r < 8; ++r) { l2 += (f32x2_t){sa[2 * r], sa[2 * r + 1]}; l2 += (f32x2_t){sb[2 * r], sb[2 * r + 1]}; }     \
            if (F8) { i32x8 w8_; const i32x4 po0_ = __builtin_bit_cast(i32x4, p0), po1_ = __builtin_bit_cast(i32x4, p1);     \
                int pmt = 0; \
                _Pragma("unroll") for (int r = 0; r < 16; ++r) { const float fa_ = sa[r], fb_ = sb[r]; const int ia_ = __float_as_int(fa_), ib_ = __float_as_int(fb_); pmt = pmt > ia_ ? pmt : ia_; pmt = pmt > ib_ ? pmt : ib_; }     \
                scA = sc1_; ATT_PACK8(po0_, po1_);     \
                if (__builtin_expect(__any(pmt > 0x43e00000), 0)) {     \
                    const int e_ = pmt > 0x43e00000 ? (pmt >> 23) - 134 : 0;     \
                    const float f_ = __int_as_float((127 - e_) << 23); \
                    _Pragma("unroll") for (int r = 0; r < 16; ++r) { sa[r] *= f_; sb[r] *= f_; } \
                    const i32x4 pa_ = __builtin_shufflevector(w8_, w8_, 0, 1, 2, 3), pb_ = __builtin_shufflevector(w8_, w8_, 4, 5, 6, 7); \
                    scA = (127 + e_) * 0x01010101; ATT_PACK8(pa_, pb_); } \
                p0 = __builtin_bit_cast(bf16x8, __builtin_shufflevector(w8_, w8_, 0, 1, 2, 3)); p1 = __builtin_bit_cast(bf16x8, __builtin_shufflevector(w8_, w8_, 4, 5, 6, 7)); \
            } else { \
            u32x4 w0, w1, w2, w3; \
            w0.x = cvtpk(sa[0], sa[1]); w0.y = cvtpk(sa[2], sa[3]); w0.z = cvtpk(sa[4], sa[5]); w0.w = cvtpk(sa[6], sa[7]); \
            w1.x = cvtpk(sa[8], sa[9]); w1.y = cvtpk(sa[10], sa[11]); w1.z = cvtpk(sa[12], sa[13]); w1.w = cvtpk(sa[14], sa[15]); \
            w2.x = cvtpk(sb[0], sb[1]); w2.y = cvtpk(sb[2], sb[3]); w2.z = cvtpk(sb[4], sb[5]); w2.w = cvtpk(sb[6], sb[7]); \
            w3.x = cvtpk(sb[8], sb[9]); w3.y = cvtpk(sb[10], sb[11]); w3.z = cvtpk(sb[12], sb[13]); w3.w = cvtpk(sb[14], sb[15]); \
            p0 = __builtin_bit_cast(bf16x8, w0); p1 = __builtin_bit_cast(bf16x8, w1); p2 = __builtin_bit_cast(bf16x8, w2); p3 = __builtin_bit_cast(bf16x8, w3); } \
        } \
        ATT_SB(); } while (0)
#define ATT_LD32(dst, db) dst = __builtin_shufflevector(*(const ATT_LAS i32x4*)(v8a + vsl_ + (db) * 2048), *(const ATT_LAS i32x4*)(v8b + vsl_ + (db) * 2048), 0, 1, 2, 3, 4, 5, 6, 7)
#define ATT_MF8(acc, vfrag) asm volatile("s_nop 1\n\tv_mfma_scale_f32_32x32x64_f8f6f4 %0, %1, %2, %0, %3, %4 op_sel_hi:[0,0,0]" : "+v"(acc) : "v"(pp8_), "v"(vfrag), "v"(scA), "v"(sc1_))
#define ATT_Y8(vslx) do { const int vsl_ = (vslx); i32x8 wa, wb, wc, wd; const i32x8 pp8_ = __builtin_shufflevector(__builtin_bit_cast(i32x4, p0), __builtin_bit_cast(i32x4, p1), 0, 1, 2, 3, 4, 5, 6, 7); \
        ATT_LD32(wa, 0); ATT_LD32(wb, 1); ATT_SB(); ATT_LD32(wc, 2); ATT_LD32(wd, 3); ATT_SB(); \
        ATT_MF8(o[0], wa); ATT_MF8(o[1], wb); ATT_SB(); ATT_MF8(o[2], wc); ATT_MF8(o[3], wd); ATT_SB(); } while (0)
#define ATT_YB(vslx) do { const int vsl_ = (vslx); bf16x8 va, vb, vc, vd, ve, vf, vg, vh;     \
        ATT_VLD(va, 0, 0); ATT_VLD(vb, 0, 1); ATT_VLD(vc, 0, 2); ATT_VLD(vd, 0, 3); ATT_SB(); \
        ATT_VLD(ve, 1, 0); ATT_VLD(vf, 1, 1); ATT_VLD(vg, 1, 2); ATT_VLD(vh, 1, 3); ATT_SB(); \
        ATT_MF(o[0], p0, va); ATT_MF(o[0], p1, vb); ATT_MF(o[0], p2, vc); ATT_MF(o[0], p3, vd); ATT_SB(); \
        ATT_VLD(va, 2, 0); ATT_VLD(vb, 2, 1); ATT_VLD(vc, 2, 2); ATT_VLD(vd, 2, 3); ATT_SB(); \
        ATT_MF(o[1], p0, ve); ATT_MF(o[1], p1, vf); ATT_MF(o[1], p2, vg); ATT_MF(o[1], p3, vh); ATT_SB(); \
        ATT_VLD(ve, 3, 0); ATT_VLD(vf, 3, 1); ATT_VLD(vg, 3, 2); ATT_VLD(vh, 3, 3); ATT_SB(); \
        ATT_MF(o[2], p0, va); ATT_MF(o[2], p1, vb); ATT_MF(o[2], p2, vc); ATT_MF(o[2], p3, vd); ATT_SB(); \
        ATT_MF(o[3], p0, ve); ATT_MF(o[3], p1, vf); ATT_MF(o[3], p2, vg); ATT_MF(o[3], p3, vh); ATT_SB(); } while (0)
#define ATT_Y(vslx) do { if (F8) ATT_Y8(vslx); else ATT_YB(vslx); } while (0)
#pragma unroll 1
    for (int t = 0; t < NT; ++t) {
        const int ksn = (ksl == 2 * KSLOT) ? 0 : ksl + KSLOT;
        const int vprev = (vsl == 0) ? 3 * VSLOT : vsl - VSLOT;
        if (MODE != 1) { if (late && t >= 1) ATT_Y(vprev); }
        ATT_X(true, ksn);
        if (MODE != 1) { if (!late) ATT_Y(vsl); }
        if (MODE != 1) { if (NV == 2) { if (t + 3 < NT) ATT_WAITBAR(3); else if (t + 2 < NT) ATT_WAITBAR(2); else ATT_WAITBAR(0); }
                         else { if (t + 3 < NT) ATT_WAITBAR(2); else if (t + 2 < NT) ATT_WAITBAR(1); else ATT_WAITBAR(0); } }
        else { if (t + 3 < NT) ATT_WAITBAR(1); else ATT_WAITBAR(0); }
        ksl = ksn; vsl = (vsl == 3 * VSLOT) ? 0 : vsl + VSLOT;
    }
    if (MODE != 1) { if (late) { const int vprev = (vsl == 0) ? 3 * VSLOT : vsl - VSLOT; ATT_Y(vprev); } ATT_WAITBAR(0); }
    if (F8) { asm volatile("s_nop 15\n\ts_nop 15" ::: "memory"); __builtin_amdgcn_sched_barrier(0); }
    if (MODE == 1) mx = fmaxf(nmx, __shfl_xor(nmx, 32)); else l = l2.x + l2.y;
#undef ATT_X
#undef ATT_PACK8
#undef ATT_Y
#undef ATT_YB
#undef ATT_Y8
#undef ATT_MF8
#undef ATT_LD32
#undef ATT_MF
#undef ATT_VLD
#undef ATT_LOADK
#undef ATT_DMAK
#undef ATT_DMAV
}

template <int MODE>
__device__ __forceinline__ bool attn_unit(int b, int h, int qb, const short* Q, const short* K, const short* V, const unsigned char* V8, const unsigned char* Q8, const unsigned char* K8, short* AO, const float* subg, float lam, float* park, char* shm) {
    const int tid = threadIdx.x, lane = tid & 63, r32 = lane & 31, hi = lane >> 5; const int wid = __builtin_amdgcn_readfirstlane(tid >> 6);
    ATT_LAS float* scr = (ATT_LAS float*)((ATT_LAS char*)shm + LDS_SCR) + wid * 64;
    volatile ATT_LAS unsigned* flgp = (volatile ATT_LAS unsigned*)((ATT_LAS char*)shm + LDS_FLG);
    const size_t qrow = (size_t)b * 4096 + qb * 256 + wid * 32;
    const short* Qw = Q + qrow * 512 + h * 128; const short* Kh = K + (size_t)b * TKV * 512 + h * 128; const short* Vh = V + (size_t)(b * 4 + h) * 128 * TKV; const unsigned char* V8h = V8 + (size_t)(b * 4 + h) * 128 * TKV; const unsigned char* Q8w = Q8 + qrow * 512 + h * 128; const unsigned char* K8h = K8 + (size_t)b * TKV * 512 + h * 128;
    if (tid == 0) *flgp = 0u;
    f32x16 o[4]; float l, mx = 0.f; bool bad = false;
    if (MODE == 2) { float dummy; attn_pass<1, false>(0, Qw, Kh, Vh, V8h, Q8w, K8h, shm, o, dummy, mx); }
    attn_pass<(MODE == 2 ? 2 : 0), (MODE == 0) && (ATT_F8MAP0 != 0)>(0, Qw, Kh, Vh, V8h, Q8w, K8h, shm, o, l, mx);
    l += __shfl_xor(l, 32); bad = bad || !(l > 0.f && l < 3.0e38f);
    if (hi == 0) scr[r32] = l;
    asm volatile("s_waitcnt lgkmcnt(0)" ::: "memory");
    {   float* pk = park + (size_t)tid * 64;
#pragma unroll
        for (int g = 0; g < 4; ++g) { float il[4];
#pragma unroll
            for (int e = 0; e < 4; ++e) il[e] = __builtin_amdgcn_rcpf(scr[crow(4 * g + e, hi)]);
#pragma unroll
            for (int db = 0; db < 4; ++db) *(f32x4*)(pk + db * 16 + 4 * g) = (f32x4){o[db][4 * g] * il[0], o[db][4 * g + 1] * il[1], o[db][4 * g + 2] * il[2], o[db][4 * g + 3] * il[3]}; } }
    if (MODE == 2) { float dummy; attn_pass<1, false>(1, Qw, Kh, Vh, V8h, Q8w, K8h, shm, o, dummy, mx); }
    attn_pass<(MODE == 2 ? 2 : 0), (MODE == 0) && (ATT_F8MAP1 != 0)>(1, Qw, Kh, Vh, V8h, Q8w, K8h, shm, o, l, mx);
    l += __shfl_xor(l, 32); bad = bad || !(l > 0.f && l < 3.0e38f);
    if (hi == 0) scr[32 + r32] = l;
    asm volatile("s_waitcnt lgkmcnt(0)" ::: "memory");
    float ss[16];
    {   const float* pk = park + (size_t)tid * 64;
#pragma unroll
        for (int r = 0; r < 16; ++r) ss[r] = 0.f;
#pragma unroll
        for (int g = 0; g < 4; ++g) { float il[4];
#pragma unroll
            for (int e = 0; e < 4; ++e) il[e] = lam * __builtin_amdgcn_rcpf(scr[32 + crow(4 * g + e, hi)]);
#pragma unroll
            for (int db = 0; db < 4; ++db) { const f32x4 pv = *(const f32x4*)(pk + db * 16 + 4 * g);
#pragma unroll
                for (int e = 0; e < 4; ++e) { const float v = pv[e] - o[db][4 * g + e] * il[e]; o[db][4 * g + e] = v; ss[4 * g + e] += v * v; } } } }
#pragma unroll
    for (int off = 1; off < 32; off <<= 1)
#pragma unroll
        for (int r = 0; r < 16; ++r) ss[r] += __shfl_xor(ss[r], off);
    float gv[4];
#pragma unroll
    for (int db = 0; db < 4; ++db) gv[db] = subg[32 * db + r32] * 0.8f;
    short* aow = AO + qrow * 1024 + h * 128 + r32;
#pragma unroll
    for (int r = 0; r < 16; ++r) { const float rs = __builtin_amdgcn_rsqf(ss[r] * (1.f / 128.f) + 1e-5f);
#pragma unroll
        for (int db = 0; db < 4; ++db) { const unsigned w = cvtpk(o[db][r] * rs * gv[db], 0.f); aow[(size_t)crow(r, hi) * 1024 + 32 * db] = (short)(w & 0xffffu); } }
    if (MODE == 0) { if (__any(bad)) { if (lane == 0) *flgp = 1u; } }
    asm volatile("s_waitcnt vmcnt(0) lgkmcnt(0)\n\ts_barrier" ::: "memory");
    const unsigned flg = *flgp;
    asm volatile("s_waitcnt lgkmcnt(0)\n\ts_barrier" ::: "memory");
    return __builtin_amdgcn_readfirstlane(flg) != 0u;
}
__device__ __forceinline__ void attn_unit_safe(int b, int h, int qb, const short* Q, const short* K, const short* V, const unsigned char* V8, const unsigned char* Q8, const unsigned char* K8, short* AO, const float* subg, float lam, float* park, char* shm, bool force_fallback) {
    const bool redo = attn_unit<0>(b, h, qb, Q, K, V, V8, Q8, K8, AO, subg, lam, park, shm);
    if (redo || force_fallback) (void)attn_unit<2>(b, h, qb, Q, K, V, V8, Q8, K8, AO, subg, lam, park, shm);
}
}

namespace lru2 {
typedef short bf16x8 __attribute__((ext_vector_type(8)));
typedef float f32x16 __attribute__((ext_vector_type(16)));
typedef float f32x4 __attribute__((ext_vector_type(4)));
typedef float f32x2 __attribute__((ext_vector_type(2)));
#define LRU2_LAS __attribute__((address_space(3)))
constexpr int TS = 144, TILE = 64 * TS;
constexpr int LDS_TILE = 0, LDS_COMP = 8 * TILE, LDS_CW = LDS_COMP + 2 * 8 * 32 * 8, LDS_BF = LDS_CW + 5 * 64 * 4, LDS_END = LDS_BF + 8192;
__device__ __forceinline__ int crow(int r, int hi) { return (r & 3) + 8 * (r >> 2) + 4 * hi; }
__device__ __forceinline__ float bf2f(unsigned short v) { return __uint_as_float((unsigned)v << 16); }
__device__ __forceinline__ unsigned short f2bf(float f) { unsigned u = __float_as_uint(f); return (unsigned short)((u + 0x7fffu + ((u >> 16) & 1u)) >> 16); }
constexpr float L2E = 1.4426950408889634f;

__device__ __forceinline__ void lru_unit(int b, int w, int nb, const unsigned short* U, const unsigned short* G, const float* convw, const float* convb, const unsigned short* WgT, const float* bg,
                                         const float* sp8, float* HS, unsigned short* AO, LRU2_LAS unsigned char* lds) {
    const int tid = threadIdx.x, lane = tid & 63, r32 = lane & 31, hi = lane >> 5; const int k = __builtin_amdgcn_readfirstlane(tid >> 6);
    LRU2_LAS unsigned char* tile = lds + LDS_TILE + k * TILE;
    LRU2_LAS f32x2* comp = (LRU2_LAS f32x2*)(lds + LDS_COMP);
    const int chn = 64 * w + 32 * nb + r32;
    const int cg = lane & 7, tg = lane >> 3;
    LRU2_LAS float* cw = (LRU2_LAS float*)(lds + LDS_CW);
    if (tid < 320) { const int jj = tid >> 6, c = tid & 63; cw[tid] = jj < 4 ? convw[jj * 512 + 64 * w + c] : convb[64 * w + c]; }
    __syncthreads();
#pragma unroll 1
    for (int dir = 0; dir < 2; ++dir) {
        { const int fi = tid >> 5, o32 = tid & 31;
            const int g = fi >> 3, ks = (fi >> 1) & 3, hi2 = fi & 1;
            *(LRU2_LAS bf16x8*)(lds + LDS_BF + fi * 512 + o32 * 16) = *(const bf16x8*)(WgT + ((size_t)(((dir * 2 + g) * 8 + w) * 64 + 32 * nb + o32)) * 64 + 16 * ks + 8 * hi2); }
        __syncthreads();
        const float br = bg[((dir * 2 + 0) * 8 + w) * 64 + 32 * nb + r32], bi = bg[((dir * 2 + 1) * 8 + w) * 64 + 32 * nb + r32], sp = sp8[dir * 512 + chn];
        float cround = 0.f;
        bf16x8 uu[11];
#define LRU2_CHUNK(p_, chunk_, isctx_, L_, s0_, rowbase_) const int chunk_ = dir == 0 ? (p_) : ((p_) < 4 ? 3 - (p_) : 71 - (p_)); const bool isctx_ = chunk_ < 4; \
        const int L_ = isctx_ ? 256 : 4096, s0_ = isctx_ ? 64 * chunk_ : 64 * (chunk_ - 4); const size_t rowbase_ = isctx_ ? (size_t)65536 + (size_t)b * 256 : (size_t)b * 4096
#define LRU2_LOADU(p_) do { if ((p_) < 68) { LRU2_CHUNK(p_, ch_, ic_, L_, s0_, rb_); _Pragma("unroll") for (int i = 0; i < 11; ++i) { const int s = s0_ + 8 * tg - 2 + i; uu[i] = (bf16x8){0, 0, 0, 0, 0, 0, 0, 0}; \
            if (s >= 0 && s < L_) uu[i] = *(const bf16x8*)(U + (rb_ + s) * 512 + 64 * w + 8 * cg); } } } while (0)
        LRU2_LOADU(k);
#pragma unroll 1
        for (int rd = 0; rd < 9; ++rd) {
            const int p = 8 * rd + k; const bool valid = p < 68;
            LRU2_CHUNK(p, chunk, isctx, L, s0, rowbase);
            (void)L;
            f32x16 z[2][2];
            float atot = 1.f, cend = 0.f, cst[8];
            if (valid) {
                {
                    float wv[4][8], bv[8];
#pragma unroll
                    for (int jj = 0; jj < 4; ++jj) { const f32x4 a = *(const LRU2_LAS f32x4*)(cw + jj * 64 + 8 * cg), c = *(const LRU2_LAS f32x4*)(cw + jj * 64 + 8 * cg + 4);
                        wv[jj][0] = a.x; wv[jj][1] = a.y; wv[jj][2] = a.z; wv[jj][3] = a.w; wv[jj][4] = c.x; wv[jj][5] = c.y; wv[jj][6] = c.z; wv[jj][7] = c.w; }
                    { const f32x4 a = *(const LRU2_LAS f32x4*)(cw + 256 + 8 * cg), c = *(const LRU2_LAS f32x4*)(cw + 256 + 8 * cg + 4); bv[0] = a.x; bv[1] = a.y; bv[2] = a.z; bv[3] = a.w; bv[4] = c.x; bv[5] = c.y; bv[6] = c.z; bv[7] = c.w; }
#pragma unroll
                    for (int tt = 0; tt < 8; ++tt) { bf16x8 o;
#pragma unroll
                        for (int e = 0; e < 8; ++e) { float acc = bv[e];
#pragma unroll
                            for (int jj = 0; jj < 4; ++jj) acc += wv[jj][e] * bf2f((unsigned short)uu[tt + jj][e]);
                            o[e] = (short)f2bf(acc); }
                        *(LRU2_LAS bf16x8*)(tile + (8 * tg + tt) * TS + cg * 16) = o; }
                }
                LRU2_LOADU(p + 8);
                asm volatile("s_waitcnt lgkmcnt(0)" ::: "memory");
#pragma unroll
                for (int g = 0; g < 2; ++g)
#pragma unroll
                    for (int tb = 0; tb < 2; ++tb) { z[g][tb] = f32x16{};
#pragma unroll
                        for (int ks = 0; ks < 4; ++ks) z[g][tb] = __builtin_amdgcn_mfma_f32_32x32x16_bf16(*(const LRU2_LAS bf16x8*)(tile + (32 * tb + r32) * TS + (16 * ks + 8 * hi) * 2), *(const LRU2_LAS bf16x8*)(lds + LDS_BF + ((g * 4 + ks) * 2 + hi) * 512 + r32 * 16), z[g][tb], 0, 0, 0); }
#pragma unroll
                for (int tb = 0; tb < 2; ++tb)
#pragma unroll
                    for (int r = 0; r < 16; ++r) {
                        const float rg = __builtin_amdgcn_rcpf(1.f + __builtin_amdgcn_exp2f(-(z[0][tb][r] + br) * L2E));
                        const float ig = __builtin_amdgcn_rcpf(1.f + __builtin_amdgcn_exp2f(-(z[1][tb][r] + bi) * L2E));
                        const float a = __builtin_amdgcn_exp2f(-rg * sp);
                        const float mult = __builtin_amdgcn_sqrtf(fabsf(1.f - a * a));
                        z[0][tb][r] = a; z[1][tb][r] = mult * ig * bf2f(*(const LRU2_LAS unsigned short*)(tile + (32 * tb + crow(r, hi)) * TS + (32 * nb + r32) * 2));
                    }
                __builtin_amdgcn_sched_barrier(0);
            }
            float Ao[8], Bo[8], Ax[8], Bx[8];
            if (valid) {
#pragma unroll
                for (int q = 0; q < 8; ++q) { const int tb = q >> 2, rb = 4 * (q & 3);
                    const float a0 = z[0][tb][rb], a1 = z[0][tb][rb + 1], a2 = z[0][tb][rb + 2], a3 = z[0][tb][rb + 3];
                    const float b0 = z[1][tb][rb], b1 = z[1][tb][rb + 1], b2 = z[1][tb][rb + 2], b3 = z[1][tb][rb + 3];
                    Ao[q] = (a0 * a1) * (a2 * a3);
                    Bo[q] = dir == 0 ? ((b0 * a1 + b1) * a2 + b2) * a3 + b3 : ((b3 * a2 + b2) * a1 + b1) * a0 + b0;
                    Ax[q] = __shfl_xor(Ao[q], 32); Bx[q] = __shfl_xor(Bo[q], 32); }
                float c = 0.f;
                if (dir == 0) {
#pragma unroll
                    for (int q = 0; q < 8; ++q) { const float Ae = hi ? Ax[q] : Ao[q], Be = hi ? Bx[q] : Bo[q], Aod = hi ? Ao[q] : Ax[q], Bod = hi ? Bo[q] : Bx[q];
                        c = Aod * (Ae * c + Be) + Bod; atot *= Ao[q] * Ax[q]; }
                } else {
#pragma unroll
                    for (int q = 7; q >= 0; --q) { const float Ae = hi ? Ax[q] : Ao[q], Be = hi ? Bx[q] : Bo[q], Aod = hi ? Ao[q] : Ax[q], Bod = hi ? Bo[q] : Bx[q];
                        c = Ae * (Aod * c + Bod) + Be; atot *= Ao[q] * Ax[q]; }
                }
                cend = c;
            }
            if (hi == 0) comp[((rd & 1) * 8 + k) * 32 + r32] = (f32x2){atot, cend};
            __syncthreads();
            float cin = cround, call = cround;
#pragma unroll
            for (int k2 = 0; k2 < 8; ++k2) { const f32x2 cc = comp[((rd & 1) * 8 + k2) * 32 + r32]; call = cc.x * call + cc.y; if (k2 < k) cin = call; }
            cround = call;
            if (valid) {
                float c = cin;
                if (dir == 0) {
#pragma unroll
                    for (int q = 0; q < 8; ++q) { const float Ae = hi ? Ax[q] : Ao[q], Be = hi ? Bx[q] : Bo[q], Aod = hi ? Ao[q] : Ax[q], Bod = hi ? Bo[q] : Bx[q];
                        const float c1 = Ae * c + Be; cst[q] = hi ? c1 : c; c = Aod * c1 + Bod; }
                } else {
#pragma unroll
                    for (int q = 7; q >= 0; --q) { const float Ae = hi ? Ax[q] : Ao[q], Be = hi ? Bx[q] : Bo[q], Aod = hi ? Ao[q] : Ax[q], Bod = hi ? Bo[q] : Bx[q];
                        const float c1 = Aod * c + Bod; cst[q] = hi ? c : c1; c = Ae * c1 + Be; }
                }
                if (!isctx) {
#pragma unroll
                    for (int q = 0; q < 8; ++q) { const int tb = q >> 2, rb = 4 * (q & 3); float hcur = cst[q];
                        if (dir == 0) {
#pragma unroll
                            for (int e = 0; e < 4; ++e) { hcur = z[0][tb][rb + e] * hcur + z[1][tb][rb + e]; z[1][tb][rb + e] = hcur; }
                        } else {
#pragma unroll
                            for (int e = 3; e >= 0; --e) { hcur = z[0][tb][rb + e] * hcur + z[1][tb][rb + e]; z[1][tb][rb + e] = hcur; }
                        } }
                    const size_t row0 = rowbase + s0;
                    const int hoff = hi * 4 * 512 + chn, aoff = hi * 4 * 1024 + 512 + chn;
                    if (dir == 0) {
#pragma unroll
                        for (int tb = 0; tb < 2; ++tb)
#pragma unroll
                            for (int r = 0; r < 16; ++r) { const size_t rowu = row0 + 32 * tb + 8 * (r >> 2) + (r & 3); (HS + rowu * 512)[hoff] = z[1][tb][r]; }
                    } else {
#pragma unroll
                        for (int tb = 0; tb < 2; ++tb) { float hf[16]; unsigned short gg[16];
#pragma unroll
                            for (int r = 0; r < 16; ++r) { const size_t rowu = row0 + 32 * tb + 8 * (r >> 2) + (r & 3); hf[r] = (HS + rowu * 512)[hoff]; gg[r] = (G + rowu * 512)[hoff]; }
#pragma unroll
                            for (int r = 0; r < 16; ++r) { const size_t rowu = row0 + 32 * tb + 8 * (r >> 2) + (r & 3); const float hsum = z[1][tb][r] + hf[r];
                                const float g = bf2f(gg[r]); const float t = 1.5957691216057308f * (g + 0.044715f * g * g * g);
                                const float y = hsum * g * __builtin_amdgcn_rcpf(1.f + __builtin_amdgcn_exp2f(-t * L2E));
                                (AO + rowu * 1024)[aoff] = f2bf(y); } }
                    }
                }
            }
        }
#undef LRU2_LOADU
#undef LRU2_CHUNK
        asm volatile("s_waitcnt vmcnt(0)" ::: "memory");
        __syncthreads();
    }
}
}

#define GAS __attribute__((address_space(1)))
#define LAS __attribute__((address_space(3)))
typedef unsigned short bf16;
typedef unsigned v4u __attribute__((ext_vector_type(4)));
typedef float f32x4 __attribute__((ext_vector_type(4)));
typedef short bf16x8 __attribute__((ext_vector_type(8)));
typedef GAS unsigned gu32;
typedef GAS unsigned long long gu64;
#define RLX_AGENT __ATOMIC_RELAXED, __HIP_MEMORY_SCOPE_AGENT
#define LDS_WAIT() asm volatile("s_waitcnt lgkmcnt(0)" ::: "memory")
#define VM_WAIT() asm volatile("s_waitcnt vmcnt(0)" ::: "memory")
__device__ __forceinline__ unsigned long long rt() { return __builtin_amdgcn_s_memrealtime(); }
__device__ __forceinline__ unsigned f2bf(float f) { unsigned u = __builtin_bit_cast(unsigned, f); return (u + 0x7fffu + ((u >> 16) & 1u)) >> 16; }
__device__ __forceinline__ unsigned pk2(float lo, float hi) { return f2bf(lo) | (f2bf(hi) << 16); }

#define XB_TMO      128
#define XB_XCNT(j)  (256  + 64 * (j))
#define XB_XSUB(j)  (1280 + 64 * (j))
#define XB_XGEN(j)  (2304 + 64 * (j))
#define XB_TOP      3328
#define XB_TOPGEN   3392
#define XCD_BAR_WORDS 3456
#define XB_SPIN_CAP (1u << 18)

__device__ __forceinline__ unsigned xb_ld(unsigned* p)              { return __hip_atomic_load(p, __ATOMIC_RELAXED, __HIP_MEMORY_SCOPE_AGENT); }
__device__ __forceinline__ unsigned xb_add(unsigned* p, unsigned v) { return __hip_atomic_fetch_add(p, v, __ATOMIC_RELAXED, __HIP_MEMORY_SCOPE_AGENT); }
__device__ __forceinline__ unsigned xb_xcc_id() { return (unsigned)__builtin_amdgcn_s_getreg((3 << 11) | 20) & 0xFu; }
#define XB_SPIN(cond, bar) do { unsigned _sp = 0; while (cond) { __builtin_amdgcn_s_sleep(1); \
    if ((++_sp & 255u) == 0u) { if (xb_ld(&(bar)[XB_TMO])) break; if (_sp > XB_SPIN_CAP) { atomicAdd(&(bar)[XB_TMO], 1u); break; } } } } while (0)

struct XcdBarrier {
    unsigned* bar; unsigned x;
    volatile LAS unsigned* st;
};

__device__ __forceinline__ XcdBarrier xcd_barrier_post(unsigned* bar, volatile LAS unsigned* st) {
    XcdBarrier b; b.bar = bar; b.x = xb_xcc_id(); b.st = st;
    if (threadIdx.x == 0) (void)xb_add(&bar[XB_XCNT(b.x)], 1u);
    return b;
}
__device__ __forceinline__ void xcd_barrier_complete(unsigned* bar, unsigned x, unsigned& nloc, unsigned& nx) {
    const unsigned G = gridDim.x * gridDim.y * gridDim.z;
    unsigned sum, cnt, mine, sp = 0u;
    for (;;) {
        sum = 0u; cnt = 0u; mine = 0u;
#pragma unroll
        for (unsigned j = 0; j < 16; ++j) { const unsigned c = xb_ld(&bar[XB_XCNT(j)]); sum += c; cnt += (c > 0u) ? 1u : 0u; mine = (j == x) ? c : mine; }
        if (sum == G) break;
        __builtin_amdgcn_s_sleep(1);
        if ((++sp & 255u) == 0u) { if (xb_ld(&bar[XB_TMO])) break; if (sp > XB_SPIN_CAP) { atomicAdd(&bar[XB_TMO], 1u); break; } }
    }
    nloc = mine > 0u ? mine : 1u; nx = cnt > 0u ? cnt : 1u;
}

__device__ __forceinline__ void xcd_barrier(const XcdBarrier& b) {
    asm volatile("s_waitcnt vmcnt(0)" ::: "memory");
    __syncthreads();
    if (threadIdx.x == 0) {
        unsigned* bar = b.bar;
        __builtin_amdgcn_s_waitcnt(0);
        unsigned nloc = b.st[0], nx = b.st[1];
        if (nloc == 0u) { xcd_barrier_complete(bar, b.x, nloc, nx); b.st[0] = nloc; b.st[1] = nx; }
        const unsigned old = xb_add(&bar[XB_XSUB(b.x)], 1u);
        const unsigned gen = old / nloc;
        if (old + 1u == (gen + 1u) * nloc) {
            __builtin_amdgcn_fence(__ATOMIC_RELEASE, "agent");
            asm volatile("s_waitcnt vmcnt(0)" ::: "memory");
            const unsigned og = xb_add(&bar[XB_TOP], 1u);
            const unsigned tg = og / nx;
            if (og + 1u == (tg + 1u) * nx) xb_add(&bar[XB_TOPGEN], 1u);
            else XB_SPIN(xb_ld(&bar[XB_TOPGEN]) == tg, bar);
            __builtin_amdgcn_fence(__ATOMIC_ACQUIRE, "agent");
            xb_add(&bar[XB_XGEN(b.x)], 1u);
            asm volatile("s_waitcnt vmcnt(0)" ::: "memory");
        } else {
            XB_SPIN(xb_ld(&bar[XB_XGEN(b.x)]) == gen, bar);
            __builtin_amdgcn_fence(__ATOMIC_ACQUIRE, "agent");
            asm volatile("s_waitcnt vmcnt(0)" ::: "memory");
        }
    }
    __syncthreads();
}

constexpr int NWAVES = 8;
#ifndef MK_N_LAUNCHES
#define MK_N_LAUNCHES 1
#endif
#ifndef X1_BF16
#define X1_BF16 (DBG ? 0 : 1)
#endif
#ifndef PHASE_BURN
#define PHASE_BURN -1
#endif
#define BURN_BEGIN() unsigned long long tburn_ = 0; if (PHASE_BURN >= 0) tburn_ = __builtin_amdgcn_s_memrealtime()
#define BURN_END(id) do { if (PHASE_BURN == (id)) { __syncthreads(); const unsigned long long w_ = __builtin_amdgcn_s_memrealtime() - tburn_; const unsigned long long tb_ = __builtin_amdgcn_s_memrealtime(); while (__builtin_amdgcn_s_memrealtime() - tb_ < w_) __builtin_amdgcn_s_sleep(1); __syncthreads(); } } while (0)
#ifndef AO_TOUCH
#define AO_TOUCH 1
#endif
constexpr int PER_PHASE = 10;
constexpr int N_LAUNCHES = MK_N_LAUNCHES;
#ifndef REPEAT_MASK
#define REPEAT_MASK 0
#endif
#ifndef TSTAMP
#define TSTAMP -1
#endif
#ifndef TS_UNIT
#define TS_UNIT 100.0f
#endif
#ifndef FP8_FFN
#define FP8_FFN 0
#endif
constexpr bool F8_IN = (FP8_FFN & 1) != 0, F8_OUT = (FP8_FFN & 2) != 0;
constexpr float W1_SCALE = 32.f, W2_SCALE = 64.f, HID_SCALE = 8.f;
#ifndef ATT_FORCE_FALLBACK
#define ATT_FORCE_FALLBACK 0
#endif
constexpr int DM = 1024, NBATCH = 16, SEQ = 4096, CTXL = 256, MLAT = NBATCH * SEQ, MCTX = NBATCH * CTXL, MALL = MLAT + MCTX, INW = 2560, FH = 2816;
constexpr float LN_EPS = 1e-6f, DN_ALPHA = 1.189207115002721f;
constexpr size_t MiB = 1u << 20;
constexpr size_t WS_CTL = 0, CTL_ZERO_BYTES = 64 * 1024;
constexpr size_t WS_MOD = 1 * MiB, WS_ROPEC = WS_MOD + 512 * 1024, WS_ROPES = WS_ROPEC + 4096, WS_SP8 = WS_ROPES + 4096, WS_LAM = WS_SP8 + 4096;
constexpr size_t WS_WIN = 2 * MiB, WS_WOUT = 8 * MiB, WS_W1 = 10 * MiB, WS_W2 = 21 * MiB, WS_WG = 27 * MiB, WS_SUM = 28 * MiB;
constexpr size_t WS_XN = 40 * MiB, WS_Q = 176 * MiB, WS_K = 240 * MiB, WS_V = 308 * MiB, WS_U = 376 * MiB, WS_G = 444 * MiB, WS_AO = 508 * MiB;
constexpr size_t WS_Y = (DBG ? 704 : 176) * MiB, WS_HID = 176 * MiB, WS_F = 528 * MiB, WS_VT8 = 636 * MiB, WS_PARK = 670 * MiB, WS_HS = 704 * MiB, WS_Q8 = 832 * MiB, WS_K8 = 864 * MiB, WS_END = (DBG ? 832 : 900) * MiB;
static_assert(WS_SUM + (size_t)16 * 68 * 2 * 512 * 8 <= WS_XN && WS_XN + (size_t)MALL * DM * 2 <= WS_Q && WS_HID + (size_t)MLAT * FH * 2 <= WS_F, "d_ws map");
constexpr int CW_BAR = 1024;
constexpr int RING_BYTES = 131072, LDSCTL_OFF = RING_BYTES, MISC_OFF = LDSCTL_OFF + 320, ROPE_OFF = RING_BYTES + 1024, LDS_BYTES = 147456;
static_assert(att::LDS_END <= RING_BYTES && lru2::LDS_END <= RING_BYTES, "LDS map");

struct Frame {
    LAS unsigned char* lds; volatile LAS unsigned* MISC; gu32* ctl;
    int tid, lane, wave, vcu, G;
};
__device__ __forceinline__ float wave_sum(float v) {
#pragma unroll
    for (int o = 1; o < 64; o <<= 1) v += __shfl_xor(v, o);
    return v;
}
template <class DEST>
__device__ __forceinline__ void p0_transpose_item(const float* W, int K, int N, bf16* WT, LAS float* scr, int item, int lane, DEST dest) {
    const int nblk = N / 32, kb = item / nblk, nb = item % nblk, k0 = 64 * kb, n0 = 32 * nb;
#pragma unroll 8
    for (int i = 0; i < 32; ++i) { const int kk = 2 * i + (lane >> 5); scr[kk * 33 + (lane & 31)] = W[(size_t)(k0 + kk) * N + n0 + (lane & 31)]; }
    LDS_WAIT(); asm volatile("" ::: "memory");
    const int c = lane & 7;
#pragma unroll
    for (int j = 0; j < 4; ++j) { const int n = (lane >> 3) + 8 * j; const LAS float* s = scr + (8 * c) * 33 + n;
        v4u o; o.x = pk2(s[0 * 33], s[1 * 33]); o.y = pk2(s[2 * 33], s[3 * 33]); o.z = pk2(s[4 * 33], s[5 * 33]); o.w = pk2(s[6 * 33], s[7 * 33]);
        *(GAS v4u*)(WT + (size_t)dest(n0 + n) * K + k0 + 8 * c) = o; }
    LDS_WAIT(); asm volatile("" ::: "memory");
}
template <class DEST>
__device__ __forceinline__ void p0_transpose_item8(const float* W, int K, int N, unsigned char* WT, LAS float* scr, int item, int lane, DEST dest, float scale) {
    const int nblk = N / 32, kb = item / nblk, nb = item % nblk, k0 = 64 * kb, n0 = 32 * nb;
#pragma unroll 8
    for (int i = 0; i < 32; ++i) { const int kk = 2 * i + (lane >> 5); scr[kk * 33 + (lane & 31)] = W[(size_t)(k0 + kk) * N + n0 + (lane & 31)] * scale; }
    LDS_WAIT(); asm volatile("" ::: "memory");
    const int c = lane & 7; typedef unsigned u32x2v __attribute__((ext_vector_type(2)));
#pragma unroll
    for (int j = 0; j < 4; ++j) { const int n = (lane >> 3) + 8 * j; const LAS float* s = scr + (8 * c) * 33 + n;
        u32x2v o; o.x = pg8::pk_fp8x4(s[0 * 33], s[1 * 33], s[2 * 33], s[3 * 33]); o.y = pg8::pk_fp8x4(s[4 * 33], s[5 * 33], s[6 * 33], s[7 * 33]);
        *(GAS u32x2v*)(WT + (size_t)dest(n0 + n) * K + k0 + 8 * c) = o; }
    LDS_WAIT(); asm volatile("" ::: "memory");
}
struct DestId { __device__ __forceinline__ int operator()(int n) const { return n; } };
struct DestWin { __device__ __forceinline__ int operator()(int n) const {
    if (n >= 1536) return n - 512; if (n >= 1024) return n + 1024; const int d = n & 63; return (n & ~63) + (d & 32) + ((d >> 2) & 3) * 8 + ((d >> 4) & 1) * 4 + (d & 3); } };
struct DestW1 { __device__ __forceinline__ int operator()(int n) const { const int hb = n >= FH, l = hb ? n - FH : n; return (l >> 7) * 256 + hb * 128 + (l & 127); } };

__device__ __forceinline__ void p0_mod_task(int cgp, const float* c, const float* cctx, const float* w_ada, const float* b_ada, float* MOD, LAS unsigned char* lds, int tid, int wave, int lane) {
    LAS float* sc = (LAS float*)lds; LAS float* red = (LAS float*)(lds + 81920);
    for (int idx = tid; idx < 17 * 1024; idx += 512) { const int r = idx >> 10, k = idx & 1023; const float v = r < 16 ? c[r * 1024 + k] : cctx[k]; sc[k * 20 + r] = v / (1.f + __expf(-v)); }
    __syncthreads();
    float acc[17];
#pragma unroll
    for (int r = 0; r < 17; ++r) acc[r] = 0.f;
    const int n = 64 * cgp + lane;
#pragma unroll 16
    for (int kk = 0; kk < 128; ++kk) { const int k = wave * 128 + kk; const float wv = __builtin_nontemporal_load(w_ada + (size_t)k * 6144 + n);
        const LAS f32x4* sp = (const LAS f32x4*)(sc + k * 20); const f32x4 s0 = sp[0], s1 = sp[1], s2 = sp[2], s3 = sp[3]; const float s16 = sc[k * 20 + 16];
        acc[0] += s0.x * wv; acc[1] += s0.y * wv; acc[2] += s0.z * wv; acc[3] += s0.w * wv; acc[4] += s1.x * wv; acc[5] += s1.y * wv; acc[6] += s1.z * wv; acc[7] += s1.w * wv;
        acc[8] += s2.x * wv; acc[9] += s2.y * wv; acc[10] += s2.z * wv; acc[11] += s2.w * wv; acc[12] += s3.x * wv; acc[13] += s3.y * wv; acc[14] += s3.z * wv; acc[15] += s3.w * wv; acc[16] += s16 * wv; }
#pragma unroll
    for (int r = 0; r < 17; ++r) red[(wave * 17 + r) * 64 + lane] = acc[r];
    __syncthreads();
    for (int idx = tid; idx < 17 * 64; idx += 512) { const int r = idx >> 6, l = idx & 63; float s = b_ada[64 * cgp + l];
#pragma unroll
        for (int w2 = 0; w2 < 8; ++w2) s += red[(w2 * 17 + r) * 64 + l];
        MOD[r * 6144 + 64 * cgp + l] = s; }
    __syncthreads();
}
__device__ __forceinline__ void ln_stats(f32x4 (&v)[4], float& mean, float& rstd) {
    float s = 0.f;
#pragma unroll
    for (int j = 0; j < 4; ++j) s += (v[j].x + v[j].y) + (v[j].z + v[j].w);
    mean = wave_sum(s) * (1.f / DM); float s2 = 0.f;
#pragma unroll
    for (int j = 0; j < 4; ++j) { v[j] = v[j] - mean; s2 += (v[j].x * v[j].x + v[j].y * v[j].y) + (v[j].z * v[j].z + v[j].w * v[j].w); }
    rstd = 1.f / sqrtf(wave_sum(s2) * (1.f / DM) + LN_EPS);
}
__device__ __forceinline__ void st_bf16x4(bf16* p, f32x4 v) { *(GAS unsigned long long*)p = (unsigned long long)pk2(v.x, v.y) | ((unsigned long long)pk2(v.z, v.w) << 32); }
__device__ __forceinline__ f32x4 ld_bf16x4(const bf16* p) { const unsigned long long w = *(const GAS unsigned long long*)p; const unsigned lo = (unsigned)w, hi = (unsigned)(w >> 32);
    return (f32x4){__uint_as_float(lo << 16), __uint_as_float(lo & 0xffff0000u), __uint_as_float(hi << 16), __uint_as_float(hi & 0xffff0000u)}; }
__device__ __forceinline__ void ln_stats2(f32x4 (&v)[2][4], float (&mean)[2], float (&rstd)[2]) {
    float s[2];
#pragma unroll
    for (int q = 0; q < 2; ++q) { s[q] = 0.f;
#pragma unroll
        for (int j = 0; j < 4; ++j) s[q] += (v[q][j].x + v[q][j].y) + (v[q][j].z + v[q][j].w); }
#pragma unroll
    for (int o = 1; o < 64; o <<= 1) { s[0] += __shfl_xor(s[0], o); s[1] += __shfl_xor(s[1], o); }
    float s2[2];
#pragma unroll
    for (int q = 0; q < 2; ++q) { mean[q] = s[q] * (1.f / DM); s2[q] = 0.f;
#pragma unroll
        for (int j = 0; j < 4; ++j) { v[q][j] = v[q][j] - mean[q]; s2[q] += (v[q][j].x * v[q][j].x + v[q][j].y * v[q][j].y) + (v[q][j].z * v[q][j].z + v[q][j].w * v[q][j].w); } }
#pragma unroll
    for (int o = 1; o < 64; o <<= 1) { s2[0] += __shfl_xor(s2[0], o); s2[1] += __shfl_xor(s2[1], o); }
#pragma unroll
    for (int q = 0; q < 2; ++q) rstd[q] = 1.f / sqrtf(s2[q] * (1.f / DM) + LN_EPS);
}
__device__ __forceinline__ void row_hmod2(const float* const (&xrow)[2], const float* const (&md)[2], bf16* const (&orow)[2], int lane) {
    f32x4 v[2][4]; float mean[2], rstd[2];
#pragma unroll
    for (int q = 0; q < 2; ++q)
#pragma unroll
        for (int j = 0; j < 4; ++j) v[q][j] = __builtin_nontemporal_load((const GAS f32x4*)(xrow[q] + 4 * lane + 256 * j));
    ln_stats2(v, mean, rstd);
#pragma unroll
    for (int q = 0; q < 2; ++q)
#pragma unroll
        for (int j = 0; j < 4; ++j) { const int c = 4 * lane + 256 * j; const f32x4 a = *(const f32x4*)(md[q] + 1024 + c), s = *(const f32x4*)(md[q] + c); st_bf16x4(orow[q] + c, v[q][j] * rstd[q] * (a + 1.f) + s); }
}
__device__ __forceinline__ void row_ln1_2(const float* const (&xrow)[2], const bf16* const (&yrow)[2], const float* const (&md)[2], const float* lng, const float* lnb, float* const (&x1row)[2], bf16* const (&h2row)[2], int lane) {
    f32x4 v[2][4]; float mean[2], rstd[2];
#pragma unroll
    for (int q = 0; q < 2; ++q)
#pragma unroll
        for (int j = 0; j < 4; ++j) { const int c = 4 * lane + 256 * j; v[q][j] = __builtin_nontemporal_load((const GAS f32x4*)(xrow[q] + c)) * DN_ALPHA + *(const f32x4*)(md[q] + 2048 + c) * ld_bf16x4(yrow[q] + c); }
    ln_stats2(v, mean, rstd);
#pragma unroll
    for (int q = 0; q < 2; ++q)
#pragma unroll
        for (int j = 0; j < 4; ++j) { const int c = 4 * lane + 256 * j; v[q][j] = v[q][j] * rstd[q] * *(const f32x4*)(lng + c) + *(const f32x4*)(lnb + c); *(GAS f32x4*)(x1row[q] + c) = v[q][j]; }
    ln_stats2(v, mean, rstd);
#pragma unroll
    for (int q = 0; q < 2; ++q)
#pragma unroll
        for (int j = 0; j < 4; ++j) { const int c = 4 * lane + 256 * j; const f32x4 hv = v[q][j] * rstd[q] * (*(const f32x4*)(md[q] + 4096 + c) + 1.f) + *(const f32x4*)(md[q] + 3072 + c);
            if (F8_IN) *(GAS unsigned*)((unsigned char*)h2row[q] + c) = pg8::pk_fp8x4(hv.x, hv.y, hv.z, hv.w); else st_bf16x4(h2row[q] + c, hv); }
}
struct Ln1Raw { f32x4 x[2][4]; unsigned long long y[2][4]; };
__device__ __forceinline__ void ln1_load(Ln1Raw& r, const float* x, const bf16* Y, int m, int m2, int lane) {
#pragma unroll
    for (int j = 0; j < 4; ++j) { const int c = 4 * lane + 256 * j;
        r.x[0][j] = __builtin_nontemporal_load((const GAS f32x4*)(x + (size_t)m * DM + c)); r.x[1][j] = __builtin_nontemporal_load((const GAS f32x4*)(x + (size_t)m2 * DM + c));
        r.y[0][j] = *(const GAS unsigned long long*)(Y + (size_t)m * DM + c); r.y[1][j] = *(const GAS unsigned long long*)(Y + (size_t)m2 * DM + c); }
}
__device__ __forceinline__ f32x4 bf16x4_to_f32(unsigned long long w) { const unsigned lo = (unsigned)w, hi = (unsigned)(w >> 32);
    return (f32x4){__uint_as_float(lo << 16), __uint_as_float(lo & 0xffff0000u), __uint_as_float(hi << 16), __uint_as_float(hi & 0xffff0000u)}; }
__device__ __forceinline__ void ln1_process(const Ln1Raw& r, const float* const (&md)[2], const float* lng, const float* lnb, float* const (&x1row)[2], bf16* const (&h2row)[2], int lane) {
    f32x4 v[2][4]; float mean[2], rstd[2];
#pragma unroll
    for (int q = 0; q < 2; ++q)
#pragma unroll
        for (int j = 0; j < 4; ++j) { const int c = 4 * lane + 256 * j; v[q][j] = r.x[q][j] * DN_ALPHA + *(const f32x4*)(md[q] + 2048 + c) * bf16x4_to_f32(r.y[q][j]); }
    ln_stats2(v, mean, rstd);
#pragma unroll
    for (int q = 0; q < 2; ++q)
#pragma unroll
        for (int j = 0; j < 4; ++j) { const int c = 4 * lane + 256 * j; v[q][j] = v[q][j] * rstd[q] * *(const f32x4*)(lng + c) + *(const f32x4*)(lnb + c); if (X1_BF16) st_bf16x4((bf16*)x1row[q] + c, v[q][j]); else *(GAS f32x4*)(x1row[q] + c) = v[q][j]; }
    ln_stats2(v, mean, rstd);
#pragma unroll
    for (int q = 0; q < 2; ++q)
#pragma unroll
        for (int j = 0; j < 4; ++j) { const int c = 4 * lane + 256 * j; const f32x4 hv = v[q][j] * rstd[q] * (*(const f32x4*)(md[q] + 4096 + c) + 1.f) + *(const f32x4*)(md[q] + 3072 + c);
            if (F8_IN) *(GAS unsigned*)((unsigned char*)h2row[q] + c) = pg8::pk_fp8x4(hv.x, hv.y, hv.z, hv.w); else st_bf16x4(h2row[q] + c, hv); }
}
__device__ __forceinline__ void row_ln2_2(float* const (&orow)[2], const bf16* const (&x1b)[2], const bf16* const (&frow)[2], const float* const (&md)[2], const float* lng, const float* lnb, int lane) {
    f32x4 v[2][4]; float mean[2], rstd[2];
#pragma unroll
    for (int q = 0; q < 2; ++q)
#pragma unroll
        for (int j = 0; j < 4; ++j) { const int c = 4 * lane + 256 * j; v[q][j] = (X1_BF16 ? ld_bf16x4(x1b[q] + c) : *(const GAS f32x4*)(orow[q] + c)) * DN_ALPHA + *(const f32x4*)(md[q] + 5120 + c) * ld_bf16x4(frow[q] + c); }
    ln_stats2(v, mean, rstd);
#pragma unroll
    for (int q = 0; q < 2; ++q)
#pragma unroll
        for (int j = 0; j < 4; ++j) { const int c = 4 * lane + 256 * j; __builtin_nontemporal_store(v[q][j] * rstd[q] * *(const f32x4*)(lng + c) + *(const f32x4*)(lnb + c), (GAS f32x4*)(orow[q] + c)); }
}

struct Ln2Raw { f32x4 x[2][4]; unsigned long long xb[2][4]; unsigned long long f[2][4]; };
__device__ __forceinline__ void ln2_load(Ln2Raw& r, const float* x1f, const bf16* x1b, const bf16* Fm, int m, int m2, int lane) {
#pragma unroll
    for (int j = 0; j < 4; ++j) { const int c = 4 * lane + 256 * j;
        if (X1_BF16) { r.xb[0][j] = __builtin_nontemporal_load((const GAS unsigned long long*)(x1b + (size_t)m * DM + c)); r.xb[1][j] = __builtin_nontemporal_load((const GAS unsigned long long*)(x1b + (size_t)m2 * DM + c)); }
        else { r.x[0][j] = *(const GAS f32x4*)(x1f + (size_t)m * DM + c); r.x[1][j] = *(const GAS f32x4*)(x1f + (size_t)m2 * DM + c); }
        r.f[0][j] = __builtin_nontemporal_load((const GAS unsigned long long*)(Fm + (size_t)m * DM + c)); r.f[1][j] = __builtin_nontemporal_load((const GAS unsigned long long*)(Fm + (size_t)m2 * DM + c)); }
}
__device__ __forceinline__ void ln2_process(const Ln2Raw& r, float* const (&orow)[2], const float* const (&md)[2], const float* lng, const float* lnb, int lane) {
    f32x4 v[2][4]; float mean[2], rstd[2];
#pragma unroll
    for (int q = 0; q < 2; ++q)
#pragma unroll
        for (int j = 0; j < 4; ++j) { const int c = 4 * lane + 256 * j; v[q][j] = (X1_BF16 ? bf16x4_to_f32(r.xb[q][j]) : r.x[q][j]) * DN_ALPHA + *(const f32x4*)(md[q] + 5120 + c) * bf16x4_to_f32(r.f[q][j]); }
    ln_stats2(v, mean, rstd);
#pragma unroll
    for (int q = 0; q < 2; ++q)
#pragma unroll
        for (int j = 0; j < 4; ++j) { const int c = 4 * lane + 256 * j; __builtin_nontemporal_store(v[q][j] * rstd[q] * *(const f32x4*)(lng + c) + *(const f32x4*)(lnb + c), (GAS f32x4*)(orow[q] + c)); }
}
struct HmRaw { f32x4 x[2][4]; };
__device__ __forceinline__ void hm_load(HmRaw& r, const float* xa, const float* xb, int lane) {
#pragma unroll
    for (int j = 0; j < 4; ++j) { r.x[0][j] = __builtin_nontemporal_load((const GAS f32x4*)(xa + 4 * lane + 256 * j)); r.x[1][j] = __builtin_nontemporal_load((const GAS f32x4*)(xb + 4 * lane + 256 * j)); }
}
__device__ __forceinline__ void hm_process(const HmRaw& r, const float* const (&md)[2], bf16* const (&orow)[2], int lane) {
    f32x4 v[2][4]; float mean[2], rstd[2];
#pragma unroll
    for (int q = 0; q < 2; ++q)
#pragma unroll
        for (int j = 0; j < 4; ++j) v[q][j] = r.x[q][j];
    ln_stats2(v, mean, rstd);
#pragma unroll
    for (int q = 0; q < 2; ++q)
#pragma unroll
        for (int j = 0; j < 4; ++j) { const int c = 4 * lane + 256 * j; const f32x4 a = *(const f32x4*)(md[q] + 1024 + c), s2 = *(const f32x4*)(md[q] + c); st_bf16x4(orow[q] + c, v[q][j] * rstd[q] * (a + 1.f) + s2); }
}
__device__ __forceinline__ void ln1_process_l(const Ln1Raw& r, const LAS f32x4* pv, bf16* const (&x1row)[2], float* const (&x1rowf)[2], bf16* const (&h2row)[2], int lane) {
    f32x4 v[2][4]; float mean[2], rstd[2];
#pragma unroll
    for (int q = 0; q < 2; ++q)
#pragma unroll
        for (int j = 0; j < 4; ++j) v[q][j] = r.x[q][j] * DN_ALPHA + pv[lane + 64 * j] * bf16x4_to_f32(r.y[q][j]);
    ln_stats2(v, mean, rstd);
#pragma unroll
    for (int q = 0; q < 2; ++q)
#pragma unroll
        for (int j = 0; j < 4; ++j) { const int c = 4 * lane + 256 * j; v[q][j] = v[q][j] * rstd[q] * pv[768 + lane + 64 * j] + pv[1024 + lane + 64 * j]; if (X1_BF16) st_bf16x4(x1row[q] + c, v[q][j]); else *(GAS f32x4*)(x1rowf[q] + c) = v[q][j]; }
    ln_stats2(v, mean, rstd);
#pragma unroll
    for (int q = 0; q < 2; ++q)
#pragma unroll
        for (int j = 0; j < 4; ++j) { const int c = 4 * lane + 256 * j; const f32x4 hv = v[q][j] * rstd[q] * (pv[512 + lane + 64 * j] + 1.f) + pv[256 + lane + 64 * j];
            if (F8_IN) *(GAS unsigned*)((unsigned char*)h2row[q] + c) = pg8::pk_fp8x4(hv.x, hv.y, hv.z, hv.w); else st_bf16x4(h2row[q] + c, hv); }
}
__device__ __forceinline__ void ln2_process_l(const Ln2Raw& r, const LAS f32x4* pv, float* const (&orow)[2], int lane) {
    f32x4 v[2][4]; float mean[2], rstd[2];
#pragma unroll
    for (int q = 0; q < 2; ++q)
#pragma unroll
        for (int j = 0; j < 4; ++j) v[q][j] = (X1_BF16 ? bf16x4_to_f32(r.xb[q][j]) : r.x[q][j]) * DN_ALPHA + pv[lane + 64 * j] * bf16x4_to_f32(r.f[q][j]);
    ln_stats2(v, mean, rstd);
#pragma unroll
    for (int q = 0; q < 2; ++q)
#pragma unroll
        for (int j = 0; j < 4; ++j) { const int c = 4 * lane + 256 * j; __builtin_nontemporal_store(v[q][j] * rstd[q] * pv[256 + lane + 64 * j] + pv[512 + lane + 64 * j], (GAS f32x4*)(orow[q] + c)); }
}
__device__ __forceinline__ void hm_process_l(const HmRaw& r, const LAS f32x4* pv, bf16* const (&orow)[2], int lane) {
    f32x4 v[2][4]; float mean[2], rstd[2];
#pragma unroll
    for (int q = 0; q < 2; ++q)
#pragma unroll
        for (int j = 0; j < 4; ++j) v[q][j] = r.x[q][j];
    ln_stats2(v, mean, rstd);
#pragma unroll
    for (int q = 0; q < 2; ++q)
#pragma unroll
        for (int j = 0; j < 4; ++j) { const int c = 4 * lane + 256 * j; st_bf16x4(orow[q] + c, v[q][j] * rstd[q] * (pv[256 + lane + 64 * j] + 1.f) + pv[lane + 64 * j]); }
}
__device__ __forceinline__ void stage_vecs(LAS f32x4* pv, const float* const* src, int nv, int tid) {
    for (int i = tid; i < nv * 256; i += NWAVES * 64) pv[i] = *(const f32x4*)(src[i >> 8] + 4 * (i & 255));
    __syncthreads();
}
struct Args { const float* in[22]; float* out; unsigned char* ws; int ph_lo, ph_hi, li, pad; };
__global__ void __launch_bounds__(NWAVES * 64, 2) mk_fwd(Args args) {
    extern __shared__ __attribute__((aligned(16))) unsigned char lds[];
    Frame F;
    F.lds = (LAS unsigned char*)lds; F.MISC = (volatile LAS unsigned*)(F.lds + MISC_OFF);
    F.tid = threadIdx.x; F.lane = F.tid & 63; F.wave = __builtin_amdgcn_readfirstlane(F.tid >> 6);
    F.G = gridDim.x; { const int bx = blockIdx.x; F.vcu = (F.G % 8 == 0) ? (bx % 8) * (F.G / 8) + bx / 8 : bx; }
    unsigned char* ws = args.ws;
    F.ctl = (gu32*)(ws + WS_CTL);
    const float* x = args.in[0]; const float* cin = args.in[1]; const float* ctx = args.in[2]; const float* cctx = args.in[3];
    float* MOD = (float*)(ws + WS_MOD); float* ROPEC = (float*)(ws + WS_ROPEC); float* ROPES = (float*)(ws + WS_ROPES); float* SP8 = (float*)(ws + WS_SP8); float* LAMP = (float*)(ws + WS_LAM);
    bf16* WinT = (bf16*)(ws + WS_WIN); bf16* WoutT = (bf16*)(ws + WS_WOUT); bf16* W1T = (bf16*)(ws + WS_W1); bf16* W2T = (bf16*)(ws + WS_W2); bf16* WgT = (bf16*)(ws + WS_WG);
        bf16* XN = (bf16*)(ws + WS_XN); bf16* Qb = (bf16*)(ws + WS_Q); bf16* Kb = (bf16*)(ws + WS_K); bf16* Vb = (bf16*)(ws + WS_V); bf16* Ub = (bf16*)(ws + WS_U); bf16* Gb = (bf16*)(ws + WS_G);
    bf16* AO = (bf16*)(ws + WS_AO); bf16* Yb = (bf16*)(ws + WS_Y); bf16* HID = (bf16*)(ws + WS_HID); bf16* Fb = (bf16*)(ws + WS_F); bf16* X1B = (bf16*)(ws + WS_HS);
    for (int u = F.tid; u < (LDS_BYTES - LDSCTL_OFF) / 4; u += NWAVES * 64) ((LAS unsigned*)(F.lds + LDSCTL_OFF))[u] = 0u;
    __syncthreads();
    XcdBarrier bar; bar.bar = (unsigned*)(F.ctl + CW_BAR); bar.x = 0; bar.st = nullptr;
    if (N_LAUNCHES != PER_PHASE) bar = xcd_barrier_post((unsigned*)(F.ctl + CW_BAR), F.MISC + 8);
#define GRID_BAR() do { if (N_LAUNCHES != PER_PHASE) xcd_barrier(bar); } while (0)
    const int lo = args.ph_lo, hi = args.ph_hi;
#define IN(k) (lo <= (k) && (k) < hi)
#define BOTH(k) (IN(k) && IN((k) + 1))
    const int gw = F.vcu * NWAVES + F.wave, NGW = F.G * NWAVES;
    unsigned long long* TS = (unsigned long long*)(ws + WS_CTL + 40960);
#define STAMP(k) do { if (TSTAMP >= 0 && blockIdx.x == 0 && F.tid == 0) TS[k] = __builtin_amdgcn_s_memrealtime(); } while (0)
    STAMP(0);

    if (IN(0)) {
        for (int rep_ = 0; rep_ < 1 + ((REPEAT_MASK >> 0) & 1); ++rep_) {
        if ((int)blockIdx.x < 96) p0_mod_task((int)blockIdx.x, cin, cctx, args.in[4], args.in[5], MOD, F.lds, F.tid, F.wave, F.lane);
        if ((int)blockIdx.x == F.G - 1) {
            for (int i = F.tid; i < 1024; i += 512) { const int pos = i >> 4, f = i & 15; const float inv = powf(10000.f, -(float)f / 16.f); const float ang = (float)pos * inv; ROPEC[i] = cosf(ang); ROPES[i] = sinf(ang); }
            for (int i = F.tid; i < 1024; i += 512) { const float l = args.in[14][i]; const float sp = log1pf(expf(-fabsf(l))) + fmaxf(-l, 0.f); SP8[i] = 8.f * sp * 1.4426950408889634f; }
            if (F.tid == 0) { float a = 0.f, b2 = 0.f; for (int i = 0; i < 64; ++i) { a += args.in[7][i] * args.in[8][i]; b2 += args.in[7][64 + i] * args.in[8][64 + i]; } LAMP[0] = expf(a) - expf(b2) + 0.2f; }
        }
        LAS float* scr = (LAS float*)(F.lds + F.wave * 16384);
        constexpr int I_IN = (DM / 64) * (INW / 32), I_OUT = (DM / 64) * (DM / 32), I_1 = (DM / 64) * (2 * FH / 32), I_2 = (FH / 64) * (DM / 32), I_G = 32 * 2;
        constexpr int NITEMS = I_IN + I_OUT + I_1 + I_2 + I_G;
        const bool modwg = (int)blockIdx.x < 96 && F.G > 96;
        const int gw0 = modwg ? NITEMS : ((F.G > 96 ? (int)blockIdx.x - 96 : (int)blockIdx.x) * NWAVES + F.wave), ngw0 = (F.G > 96 ? F.G - 96 : F.G) * NWAVES;
        for (int it = gw0; it < NITEMS; it += ngw0) {
            int r = it;
            if (r < I_IN) { p0_transpose_item(args.in[6], DM, INW, WinT, scr, r, F.lane, DestWin{}); continue; } r -= I_IN;
            if (r < I_OUT) { p0_transpose_item(args.in[15], DM, DM, WoutT, scr, r, F.lane, DestId{}); continue; } r -= I_OUT;
            if (r < I_1) { if (F8_IN) p0_transpose_item8(args.in[18], DM, 2 * FH, (unsigned char*)W1T, scr, r, F.lane, DestW1{}, W1_SCALE); else p0_transpose_item(args.in[18], DM, 2 * FH, W1T, scr, r, F.lane, DestW1{}); continue; } r -= I_1;
            if (r < I_2) { if (F8_OUT) p0_transpose_item8(args.in[19], FH, DM, (unsigned char*)W2T, scr, r, F.lane, DestId{}, W2_SCALE); else p0_transpose_item(args.in[19], FH, DM, W2T, scr, r, F.lane, DestId{}); continue; } r -= I_2;
            { const int mat = r >> 1; p0_transpose_item(args.in[12] + (size_t)mat * 4096, 64, 64, WgT + (size_t)mat * 4096, scr, r & 1, F.lane, DestId{}); }
        }
        }
        if (BOTH(0)) GRID_BAR();
        STAMP(1);
    }
    if (IN(1)) { BURN_BEGIN();
        for (int rep_ = 0; rep_ < 1 + ((REPEAT_MASK >> 1) & 1); ++rep_) {
#define P1_XROW(mm) ((mm) < MLAT ? x + (size_t)(mm) * DM : ctx + (size_t)((mm) - MLAT) * DM)
        if (F.G == 256) {
            const int bq = gw >> 7, r0 = gw & 127; const float* mdp = MOD + bq * 6144;
            LAS f32x4* pv = (LAS f32x4*)F.lds; { const float* const src[2] = {mdp, mdp + 1024}; stage_vecs(pv, src, 2, F.tid); }
#define P1_ROW(k_) (bq * 4096 + r0 + 128 * (k_))
            { HmRaw cur; hm_load(cur, x + (size_t)P1_ROW(0) * DM, x + (size_t)P1_ROW(1) * DM, F.lane);
              for (int k = 0; k < 32; k += 2) { const int m = P1_ROW(k), m2 = P1_ROW(k + 1);
                HmRaw nxt; if (k + 2 < 32) hm_load(nxt, x + (size_t)P1_ROW(k + 2) * DM, x + (size_t)P1_ROW(k + 3) * DM, F.lane);
                bf16* const orow[2] = {XN + (size_t)m * DM, XN + (size_t)m2 * DM};
                hm_process_l(cur, pv, orow, F.lane);
                if (k + 2 < 32) cur = nxt; } }
#undef P1_ROW
            { const int m = MLAT + gw, m2 = m + NGW;
              HmRaw cur; hm_load(cur, P1_XROW(m), P1_XROW(m2), F.lane);
              const float* const md[2] = {MOD + 16 * 6144, MOD + 16 * 6144}; bf16* const orow[2] = {XN + (size_t)m * DM, XN + (size_t)m2 * DM};
              hm_process(cur, md, orow, F.lane); }
            __syncthreads();
        } else
        { HmRaw cur; hm_load(cur, P1_XROW(gw), P1_XROW(gw + NGW), F.lane);
          for (int m = gw; m < MALL; m += 2 * NGW) { const int m2 = m + NGW, mn = m + 2 * NGW;
            HmRaw nxt; if (mn < MALL) hm_load(nxt, P1_XROW(mn), P1_XROW(mn + NGW), F.lane);
            const float* const md[2] = {MOD + (m < MLAT ? (m >> 12) : 16) * 6144, MOD + (m2 < MLAT ? (m2 >> 12) : 16) * 6144};
            bf16* const orow[2] = {XN + (size_t)m * DM, XN + (size_t)m2 * DM};
            hm_process(cur, md, orow, F.lane);
            if (mn < MALL) cur = nxt; } }
#undef P1_XROW
        }
        BURN_END(1);
        if (BOTH(1)) GRID_BAR();
        STAMP(2);
    }
    if (IN(2)) { BURN_BEGIN();
        {
        LAS float* ropeL = (LAS float*)(F.lds + ROPE_OFF);
        for (int i = F.tid; i < 2048; i += NWAVES * 64) ropeL[i] = ROPEC[i];
        __syncthreads();
        { pg8::Gemm g{XN, WinT, MALL, INW, DM}; pg8::InProjOrder S; S.init(F.G, (int)blockIdx.x);
          pg8::EpiInProj E{Qb, Kb, Vb, Ub, Gb, (unsigned char*)(ws + WS_VT8), ropeL, ropeL + 1024, (unsigned char*)(ws + WS_Q8), (unsigned char*)(ws + WS_K8)};
          pg8::gemm_phase<pg8::EpiInProj, pg8::InProjOrder, true, true>(F.lds, g, S, E); }
        }
#if (REPEAT_MASK >> 2) & 1
        {
        LAS float* ropeL = (LAS float*)(F.lds + ROPE_OFF);
        for (int i = F.tid; i < 2048; i += NWAVES * 64) ropeL[i] = ROPEC[i];
        __syncthreads();
        { pg8::Gemm g{XN, WinT, MALL, INW, DM}; pg8::InProjOrder S; S.init(F.G, (int)blockIdx.x);
          pg8::EpiInProj E{Qb, Kb, Vb, Ub, Gb, (unsigned char*)(ws + WS_VT8), ropeL, ropeL + 1024, (unsigned char*)(ws + WS_Q8), (unsigned char*)(ws + WS_K8)};
          pg8::gemm_phase<pg8::EpiInProj, pg8::InProjOrder, true, true>(F.lds, g, S, E); }
        }
#endif
        BURN_END(2);
        if (BOTH(2)) GRID_BAR();
        STAMP(3);
    }
    if (IN(3)) {
        for (int rep_ = 0; rep_ < 1 + ((REPEAT_MASK >> 3) & 1); ++rep_) {
#ifndef SKIP_ATT
        { BURN_BEGIN();
        const float lam = LAMP[0]; float* PARK = (float*)(ws + WS_PARK) + (size_t)blockIdx.x * att::PARK_FLOATS;
        const int xg = F.vcu >> 5, vl = F.vcu & 31;
        for (int ra_ = 0; ra_ < 1 + ((REPEAT_MASK >> 9) & 1); ++ra_)
        if (F.G == 256) {
            for (int i = 0; i < 4; ++i) { const int bh = xg * 8 + i * 2 + (vl >> 4), qb = vl & 15;
                att::attn_unit_safe(bh >> 2, bh & 3, qb, (const short*)Qb, (const short*)Kb, (const short*)Vb, (const unsigned char*)(ws + WS_VT8), (const unsigned char*)(ws + WS_Q8), (const unsigned char*)(ws + WS_K8), (short*)AO, args.in[9], lam, PARK, (char*)lds, ATT_FORCE_FALLBACK != 0); }
        } else {
            for (int un = (int)blockIdx.x; un < 1024; un += F.G) { const int bh = un >> 4, qb = un & 15;
                att::attn_unit_safe(bh >> 2, bh & 3, qb, (const short*)Qb, (const short*)Kb, (const short*)Vb, (const unsigned char*)(ws + WS_VT8), (const unsigned char*)(ws + WS_Q8), (const unsigned char*)(ws + WS_K8), (short*)AO, args.in[9], lam, PARK, (char*)lds, ATT_FORCE_FALLBACK != 0); }
        }
        BURN_END(30); }
#endif
#ifndef SKIP_LRU1
        { BURN_BEGIN();
        if (AO_TOUCH && F.G == 256) {
            const unsigned char* tb_ = (const unsigned char*)AO + (size_t)blockIdx.x * (256u * 2048u);
            unsigned tt_ = (unsigned)F.tid; asm volatile("" : "+v"(tt_));
            const unsigned to_ = (tt_ >> 3) * 2048u + (tt_ & 7u) * 128u;
            const unsigned t0_ = *(const GAS unsigned*)(tb_ + to_), t1_ = *(const GAS unsigned*)(tb_ + to_ + 64u * 2048u), t2_ = *(const GAS unsigned*)(tb_ + to_ + 128u * 2048u), t3_ = *(const GAS unsigned*)(tb_ + to_ + 192u * 2048u);
            asm volatile("" :: "v"(t0_), "v"(t1_), "v"(t2_), "v"(t3_));
        }
        for (int rl_ = 0; rl_ < 1 + ((REPEAT_MASK >> 10) & 1); ++rl_)
        for (int un = F.vcu; un < 256; un += F.G)
            lru2::lru_unit(un >> 4, (un >> 1) & 7, un & 1, Ub, Gb, args.in[10], args.in[11], WgT, args.in[13], SP8, (float*)(ws + WS_HS), AO, F.lds);
        BURN_END(31); }
#endif
        }
        if (BOTH(3)) GRID_BAR();
        STAMP(4);
    }
    if (IN(4)) { STAMP(5); }
    if (IN(5)) { BURN_BEGIN();
        {
        pg8::Gemm g{AO, WoutT, MLAT, DM, DM}; pg8::StaticOrder S; S.init(MLAT, DM, F.G, (int)blockIdx.x);
        pg8::EpiPlain E{Yb, DM, 1.f};
        pg8::gemm_phase<pg8::EpiPlain, pg8::StaticOrder, true, true>(F.lds, g, S, E);
        }
#if (REPEAT_MASK >> 5) & 1
        {
        pg8::Gemm g{AO, WoutT, MLAT, DM, DM}; pg8::StaticOrder S; S.init(MLAT, DM, F.G, (int)blockIdx.x);
        pg8::EpiPlain E{Yb, DM, 1.f};
        pg8::gemm_phase<pg8::EpiPlain, pg8::StaticOrder, true, true>(F.lds, g, S, E);
        }
#endif
        BURN_END(5);
        if (BOTH(5)) GRID_BAR();
        STAMP(6);
    }
    if (IN(6)) { BURN_BEGIN();
        for (int rep_ = 0; rep_ < 1 + ((REPEAT_MASK >> 6) & 1); ++rep_) {
        if (F.G == 256) {
            const int bq = gw >> 7, r0 = gw & 127; const float* mdp = MOD + bq * 6144;
            LAS f32x4* pv = (LAS f32x4*)F.lds; { const float* const src[5] = {mdp + 2048, mdp + 3072, mdp + 4096, args.in[16], args.in[17]}; stage_vecs(pv, src, 5, F.tid); }
#define P6_ROW(k_) (bq * 4096 + r0 + 128 * (k_))
            { Ln1Raw cur; ln1_load(cur, x, Yb, P6_ROW(0), P6_ROW(1), F.lane);
              for (int k = 0; k < 32; k += 2) { const int m = P6_ROW(k), m2 = P6_ROW(k + 1);
                Ln1Raw nxt; if (k + 2 < 32) ln1_load(nxt, x, Yb, P6_ROW(k + 2), P6_ROW(k + 3), F.lane);
                bf16* const x1r[2] = {X1B + (size_t)m * DM, X1B + (size_t)m2 * DM}; float* const x1f[2] = {args.out + (size_t)m * DM, args.out + (size_t)m2 * DM};
                bf16* const h2r[2] = {F8_IN ? (bf16*)((unsigned char*)XN + (size_t)m * DM) : XN + (size_t)m * DM, F8_IN ? (bf16*)((unsigned char*)XN + (size_t)m2 * DM) : XN + (size_t)m2 * DM};
                ln1_process_l(cur, pv, x1r, x1f, h2r, F.lane);
                if (k + 2 < 32) cur = nxt; } }
#undef P6_ROW
            __syncthreads();
        } else
        { Ln1Raw cur; ln1_load(cur, x, Yb, gw, gw + NGW, F.lane);
          for (int m = gw; m < MLAT; m += 2 * NGW) { const int m2 = m + NGW, mn = m + 2 * NGW;
            Ln1Raw nxt; if (mn < MLAT) ln1_load(nxt, x, Yb, mn, mn + NGW, F.lane);
            const float* const md[2] = {MOD + (m >> 12) * 6144, MOD + (m2 >> 12) * 6144};
            float* const x1r[2] = {X1_BF16 ? (float*)(X1B + (size_t)m * DM) : args.out + (size_t)m * DM, X1_BF16 ? (float*)(X1B + (size_t)m2 * DM) : args.out + (size_t)m2 * DM};
            bf16* const h2r[2] = {F8_IN ? (bf16*)((unsigned char*)XN + (size_t)m * DM) : XN + (size_t)m * DM, F8_IN ? (bf16*)((unsigned char*)XN + (size_t)m2 * DM) : XN + (size_t)m2 * DM};
            ln1_process(cur, md, args.in[16], args.in[17], x1r, h2r, F.lane);
            if (mn < MLAT) cur = nxt; } }
        }
        BURN_END(6);
        if (BOTH(6)) GRID_BAR();
        STAMP(7);
    }
    if (IN(7)) { BURN_BEGIN();
        {
        pg8::Gemm g{XN, W1T, MLAT, 2 * FH, F8_IN ? DM / 2 : DM}; pg8::StaticOrder S; S.init(MLAT, 2 * FH, F.G, (int)blockIdx.x);
        pg8::EpiSwiglu<F8_OUT> E{HID, FH, F8_IN ? 1.f / W1_SCALE : 1.f, F8_OUT ? HID_SCALE : 1.f};
        pg8::gemm_phase<pg8::EpiSwiglu<F8_OUT>, pg8::StaticOrder, true, true, F8_IN>(F.lds, g, S, E);
        }
#if (REPEAT_MASK >> 7) & 1
        {
        pg8::Gemm g{XN, W1T, MLAT, 2 * FH, F8_IN ? DM / 2 : DM}; pg8::StaticOrder S; S.init(MLAT, 2 * FH, F.G, (int)blockIdx.x);
        pg8::EpiSwiglu<F8_OUT> E{HID, FH, F8_IN ? 1.f / W1_SCALE : 1.f, F8_OUT ? HID_SCALE : 1.f};
        pg8::gemm_phase<pg8::EpiSwiglu<F8_OUT>, pg8::StaticOrder, true, true, F8_IN>(F.lds, g, S, E);
        }
#endif
        BURN_END(7);
        if (BOTH(7)) GRID_BAR();
        STAMP(8);
    }
    if (IN(8)) { BURN_BEGIN();
        {
        pg8::Gemm g{HID, W2T, MLAT, DM, F8_OUT ? FH / 2 : FH}; pg8::StaticOrder S; S.init(MLAT, DM, F.G, (int)blockIdx.x);
        pg8::EpiPlain E{Fb, DM, F8_OUT ? 1.f / (W2_SCALE * HID_SCALE) : 1.f};
        pg8::gemm_phase<pg8::EpiPlain, pg8::StaticOrder, true, true, F8_OUT>(F.lds, g, S, E);
        }
#if (REPEAT_MASK >> 8) & 1
        {
        pg8::Gemm g{HID, W2T, MLAT, DM, F8_OUT ? FH / 2 : FH}; pg8::StaticOrder S; S.init(MLAT, DM, F.G, (int)blockIdx.x);
        pg8::EpiPlain E{Fb, DM, F8_OUT ? 1.f / (W2_SCALE * HID_SCALE) : 1.f};
        pg8::gemm_phase<pg8::EpiPlain, pg8::StaticOrder, true, true, F8_OUT>(F.lds, g, S, E);
        }
#endif
        BURN_END(8);
        if (BOTH(8)) GRID_BAR();
        STAMP(9);
    }
    if (IN(9)) { BURN_BEGIN();
        if (F.G == 256) {
            const int bq = gw >> 7, r0 = gw & 127; const float* mdp = MOD + bq * 6144;
            LAS f32x4* pv = (LAS f32x4*)F.lds; { const float* const src[3] = {mdp + 5120, args.in[20], args.in[21]}; stage_vecs(pv, src, 3, F.tid); }
#define P9_ROW(k_) (bq * 4096 + r0 + 128 * (k_))
            { Ln2Raw cur; ln2_load(cur, args.out, X1B, Fb, P9_ROW(0), P9_ROW(1), F.lane);
              for (int k = 0; k < 32; k += 2) { const int m = P9_ROW(k), m2 = P9_ROW(k + 1);
                Ln2Raw nxt; if (k + 2 < 32) ln2_load(nxt, args.out, X1B, Fb, P9_ROW(k + 2), P9_ROW(k + 3), F.lane);
                float* const orow[2] = {args.out + (size_t)m * DM, args.out + (size_t)m2 * DM};
                ln2_process_l(cur, pv, orow, F.lane);
                if (k + 2 < 32) cur = nxt; } }
#undef P9_ROW
        } else
        { Ln2Raw cur; ln2_load(cur, args.out, X1B, Fb, gw, gw + NGW, F.lane);
          for (int m = gw; m < MLAT; m += 2 * NGW) { const int m2 = m + NGW, mn = m + 2 * NGW;
            Ln2Raw nxt; if (mn < MLAT) ln2_load(nxt, args.out, X1B, Fb, mn, mn + NGW, F.lane);
            float* const orow[2] = {args.out + (size_t)m * DM, args.out + (size_t)m2 * DM};
            const float* const md[2] = {MOD + (m >> 12) * 6144, MOD + (m2 >> 12) * 6144};
            ln2_process(cur, orow, md, args.in[20], args.in[21], F.lane);
            if (mn < MLAT) cur = nxt; } }
        BURN_END(9);
        STAMP(10);
        if (TSTAMP >= 0) {
            asm volatile("s_waitcnt vmcnt(0)" ::: "memory"); GRID_BAR();
            const unsigned long long t0 = __hip_atomic_load(TS + TSTAMP, __ATOMIC_RELAXED, __HIP_MEMORY_SCOPE_AGENT), t1 = __hip_atomic_load(TS + TSTAMP + 1, __ATOMIC_RELAXED, __HIP_MEMORY_SCOPE_AGENT);
            const float v = (float)(t1 - t0) * 0.01f / (TS_UNIT);
            for (int m = gw; m < MLAT; m += NGW) { GAS f32x4* o = (GAS f32x4*)(args.out + (size_t)m * DM) + F.lane;
#pragma unroll
                for (int j = 0; j < 4; ++j) o[64 * j] = (f32x4){v, v, v, v}; }
        }
    }
#undef IN
#undef BOTH
#undef GRID_BAR
}

#ifndef DBG
#define DBG 0
#endif
#if DBG
constexpr size_t WS_DBGTAB = 32 * 1024, WS_NAIVE = 832 * MiB;
static void dbg_run(void* const* d_in, float* out, unsigned char* ws, hipStream_t st) {
    float* tab = (float*)(ws + WS_DBGTAB);
    nv::Bufs B = nv::carve((char*)ws + WS_NAIVE);
    nv::run_common(d_in, B, st);
    dbg::cmp(st, tab, 1, ws + WS_MOD, 0, 0, 6144, 0, 0, 1.f, B.mod, 0, 6144, 0, 17, 6144);
    using namespace nv;
    for (int b = 0; b < 16; ++b) {
        const float* x = (const float*)d_in[0] + (size_t)b * S * D; const float* ctx = (const float*)d_in[2] + (size_t)b * CT * D;
        const float* mod = B.mod + b * 6144; const float* modc = B.mod + 16 * 6144;
        k_lnmod<<<S, 256, 0, st>>>(x, mod + 0, mod + 1024, B.h);
        k_lnmod<<<CT, 256, 0, st>>>(ctx, modc + 0, modc + 1024, B.h + (size_t)S * D);
        dbg::cmp(st, tab, 2, ws + WS_XN, 1, (size_t)65536 + b * 256, 1024, 0, 0, 1.f, B.h, 4096, 1024, 0, 256, 1024);
        k_gemm<<<dim3(nv::INW / 64, T / 64), 256, 0, st>>>(B.h, (const float*)d_in[6], B.p, T, nv::INW, D);
        k_rope<<<S * 512 / 256, 256, 0, st>>>(B.p);
        dbg::k_cmp_vt<<<(4352 * 512 + 255) / 256, 256, 0, st>>>((const unsigned short*)(ws + WS_V), b, B.p, nv::INW, 1024, tab + 2 * 3);
        dbg::cmp(st, tab, 4, ws + WS_U, 1, (size_t)b * 4096, 512, 0, 0, 1.f, B.p, 0, nv::INW, 1536, 4096, 512);
        dbg::cmp(st, tab, 4, ws + WS_U, 1, (size_t)65536 + b * 256, 512, 0, 0, 1.f, B.p, 4096, nv::INW, 1536, 256, 512);
        dbg::cmp(st, tab, 5, ws + WS_G, 1, (size_t)b * 4096, 512, 0, 0, 1.f, B.p, 0, nv::INW, 2048, 4096, 512);
        dbg::cmp(st, tab, 6, ws + WS_K, 1, (size_t)b * 4352 + 4096, 512, 0, 1, 1.f, B.p, 4096, nv::INW, 512, 256, 512);
        dbg::cmp(st, tab, 7, ws + WS_K, 1, (size_t)b * 4352, 512, 0, 1, 1.f, B.p, 0, nv::INW, 512, 4096, 512);
        dbg::cmp(st, tab, 8, ws + WS_Q, 1, (size_t)b * 4096, 512, 0, 1, 1.f / pg8::QK_C2, B.p, 0, nv::INW, 0, 4096, 512);
        k_attn_stats<<<dim3(S / 256, 4), 256, 0, st>>>(B.p, B.stats);
        k_attn_pv<<<dim3(S / 256, 16), 256, 0, st>>>(B.p, B.stats, B.lam, B.o);
        k_headnorm<<<S * 4 / 256, 256, 0, st>>>(B.o, (const float*)d_in[9], B.ao);
        dbg::cmp(st, tab, 9, ws + WS_AO, 1, (size_t)b * 4096, 1024, 0, 0, 1.f, B.ao, 0, 1024, 0, 4096, 512);
        k_conv<<<S * 512 / 256, 256, 0, st>>>(B.p, 0, S, (const float*)d_in[10], (const float*)d_in[11], B.uc);
        k_conv<<<CT * 512 / 256, 256, 0, st>>>(B.p, S, CT, (const float*)d_in[10], (const float*)d_in[11], B.uc);
        k_gates<<<2 * T * 512 / 256, 256, 0, st>>>(B.uc, (const float*)d_in[12], (const float*)d_in[13], (const float*)d_in[14], B.av, B.bv);
        k_scan<<<4, 256, 0, st>>>(B.av, B.bv, B.hs);
        k_ylru<<<S * 512 / 256, 256, 0, st>>>(B.hs, B.p, B.ao);
        dbg::cmp(st, tab, 10, ws + WS_AO, 1, (size_t)b * 4096, 1024, 512, 0, 1.f, B.ao, 0, 1024, 512, 4096, 512);
        k_gemm<<<dim3(D / 64, S / 64), 256, 0, st>>>(B.ao, (const float*)d_in[15], B.y, S, D, D);
        dbg::cmp(st, tab, 11, ws + WS_Y, 1, (size_t)b * 4096, 1024, 0, 0, 1.f, B.y, 0, 1024, 0, 4096, 1024);
        k_lnres<<<S, 256, 0, st>>>(x, B.y, mod + 2048, (const float*)d_in[16], (const float*)d_in[17], B.x1);
        dbg::cmp(st, tab, 12, out, 0, (size_t)b * 4096, 1024, 0, 0, 1.f, B.x1, 0, 1024, 0, 4096, 1024);
        k_lnmod<<<S, 256, 0, st>>>(B.x1, mod + 3072, mod + 4096, B.h2);
        dbg::cmp(st, tab, 13, ws + WS_XN, 1, (size_t)b * 4096, 1024, 0, 0, 1.f, B.h2, 0, 1024, 0, 4096, 1024);
    }
}
#endif
extern "C" void kernel_launch(void* const* d_in, const int* in_sizes, int n_in, void* d_out, int out_size, void* d_ws, size_t ws_size, hipStream_t stream) {
    static int grid = 0;
    if (grid == 0) {
        if (n_in != 22 || out_size != MLAT * DM || ws_size < (DBG ? (size_t)1012 * MiB : WS_END)) { fprintf(stderr, "kernel_launch: unexpected shapes / workspace (n_in %d out %d ws %zu)\n", n_in, out_size, ws_size); grid = -1; return; }
        int dev = 0, cus = 0, per_cu = 0;
        if (hipGetDevice(&dev) != hipSuccess || hipDeviceGetAttribute(&cus, hipDeviceAttributeMultiprocessorCount, dev) != hipSuccess) { grid = -1; return; }
        if (hipFuncSetAttribute((const void*)mk_fwd, hipFuncAttributeMaxDynamicSharedMemorySize, LDS_BYTES) != hipSuccess) { fprintf(stderr, "kernel_launch: hipFuncSetAttribute failed\n"); grid = -1; return; }
        if (hipOccupancyMaxActiveBlocksPerMultiprocessor(&per_cu, (const void*)mk_fwd, NWAVES * 64, LDS_BYTES) != hipSuccess || per_cu < 1) { fprintf(stderr, "kernel_launch: occupancy query says %d blocks/CU; nothing launched\n", per_cu); (void)hipGetLastError(); grid = -1; return; }
        grid = cus;
    }
    if (grid < 0) return;
    (void)hipMemsetAsync((char*)d_ws + WS_CTL, 0, CTL_ZERO_BYTES, stream);
    Args a{};
    for (int i = 0; i < 22; ++i) a.in[i] = (const float*)d_in[i];
    a.out = (float*)d_out; a.ws = (unsigned char*)d_ws;
#if DBG
    if (N_LAUNCHES == PER_PHASE) { for (int li = 0; li < 7; ++li) { a.ph_lo = li; a.ph_hi = li + 1; a.li = 0; hipLaunchKernelGGL(mk_fwd, dim3(grid), dim3(NWAVES * 64), LDS_BYTES, stream, a); } }
    else { a.ph_lo = 0; a.ph_hi = 7; a.li = 0; hipLaunchKernelGGL(mk_fwd, dim3(grid), dim3(NWAVES * 64), LDS_BYTES, stream, a); }
    dbg_run(d_in, (float*)d_out, (unsigned char*)d_ws, stream);
    if (N_LAUNCHES == PER_PHASE) { for (int li = 7; li < PER_PHASE; ++li) { a.ph_lo = li; a.ph_hi = li + 1; a.li = 0; hipLaunchKernelGGL(mk_fwd, dim3(grid), dim3(NWAVES * 64), LDS_BYTES, stream, a); } }
    else { a.ph_lo = 7; a.ph_hi = PER_PHASE; a.li = 1; hipLaunchKernelGGL(mk_fwd, dim3(grid), dim3(NWAVES * 64), LDS_BYTES, stream, a); }
    dbg::k_verdict<<<(unsigned)(((size_t)MLAT * DM + 255) / 256), 256, 0, stream>>>((const float*)((unsigned char*)d_ws + WS_DBGTAB), (float*)d_out, (size_t)MLAT * DM);
#else
    if (N_LAUNCHES == PER_PHASE) { for (int li = 0; li < PER_PHASE; ++li) { a.ph_lo = li; a.ph_hi = li + 1; a.li = 0; hipLaunchKernelGGL(mk_fwd, dim3(grid), dim3(NWAVES * 64), LDS_BYTES, stream, a); } }
    else { a.ph_lo = 0; a.ph_hi = PER_PHASE; a.li = 0; hipLaunchKernelGGL(mk_fwd, dim3(grid), dim3(NWAVES * 64), LDS_BYTES, stream, a); }
#endif
    const hipError_t le = hipPeekAtLastError();
    if (le != hipSuccess) fprintf(stderr, "kernel_launch: launch failed: %s\n", hipGetErrorName(le));
}
```
